# Optimizing an MI355X kernel written in HIP

```python
import jax, jax.numpy as jnp
from jax import lax
import numpy as np

D_MODEL = 1024
BATCH = 2
SEQ = 8192
DEPTH = 1

GRID_W = 64
NA_HEAD_DIM = 64
NA_WIDTH = D_MODEL // 2
NA_HEADS = NA_WIDTH // NA_HEAD_DIM
NA_KH = 8
NA_KW = 16
GLA_HEADS = 4
GLA_VAL_WIDTH = D_MODEL - NA_WIDTH
GLA_DV = GLA_VAL_WIDTH // GLA_HEADS
GLA_DK = GLA_DV // 2
GLA_KEY_WIDTH = GLA_HEADS * GLA_DK
GLA_GATE_RANK = 16
GLA_GATE_NORM = 16.0
GLA_CHUNK = 64
D_MIX = NA_WIDTH + GLA_VAL_WIDTH
D_FF = 4 * D_MODEL
IN_SPLITS = [NA_WIDTH, NA_WIDTH, NA_WIDTH,
             GLA_KEY_WIDTH, GLA_KEY_WIDTH, GLA_VAL_WIDTH, GLA_VAL_WIDTH,
             GLA_GATE_RANK, GLA_GATE_RANK]
D_IN = sum(IN_SPLITS)
EPS = 1e-6

kernel_name = "hybrid_natten_gla_encoder_block"


def rmsnorm(x, g):
    xf = x.astype(jnp.float32)
    y = xf * lax.rsqrt(jnp.mean(xf * xf, axis=-1, keepdims=True) + EPS)
    return (y * g.astype(jnp.float32)).astype(x.dtype)


def neighbourhood_attention(q, k, v, rpb):
    B, T, H, dh = q.shape
    R = T // GRID_W
    W = GRID_W
    KH = min(NA_KH, R)
    KW = NA_KW
    grid = lambda t: t.reshape(B, R, W, H, dh).transpose(0, 3, 1, 2, 4)
    qg, kg, vg = grid(q), grid(k), grid(v)
    rows = jnp.arange(R)
    row_start = jnp.clip(rows - KH // 2, 0, R - KH)
    row_idx = row_start[:, None] + jnp.arange(KH)[None, :]
    k_rows = kg[:, :, row_idx]
    v_rows = vg[:, :, row_idx]
    scores = jnp.einsum('bhrqd,bhrikd->bhrqik', qg, k_rows).astype(jnp.float32)
    scores = scores * (dh ** -0.5)
    dr_idx = row_idx - rows[:, None] + (NA_KH - 1)
    cols = jnp.arange(W)
    dc = cols[None, :] - cols[:, None]
    dc_idx = jnp.clip(dc, -(KW - 1), KW - 1) + (KW - 1)
    bias = rpb.astype(jnp.float32)[:, dr_idx[:, None, :, None], dc_idx[None, :, None, :]]
    col_start = jnp.clip(cols - KW // 2, 0, W - KW)
    in_win = (cols[None, :] >= col_start[:, None]) & (cols[None, :] < col_start[:, None] + KW)
    scores = jnp.where(in_win[None, None, None, :, None, :], scores + bias[None], -jnp.inf)
    p = jax.nn.softmax(scores.reshape(B, H, R, W, KH * W), axis=-1).reshape(B, H, R, W, KH, W)
    out = jnp.einsum('bhrqik,bhrikd->bhrqd', p.astype(v.dtype), v_rows)
    return out.transpose(0, 2, 3, 1, 4).reshape(B, T, H * dh)


def gla_chunked(q, k, v, log_a, strict):
    B, H, T, dk = q.shape
    dv = v.shape[-1]
    C = GLA_CHUNK
    N = T // C
    q = q.reshape(B, H, N, C, dk)
    k = k.reshape(B, H, N, C, dk)
    v = v.reshape(B, H, N, C, dv)
    b = jnp.cumsum(log_a.reshape(B, H, N, C, dk), axis=-2)
    q_dec = q * jnp.exp(b)
    k_inv = k * jnp.exp(-b)
    mask = jnp.tril(jnp.ones((C, C), dtype=bool), k=-1 if strict else 0)
    A = jnp.where(mask, jnp.einsum('bhnid,bhnjd->bhnij', q_dec, k_inv), 0.0)
    o_intra = jnp.einsum('bhnij,bhnje->bhnie', A, v)
    b_last = b[..., -1:, :]
    contrib = jnp.einsum('bhncd,bhnce->bhnde', k * jnp.exp(b_last - b), v)
    decay = jnp.exp(b_last[..., 0, :])

    def step(S, inp):
        g, c = inp
        return g[..., None] * S + c, S

    S0 = jnp.zeros((B, H, dk, dv), dtype=contrib.dtype)
    _, S_prev = lax.scan(step, S0, (jnp.moveaxis(decay, 2, 0), jnp.moveaxis(contrib, 2, 0)))
    S_prev = jnp.moveaxis(S_prev, 0, 2)
    o = o_intra + jnp.einsum('bhncd,bhnde->bhnce', q_dec, S_prev)
    return o.reshape(B, H, T, dv)


def bidirectional_gla(q, k, v, r, z_f, z_b, gu_f, gb_f, gu_b, gb_b, norm_g):
    B, T, _ = q.shape
    bhtd = lambda t, d: t.reshape(B, T, GLA_HEADS, d).transpose(0, 2, 1, 3)
    qh = bhtd(q, GLA_DK) * (GLA_DK ** -0.5)
    kh = bhtd(k, GLA_DK)
    vh = bhtd(v, GLA_DV)
    log_a_f = jax.nn.log_sigmoid((z_f @ gu_f + gb_f).astype(jnp.float32)) / GLA_GATE_NORM
    log_a_b = jax.nn.log_sigmoid((z_b @ gu_b + gb_b).astype(jnp.float32)) / GLA_GATE_NORM
    la_f = bhtd(log_a_f, GLA_DK)
    la_b = bhtd(log_a_b, GLA_DK)
    fwd = gla_chunked(qh, kh, vh, la_f, strict=False)
    flip = lambda t: jnp.flip(t, axis=2)
    bwd = flip(gla_chunked(flip(qh), flip(kh), flip(vh), flip(la_b), strict=True))
    o = (fwd + bwd).astype(v.dtype).transpose(0, 2, 1, 3)
    o = rmsnorm(o, norm_g) * jax.nn.silu(r.reshape(B, T, GLA_HEADS, GLA_DV))
    return o.reshape(B, T, GLA_VAL_WIDTH)


def hybrid_mixer(h, ln_g, w_in, rpb, gu_f, gb_f, gu_b, gb_b, norm_g, w_out):
    B, T, _ = h.shape
    n = rmsnorm(h, ln_g)
    proj = n @ w_in
    offsets = [int(o) for o in np.cumsum(IN_SPLITS)[:-1]]
    qa, ka, va, qg, kg, vg, rg, zf, zb = jnp.split(proj, offsets, axis=-1)
    na_heads = lambda t: t.reshape(B, T, NA_HEADS, NA_HEAD_DIM)
    y_na = neighbourhood_attention(na_heads(qa), na_heads(ka), na_heads(va), rpb)
    y_gla = bidirectional_gla(qg, kg, vg, rg, zf, zb, gu_f, gb_f, gu_b, gb_b, norm_g)
    return jnp.concatenate([y_na, y_gla], axis=-1) @ w_out


def sqrelu_mlp(h, ln_g, w1, w2):
    u = rmsnorm(h, ln_g) @ w1
    return jnp.square(jax.nn.relu(u)) @ w2


def setup_inputs(seed: int = 0) -> dict:
    key = jax.random.key(seed)
    ks = jax.random.split(key, 16)
    nrm = lambda k, shape, s: jax.random.normal(k, shape, jnp.float32) * s
    L = DEPTH
    return {
        "x": nrm(ks[0], (BATCH, SEQ, D_MODEL), 1.0),
        "ln_mix_g": 1.0 + nrm(ks[1], (L, D_MODEL), 0.02),
        "w_in": nrm(ks[2], (L, D_MODEL, D_IN), D_MODEL ** -0.5),
        "na_rpb": nrm(ks[3], (L, NA_HEADS, 2 * NA_KH - 1, 2 * NA_KW - 1), 0.02),
        "gla_gate_up_fwd": nrm(ks[4], (L, GLA_GATE_RANK, GLA_KEY_WIDTH), GLA_GATE_RANK ** -0.5),
        "gla_gate_bias_fwd": nrm(ks[5], (L, GLA_KEY_WIDTH), 0.1),
        "gla_gate_up_bwd": nrm(ks[6], (L, GLA_GATE_RANK, GLA_KEY_WIDTH), GLA_GATE_RANK ** -0.5),
        "gla_gate_bias_bwd": nrm(ks[7], (L, GLA_KEY_WIDTH), 0.1),
        "gla_norm_g": 1.0 + nrm(ks[8], (L, GLA_DV), 0.02),
        "w_out": nrm(ks[9], (L, D_MIX, D_MODEL), D_MIX ** -0.5),
        "ln_ff_g": 1.0 + nrm(ks[10], (L, D_MODEL), 0.02),
        "w_ff1": nrm(ks[11], (L, D_MODEL, D_FF), D_MODEL ** -0.5),
        "w_ff2": nrm(ks[12], (L, D_FF, D_MODEL), D_FF ** -0.5),
        "ln_final_g": 1.0 + nrm(ks[13], (D_MODEL,), 0.02),
    }


def reference(x, ln_mix_g, w_in, na_rpb, gla_gate_up_fwd, gla_gate_bias_fwd,
              gla_gate_up_bwd, gla_gate_bias_bwd, gla_norm_g, w_out,
              ln_ff_g, w_ff1, w_ff2, ln_final_g):
    h = x
    for l in range(DEPTH):
        h = h + hybrid_mixer(h, ln_mix_g[l], w_in[l], na_rpb[l],
                             gla_gate_up_fwd[l], gla_gate_bias_fwd[l],
                             gla_gate_up_bwd[l], gla_gate_bias_bwd[l],
                             gla_norm_g[l], w_out[l])
        h = h + sqrelu_mlp(h, ln_ff_g[l], w_ff1[l], w_ff2[l])
    return rmsnorm(h, ln_final_g)
```

```cpp
#include <hip/hip_runtime.h>
#include <hip/hip_cooperative_groups.h>
#include <cstdio>
#include <cstdint>
#include <cmath>
namespace cg = cooperative_groups;
namespace pg8 {
#define PG8_LAS __attribute__((address_space(3)))
typedef unsigned short bf16_t;
typedef short bf16x8 __attribute__((ext_vector_type(8)));
typedef float f32x4 __attribute__((ext_vector_type(4)));
typedef unsigned u32x4 __attribute__((ext_vector_type(4)));
constexpr int BM = 256, BK = 64, HALF = 128, HTB = HALF * BK * 2  , STAGE_BYTES = 8 * HTB, NXCD = 8, WGM = 8;

__host__ __device__ __forceinline__ int lds_byte(int r, int c) { const int st = (r >> 4) * 2 + (c >> 5), rr = r & 15, cc = c & 31, ob = rr * 64 + cc * 2; return st * 1024 + (ob ^ (((ob >> 9) & 1) << 5)); }
__host__ __device__ __forceinline__ void stage_rc(int b, int& R, int& C) { const int st = b / 1024, sb = b % 1024, swz = sb ^ (((sb >> 9) & 1) << 5); R = (st >> 1) * 16 + swz / 64; C = (st & 1) * 32 + (swz % 64) / 2; }
__host__ __device__ __forceinline__ int perm32(int rho) { const int n = rho >> 4, i = rho & 15; return 8 * (i >> 2) + 4 * n + (i & 3); }

struct Unit { int pm, pn; };
struct Gemm { const bf16_t* A; const bf16_t* Bt; int M, N, K; };

struct StaticOrder {
    int nM, nN, nwg, G, c;
    __host__ __device__ void init(int M, int N, int G_, int c_) { nM = M / BM; nN = N / BM; nwg = nM * nN; G = G_; c = c_; }
    __host__ __device__ bool next(int i, Unit& u) const {
        const long L = (long)i * G + c; if (L >= nwg) return false;
        int wgid = (int)L; { const int q = nwg / NXCD, r = nwg % NXCD, xcd = wgid % NXCD, off = wgid / NXCD; wgid = (xcd < r ? xcd * (q + 1) : r * (q + 1) + (xcd - r) * q) + off; }
        const int nig = WGM * nN, gid = wgid / nig, fm = gid * WGM, gsz = (nM - fm) < WGM ? (nM - fm) : WGM;
        u.pm = fm + ((wgid % nig) % gsz); u.pn = (wgid % nig) / gsz; return true;
    }
    __device__ __forceinline__ void a_ready(const Unit&) const {}
    __device__ __forceinline__ void done(const Unit&) const {}
};

__device__ __forceinline__ unsigned cvt_pk_bf16(float lo, float hi) { unsigned r; asm volatile("v_cvt_pk_bf16_f32 %0, %1, %2" : "=v"(r) : "v"(lo), "v"(hi)); return r; }
typedef unsigned u32x2 __attribute__((ext_vector_type(2)));
struct EpiProj {
    static constexpr bool PERM = true, AFTER_DRAIN = false;
    bf16_t* O; int ldc;
    __device__ __forceinline__ void operator()(const f32x4 (&acc)[2][2][4][2], const Unit& u, int wr, int wc, int fr, int fq) const {
        const int row0 = u.pm * BM + wr * 64 + fr, col0 = u.pn * BM + wc * 32 + 8 * fq;
#pragma unroll
        for (int ai = 0; ai < 2; ++ai)
#pragma unroll
            for (int m = 0; m < 4; ++m) { bf16_t* rowp = O + (size_t)(row0 + ai * HALF + m * 16) * ldc + col0;
#pragma unroll
                for (int bj = 0; bj < 2; ++bj) { const f32x4 v0 = acc[ai][bj][m][0], v1 = acc[ai][bj][m][1];
                    u32x4 w; w.x = cvt_pk_bf16(v0[0], v0[1]); w.y = cvt_pk_bf16(v0[2], v0[3]); w.z = cvt_pk_bf16(v1[0], v1[1]); w.w = cvt_pk_bf16(v1[2], v1[3]);
                    *(u32x4*)(rowp + bj * HALF) = w; } }
    }
};
struct EpiFF1 {
    static constexpr bool PERM = true, AFTER_DRAIN = false;
    bf16_t* O; int ldc; const float* sumsq; float inv_n, eps;
    __device__ __forceinline__ void operator()(const f32x4 (&acc)[2][2][4][2], const Unit& u, int wr, int wc, int fr, int fq) const {
        const int row0 = u.pm * BM + wr * 64 + fr, col0 = u.pn * BM + wc * 32 + 8 * fq;
#pragma unroll
        for (int ai = 0; ai < 2; ++ai)
#pragma unroll
            for (int m = 0; m < 4; ++m) { const int row = row0 + ai * HALF + m * 16; bf16_t* rowp = O + (size_t)row * ldc + col0;
                const float rs = 1.0f / sqrtf(sumsq[row] * inv_n + eps);
#pragma unroll
                for (int bj = 0; bj < 2; ++bj) { f32x4 v0 = acc[ai][bj][m][0] * rs, v1 = acc[ai][bj][m][1] * rs;
#pragma unroll
                    for (int e = 0; e < 4; ++e) { const float a = fmaxf(v0[e], 0.f), b = fmaxf(v1[e], 0.f); v0[e] = a * a; v1[e] = b * b; }
                    u32x4 w; w.x = cvt_pk_bf16(v0[0], v0[1]); w.y = cvt_pk_bf16(v0[2], v0[3]); w.z = cvt_pk_bf16(v1[0], v1[1]); w.w = cvt_pk_bf16(v1[2], v1[3]);
                    *(u32x4*)(rowp + bj * HALF) = w; } }
    }
};
struct EpiRes {
    static constexpr bool PERM = false, AFTER_DRAIN = false;
    const float* base; float* out; bf16_t* hb; float* sumsq; int ldc;
    __device__ __forceinline__ void operator()(const f32x4 (&acc)[2][2][4][2], const Unit& u, int wr, int wc, int fr, int fq) const {
        const int col0 = u.pn * BM + wc * 32 + 4 * fq;
#pragma unroll
        for (int ai = 0; ai < 2; ++ai)
#pragma unroll
            for (int m = 0; m < 4; ++m) { const int row = u.pm * BM + ai * HALF + wr * 64 + m * 16 + fr; const size_t off = (size_t)row * ldc + col0; float s = 0.f;
#pragma unroll
                for (int bj = 0; bj < 2; ++bj)
#pragma unroll
                    for (int n = 0; n < 2; ++n) { const f32x4 bs = *(const f32x4*)(base + off + bj * HALF + n * 16); const f32x4 o = bs + acc[ai][bj][m][n];
                        *(f32x4*)(out + off + bj * HALF + n * 16) = o;
                        if (hb) { u32x2 w; w.x = cvt_pk_bf16(o[0], o[1]); w.y = cvt_pk_bf16(o[2], o[3]); *(u32x2*)(hb + off + bj * HALF + n * 16) = w; }
                        s += (o[0] * o[0] + o[1] * o[1]) + (o[2] * o[2] + o[3] * o[3]); }
                s += __shfl_xor(s, 16); s += __shfl_xor(s, 32);
                if (fq == 0) unsafeAtomicAdd(sumsq + row, s);
                asm volatile("" ::: "memory"); }
    }
};
template <class Epi, class Sched, bool ALIGN_EPI = false, bool SP2 = false>
__device__ __forceinline__ void gemm_phase(PG8_LAS unsigned char* lds, const Gemm g, const Sched& S, const Epi& E) {
    const int tid = threadIdx.x, wid = __builtin_amdgcn_readfirstlane(tid >> 6), lane = tid & 63, wr = wid >> 2, wc = wid & 3, fr = lane & 15, fq = lane >> 4;
    const int K = g.K, nt = K / BK;
    unsigned voffA[2], voffB[2];
#pragma unroll
    for (int i = 0; i < 2; ++i) { int R, C; stage_rc(tid * 16 + i * 8192, R, C); const int Rb = Epi::PERM ? ((R & ~31) + perm32(R & 31)) : R;
        voffA[i] = (unsigned)(R * K + C) * 2u; voffB[i] = (unsigned)(Rb * K + C) * 2u; }
    const size_t kstep = (size_t)(BK * 2);
    const size_t hstep = (size_t)HALF * K * 2;
    const size_t tstep = 2 * hstep;
    const unsigned ldsw = (unsigned)wid * 1024u;
    const int aoff = lds_byte(wr * 64 + fr, fq * 8), boff = lds_byte(wc * 32 + fr, fq * 8);
#define PG8_SA(b, h) (((b) * 2 + (h)) * HTB)
#define PG8_SB(b, h) ((4 + (b) * 2 + (h)) * HTB)
#define PG8_STAGE(bufoff, gbase, voff) do { _Pragma("unroll") for (int _i = 0; _i < 2; ++_i) \
        __builtin_amdgcn_global_load_lds((const unsigned*)((const char*)(gbase) + (voff)[_i]), (PG8_LAS unsigned*)(lds + (bufoff) + ldsw + _i * 8192), 16, 0, 0); } while (0)
#define PG8_LDA(dst, b, h) do { _Pragma("unroll") for (int m = 0; m < 4; ++m) _Pragma("unroll") for (int k = 0; k < 2; ++k) dst[m][k] = *(const PG8_LAS bf16x8*)(lds + PG8_SA(b, h) + aoff + m * 2048 + k * 1024); } while (0)
#define PG8_LDB(dst, b, h) do { _Pragma("unroll") for (int n = 0; n < 2; ++n) _Pragma("unroll") for (int k = 0; k < 2; ++k) dst[n][k] = *(const PG8_LAS bf16x8*)(lds + PG8_SB(b, h) + boff + n * 2048 + k * 1024); } while (0)
#define PG8_MMA(ai, bj, At, Bt) do { __builtin_amdgcn_s_setprio(1); _Pragma("unroll") for (int m = 0; m < 4; ++m) _Pragma("unroll") for (int n = 0; n < 2; ++n) _Pragma("unroll") for (int k = 0; k < 2; ++k) \
        acc[ai][bj][m][n] = __builtin_amdgcn_mfma_f32_16x16x32_bf16(Bt[n][k], At[m][k], acc[ai][bj][m][n], 0, 0, 0); __builtin_amdgcn_s_setprio(0); } while (0)
#define PG8_WAIT_V(n) asm volatile("s_waitcnt vmcnt(" #n ")" ::: "memory")
#define PG8_WAIT_L(n) asm volatile("s_waitcnt lgkmcnt(" #n ")" ::: "memory")
#define PG8_BAR __builtin_amdgcn_s_barrier()
#define PG8_SCHED __builtin_amdgcn_sched_barrier(0)
    Unit cur, nxt; int ui = 0;
    if (!S.next(0, cur)) return;
    f32x4 acc[2][2][4][2];
#pragma unroll
    for (int a = 0; a < 2; ++a)
#pragma unroll
        for (int b = 0; b < 2; ++b)
#pragma unroll
            for (int m = 0; m < 4; ++m)
#pragma unroll
                for (int n = 0; n < 2; ++n) acc[a][b][m][n] = (f32x4){0.f, 0.f, 0.f, 0.f};
    bf16x8 At[4][2], B0[2][2], B1[2][2];
    const char* cA = (const char*)g.A + (size_t)cur.pm * tstep; const char* cB = (const char*)g.Bt + (size_t)cur.pn * tstep;
    S.a_ready(cur);
    if constexpr (SP2) {
        PG8_STAGE(PG8_SB(0, 0), cB, voffB); PG8_STAGE(PG8_SB(0, 1), cB + hstep, voffB); PG8_STAGE(PG8_SA(0, 0), cA, voffA); PG8_STAGE(PG8_SA(0, 1), cA + hstep, voffA);
        if (wr == 1) PG8_BAR;
        PG8_WAIT_V(2); PG8_BAR;
        PG8_STAGE(PG8_SB(1, 0), cB + kstep, voffB); PG8_STAGE(PG8_SA(1, 0), cA + kstep, voffA); PG8_STAGE(PG8_SB(1, 1), cB + hstep + kstep, voffB);
        PG8_WAIT_V(6); PG8_BAR;
    } else {
        PG8_STAGE(PG8_SB(0, 0), cB, voffB); PG8_STAGE(PG8_SA(0, 0), cA, voffA); PG8_STAGE(PG8_SB(0, 1), cB + hstep, voffB); PG8_STAGE(PG8_SA(0, 1), cA + hstep, voffA);
        if (wr == 1) PG8_BAR;
        PG8_WAIT_V(4); PG8_BAR;
        PG8_STAGE(PG8_SB(1, 0), cB + kstep, voffB); PG8_STAGE(PG8_SA(1, 0), cA + kstep, voffA); PG8_STAGE(PG8_SB(1, 1), cB + hstep + kstep, voffB);
        PG8_WAIT_V(6); PG8_BAR;
    }
    for (;;) {
        const bool has_next = S.next(ui + 1, nxt);
        const char* nA = has_next ? (const char*)g.A + (size_t)nxt.pm * tstep : cA; const char* nB = has_next ? (const char*)g.Bt + (size_t)nxt.pn * tstep : cB;
        for (int t = 0; t < nt; t += 2) {
            const bool last = (t == nt - 2);
            const char* a1 = cA + (size_t)(t + 1) * kstep;
            const char* a2 = last ? nA : cA + (size_t)(t + 2) * kstep; const char* b2 = last ? nB : cB + (size_t)(t + 2) * kstep;
            const char* a3 = a2 + kstep; const char* b3 = b2 + kstep;
            if (last && has_next) S.a_ready(nxt);
            if constexpr (SP2) {
            PG8_LDB(B0, 0, 0); PG8_LDB(B1, 0, 1); PG8_SCHED; PG8_LDA(At, 0, 0); PG8_STAGE(PG8_SA(1, 1), a1 + hstep, voffA);
            PG8_WAIT_V(8); PG8_WAIT_L(0); PG8_BAR; PG8_MMA(0, 0, At, B0); PG8_MMA(0, 1, At, B1); PG8_BAR; PG8_SCHED;
            PG8_LDA(At, 0, 1); PG8_STAGE(PG8_SB(0, 0), b2, voffB); PG8_STAGE(PG8_SB(0, 1), b2 + hstep, voffB); PG8_STAGE(PG8_SA(0, 0), a2, voffA);
            PG8_WAIT_V(8); PG8_WAIT_L(0); PG8_BAR; PG8_MMA(1, 0, At, B0); PG8_MMA(1, 1, At, B1); PG8_BAR; PG8_SCHED;
            PG8_LDB(B0, 1, 0); PG8_LDB(B1, 1, 1); PG8_SCHED; PG8_LDA(At, 1, 0); PG8_STAGE(PG8_SA(0, 1), a2 + hstep, voffA);
            PG8_WAIT_V(8); PG8_WAIT_L(0); PG8_BAR; PG8_MMA(0, 0, At, B0); PG8_MMA(0, 1, At, B1); PG8_BAR; PG8_SCHED;
            PG8_LDA(At, 1, 1); PG8_STAGE(PG8_SB(1, 0), b3, voffB); PG8_STAGE(PG8_SB(1, 1), b3 + hstep, voffB); PG8_STAGE(PG8_SA(1, 0), a3, voffA);
            PG8_WAIT_V(8); PG8_WAIT_L(0); PG8_BAR; PG8_MMA(1, 0, At, B0); PG8_MMA(1, 1, At, B1); PG8_BAR; PG8_SCHED;
            } else {
            PG8_LDB(B0, 0, 0); PG8_SCHED; PG8_LDA(At, 0, 0); PG8_STAGE(PG8_SA(1, 1), a1 + hstep, voffA);
            PG8_WAIT_L(8); PG8_BAR; PG8_WAIT_L(0); PG8_MMA(0, 0, At, B0); PG8_BAR; PG8_SCHED;
            PG8_LDB(B1, 0, 1); PG8_STAGE(PG8_SB(0, 0), b2, voffB);
            PG8_BAR; PG8_WAIT_L(0); PG8_MMA(0, 1, At, B1); PG8_BAR;
            PG8_LDA(At, 0, 1); PG8_STAGE(PG8_SA(0, 0), a2, voffA);
            PG8_BAR; PG8_WAIT_L(0); PG8_MMA(1, 0, At, B0); PG8_BAR; PG8_SCHED;
            PG8_STAGE(PG8_SB(0, 1), b2 + hstep, voffB);
            PG8_WAIT_V(6); PG8_BAR; PG8_MMA(1, 1, At, B1); PG8_BAR;
            PG8_LDB(B0, 1, 0); PG8_SCHED; PG8_LDA(At, 1, 0); PG8_STAGE(PG8_SA(0, 1), a2 + hstep, voffA);
            PG8_WAIT_L(8); PG8_BAR; PG8_WAIT_L(0); PG8_MMA(0, 0, At, B0); PG8_BAR; PG8_SCHED;
            PG8_LDB(B1, 1, 1); PG8_STAGE(PG8_SB(1, 0), b3, voffB);
            PG8_BAR; PG8_WAIT_L(0); PG8_MMA(0, 1, At, B1); PG8_BAR;
            PG8_LDA(At, 1, 1); PG8_STAGE(PG8_SA(1, 0), a3, voffA);
            PG8_BAR; PG8_WAIT_L(0); PG8_MMA(1, 0, At, B0); PG8_BAR; PG8_SCHED;
            PG8_STAGE(PG8_SB(1, 1), b3 + hstep, voffB);
            PG8_WAIT_V(6); PG8_BAR; PG8_MMA(1, 1, At, B1); PG8_BAR;
            }
        }
        if constexpr (ALIGN_EPI) { if (wr == 0) PG8_BAR; }
        if constexpr (!Epi::AFTER_DRAIN) { E(acc, cur, wr, wc, fr, fq); S.done(cur); }
        if (!has_next) break;
#pragma unroll
        for (int a = 0; a < 2; ++a)
#pragma unroll
            for (int b = 0; b < 2; ++b)
#pragma unroll
                for (int m = 0; m < 4; ++m)
#pragma unroll
                    for (int n = 0; n < 2; ++n) acc[a][b][m][n] = (f32x4){0.f, 0.f, 0.f, 0.f};
        cur = nxt; cA = nA; cB = nB; ++ui;
        if constexpr (ALIGN_EPI) { if (wr == 1) PG8_BAR; }
    }
    PG8_WAIT_V(0);
    if constexpr (!ALIGN_EPI) { if (wr == 0) PG8_BAR; }
    PG8_BAR;
    if constexpr (Epi::AFTER_DRAIN) { E.fused(acc, cur, wr, wc, fr, fq, lds, wid, lane); S.done(cur); }
#undef PG8_SA
#undef PG8_SB
#undef PG8_STAGE
#undef PG8_LDA
#undef PG8_LDB
#undef PG8_MMA
#undef PG8_WAIT_V
#undef PG8_WAIT_L
#undef PG8_BAR
#undef PG8_SCHED
}
}
#define GAS __attribute__((address_space(1)))
#define LAS __attribute__((address_space(3)))
typedef unsigned short bf16;
typedef unsigned v4u __attribute__((ext_vector_type(4)));
typedef unsigned v2u __attribute__((ext_vector_type(2)));
typedef float f32x4 __attribute__((ext_vector_type(4)));
typedef short bf16x8 __attribute__((ext_vector_type(8)));
typedef short s16x4 __attribute__((ext_vector_type(4)));

constexpr int NWAVES = 8, NTHR = 512;
constexpr int T = 8192, D = 1024, M = 16384, NPROJ = 3072, DIN = 3104, FF = 4096;
constexpr float EPS = 1e-6f;
constexpr int C_QA = 0, C_KA = 512, C_VA = 1024, C_QG = 1536, C_KG = 1792, C_VG = 2048, C_RG = 2560;

constexpr size_t MiB = 1u << 20;
constexpr size_t WS_SS2 = 0, WS_SS3 = 65536, WS_DEC = 262144, WS_Z = 1 * MiB;
constexpr size_t WS_WIN = 4 * MiB, WS_WO = 11 * MiB, WS_W1 = 13 * MiB, WS_W2 = 21 * MiB;
constexpr size_t WS_XN = 32 * MiB, WS_Y = 32 * MiB, WS_PROJ = 64 * MiB, WS_CON = 160 * MiB, WS_SP = 224 * MiB;
constexpr size_t WS_HB = 64 * MiB, WS_ACT = 96 * MiB, WS_END = 256 * MiB;
constexpr int LDS_BYTES = 155648;

__device__ __forceinline__ unsigned f2bf(float f) { unsigned u = __builtin_bit_cast(unsigned, f); return (u + 0x7fffu + ((u >> 16) & 1u)) >> 16; }
__device__ __forceinline__ unsigned pk2(float lo, float hi) { return f2bf(lo) | (f2bf(hi) << 16); }
__device__ __forceinline__ float bf2f(unsigned short h) { return __builtin_bit_cast(float, (unsigned)h << 16); }
__device__ __forceinline__ float wave_sum(float v) {
#pragma unroll
    for (int o = 1; o < 64; o <<= 1) v += __shfl_xor(v, o);
    return v;
}
__device__ __forceinline__ f32x4 mfma16(bf16x8 x, bf16x8 y, f32x4 c) { return __builtin_amdgcn_mfma_f32_16x16x32_bf16(x, y, c, 0, 0, 0); }
typedef short v4i16_t __attribute__((ext_vector_type(4)));
__device__ __forceinline__ s16x4 tr4(const LAS unsigned char* p) { return __builtin_bit_cast(s16x4, __builtin_amdgcn_ds_read_tr16_b64_v4i16((LAS v4i16_t*)p)); }
__device__ __forceinline__ bf16x8 cat8(s16x4 a, s16x4 b) { bf16x8 r; r[0] = a[0]; r[1] = a[1]; r[2] = a[2]; r[3] = a[3]; r[4] = b[0]; r[5] = b[1]; r[6] = b[2]; r[7] = b[3]; return r; }
__device__ __forceinline__ bf16x8 pack8(f32x4 a, f32x4 b) {
    v4u w; w.x = pg8::cvt_pk_bf16(a[0], a[1]); w.y = pg8::cvt_pk_bf16(a[2], a[3]); w.z = pg8::cvt_pk_bf16(b[0], b[1]); w.w = pg8::cvt_pk_bf16(b[2], b[3]);
    return __builtin_bit_cast(bf16x8, w);
}

struct Frame {
    LAS unsigned char* lds;
    int tid, lane, wave, vcu, G;
};

__device__ __forceinline__ void p0_transpose_item(const float* W, int K, int N, bf16* WT, const float* gk, LAS float* scr, int item, int lane) {
    const int nblk = N / 32, kb = item / nblk, nb = item % nblk, k0 = 64 * kb, n0 = 32 * nb;
#pragma unroll 8
    for (int i = 0; i < 32; ++i) { const int kk = 2 * i + (lane >> 5); float v = W[(size_t)(k0 + kk) * N + n0 + (lane & 31)]; if (gk) v *= gk[k0 + kk]; scr[kk * 33 + (lane & 31)] = v; }
    asm volatile("s_waitcnt lgkmcnt(0)" ::: "memory");
    const int c = lane & 7;
#pragma unroll
    for (int j = 0; j < 4; ++j) { const int n = (lane >> 3) + 8 * j; const LAS float* s = scr + (8 * c) * 33 + n;
        v4u o; o.x = pk2(s[0 * 33], s[1 * 33]); o.y = pk2(s[2 * 33], s[3 * 33]); o.z = pk2(s[4 * 33], s[5 * 33]); o.w = pk2(s[6 * 33], s[7 * 33]);
        *(v4u*)(WT + (size_t)(n0 + n) * K + k0 + 8 * c) = o; }
    asm volatile("s_waitcnt lgkmcnt(0)" ::: "memory");
}
__device__ __forceinline__ void phase_prologue(const Frame& F, const float* x, const float* g_mix, const float* w_in, const float* w_out, const float* g_ff, const float* w1, const float* w2, unsigned char* ws) {
    LAS float* scr = (LAS float*)(F.lds + F.wave * 16384);
    const int gw = F.vcu * NWAVES + F.wave, NGW = F.G * NWAVES;
    constexpr int I_IN = (D / 64) * (DIN / 32), I_O = (D / 64) * (D / 32), I_1 = (D / 64) * (FF / 32), I_2 = (FF / 64) * (D / 32);
    constexpr int NITEMS = I_IN + I_O + I_1 + I_2;
    for (int it = gw; it < NITEMS; it += NGW) {
        int r = it;
        if (r < I_IN) { p0_transpose_item(w_in, D, DIN, (bf16*)(ws + WS_WIN), nullptr, scr, r, F.lane); continue; } r -= I_IN;
        if (r < I_O) { p0_transpose_item(w_out, D, D, (bf16*)(ws + WS_WO), nullptr, scr, r, F.lane); continue; } r -= I_O;
        if (r < I_1) { p0_transpose_item(w1, D, FF, (bf16*)(ws + WS_W1), g_ff, scr, r, F.lane); continue; } r -= I_1;
        p0_transpose_item(w2, FF, D, (bf16*)(ws + WS_W2), nullptr, scr, r, F.lane);
    }
    { float* ss = (float*)(ws + WS_SS2); for (int i = (F.vcu * NTHR + F.tid); i < 2 * M; i += F.G * NTHR) ss[i] = 0.f; }
    bf16* XN = (bf16*)(ws + WS_XN);
    f32x4 gv[4];
#pragma unroll
    for (int j = 0; j < 4; ++j) gv[j] = ((const f32x4*)g_mix)[F.lane + 64 * j];
    for (int m = gw; m < M; m += NGW) {
        const f32x4* xr = (const f32x4*)(x + (size_t)m * D) + F.lane;
        f32x4 v[4]; float s = 0.f;
#pragma unroll
        for (int j = 0; j < 4; ++j) { v[j] = xr[64 * j]; s += (v[j].x * v[j].x + v[j].y * v[j].y) + (v[j].z * v[j].z + v[j].w * v[j].w); }
        const float rs = 1.0f / sqrtf(wave_sum(s) * (1.f / D) + EPS);
        unsigned long long* o8 = (unsigned long long*)(XN + (size_t)m * D) + F.lane;
#pragma unroll
        for (int j = 0; j < 4; ++j) { const f32x4 o = v[j] * rs * gv[j]; o8[64 * j] = (unsigned long long)pk2(o.x, o.y) | ((unsigned long long)pk2(o.z, o.w) << 32); }
    }
}

__device__ __forceinline__ void phase_z(const Frame& F, const bf16* XN, const bf16* Wz, float* Z) {
    const int fr = F.lane & 15, fq = F.lane >> 4, mt = F.wave & 3, nt = F.wave >> 2;
    for (int rb = F.vcu; rb < M / 64; rb += F.G) {
        const bf16* ap = XN + (size_t)(rb * 64 + mt * 16 + fr) * D + 8 * fq;
        const bf16* bp = Wz + (size_t)(nt * 16 + fr) * D + 8 * fq;
        f32x4 acc = {0.f, 0.f, 0.f, 0.f};
#pragma unroll 8
        for (int ks = 0; ks < D / 32; ++ks) { const bf16x8 a = *(const bf16x8*)(ap + ks * 32), b = *(const bf16x8*)(bp + ks * 32); acc = mfma16(b, a, acc); }
        *(f32x4*)(Z + (size_t)(rb * 64 + mt * 16 + fr) * 32 + nt * 16 + 4 * fq) = acc;
    }
}

constexpr int NA_STR = 144, NA_K_OFF = 0, NA_V_OFF = 512 * NA_STR, NA_RPB_OFF = 2 * 512 * NA_STR;
__device__ __forceinline__ void natten_unit(const Frame& F, const bf16* PROJ, const float* rpb, bf16* Y, int unit) {
    LAS unsigned char* lds = F.lds;
    const int r = unit & 127, h = (unit >> 7) & 7, b = unit >> 10;
    const int rs = min(max(r - 4, 0), 120);
    const size_t tokq0 = (size_t)b * T + r * 64, tokk0 = (size_t)b * T + rs * 64;
#pragma unroll
    for (int it = 0; it < 8; ++it) { const int id = F.tid + NTHR * it, key = id >> 3, ch = id & 7;
        const bf16* src = PROJ + (tokk0 + key) * NPROJ + C_KA + h * 64 + ch * 8;
        const v4u kv = *(const v4u*)src, vv = *(const v4u*)(src + (C_VA - C_KA));
        *(LAS v4u*)(lds + NA_K_OFF + key * NA_STR + ch * 16) = kv; *(LAS v4u*)(lds + NA_V_OFF + key * NA_STR + ch * 16) = vv; }
    if (F.tid < 465) ((LAS float*)(lds + NA_RPB_OFF))[F.tid] = rpb[h * 465 + F.tid];
    const int fr = F.lane & 15, fq = F.lane >> 4, jq = F.wave & 3, dh = F.wave >> 2;
    const int wc0 = (jq == 0) ? 0 : (jq == 1) ? 8 : (jq == 2) ? 24 : 32;
    bf16x8 qf[2];
    { const bf16* qp = PROJ + (tokq0 + 16 * jq + fr) * NPROJ + C_QA + h * 64 + 8 * fq; qf[0] = *(const bf16x8*)qp; qf[1] = *(const bf16x8*)(qp + 32); }
    __syncthreads();
    f32x4 s[16];
#pragma unroll
    for (int i = 0; i < 8; ++i)
#pragma unroll
        for (int ct = 0; ct < 2; ++ct) {
            const LAS unsigned char* kp = lds + NA_K_OFF + (i * 64 + wc0 + 16 * ct + fr) * NA_STR + fq * 16;
            const bf16x8 k0 = *(const LAS bf16x8*)kp, k1 = *(const LAS bf16x8*)(kp + 64);
            f32x4 a = {0.f, 0.f, 0.f, 0.f}; a = mfma16(k0, qf[0], a); a = mfma16(k1, qf[1], a); s[i * 2 + ct] = a; }
    const int cq = 16 * jq + fr, cs = min(max(cq - 8, 0), 48);
    const LAS float* rp = (const LAS float*)(lds + NA_RPB_OFF);
    float mx = -INFINITY;
#pragma unroll
    for (int i = 0; i < 8; ++i) { const int dr = rs + i - r + 7;
#pragma unroll
        for (int ct = 0; ct < 2; ++ct)
#pragma unroll
            for (int e = 0; e < 4; ++e) { const int ck = wc0 + 16 * ct + 4 * fq + e; const bool in = (ck >= cs) && (ck < cs + 16);
                const int dc = min(max(ck - cq + 15, 0), 30);
                const float v = in ? s[i * 2 + ct][e] * 0.125f + rp[dr * 31 + dc] : -INFINITY; s[i * 2 + ct][e] = v; mx = fmaxf(mx, v); } }
    mx = fmaxf(mx, __shfl_xor(mx, 16)); mx = fmaxf(mx, __shfl_xor(mx, 32));
    float l = 0.f;
#pragma unroll
    for (int t = 0; t < 16; ++t)
#pragma unroll
        for (int e = 0; e < 4; ++e) { const float p = __expf(s[t][e] - mx); s[t][e] = p; l += p; }
    l += __shfl_xor(l, 16); l += __shfl_xor(l, 32);
    f32x4 o[2] = {{0.f, 0.f, 0.f, 0.f}, {0.f, 0.f, 0.f, 0.f}};
#pragma unroll
    for (int i = 0; i < 8; ++i) { const bf16x8 pb = pack8(s[2 * i], s[2 * i + 1]);
#pragma unroll
        for (int dt = 0; dt < 2; ++dt) { const int d0 = 32 * dh + 16 * dt;
            const LAS unsigned char* vp = lds + NA_V_OFF + (i * 64 + wc0 + 4 * fq + (fr >> 2)) * NA_STR + (d0 + 4 * (fr & 3)) * 2;
            const bf16x8 x = cat8(tr4(vp), tr4(vp + 16 * NA_STR)); o[dt] = mfma16(x, pb, o[dt]); } }
    const float inv = 1.0f / l;
#pragma unroll
    for (int dt = 0; dt < 2; ++dt) { v2u w; w.x = pg8::cvt_pk_bf16(o[dt][0] * inv, o[dt][1] * inv); w.y = pg8::cvt_pk_bf16(o[dt][2] * inv, o[dt][3] * inv);
        *(v2u*)(Y + (tokq0 + 16 * jq + fr) * D + h * 64 + 32 * dh + 16 * dt + 4 * fq) = w; }
    __syncthreads();
}

constexpr int GL_Z = 0, GL_GU = 8192, GL_GB = 16384, GL_GT = 16896, GL_I0 = 20992;
constexpr int IS = 144, IMG = 64 * IS;
constexpr int VS = 272, VIMG = 64 * VS;
constexpr int GL_QF = GL_I0, GL_QB = GL_I0 + IMG, GL_KF = GL_I0 + 2 * IMG, GL_KB = GL_I0 + 3 * IMG, GL_V = GL_I0 + 4 * IMG, GL_SF = GL_V + VIMG, GL_SB = GL_SF + VIMG;
static_assert(GL_SB + VIMG <= LDS_BYTES, "GLA LDS map");
__device__ __forceinline__ float logsig(float x) { return fminf(x, 0.f) - log1pf(__expf(-fabsf(x))); }

__device__ __forceinline__ void gla_gate(const Frame& F, const float* Z, const float* guf, const float* gbf, const float* gub, const float* gbb, int h, size_t t0,
                                         float (&bf)[8], float (&bb)[8], float& totf, float& totb) {
    LAS unsigned char* lds = F.lds; const int tid = F.tid, d = tid & 63, g = F.wave;
    *(LAS f32x4*)(lds + GL_Z + tid * 16) = *(const f32x4*)(Z + t0 * 32 + tid * 4);
    { const int idx = tid * 4, dir = idx >> 10, rr = (idx >> 6) & 15, dd = idx & 63; const float* src = (dir ? gub : guf) + rr * 256 + h * 64 + dd; *(LAS f32x4*)(lds + GL_GU + idx * 4) = *(const f32x4*)src; }
    if (tid < 128) { const int dir = tid >> 6, dd = tid & 63; ((LAS float*)(lds + GL_GB))[tid] = (dir ? gbb : gbf)[h * 64 + dd]; }
    __syncthreads();
    const LAS float* Zl = (const LAS float*)(lds + GL_Z); const LAS float* GU = (const LAS float*)(lds + GL_GU); const LAS float* GB = (const LAS float*)(lds + GL_GB);
    float uf[16], ub[16];
#pragma unroll
    for (int rr = 0; rr < 16; ++rr) { uf[rr] = GU[rr * 64 + d]; ub[rr] = GU[1024 + rr * 64 + d]; }
    const float gf0 = GB[d], gb0 = GB[64 + d];
    float laf[8], lab[8];
#pragma unroll
    for (int j = 0; j < 8; ++j) { const int c = 8 * g + j; float pf = gf0, pb = gb0;
#pragma unroll
        for (int rr = 0; rr < 16; ++rr) { pf += Zl[c * 32 + rr] * uf[rr]; pb += Zl[c * 32 + 16 + rr] * ub[rr]; }
        laf[j] = logsig(pf) * (1.0f / 16.0f); lab[j] = logsig(pb) * (1.0f / 16.0f); }
    float run = 0.f;
#pragma unroll
    for (int j = 0; j < 8; ++j) { run += laf[j]; bf[j] = run; }
    float runb = 0.f;
#pragma unroll
    for (int j = 7; j >= 0; --j) { runb += lab[j]; bb[j] = runb; }
    LAS float* GT = (LAS float*)(lds + GL_GT);
    GT[g * 64 + d] = run; GT[512 + g * 64 + d] = runb;
    __syncthreads();
    float of = 0.f, ob = 0.f; totf = 0.f; totb = 0.f;
#pragma unroll
    for (int gp = 0; gp < 8; ++gp) { const float a = GT[gp * 64 + d], c = GT[512 + gp * 64 + d]; totf += a; totb += c; if (gp < g) of += a; if (gp > g) ob += c; }
#pragma unroll
    for (int j = 0; j < 8; ++j) { bf[j] += of; bb[j] += ob; }
}
__device__ __forceinline__ void stage_img128(LAS unsigned char* dst, const bf16* src, size_t row_stride, int tid) {
#pragma unroll
    for (int it = 0; it < 2; ++it) { const int id = tid + NTHR * it, row = id >> 4, ch = id & 15; *(LAS v4u*)(dst + row * VS + ch * 16) = *(const v4u*)(src + (size_t)row * row_stride + ch * 8); }
}

__device__ __forceinline__ void gla_a_unit(const Frame& F, const bf16* PROJ, const float* Z, const float* guf, const float* gbf, const float* gub, const float* gbb, float* CON, float* DEC, int unit) {
    LAS unsigned char* lds = F.lds; const int tid = F.tid, d = tid & 63, g = F.wave;
    const int n = unit & 127, bh = unit >> 7, h = bh & 3, b = bh >> 2; const size_t t0 = (size_t)b * T + 64 * n;
    unsigned short kraw[8];
#pragma unroll
    for (int j = 0; j < 8; ++j) kraw[j] = PROJ[(t0 + 8 * g + j) * NPROJ + C_KG + h * 64 + d];
    stage_img128(lds + GL_V, PROJ + t0 * NPROJ + C_VG + h * 128, NPROJ, tid);
    float bf[8], bb[8], totf, totb;
    gla_gate(F, Z, guf, gbf, gub, gbb, h, t0, bf, bb, totf, totb);
#pragma unroll
    for (int j = 0; j < 8; ++j) { const float k = bf2f(kraw[j]); const int c = 8 * g + j;
        *(LAS unsigned short*)(lds + GL_KF + c * IS + d * 2) = (unsigned short)f2bf(k * __expf(totf - bf[j]));
        *(LAS unsigned short*)(lds + GL_KB + c * IS + d * 2) = (unsigned short)f2bf(k * __expf(totb - bb[j])); }
    if (g == 0) { DEC[(size_t)unit * 64 + d] = __expf(totf); DEC[(size_t)(1024 + unit) * 64 + d] = __expf(totb); }
    __syncthreads();
    const int fr = F.lane & 15, fq = F.lane >> 4, dir = F.wave >> 2, dt = F.wave & 3;
    const LAS unsigned char* kimg = lds + (dir ? GL_KB : GL_KF);
    bf16x8 yk[2];
#pragma unroll
    for (int s = 0; s < 2; ++s) { const LAS unsigned char* p = kimg + (32 * s + 4 * fq + (fr >> 2)) * IS + (16 * dt + 4 * (fr & 3)) * 2; yk[s] = cat8(tr4(p), tr4(p + 16 * IS)); }
    float* cbase = CON + ((size_t)(dir * 1024 + unit) * 64 + 16 * dt + fr) * 128 + 4 * fq;
#pragma unroll
    for (int et = 0; et < 8; ++et) { f32x4 acc = {0.f, 0.f, 0.f, 0.f};
#pragma unroll
        for (int s = 0; s < 2; ++s) { const LAS unsigned char* p = lds + GL_V + (32 * s + 4 * fq + (fr >> 2)) * VS + (16 * et + 4 * (fr & 3)) * 2; acc = mfma16(cat8(tr4(p), tr4(p + 16 * VS)), yk[s], acc); }
        *(f32x4*)(cbase + 16 * et) = acc; }
    __syncthreads();
}

__device__ __forceinline__ void phase_scan(const Frame& F, const float* __restrict__ CON, const float* __restrict__ DEC, bf16* __restrict__ SP) {
    for (int chain = F.vcu * NTHR + F.tid; chain < 2 * 8 * 64 * 128; chain += F.G * NTHR) {
        const int e = chain & 127, d = (chain >> 7) & 63, bh = (chain >> 13) & 7, dir = chain >> 16;
        const size_t ubase = (size_t)dir * 1024 + bh * 128;
        const float* con = CON + (ubase * 64 + d) * 128 + e; const float* dec = DEC + ubase * 64 + d; bf16* sp = SP + (ubase * 64 + d) * 128 + e;
        float S = 0.f;
        for (int nb = 0; nb < 16; ++nb) { float c[8], gg[8];
#pragma unroll
            for (int u = 0; u < 8; ++u) { const int n = nb * 8 + u, ne = dir ? 127 - n : n; c[u] = con[(size_t)ne * 8192]; gg[u] = dec[ne * 64]; }
#pragma unroll
            for (int u = 0; u < 8; ++u) { const int n = nb * 8 + u, ne = dir ? 127 - n : n; sp[(size_t)ne * 8192] = (bf16)f2bf(S); S = gg[u] * S + c[u]; } }
    }
}

__device__ __forceinline__ void gla_c_unit(const Frame& F, const bf16* PROJ, const float* Z, const float* guf, const float* gbf, const float* gub, const float* gbb, const bf16* SP, const float* norm_g, bf16* Y, int unit) {
    LAS unsigned char* lds = F.lds; const int tid = F.tid, d = tid & 63, g = F.wave;
    const int n = unit & 127, bh = unit >> 7, h = bh & 3, b = bh >> 2; const size_t t0 = (size_t)b * T + 64 * n;
    unsigned short kraw[8], qraw[8];
#pragma unroll
    for (int j = 0; j < 8; ++j) { const bf16* p = PROJ + (t0 + 8 * g + j) * NPROJ + h * 64 + d; qraw[j] = p[C_QG]; kraw[j] = p[C_KG]; }
    stage_img128(lds + GL_V, PROJ + t0 * NPROJ + C_VG + h * 128, NPROJ, tid);
    stage_img128(lds + GL_SF, SP + (size_t)unit * 8192, 128, tid);
    stage_img128(lds + GL_SB, SP + (size_t)(1024 + unit) * 8192, 128, tid);
    float bf[8], bb[8], totf, totb;
    gla_gate(F, Z, guf, gbf, gub, gbb, h, t0, bf, bb, totf, totb);
#pragma unroll
    for (int j = 0; j < 8; ++j) { const float k = bf2f(kraw[j]), q = bf2f(qraw[j]) * 0.125f; const int off = (8 * g + j) * IS + d * 2;
        const float ef = __expf(bf[j]), eb = __expf(bb[j]);
        *(LAS unsigned short*)(lds + GL_QF + off) = (unsigned short)f2bf(q * ef);
        *(LAS unsigned short*)(lds + GL_KF + off) = (unsigned short)f2bf(k / ef);
        *(LAS unsigned short*)(lds + GL_QB + off) = (unsigned short)f2bf(q * eb);
        *(LAS unsigned short*)(lds + GL_KB + off) = (unsigned short)f2bf(k / eb); }
    __syncthreads();
    if (F.wave < 4) {
        const int fr = F.lane & 15, fq = F.lane >> 4, it = F.wave;
        bf16x8 yqf[2], yqb[2];
#pragma unroll
        for (int s = 0; s < 2; ++s) { const int off = (16 * it + fr) * IS + (32 * s + 8 * fq) * 2; yqf[s] = *(const LAS bf16x8*)(lds + GL_QF + off); yqb[s] = *(const LAS bf16x8*)(lds + GL_QB + off); }
        f32x4 a[4];
        const int i = 16 * it + fr;
#pragma unroll
        for (int jt = 0; jt < 4; ++jt) { f32x4 af = {0.f, 0.f, 0.f, 0.f}, ab = {0.f, 0.f, 0.f, 0.f};
#pragma unroll
            for (int s = 0; s < 2; ++s) { const int off = (16 * jt + fr) * IS + (32 * s + 8 * fq) * 2;
                af = mfma16(*(const LAS bf16x8*)(lds + GL_KF + off), yqf[s], af); ab = mfma16(*(const LAS bf16x8*)(lds + GL_KB + off), yqb[s], ab); }
#pragma unroll
            for (int e = 0; e < 4; ++e) { const int j = 16 * jt + 4 * fq + e; a[jt][e] = (j <= i) ? af[e] : ab[e]; } }
        f32x4 o[8];
#pragma unroll
        for (int et = 0; et < 8; ++et) o[et] = (f32x4){0.f, 0.f, 0.f, 0.f};
#pragma unroll
        for (int s = 0; s < 2; ++s) { const bf16x8 pb = pack8(a[2 * s], a[2 * s + 1]);
#pragma unroll
            for (int et = 0; et < 8; ++et) { const LAS unsigned char* p = lds + GL_V + (32 * s + 4 * fq + (fr >> 2)) * VS + (16 * et + 4 * (fr & 3)) * 2; o[et] = mfma16(cat8(tr4(p), tr4(p + 16 * VS)), pb, o[et]); } }
#pragma unroll
        for (int s = 0; s < 2; ++s)
#pragma unroll
            for (int et = 0; et < 8; ++et) { const int off = (32 * s + 8 * fq + (fr >> 2)) * VS + (16 * et + 4 * (fr & 3)) * 2;
                o[et] = mfma16(cat8(tr4(lds + GL_SF + off), tr4(lds + GL_SF + off + 4 * VS)), yqf[s], o[et]);
                o[et] = mfma16(cat8(tr4(lds + GL_SB + off), tr4(lds + GL_SB + off + 4 * VS)), yqb[s], o[et]); }
        float ss = 0.f;
#pragma unroll
        for (int et = 0; et < 8; ++et) ss += (o[et][0] * o[et][0] + o[et][1] * o[et][1]) + (o[et][2] * o[et][2] + o[et][3] * o[et][3]);
        ss += __shfl_xor(ss, 16); ss += __shfl_xor(ss, 32);
        const float rs = 1.0f / sqrtf(ss * (1.0f / 128.0f) + EPS);
        const bf16* rp = PROJ + (t0 + i) * NPROJ + C_RG + h * 128 + 4 * fq; bf16* yp = Y + (t0 + i) * D + 512 + h * 128 + 4 * fq;
#pragma unroll
        for (int et = 0; et < 8; ++et) { const v2u rw = *(const v2u*)(rp + 16 * et); const f32x4 gn = *(const f32x4*)(norm_g + 16 * et + 4 * fq);
            float rv[4] = {__builtin_bit_cast(float, rw.x << 16), __builtin_bit_cast(float, rw.x & 0xffff0000u), __builtin_bit_cast(float, rw.y << 16), __builtin_bit_cast(float, rw.y & 0xffff0000u)};
            float ov[4];
#pragma unroll
            for (int e = 0; e < 4; ++e) { const float sg = rv[e] / (1.0f + __expf(-rv[e])); ov[e] = o[et][e] * rs * gn[e] * sg; }
            v2u w; w.x = pg8::cvt_pk_bf16(ov[0], ov[1]); w.y = pg8::cvt_pk_bf16(ov[2], ov[3]); *(v2u*)(yp + 16 * et) = w; }
    }
    __syncthreads();
}

__device__ __forceinline__ void phase_final(const Frame& F, float* out, const float* ss, const float* g) {
    const int gw = F.vcu * NWAVES + F.wave, NGW = F.G * NWAVES;
    f32x4 gv[4];
#pragma unroll
    for (int j = 0; j < 4; ++j) gv[j] = ((const f32x4*)g)[F.lane + 64 * j];
    for (int m = gw; m < M; m += NGW) { f32x4* xr = (f32x4*)(out + (size_t)m * D) + F.lane; const float rs = 1.0f / sqrtf(ss[m] * (1.f / D) + EPS);
#pragma unroll
        for (int j = 0; j < 4; ++j) xr[64 * j] = xr[64 * j] * rs * gv[j]; }
}

struct Args { const float* in[14]; float* out; unsigned char* ws; int lo, hi; };
constexpr int NPHASE = 9;
__global__ void __launch_bounds__(NTHR, 2) mk_fwd(Args a) {
    extern __shared__ __attribute__((aligned(16))) unsigned char lds_raw[];
    Frame F; F.lds = (LAS unsigned char*)lds_raw; F.tid = threadIdx.x; F.lane = F.tid & 63; F.wave = __builtin_amdgcn_readfirstlane(F.tid >> 6);
    F.G = gridDim.x; { const int bx = blockIdx.x; F.vcu = (F.G % 8 == 0) ? (bx % 8) * (F.G / 8) + bx / 8 : bx; }
    unsigned char* ws = a.ws;
    const float* x = a.in[0];
    bf16* XN = (bf16*)(ws + WS_XN); bf16* Yb = (bf16*)(ws + WS_Y); bf16* PROJ = (bf16*)(ws + WS_PROJ); bf16* HB = (bf16*)(ws + WS_HB); bf16* ACT = (bf16*)(ws + WS_ACT);
    float* Z = (float*)(ws + WS_Z); float* CON = (float*)(ws + WS_CON); float* DEC = (float*)(ws + WS_DEC); bf16* SP = (bf16*)(ws + WS_SP);
    float* SS2 = (float*)(ws + WS_SS2); float* SS3 = (float*)(ws + WS_SS3);
    const int lo = a.lo, hi = a.hi;
#define IN(k) (lo <= (k) && (k) < hi)
#define SEAM(k) do { if (IN(k) && IN((k) + 1)) cg::this_grid().sync(); } while (0)
    if (IN(0)) phase_prologue(F, x, a.in[1], a.in[2], a.in[9], a.in[10], a.in[11], a.in[12], ws);
    SEAM(0);
    if (IN(1)) {
        pg8::Gemm g{XN, (const bf16*)(ws + WS_WIN), M, NPROJ, D}; pg8::StaticOrder S; S.init(M, NPROJ, F.G, (int)blockIdx.x);
        pg8::EpiProj E{PROJ, NPROJ};
        pg8::gemm_phase<pg8::EpiProj, pg8::StaticOrder, true, true>(F.lds, g, S, E);
        phase_z(F, XN, (const bf16*)(ws + WS_WIN) + (size_t)NPROJ * D, Z);
    }
    SEAM(1);
    if (IN(2)) {
        for (int u = F.vcu; u < 1024 + 2048; u += F.G) {
            if (u < 1024) gla_a_unit(F, PROJ, Z, a.in[4], a.in[5], a.in[6], a.in[7], CON, DEC, u);
            else natten_unit(F, PROJ, a.in[3], Yb, u - 1024);
        }
    }
    SEAM(2);
    if (IN(3)) phase_scan(F, CON, DEC, SP);
    SEAM(3);
    if (IN(4)) { for (int u = F.vcu; u < 1024; u += F.G) gla_c_unit(F, PROJ, Z, a.in[4], a.in[5], a.in[6], a.in[7], SP, a.in[8], Yb, u); }
    SEAM(4);
    if (IN(5)) {
        pg8::Gemm g{Yb, (const bf16*)(ws + WS_WO), M, D, D}; pg8::StaticOrder S; S.init(M, D, F.G, (int)blockIdx.x);
        pg8::EpiRes E{x, a.out, HB, SS2, D};
        pg8::gemm_phase<pg8::EpiRes, pg8::StaticOrder, false, true>(F.lds, g, S, E);
    }
    SEAM(5);
    if (IN(6)) {
        pg8::Gemm g{HB, (const bf16*)(ws + WS_W1), M, FF, D}; pg8::StaticOrder S; S.init(M, FF, F.G, (int)blockIdx.x);
        pg8::EpiFF1 E{ACT, FF, SS2, 1.0f / D, EPS};
        pg8::gemm_phase<pg8::EpiFF1, pg8::StaticOrder, true, true>(F.lds, g, S, E);
    }
    SEAM(6);
    if (IN(7)) {
        pg8::Gemm g{ACT, (const bf16*)(ws + WS_W2), M, D, FF}; pg8::StaticOrder S; S.init(M, D, F.G, (int)blockIdx.x);
        pg8::EpiRes E{a.out, a.out, nullptr, SS3, D};
        pg8::gemm_phase<pg8::EpiRes, pg8::StaticOrder, false, true>(F.lds, g, S, E);
    }
    SEAM(7);
    if (IN(8)) phase_final(F, a.out, SS3, a.in[13]);
#undef IN
#undef SEAM
}

#ifndef MK_ONE_LAUNCH
#define MK_ONE_LAUNCH 1
#endif
extern "C" void kernel_launch(void* const* d_in, const int* in_sizes, int n_in, void* d_out, int out_size, void* d_ws, size_t ws_size, hipStream_t stream) {
    static int grid = 0;
    if (grid == 0) {
        if (n_in != 14 || out_size != M * D || ws_size < WS_END) { fprintf(stderr, "kernel_launch: unexpected shapes (n_in %d out %d ws %zu)\n", n_in, out_size, ws_size); grid = -1; return; }
        int dev = 0, cus = 0, per_cu = 0;
        hipGetDevice(&dev); hipDeviceGetAttribute(&cus, hipDeviceAttributeMultiprocessorCount, dev);
        if (hipFuncSetAttribute((const void*)mk_fwd, hipFuncAttributeMaxDynamicSharedMemorySize, LDS_BYTES) != hipSuccess) { fprintf(stderr, "kernel_launch: hipFuncSetAttribute failed\n"); grid = -1; return; }
        if (hipOccupancyMaxActiveBlocksPerMultiprocessor(&per_cu, (const void*)mk_fwd, NTHR, LDS_BYTES) != hipSuccess || per_cu < 1) { fprintf(stderr, "kernel_launch: occupancy query says %d\n", per_cu); per_cu = 1; }
        (void)hipGetLastError();
        grid = cus * 1;
    }
    if (grid < 0) return;
    Args a{};
    for (int i = 0; i < 14; ++i) a.in[i] = (const float*)d_in[i];
    a.out = (float*)d_out; a.ws = (unsigned char*)d_ws;
#if MK_ONE_LAUNCH
    a.lo = 0; a.hi = NPHASE;
    void* args[] = {&a};
    hipError_t e = hipLaunchCooperativeKernel((const void*)mk_fwd, dim3(grid), dim3(NTHR), args, LDS_BYTES, stream);
    if (e != hipSuccess) fprintf(stderr, "cooperative launch failed: %s (grid %d)\n", hipGetErrorString(e), grid);
#else
    for (int p = 0; p < NPHASE; ++p) { a.lo = p; a.hi = p + 1; hipLaunchKernelGGL(mk_fwd, dim3(grid), dim3(NTHR), LDS_BYTES, stream, a); }
#endif
}
```

```cpp
#include <hip/hip_runtime.h>
#include <hip/hip_cooperative_groups.h>
#include <cstdio>
#include <cstdint>
#include <cmath>
namespace cg = cooperative_groups;
namespace pg8 {
#define PG8_LAS __attribute__((address_space(3)))
typedef unsigned short bf16_t;
typedef short bf16x8 __attribute__((ext_vector_type(8)));
typedef float f32x4 __attribute__((ext_vector_type(4)));
typedef unsigned u32x4 __attribute__((ext_vector_type(4)));
constexpr int BM = 256, BK = 64, HALF = 128, HTB = HALF * BK * 2  , STAGE_BYTES = 8 * HTB, NXCD = 8, WGM = 8;

__host__ __device__ __forceinline__ int lds_byte(int r, int c) { const int st = (r >> 4) * 2 + (c >> 5), rr = r & 15, cc = c & 31, ob = rr * 64 + cc * 2; return st * 1024 + (ob ^ (((ob >> 9) & 1) << 5)); }
__host__ __device__ __forceinline__ void stage_rc(int b, int& R, int& C) { const int st = b / 1024, sb = b % 1024, swz = sb ^ (((sb >> 9) & 1) << 5); R = (st >> 1) * 16 + swz / 64; C = (st & 1) * 32 + (swz % 64) / 2; }
__host__ __device__ __forceinline__ int perm32(int rho) { const int n = rho >> 4, i = rho & 15; return 8 * (i >> 2) + 4 * n + (i & 3); }

struct Unit { int pm, pn; };
struct Gemm { const bf16_t* A; const bf16_t* Bt; int M, N, K; };

struct StaticOrder {
    int nM, nN, nwg, G, c;
    __host__ __device__ void init(int M, int N, int G_, int c_) { nM = M / BM; nN = N / BM; nwg = nM * nN; G = G_; c = c_; }
    __host__ __device__ bool next(int i, Unit& u) const {
        const long L = (long)i * G + c; if (L >= nwg) return false;
        int wgid = (int)L; { const int q = nwg / NXCD, r = nwg % NXCD, xcd = wgid % NXCD, off = wgid / NXCD; wgid = (xcd < r ? xcd * (q + 1) : r * (q + 1) + (xcd - r) * q) + off; }
        const int nig = WGM * nN, gid = wgid / nig, fm = gid * WGM, gsz = (nM - fm) < WGM ? (nM - fm) : WGM;
        u.pm = fm + ((wgid % nig) % gsz); u.pn = (wgid % nig) / gsz; return true;
    }
    __device__ __forceinline__ void a_ready(const Unit&) const {}
    __device__ __forceinline__ void done(const Unit&) const {}
};

__device__ __forceinline__ unsigned cvt_pk_bf16(float lo, float hi) { unsigned r; asm volatile("v_cvt_pk_bf16_f32 %0, %1, %2" : "=v"(r) : "v"(lo), "v"(hi)); return r; }
typedef unsigned u32x2 __attribute__((ext_vector_type(2)));
struct EpiProj {
    static constexpr bool PERM = true, AFTER_DRAIN = false;
    bf16_t* O; int ldc;
    __device__ __forceinline__ void operator()(const f32x4 (&acc)[2][2][4][2], const Unit& u, int wr, int wc, int fr, int fq) const {
        const int row0 = u.pm * BM + wr * 64 + fr, col0 = u.pn * BM + wc * 32 + 8 * fq;
#pragma unroll
        for (int ai = 0; ai < 2; ++ai)
#pragma unroll
            for (int m = 0; m < 4; ++m) { bf16_t* rowp = O + (size_t)(row0 + ai * HALF + m * 16) * ldc + col0;
#pragma unroll
                for (int bj = 0; bj < 2; ++bj) { const f32x4 v0 = acc[ai][bj][m][0], v1 = acc[ai][bj][m][1];
                    u32x4 w; w.x = cvt_pk_bf16(v0[0], v0[1]); w.y = cvt_pk_bf16(v0[2], v0[3]); w.z = cvt_pk_bf16(v1[0], v1[1]); w.w = cvt_pk_bf16(v1[2], v1[3]);
                    *(u32x4*)(rowp + bj * HALF) = w; } }
    }
};
struct EpiFF1 {
    static constexpr bool PERM = true, AFTER_DRAIN = false;
    bf16_t* O; int ldc; const float* sumsq; float inv_n, eps;
    __device__ __forceinline__ void operator()(const f32x4 (&acc)[2][2][4][2], const Unit& u, int wr, int wc, int fr, int fq) const {
        const int row0 = u.pm * BM + wr * 64 + fr, col0 = u.pn * BM + wc * 32 + 8 * fq;
#pragma unroll
        for (int ai = 0; ai < 2; ++ai)
#pragma unroll
            for (int m = 0; m < 4; ++m) { const int row = row0 + ai * HALF + m * 16; bf16_t* rowp = O + (size_t)row * ldc + col0;
                const float rs = 1.0f / sqrtf(sumsq[row] * inv_n + eps);
#pragma unroll
                for (int bj = 0; bj < 2; ++bj) { f32x4 v0 = acc[ai][bj][m][0] * rs, v1 = acc[ai][bj][m][1] * rs;
#pragma unroll
                    for (int e = 0; e < 4; ++e) { const float a = fmaxf(v0[e], 0.f), b = fmaxf(v1[e], 0.f); v0[e] = a * a; v1[e] = b * b; }
                    u32x4 w; w.x = cvt_pk_bf16(v0[0], v0[1]); w.y = cvt_pk_bf16(v0[2], v0[3]); w.z = cvt_pk_bf16(v1[0], v1[1]); w.w = cvt_pk_bf16(v1[2], v1[3]);
                    *(u32x4*)(rowp + bj * HALF) = w; } }
    }
};
struct EpiRes {
    static constexpr bool PERM = false, AFTER_DRAIN = false;
    const float* base; float* out; bf16_t* hb; float* sumsq; int ldc;
    __device__ __forceinline__ void operator()(const f32x4 (&acc)[2][2][4][2], const Unit& u, int wr, int wc, int fr, int fq) const {
        const int col0 = u.pn * BM + wc * 32 + 4 * fq;
#pragma unroll
        for (int ai = 0; ai < 2; ++ai)
#pragma unroll
            for (int m = 0; m < 4; ++m) { const int row = u.pm * BM + ai * HALF + wr * 64 + m * 16 + fr; const size_t off = (size_t)row * ldc + col0; float s = 0.f;
#pragma unroll
                for (int bj = 0; bj < 2; ++bj)
#pragma unroll
                    for (int n = 0; n < 2; ++n) { const f32x4 bs = *(const f32x4*)(base + off + bj * HALF + n * 16); const f32x4 o = bs + acc[ai][bj][m][n];
                        *(f32x4*)(out + off + bj * HALF + n * 16) = o;
                        if (hb) { u32x2 w; w.x = cvt_pk_bf16(o[0], o[1]); w.y = cvt_pk_bf16(o[2], o[3]); *(u32x2*)(hb + off + bj * HALF + n * 16) = w; }
                        s += (o[0] * o[0] + o[1] * o[1]) + (o[2] * o[2] + o[3] * o[3]); }
                s += __shfl_xor(s, 16); s += __shfl_xor(s, 32);
                if (fq == 0) unsafeAtomicAdd(sumsq + row, s);
                asm volatile("" ::: "memory"); }
    }
};
template <class Epi, class Sched, bool ALIGN_EPI = false, bool SP2 = false>
__device__ __forceinline__ void gemm_phase(PG8_LAS unsigned char* lds, const Gemm g, const Sched& S, const Epi& E) {
    const int tid = threadIdx.x, wid = __builtin_amdgcn_readfirstlane(tid >> 6), lane = tid & 63, wr = wid >> 2, wc = wid & 3, fr = lane & 15, fq = lane >> 4;
    const int K = g.K, nt = K / BK;
    unsigned voffA[2], voffB[2];
#pragma unroll
    for (int i = 0; i < 2; ++i) { int R, C; stage_rc(tid * 16 + i * 8192, R, C); const int Rb = Epi::PERM ? ((R & ~31) + perm32(R & 31)) : R;
        voffA[i] = (unsigned)(R * K + C) * 2u; voffB[i] = (unsigned)(Rb * K + C) * 2u; }
    const size_t kstep = (size_t)(BK * 2);
    const size_t hstep = (size_t)HALF * K * 2;
    const size_t tstep = 2 * hstep;
    const unsigned ldsw = (unsigned)wid * 1024u;
    const int aoff = lds_byte(wr * 64 + fr, fq * 8), boff = lds_byte(wc * 32 + fr, fq * 8);
#define PG8_SA(b, h) (((b) * 2 + (h)) * HTB)
#define PG8_SB(b, h) ((4 + (b) * 2 + (h)) * HTB)
#define PG8_STAGE(bufoff, gbase, voff) do { _Pragma("unroll") for (int _i = 0; _i < 2; ++_i) \
        __builtin_amdgcn_global_load_lds((const unsigned*)((const char*)(gbase) + (voff)[_i]), (PG8_LAS unsigned*)(lds + (bufoff) + ldsw + _i * 8192), 16, 0, 0); } while (0)
#define PG8_LDA(dst, b, h) do { _Pragma("unroll") for (int m = 0; m < 4; ++m) _Pragma("unroll") for (int k = 0; k < 2; ++k) dst[m][k] = *(const PG8_LAS bf16x8*)(lds + PG8_SA(b, h) + aoff + m * 2048 + k * 1024); } while (0)
#define PG8_LDB(dst, b, h) do { _Pragma("unroll") for (int n = 0; n < 2; ++n) _Pragma("unroll") for (int k = 0; k < 2; ++k) dst[n][k] = *(const PG8_LAS bf16x8*)(lds + PG8_SB(b, h) + boff + n * 2048 + k * 1024); } while (0)
#define PG8_MMA(ai, bj, At, Bt) do { __builtin_amdgcn_s_setprio(1); _Pragma("unroll") for (int m = 0; m < 4; ++m) _Pragma("unroll") for (int n = 0; n < 2; ++n) _Pragma("unroll") for (int k = 0; k < 2; ++k) \
        acc[ai][bj][m][n] = __builtin_amdgcn_mfma_f32_16x16x32_bf16(Bt[n][k], At[m][k], acc[ai][bj][m][n], 0, 0, 0); __builtin_amdgcn_s_setprio(0); } while (0)
#define PG8_WAIT_V(n) asm volatile("s_waitcnt vmcnt(" #n ")" ::: "memory")
#define PG8_WAIT_L(n) asm volatile("s_waitcnt lgkmcnt(" #n ")" ::: "memory")
#define PG8_BAR __builtin_amdgcn_s_barrier()
#define PG8_SCHED __builtin_amdgcn_sched_barrier(0)
    Unit cur, nxt; int ui = 0;
    if (!S.next(0, cur)) return;
    f32x4 acc[2][2][4][2];
#pragma unroll
    for (int a = 0; a < 2; ++a)
#pragma unroll
        for (int b = 0; b < 2; ++b)
#pragma unroll
            for (int m = 0; m < 4; ++m)
#pragma unroll
                for (int n = 0; n < 2; ++n) acc[a][b][m][n] = (f32x4){0.f, 0.f, 0.f, 0.f};
    bf16x8 At[4][2], B0[2][2], B1[2][2];
    const char* cA = (const char*)g.A + (size_t)cur.pm * tstep; const char* cB = (const char*)g.Bt + (size_t)cur.pn * tstep;
    S.a_ready(cur);
    if constexpr (SP2) {
        PG8_STAGE(PG8_SB(0, 0), cB, voffB); PG8_STAGE(PG8_SB(0, 1), cB + hstep, voffB); PG8_STAGE(PG8_SA(0, 0), cA, voffA); PG8_STAGE(PG8_SA(0, 1), cA + hstep, voffA);
        if (wr == 1) PG8_BAR;
        PG8_WAIT_V(2); PG8_BAR;
        PG8_STAGE(PG8_SB(1, 0), cB + kstep, voffB); PG8_STAGE(PG8_SA(1, 0), cA + kstep, voffA); PG8_STAGE(PG8_SB(1, 1), cB + hstep + kstep, voffB);
        PG8_WAIT_V(6); PG8_BAR;
    } else {
        PG8_STAGE(PG8_SB(0, 0), cB, voffB); PG8_STAGE(PG8_SA(0, 0), cA, voffA); PG8_STAGE(PG8_SB(0, 1), cB + hstep, voffB); PG8_STAGE(PG8_SA(0, 1), cA + hstep, voffA);
        if (wr == 1) PG8_BAR;
        PG8_WAIT_V(4); PG8_BAR;
        PG8_STAGE(PG8_SB(1, 0), cB + kstep, voffB); PG8_STAGE(PG8_SA(1, 0), cA + kstep, voffA); PG8_STAGE(PG8_SB(1, 1), cB + hstep + kstep, voffB);
        PG8_WAIT_V(6); PG8_BAR;
    }
    for (;;) {
        const bool has_next = S.next(ui + 1, nxt);
        const char* nA = has_next ? (const char*)g.A + (size_t)nxt.pm * tstep : cA; const char* nB = has_next ? (const char*)g.Bt + (size_t)nxt.pn * tstep : cB;
        for (int t = 0; t < nt; t += 2) {
            const bool last = (t == nt - 2);
            const char* a1 = cA + (size_t)(t + 1) * kstep;
            const char* a2 = last ? nA : cA + (size_t)(t + 2) * kstep; const char* b2 = last ? nB : cB + (size_t)(t + 2) * kstep;
            const char* a3 = a2 + kstep; const char* b3 = b2 + kstep;
            if (last && has_next) S.a_ready(nxt);
            if constexpr (SP2) {
            PG8_LDB(B0, 0, 0); PG8_LDB(B1, 0, 1); PG8_SCHED; PG8_LDA(At, 0, 0); PG8_STAGE(PG8_SA(1, 1), a1 + hstep, voffA);
            PG8_WAIT_V(8); PG8_WAIT_L(0); PG8_BAR; PG8_MMA(0, 0, At, B0); PG8_MMA(0, 1, At, B1); PG8_BAR; PG8_SCHED;
            PG8_LDA(At, 0, 1); PG8_STAGE(PG8_SB(0, 0), b2, voffB); PG8_STAGE(PG8_SB(0, 1), b2 + hstep, voffB); PG8_STAGE(PG8_SA(0, 0), a2, voffA);
            PG8_WAIT_V(8); PG8_WAIT_L(0); PG8_BAR; PG8_MMA(1, 0, At, B0); PG8_MMA(1, 1, At, B1); PG8_BAR; PG8_SCHED;
            PG8_LDB(B0, 1, 0); PG8_LDB(B1, 1, 1); PG8_SCHED; PG8_LDA(At, 1, 0); PG8_STAGE(PG8_SA(0, 1), a2 + hstep, voffA);
            PG8_WAIT_V(8); PG8_WAIT_L(0); PG8_BAR; PG8_MMA(0, 0, At, B0); PG8_MMA(0, 1, At, B1); PG8_BAR; PG8_SCHED;
            PG8_LDA(At, 1, 1); PG8_STAGE(PG8_SB(1, 0), b3, voffB); PG8_STAGE(PG8_SB(1, 1), b3 + hstep, voffB); PG8_STAGE(PG8_SA(1, 0), a3, voffA);
            PG8_WAIT_V(8); PG8_WAIT_L(0); PG8_BAR; PG8_MMA(1, 0, At, B0); PG8_MMA(1, 1, At, B1); PG8_BAR; PG8_SCHED;
            } else {
            PG8_LDB(B0, 0, 0); PG8_SCHED; PG8_LDA(At, 0, 0); PG8_STAGE(PG8_SA(1, 1), a1 + hstep, voffA);
            PG8_WAIT_L(8); PG8_BAR; PG8_WAIT_L(0); PG8_MMA(0, 0, At, B0); PG8_BAR; PG8_SCHED;
            PG8_LDB(B1, 0, 1); PG8_STAGE(PG8_SB(0, 0), b2, voffB);
            PG8_BAR; PG8_WAIT_L(0); PG8_MMA(0, 1, At, B1); PG8_BAR;
            PG8_LDA(At, 0, 1); PG8_STAGE(PG8_SA(0, 0), a2, voffA);
            PG8_BAR; PG8_WAIT_L(0); PG8_MMA(1, 0, At, B0); PG8_BAR; PG8_SCHED;
            PG8_STAGE(PG8_SB(0, 1), b2 + hstep, voffB);
            PG8_WAIT_V(6); PG8_BAR; PG8_MMA(1, 1, At, B1); PG8_BAR;
            PG8_LDB(B0, 1, 0); PG8_SCHED; PG8_LDA(At, 1, 0); PG8_STAGE(PG8_SA(0, 1), a2 + hstep, voffA);
            PG8_WAIT_L(8); PG8_BAR; PG8_WAIT_L(0); PG8_MMA(0, 0, At, B0); PG8_BAR; PG8_SCHED;
            PG8_LDB(B1, 1, 1); PG8_STAGE(PG8_SB(1, 0), b3, voffB);
            PG8_BAR; PG8_WAIT_L(0); PG8_MMA(0, 1, At, B1); PG8_BAR;
            PG8_LDA(At, 1, 1); PG8_STAGE(PG8_SA(1, 0), a3, voffA);
            PG8_BAR; PG8_WAIT_L(0); PG8_MMA(1, 0, At, B0); PG8_BAR; PG8_SCHED;
            PG8_STAGE(PG8_SB(1, 1), b3 + hstep, voffB);
            PG8_WAIT_V(6); PG8_BAR; PG8_MMA(1, 1, At, B1); PG8_BAR;
            }
        }
        if constexpr (ALIGN_EPI) { if (wr == 0) PG8_BAR; }
        if constexpr (!Epi::AFTER_DRAIN) { E(acc, cur, wr, wc, fr, fq); S.done(cur); }
        if (!has_next) break;
#pragma unroll
        for (int a = 0; a < 2; ++a)
#pragma unroll
            for (int b = 0; b < 2; ++b)
#pragma unroll
                for (int m = 0; m < 4; ++m)
#pragma unroll
                    for (int n = 0; n < 2; ++n) acc[a][b][m][n] = (f32x4){0.f, 0.f, 0.f, 0.f};
        cur = nxt; cA = nA; cB = nB; ++ui;
        if constexpr (ALIGN_EPI) { if (wr == 1) PG8_BAR; }
    }
    PG8_WAIT_V(0);
    if constexpr (!ALIGN_EPI) { if (wr == 0) PG8_BAR; }
    PG8_BAR;
    if constexpr (Epi::AFTER_DRAIN) { E.fused(acc, cur, wr, wc, fr, fq, lds, wid, lane); S.done(cur); }
#undef PG8_SA
#undef PG8_SB
#undef PG8_STAGE
#undef PG8_LDA
#undef PG8_LDB
#undef PG8_MMA
#undef PG8_WAIT_V
#undef PG8_WAIT_L
#undef PG8_BAR
#undef PG8_SCHED
}
}
#define GAS __attribute__((address_space(1)))
#define LAS __attribute__((address_space(3)))
typedef unsigned short bf16;
typedef unsigned v4u __attribute__((ext_vector_type(4)));
typedef unsigned v2u __attribute__((ext_vector_type(2)));
typedef float f32x4 __attribute__((ext_vector_type(4)));
typedef short bf16x8 __attribute__((ext_vector_type(8)));
typedef short s16x4 __attribute__((ext_vector_type(4)));

constexpr int NWAVES = 8, NTHR = 512;
constexpr int T = 8192, D = 1024, M = 16384, NPROJ = 3072, DIN = 3104, FF = 4096;
constexpr float EPS = 1e-6f;
constexpr int C_QA = 0, C_KA = 512, C_VA = 1024, C_QG = 1536, C_KG = 1792, C_VG = 2048, C_RG = 2560;

constexpr size_t MiB = 1u << 20;
constexpr size_t WS_SS2 = 0, WS_SS3 = 65536, WS_BAR = 131072, WS_DEC = 262144, WS_Z = 1 * MiB;
constexpr size_t WS_WIN = 4 * MiB, WS_WO = 11 * MiB, WS_W1 = 13 * MiB, WS_W2 = 21 * MiB;
constexpr size_t WS_XN = 32 * MiB, WS_Y = 32 * MiB, WS_PROJ = 64 * MiB, WS_CON = 160 * MiB, WS_SP = 224 * MiB;
constexpr size_t WS_HB = 64 * MiB, WS_ACT = 96 * MiB, WS_END = 256 * MiB;
constexpr int LDS_BYTES = 155648;

__device__ __forceinline__ unsigned f2bf(float f) { unsigned u = __builtin_bit_cast(unsigned, f); return (u + 0x7fffu + ((u >> 16) & 1u)) >> 16; }
__device__ __forceinline__ unsigned pk2(float lo, float hi) { return f2bf(lo) | (f2bf(hi) << 16); }
__device__ __forceinline__ float bf2f(unsigned short h) { return __builtin_bit_cast(float, (unsigned)h << 16); }
__device__ __forceinline__ float wave_sum(float v) {
#pragma unroll
    for (int o = 1; o < 64; o <<= 1) v += __shfl_xor(v, o);
    return v;
}
__device__ __forceinline__ f32x4 mfma16(bf16x8 x, bf16x8 y, f32x4 c) { return __builtin_amdgcn_mfma_f32_16x16x32_bf16(x, y, c, 0, 0, 0); }
typedef short v4i16_t __attribute__((ext_vector_type(4)));
__device__ __forceinline__ s16x4 tr4(const LAS unsigned char* p) { return __builtin_bit_cast(s16x4, __builtin_amdgcn_ds_read_tr16_b64_v4i16((LAS v4i16_t*)p)); }
__device__ __forceinline__ bf16x8 cat8(s16x4 a, s16x4 b) { bf16x8 r; r[0] = a[0]; r[1] = a[1]; r[2] = a[2]; r[3] = a[3]; r[4] = b[0]; r[5] = b[1]; r[6] = b[2]; r[7] = b[3]; return r; }
__device__ __forceinline__ bf16x8 pack8(f32x4 a, f32x4 b) {
    v4u w; w.x = pg8::cvt_pk_bf16(a[0], a[1]); w.y = pg8::cvt_pk_bf16(a[2], a[3]); w.z = pg8::cvt_pk_bf16(b[0], b[1]); w.w = pg8::cvt_pk_bf16(b[2], b[3]);
    return __builtin_bit_cast(bf16x8, w);
}

struct Frame {
    LAS unsigned char* lds;
    int tid, lane, wave, vcu, G;
};

__device__ __forceinline__ void p0_transpose_item(const float* W, int K, int N, bf16* WT, const float* gk, LAS float* scr, int item, int lane) {
    const int nblk = N / 32, kb = item / nblk, nb = item % nblk, k0 = 64 * kb, n0 = 32 * nb;
#pragma unroll 8
    for (int i = 0; i < 32; ++i) { const int kk = 2 * i + (lane >> 5); float v = W[(size_t)(k0 + kk) * N + n0 + (lane & 31)]; if (gk) v *= gk[k0 + kk]; scr[kk * 33 + (lane & 31)] = v; }
    asm volatile("s_waitcnt lgkmcnt(0)" ::: "memory");
    const int c = lane & 7;
#pragma unroll
    for (int j = 0; j < 4; ++j) { const int n = (lane >> 3) + 8 * j; const LAS float* s = scr + (8 * c) * 33 + n;
        v4u o; o.x = pk2(s[0 * 33], s[1 * 33]); o.y = pk2(s[2 * 33], s[3 * 33]); o.z = pk2(s[4 * 33], s[5 * 33]); o.w = pk2(s[6 * 33], s[7 * 33]);
        *(v4u*)(WT + (size_t)(n0 + n) * K + k0 + 8 * c) = o; }
    asm volatile("s_waitcnt lgkmcnt(0)" ::: "memory");
}
__device__ __forceinline__ void phase_prologue(const Frame& F, const float* x, const float* g_mix, const float* w_in, const float* w_out, const float* g_ff, const float* w1, const float* w2, unsigned char* ws) {
    LAS float* scr = (LAS float*)(F.lds + F.wave * 16384);
    const int gw = F.vcu * NWAVES + F.wave, NGW = F.G * NWAVES;
    constexpr int I_IN = (D / 64) * (DIN / 32), I_O = (D / 64) * (D / 32), I_1 = (D / 64) * (FF / 32), I_2 = (FF / 64) * (D / 32);
    constexpr int NITEMS = I_IN + I_O + I_1 + I_2;
    for (int it = gw; it < NITEMS; it += NGW) {
        int r = it;
        if (r < I_IN) { p0_transpose_item(w_in, D, DIN, (bf16*)(ws + WS_WIN), nullptr, scr, r, F.lane); continue; } r -= I_IN;
        if (r < I_O) { p0_transpose_item(w_out, D, D, (bf16*)(ws + WS_WO), nullptr, scr, r, F.lane); continue; } r -= I_O;
        if (r < I_1) { p0_transpose_item(w1, D, FF, (bf16*)(ws + WS_W1), g_ff, scr, r, F.lane); continue; } r -= I_1;
        p0_transpose_item(w2, FF, D, (bf16*)(ws + WS_W2), nullptr, scr, r, F.lane);
    }
    { float* ss = (float*)(ws + WS_SS2); for (int i = (F.vcu * NTHR + F.tid); i < 2 * M; i += F.G * NTHR) ss[i] = 0.f; }
    bf16* XN = (bf16*)(ws + WS_XN);
    f32x4 gv[4];
#pragma unroll
    for (int j = 0; j < 4; ++j) gv[j] = ((const f32x4*)g_mix)[F.lane + 64 * j];
    for (int m = gw; m < M; m += NGW) {
        const f32x4* xr = (const f32x4*)(x + (size_t)m * D) + F.lane;
        f32x4 v[4]; float s = 0.f;
#pragma unroll
        for (int j = 0; j < 4; ++j) { v[j] = xr[64 * j]; s += (v[j].x * v[j].x + v[j].y * v[j].y) + (v[j].z * v[j].z + v[j].w * v[j].w); }
        const float rs = 1.0f / sqrtf(wave_sum(s) * (1.f / D) + EPS);
        unsigned long long* o8 = (unsigned long long*)(XN + (size_t)m * D) + F.lane;
#pragma unroll
        for (int j = 0; j < 4; ++j) { const f32x4 o = v[j] * rs * gv[j]; o8[64 * j] = (unsigned long long)pk2(o.x, o.y) | ((unsigned long long)pk2(o.z, o.w) << 32); }
    }
}

__device__ __forceinline__ void phase_z(const Frame& F, const bf16* XN, const bf16* Wz, float* Z) {
    const int fr = F.lane & 15, fq = F.lane >> 4, mt = F.wave & 3, nt = F.wave >> 2;
    for (int rb = F.vcu; rb < M / 64; rb += F.G) {
        const bf16* ap = XN + (size_t)(rb * 64 + mt * 16 + fr) * D + 8 * fq;
        const bf16* bp = Wz + (size_t)(nt * 16 + fr) * D + 8 * fq;
        f32x4 acc = {0.f, 0.f, 0.f, 0.f};
#pragma unroll 8
        for (int ks = 0; ks < D / 32; ++ks) { const bf16x8 a = *(const bf16x8*)(ap + ks * 32), b = *(const bf16x8*)(bp + ks * 32); acc = mfma16(b, a, acc); }
        *(f32x4*)(Z + (size_t)(rb * 64 + mt * 16 + fr) * 32 + nt * 16 + 4 * fq) = acc;
    }
}

constexpr int NA_STR = 144, NA_K_OFF = 0, NA_V_OFF = 512 * NA_STR, NA_RPB_OFF = 2 * 512 * NA_STR;
__device__ __forceinline__ void natten_unit(const Frame& F, const bf16* PROJ, const float* rpb, bf16* Y, int unit) {
    LAS unsigned char* lds = F.lds;
    const int r = unit & 127, h = (unit >> 7) & 7, b = unit >> 10;
    const int rs = min(max(r - 4, 0), 120);
    const size_t tokq0 = (size_t)b * T + r * 64, tokk0 = (size_t)b * T + rs * 64;
#pragma unroll
    for (int it = 0; it < 8; ++it) { const int id = F.tid + NTHR * it, key = id >> 3, ch = id & 7;
        const bf16* src = PROJ + (tokk0 + key) * NPROJ + C_KA + h * 64 + ch * 8;
        const v4u kv = *(const v4u*)src, vv = *(const v4u*)(src + (C_VA - C_KA));
        *(LAS v4u*)(lds + NA_K_OFF + key * NA_STR + ch * 16) = kv; *(LAS v4u*)(lds + NA_V_OFF + key * NA_STR + ch * 16) = vv; }
    if (F.tid < 465) ((LAS float*)(lds + NA_RPB_OFF))[F.tid] = rpb[h * 465 + F.tid];
    const int fr = F.lane & 15, fq = F.lane >> 4, jq = F.wave & 3, dh = F.wave >> 2;
    const int wc0 = (jq == 0) ? 0 : (jq == 1) ? 8 : (jq == 2) ? 24 : 32;
    bf16x8 qf[2];
    { const bf16* qp = PROJ + (tokq0 + 16 * jq + fr) * NPROJ + C_QA + h * 64 + 8 * fq; qf[0] = *(const bf16x8*)qp; qf[1] = *(const bf16x8*)(qp + 32); }
    __syncthreads();
    f32x4 s[16];
#pragma unroll
    for (int i = 0; i < 8; ++i)
#pragma unroll
        for (int ct = 0; ct < 2; ++ct) {
            const LAS unsigned char* kp = lds + NA_K_OFF + (i * 64 + wc0 + 16 * ct + fr) * NA_STR + fq * 16;
            const bf16x8 k0 = *(const LAS bf16x8*)kp, k1 = *(const LAS bf16x8*)(kp + 64);
            f32x4 a = {0.f, 0.f, 0.f, 0.f}; a = mfma16(k0, qf[0], a); a = mfma16(k1, qf[1], a); s[i * 2 + ct] = a; }
    const int cq = 16 * jq + fr, cs = min(max(cq - 8, 0), 48);
    const LAS float* rp = (const LAS float*)(lds + NA_RPB_OFF);
    float mx = -INFINITY;
#pragma unroll
    for (int i = 0; i < 8; ++i) { const int dr = rs + i - r + 7;
#pragma unroll
        for (int ct = 0; ct < 2; ++ct)
#pragma unroll
            for (int e = 0; e < 4; ++e) { const int ck = wc0 + 16 * ct + 4 * fq + e; const bool in = (ck >= cs) && (ck < cs + 16);
                const int dc = min(max(ck - cq + 15, 0), 30);
                const float v = in ? s[i * 2 + ct][e] * 0.125f + rp[dr * 31 + dc] : -INFINITY; s[i * 2 + ct][e] = v; mx = fmaxf(mx, v); } }
    mx = fmaxf(mx, __shfl_xor(mx, 16)); mx = fmaxf(mx, __shfl_xor(mx, 32));
    float l = 0.f;
#pragma unroll
    for (int t = 0; t < 16; ++t)
#pragma unroll
        for (int e = 0; e < 4; ++e) { const float p = __expf(s[t][e] - mx); s[t][e] = p; l += p; }
    l += __shfl_xor(l, 16); l += __shfl_xor(l, 32);
    f32x4 o[2] = {{0.f, 0.f, 0.f, 0.f}, {0.f, 0.f, 0.f, 0.f}};
#pragma unroll
    for (int i = 0; i < 8; ++i) { const bf16x8 pb = pack8(s[2 * i], s[2 * i + 1]);
#pragma unroll
        for (int dt = 0; dt < 2; ++dt) { const int d0 = 32 * dh + 16 * dt;
            const LAS unsigned char* vp = lds + NA_V_OFF + (i * 64 + wc0 + 4 * fq + (fr >> 2)) * NA_STR + (d0 + 4 * (fr & 3)) * 2;
            const bf16x8 x = cat8(tr4(vp), tr4(vp + 16 * NA_STR)); o[dt] = mfma16(x, pb, o[dt]); } }
    const float inv = 1.0f / l;
#pragma unroll
    for (int dt = 0; dt < 2; ++dt) { v2u w; w.x = pg8::cvt_pk_bf16(o[dt][0] * inv, o[dt][1] * inv); w.y = pg8::cvt_pk_bf16(o[dt][2] * inv, o[dt][3] * inv);
        *(v2u*)(Y + (tokq0 + 16 * jq + fr) * D + h * 64 + 32 * dh + 16 * dt + 4 * fq) = w; }
    __syncthreads();
}

constexpr int GL_Z = 0, GL_GU = 8192, GL_GB = 16384, GL_GT = 16896, GL_I0 = 20992;
constexpr int IS = 144, IMG = 64 * IS;
constexpr int VS = 272, VIMG = 64 * VS;
constexpr int GL_QF = GL_I0, GL_QB = GL_I0 + IMG, GL_KF = GL_I0 + 2 * IMG, GL_KB = GL_I0 + 3 * IMG, GL_V = GL_I0 + 4 * IMG, GL_SF = GL_V + VIMG, GL_SB = GL_SF + VIMG;
static_assert(GL_SB + VIMG <= LDS_BYTES, "GLA LDS map");
__device__ __forceinline__ float logsig(float x) { return fminf(x, 0.f) - log1pf(__expf(-fabsf(x))); }

__device__ __forceinline__ void gla_gate(const Frame& F, const float* Z, const float* guf, const float* gbf, const float* gub, const float* gbb, int h, size_t t0,
                                         float (&bf)[8], float (&bb)[8], float& totf, float& totb) {
    LAS unsigned char* lds = F.lds; const int tid = F.tid, d = tid & 63, g = F.wave;
    *(LAS f32x4*)(lds + GL_Z + tid * 16) = *(const f32x4*)(Z + t0 * 32 + tid * 4);
    { const int idx = tid * 4, dir = idx >> 10, rr = (idx >> 6) & 15, dd = idx & 63; const float* src = (dir ? gub : guf) + rr * 256 + h * 64 + dd; *(LAS f32x4*)(lds + GL_GU + idx * 4) = *(const f32x4*)src; }
    if (tid < 128) { const int dir = tid >> 6, dd = tid & 63; ((LAS float*)(lds + GL_GB))[tid] = (dir ? gbb : gbf)[h * 64 + dd]; }
    __syncthreads();
    const LAS float* Zl = (const LAS float*)(lds + GL_Z); const LAS float* GU = (const LAS float*)(lds + GL_GU); const LAS float* GB = (const LAS float*)(lds + GL_GB);
    float uf[16], ub[16];
#pragma unroll
    for (int rr = 0; rr < 16; ++rr) { uf[rr] = GU[rr * 64 + d]; ub[rr] = GU[1024 + rr * 64 + d]; }
    const float gf0 = GB[d], gb0 = GB[64 + d];
    float laf[8], lab[8];
#pragma unroll
    for (int j = 0; j < 8; ++j) { const int c = 8 * g + j; float pf = gf0, pb = gb0;
#pragma unroll
        for (int rr = 0; rr < 16; ++rr) { pf += Zl[c * 32 + rr] * uf[rr]; pb += Zl[c * 32 + 16 + rr] * ub[rr]; }
        laf[j] = logsig(pf) * (1.0f / 16.0f); lab[j] = logsig(pb) * (1.0f / 16.0f); }
    float run = 0.f;
#pragma unroll
    for (int j = 0; j < 8; ++j) { run += laf[j]; bf[j] = run; }
    float runb = 0.f;
#pragma unroll
    for (int j = 7; j >= 0; --j) { runb += lab[j]; bb[j] = runb; }
    LAS float* GT = (LAS float*)(lds + GL_GT);
    GT[g * 64 + d] = run; GT[512 + g * 64 + d] = runb;
    __syncthreads();
    float of = 0.f, ob = 0.f; totf = 0.f; totb = 0.f;
#pragma unroll
    for (int gp = 0; gp < 8; ++gp) { const float a = GT[gp * 64 + d], c = GT[512 + gp * 64 + d]; totf += a; totb += c; if (gp < g) of += a; if (gp > g) ob += c; }
#pragma unroll
    for (int j = 0; j < 8; ++j) { bf[j] += of; bb[j] += ob; }
}
__device__ __forceinline__ void stage_img128(LAS unsigned char* dst, const bf16* src, size_t row_stride, int tid) {
#pragma unroll
    for (int it = 0; it < 2; ++it) { const int id = tid + NTHR * it, row = id >> 4, ch = id & 15; *(LAS v4u*)(dst + row * VS + ch * 16) = *(const v4u*)(src + (size_t)row * row_stride + ch * 8); }
}

__device__ __forceinline__ void gla_a_unit(const Frame& F, const bf16* PROJ, const float* Z, const float* guf, const float* gbf, const float* gub, const float* gbb, float* CON, float* DEC, int unit) {
    LAS unsigned char* lds = F.lds; const int tid = F.tid, d = tid & 63, g = F.wave;
    const int n = unit & 127, bh = unit >> 7, h = bh & 3, b = bh >> 2; const size_t t0 = (size_t)b * T + 64 * n;
    unsigned short kraw[8];
#pragma unroll
    for (int j = 0; j < 8; ++j) kraw[j] = PROJ[(t0 + 8 * g + j) * NPROJ + C_KG + h * 64 + d];
    stage_img128(lds + GL_V, PROJ + t0 * NPROJ + C_VG + h * 128, NPROJ, tid);
    float bf[8], bb[8], totf, totb;
    gla_gate(F, Z, guf, gbf, gub, gbb, h, t0, bf, bb, totf, totb);
#pragma unroll
    for (int j = 0; j < 8; ++j) { const float k = bf2f(kraw[j]); const int c = 8 * g + j;
        *(LAS unsigned short*)(lds + GL_KF + c * IS + d * 2) = (unsigned short)f2bf(k * __expf(totf - bf[j]));
        *(LAS unsigned short*)(lds + GL_KB + c * IS + d * 2) = (unsigned short)f2bf(k * __expf(totb - bb[j])); }
    if (g == 0) { DEC[(size_t)unit * 64 + d] = __expf(totf); DEC[(size_t)(1024 + unit) * 64 + d] = __expf(totb); }
    __syncthreads();
    const int fr = F.lane & 15, fq = F.lane >> 4, dir = F.wave >> 2, dt = F.wave & 3;
    const LAS unsigned char* kimg = lds + (dir ? GL_KB : GL_KF);
    bf16x8 yk[2];
#pragma unroll
    for (int s = 0; s < 2; ++s) { const LAS unsigned char* p = kimg + (32 * s + 4 * fq + (fr >> 2)) * IS + (16 * dt + 4 * (fr & 3)) * 2; yk[s] = cat8(tr4(p), tr4(p + 16 * IS)); }
    float* cbase = CON + ((size_t)(dir * 1024 + unit) * 64 + 16 * dt + fr) * 128 + 4 * fq;
#pragma unroll
    for (int et = 0; et < 8; ++et) { f32x4 acc = {0.f, 0.f, 0.f, 0.f};
#pragma unroll
        for (int s = 0; s < 2; ++s) { const LAS unsigned char* p = lds + GL_V + (32 * s + 4 * fq + (fr >> 2)) * VS + (16 * et + 4 * (fr & 3)) * 2; acc = mfma16(cat8(tr4(p), tr4(p + 16 * VS)), yk[s], acc); }
        *(f32x4*)(cbase + 16 * et) = acc; }
    __syncthreads();
}

__device__ __forceinline__ void phase_scan(const Frame& F, const float* __restrict__ CON, const float* __restrict__ DEC, bf16* __restrict__ SP) {
    for (int chain = F.vcu * NTHR + F.tid; chain < 2 * 8 * 64 * 128; chain += F.G * NTHR) {
        const int e = chain & 127, d = (chain >> 7) & 63, bh = (chain >> 13) & 7, dir = chain >> 16;
        const size_t ubase = (size_t)dir * 1024 + bh * 128;
        const float* con = CON + (ubase * 64 + d) * 128 + e; const float* dec = DEC + ubase * 64 + d; bf16* sp = SP + (ubase * 64 + d) * 128 + e;
        float S = 0.f;
        for (int nb = 0; nb < 16; ++nb) { float c[8], gg[8];
#pragma unroll
            for (int u = 0; u < 8; ++u) { const int n = nb * 8 + u, ne = dir ? 127 - n : n; c[u] = con[(size_t)ne * 8192]; gg[u] = dec[ne * 64]; }
#pragma unroll
            for (int u = 0; u < 8; ++u) { const int n = nb * 8 + u, ne = dir ? 127 - n : n; sp[(size_t)ne * 8192] = (bf16)f2bf(S); S = gg[u] * S + c[u]; } }
    }
}

__device__ __forceinline__ void gla_c_unit(const Frame& F, const bf16* PROJ, const float* Z, const float* guf, const float* gbf, const float* gub, const float* gbb, const bf16* SP, const float* norm_g, bf16* Y, int unit) {
    LAS unsigned char* lds = F.lds; const int tid = F.tid, d = tid & 63, g = F.wave;
    const int n = unit & 127, bh = unit >> 7, h = bh & 3, b = bh >> 2; const size_t t0 = (size_t)b * T + 64 * n;
    unsigned short kraw[8], qraw[8];
#pragma unroll
    for (int j = 0; j < 8; ++j) { const bf16* p = PROJ + (t0 + 8 * g + j) * NPROJ + h * 64 + d; qraw[j] = p[C_QG]; kraw[j] = p[C_KG]; }
    stage_img128(lds + GL_V, PROJ + t0 * NPROJ + C_VG + h * 128, NPROJ, tid);
    stage_img128(lds + GL_SF, SP + (size_t)unit * 8192, 128, tid);
    stage_img128(lds + GL_SB, SP + (size_t)(1024 + unit) * 8192, 128, tid);
    float bf[8], bb[8], totf, totb;
    gla_gate(F, Z, guf, gbf, gub, gbb, h, t0, bf, bb, totf, totb);
#pragma unroll
    for (int j = 0; j < 8; ++j) { const float k = bf2f(kraw[j]), q = bf2f(qraw[j]) * 0.125f; const int off = (8 * g + j) * IS + d * 2;
        const float ef = __expf(bf[j]), eb = __expf(bb[j]);
        *(LAS unsigned short*)(lds + GL_QF + off) = (unsigned short)f2bf(q * ef);
        *(LAS unsigned short*)(lds + GL_KF + off) = (unsigned short)f2bf(k / ef);
        *(LAS unsigned short*)(lds + GL_QB + off) = (unsigned short)f2bf(q * eb);
        *(LAS unsigned short*)(lds + GL_KB + off) = (unsigned short)f2bf(k / eb); }
    __syncthreads();
    if (F.wave < 4) {
        const int fr = F.lane & 15, fq = F.lane >> 4, it = F.wave;
        bf16x8 yqf[2], yqb[2];
#pragma unroll
        for (int s = 0; s < 2; ++s) { const int off = (16 * it + fr) * IS + (32 * s + 8 * fq) * 2; yqf[s] = *(const LAS bf16x8*)(lds + GL_QF + off); yqb[s] = *(const LAS bf16x8*)(lds + GL_QB + off); }
        f32x4 a[4];
        const int i = 16 * it + fr;
#pragma unroll
        for (int jt = 0; jt < 4; ++jt) { f32x4 af = {0.f, 0.f, 0.f, 0.f}, ab = {0.f, 0.f, 0.f, 0.f};
#pragma unroll
            for (int s = 0; s < 2; ++s) { const int off = (16 * jt + fr) * IS + (32 * s + 8 * fq) * 2;
                af = mfma16(*(const LAS bf16x8*)(lds + GL_KF + off), yqf[s], af); ab = mfma16(*(const LAS bf16x8*)(lds + GL_KB + off), yqb[s], ab); }
#pragma unroll
            for (int e = 0; e < 4; ++e) { const int j = 16 * jt + 4 * fq + e; a[jt][e] = (j <= i) ? af[e] : ab[e]; } }
        f32x4 o[8];
#pragma unroll
        for (int et = 0; et < 8; ++et) o[et] = (f32x4){0.f, 0.f, 0.f, 0.f};
#pragma unroll
        for (int s = 0; s < 2; ++s) { const bf16x8 pb = pack8(a[2 * s], a[2 * s + 1]);
#pragma unroll
            for (int et = 0; et < 8; ++et) { const LAS unsigned char* p = lds + GL_V + (32 * s + 4 * fq + (fr >> 2)) * VS + (16 * et + 4 * (fr & 3)) * 2; o[et] = mfma16(cat8(tr4(p), tr4(p + 16 * VS)), pb, o[et]); } }
#pragma unroll
        for (int s = 0; s < 2; ++s)
#pragma unroll
            for (int et = 0; et < 8; ++et) { const int off = (32 * s + 8 * fq + (fr >> 2)) * VS + (16 * et + 4 * (fr & 3)) * 2;
                o[et] = mfma16(cat8(tr4(lds + GL_SF + off), tr4(lds + GL_SF + off + 4 * VS)), yqf[s], o[et]);
                o[et] = mfma16(cat8(tr4(lds + GL_SB + off), tr4(lds + GL_SB + off + 4 * VS)), yqb[s], o[et]); }
        float ss = 0.f;
#pragma unroll
        for (int et = 0; et < 8; ++et) ss += (o[et][0] * o[et][0] + o[et][1] * o[et][1]) + (o[et][2] * o[et][2] + o[et][3] * o[et][3]);
        ss += __shfl_xor(ss, 16); ss += __shfl_xor(ss, 32);
        const float rs = 1.0f / sqrtf(ss * (1.0f / 128.0f) + EPS);
        const bf16* rp = PROJ + (t0 + i) * NPROJ + C_RG + h * 128 + 4 * fq; bf16* yp = Y + (t0 + i) * D + 512 + h * 128 + 4 * fq;
#pragma unroll
        for (int et = 0; et < 8; ++et) { const v2u rw = *(const v2u*)(rp + 16 * et); const f32x4 gn = *(const f32x4*)(norm_g + 16 * et + 4 * fq);
            float rv[4] = {__builtin_bit_cast(float, rw.x << 16), __builtin_bit_cast(float, rw.x & 0xffff0000u), __builtin_bit_cast(float, rw.y << 16), __builtin_bit_cast(float, rw.y & 0xffff0000u)};
            float ov[4];
#pragma unroll
            for (int e = 0; e < 4; ++e) { const float sg = rv[e] / (1.0f + __expf(-rv[e])); ov[e] = o[et][e] * rs * gn[e] * sg; }
            v2u w; w.x = pg8::cvt_pk_bf16(ov[0], ov[1]); w.y = pg8::cvt_pk_bf16(ov[2], ov[3]); *(v2u*)(yp + 16 * et) = w; }
    }
    __syncthreads();
}

__device__ __forceinline__ void phase_final(const Frame& F, float* out, const float* ss, const float* g) {
    const int gw = F.vcu * NWAVES + F.wave, NGW = F.G * NWAVES;
    f32x4 gv[4];
#pragma unroll
    for (int j = 0; j < 4; ++j) gv[j] = ((const f32x4*)g)[F.lane + 64 * j];
    for (int m = gw; m < M; m += NGW) { f32x4* xr = (f32x4*)(out + (size_t)m * D) + F.lane; const float rs = 1.0f / sqrtf(ss[m] * (1.f / D) + EPS);
#pragma unroll
        for (int j = 0; j < 4; ++j) xr[64 * j] = xr[64 * j] * rs * gv[j]; }
}

#define XB_TMO      128
#define XB_XCNT(j)  (256  + 64 * (j))
#define XB_XSUB(j)  (1280 + 64 * (j))
#define XB_XGEN(j)  (2304 + 64 * (j))
#define XB_TOP      3328
#define XB_TOPGEN   3392
#define XCD_BAR_WORDS 3456
#define XB_SPIN_CAP (1u << 18)

__device__ __forceinline__ unsigned xb_ld(unsigned* p)              { return __hip_atomic_load(p, __ATOMIC_RELAXED, __HIP_MEMORY_SCOPE_AGENT); }
__device__ __forceinline__ unsigned xb_add(unsigned* p, unsigned v) { return __hip_atomic_fetch_add(p, v, __ATOMIC_RELAXED, __HIP_MEMORY_SCOPE_AGENT); }
__device__ __forceinline__ unsigned xb_xcc_id() { return (unsigned)__builtin_amdgcn_s_getreg((3 << 11) | 20) & 0xFu; }
#define XB_SPIN(cond, bar) do { unsigned _sp = 0; while (cond) { __builtin_amdgcn_s_sleep(1); \
    if ((++_sp & 255u) == 0u) { if (xb_ld(&(bar)[XB_TMO])) break; if (_sp > XB_SPIN_CAP) { atomicAdd(&(bar)[XB_TMO], 1u); break; } } } } while (0)

struct XcdBarrier {
    unsigned* bar; unsigned x;
    volatile LAS unsigned* st;
};

__device__ __forceinline__ XcdBarrier xcd_barrier_post(unsigned* bar, volatile LAS unsigned* st) {
    XcdBarrier b; b.bar = bar; b.x = xb_xcc_id(); b.st = st;
    if (threadIdx.x == 0) (void)xb_add(&bar[XB_XCNT(b.x)], 1u);
    return b;
}
__device__ __forceinline__ void xcd_barrier_complete(unsigned* bar, unsigned x, unsigned& nloc, unsigned& nx) {
    const unsigned G = gridDim.x * gridDim.y * gridDim.z;
    unsigned sum, cnt, mine, sp = 0u;
    for (;;) {
        sum = 0u; cnt = 0u; mine = 0u;
#pragma unroll
        for (unsigned j = 0; j < 16; ++j) { const unsigned c = xb_ld(&bar[XB_XCNT(j)]); sum += c; cnt += (c > 0u) ? 1u : 0u; mine = (j == x) ? c : mine; }
        if (sum == G) break;
        __builtin_amdgcn_s_sleep(1);
        if ((++sp & 255u) == 0u) { if (xb_ld(&bar[XB_TMO])) break; if (sp > XB_SPIN_CAP) { atomicAdd(&bar[XB_TMO], 1u); break; } }
    }
    nloc = mine > 0u ? mine : 1u; nx = cnt > 0u ? cnt : 1u;
}

__device__ __forceinline__ void xcd_barrier(const XcdBarrier& b) {
    asm volatile("s_waitcnt vmcnt(0)" ::: "memory");
    __syncthreads();
    if (threadIdx.x == 0) {
        unsigned* bar = b.bar;
        __builtin_amdgcn_s_waitcnt(0);
        unsigned nloc = b.st[0], nx = b.st[1];
        if (nloc == 0u) { xcd_barrier_complete(bar, b.x, nloc, nx); b.st[0] = nloc; b.st[1] = nx; }
        const unsigned old = xb_add(&bar[XB_XSUB(b.x)], 1u);
        const unsigned gen = old / nloc;
        if (old + 1u == (gen + 1u) * nloc) {
            __builtin_amdgcn_fence(__ATOMIC_RELEASE, "agent");
            asm volatile("s_waitcnt vmcnt(0)" ::: "memory");
            const unsigned og = xb_add(&bar[XB_TOP], 1u);
            const unsigned tg = og / nx;
            if (og + 1u == (tg + 1u) * nx) xb_add(&bar[XB_TOPGEN], 1u);
            else XB_SPIN(xb_ld(&bar[XB_TOPGEN]) == tg, bar);
            __builtin_amdgcn_fence(__ATOMIC_ACQUIRE, "agent");
            xb_add(&bar[XB_XGEN(b.x)], 1u);
            asm volatile("s_waitcnt vmcnt(0)" ::: "memory");
        } else {
            XB_SPIN(xb_ld(&bar[XB_XGEN(b.x)]) == gen, bar);
            __builtin_amdgcn_fence(__ATOMIC_ACQUIRE, "agent");
            asm volatile("s_waitcnt vmcnt(0)" ::: "memory");
        }
    }
    __syncthreads();
}
#ifndef MK_DUP
#define MK_DUP 0
#endif
struct Args { const float* in[14]; float* out; unsigned char* ws; int lo, hi; };
constexpr int NPHASE = 9;
__global__ void __launch_bounds__(NTHR, 2) mk_fwd(Args a) {
    extern __shared__ __attribute__((aligned(16))) unsigned char lds_raw[];
    Frame F; F.lds = (LAS unsigned char*)lds_raw; F.tid = threadIdx.x; F.lane = F.tid & 63; F.wave = __builtin_amdgcn_readfirstlane(F.tid >> 6);
    F.G = gridDim.x; { const int bx = blockIdx.x; F.vcu = (F.G % 8 == 0) ? (bx % 8) * (F.G / 8) + bx / 8 : bx; }
    unsigned char* ws = a.ws;
    const float* x = a.in[0];
    bf16* XN = (bf16*)(ws + WS_XN); bf16* Yb = (bf16*)(ws + WS_Y); bf16* PROJ = (bf16*)(ws + WS_PROJ); bf16* HB = (bf16*)(ws + WS_HB); bf16* ACT = (bf16*)(ws + WS_ACT);
    float* Z = (float*)(ws + WS_Z); float* CON = (float*)(ws + WS_CON); float* DEC = (float*)(ws + WS_DEC); bf16* SP = (bf16*)(ws + WS_SP);
    float* SS2 = (float*)(ws + WS_SS2); float* SS3 = (float*)(ws + WS_SS3);
    const int lo = a.lo, hi = a.hi;
#define IN(k) (lo <= (k) && (k) < hi)
#define SEAM(k) do { if (IN(k) && IN((k) + 1)) xcd_barrier(bar); } while (0)
    volatile LAS unsigned* MISC = (volatile LAS unsigned*)(F.lds + LDS_BYTES - 64);
    if (F.tid < 16) MISC[F.tid] = 0u;
    __syncthreads();
    unsigned* barw = (unsigned*)(ws + WS_BAR);
    if (IN(0)) {
        if (blockIdx.x == 0) for (int i = F.tid; i < XCD_BAR_WORDS; i += NTHR) barw[i] = 0u;
        phase_prologue(F, x, a.in[1], a.in[2], a.in[9], a.in[10], a.in[11], a.in[12], ws);
    }
    XcdBarrier bar; bar.bar = barw; bar.x = 0; bar.st = nullptr;
    if (IN(0) && IN(1)) { cg::this_grid().sync(); bar = xcd_barrier_post(barw, MISC + 8); }
    for (int rep_ = 0; rep_ < 1 + ((MK_DUP >> 1) & 1); ++rep_) if (IN(1)) {
        pg8::Gemm g{XN, (const bf16*)(ws + WS_WIN), M, NPROJ, D}; pg8::StaticOrder S; S.init(M, NPROJ, F.G, (int)blockIdx.x);
        pg8::EpiProj E{PROJ, NPROJ};
        pg8::gemm_phase<pg8::EpiProj, pg8::StaticOrder, true, true>(F.lds, g, S, E);
        phase_z(F, XN, (const bf16*)(ws + WS_WIN) + (size_t)NPROJ * D, Z);
    }
    SEAM(1);
    for (int rep_ = 0; rep_ < 1 + ((MK_DUP >> 2) & 1); ++rep_) if (IN(2)) {
        for (int u = F.vcu; u < 1024 + 2048; u += F.G) {
            if (u < 1024) gla_a_unit(F, PROJ, Z, a.in[4], a.in[5], a.in[6], a.in[7], CON, DEC, u);
            else natten_unit(F, PROJ, a.in[3], Yb, u - 1024);
        }
    }
    SEAM(2);
    for (int rep_ = 0; rep_ < 1 + ((MK_DUP >> 3) & 1); ++rep_) if (IN(3)) phase_scan(F, CON, DEC, SP);
    SEAM(3);
    for (int rep_ = 0; rep_ < 1 + ((MK_DUP >> 4) & 1); ++rep_) if (IN(4)) { for (int u = F.vcu; u < 1024; u += F.G) gla_c_unit(F, PROJ, Z, a.in[4], a.in[5], a.in[6], a.in[7], SP, a.in[8], Yb, u); }
    SEAM(4);
    if (IN(5)) {
        pg8::Gemm g{Yb, (const bf16*)(ws + WS_WO), M, D, D}; pg8::StaticOrder S; S.init(M, D, F.G, (int)blockIdx.x);
        pg8::EpiRes E{x, a.out, HB, SS2, D};
        pg8::gemm_phase<pg8::EpiRes, pg8::StaticOrder, false, true>(F.lds, g, S, E);
    }
    SEAM(5);
    for (int rep_ = 0; rep_ < 1 + ((MK_DUP >> 6) & 1); ++rep_) if (IN(6)) {
        pg8::Gemm g{HB, (const bf16*)(ws + WS_W1), M, FF, D}; pg8::StaticOrder S; S.init(M, FF, F.G, (int)blockIdx.x);
        pg8::EpiFF1 E{ACT, FF, SS2, 1.0f / D, EPS};
        pg8::gemm_phase<pg8::EpiFF1, pg8::StaticOrder, true, true>(F.lds, g, S, E);
    }
    SEAM(6);
    if (IN(7)) {
        pg8::Gemm g{ACT, (const bf16*)(ws + WS_W2), M, D, FF}; pg8::StaticOrder S; S.init(M, D, F.G, (int)blockIdx.x);
        pg8::EpiRes E{a.out, a.out, nullptr, SS3, D};
        pg8::gemm_phase<pg8::EpiRes, pg8::StaticOrder, false, true>(F.lds, g, S, E);
    }
    SEAM(7);
    if (IN(8)) phase_final(F, a.out, SS3, a.in[13]);
#undef IN
#undef SEAM
}

#ifndef MK_ONE_LAUNCH
#define MK_ONE_LAUNCH 1
#endif
extern "C" void kernel_launch(void* const* d_in, const int* in_sizes, int n_in, void* d_out, int out_size, void* d_ws, size_t ws_size, hipStream_t stream) {
    static int grid = 0;
    if (grid == 0) {
        if (n_in != 14 || out_size != M * D || ws_size < WS_END) { fprintf(stderr, "kernel_launch: unexpected shapes (n_in %d out %d ws %zu)\n", n_in, out_size, ws_size); grid = -1; return; }
        int dev = 0, cus = 0, per_cu = 0;
        hipGetDevice(&dev); hipDeviceGetAttribute(&cus, hipDeviceAttributeMultiprocessorCount, dev);
        if (hipFuncSetAttribute((const void*)mk_fwd, hipFuncAttributeMaxDynamicSharedMemorySize, LDS_BYTES) != hipSuccess) { fprintf(stderr, "kernel_launch: hipFuncSetAttribute failed\n"); grid = -1; return; }
        if (hipOccupancyMaxActiveBlocksPerMultiprocessor(&per_cu, (const void*)mk_fwd, NTHR, LDS_BYTES) != hipSuccess || per_cu < 1) { fprintf(stderr, "kernel_launch: occupancy query says %d\n", per_cu); per_cu = 1; }
        (void)hipGetLastError();
        grid = cus * 1;
    }
    if (grid < 0) return;
    Args a{};
    for (int i = 0; i < 14; ++i) a.in[i] = (const float*)d_in[i];
    a.out = (float*)d_out; a.ws = (unsigned char*)d_ws;
#if MK_ONE_LAUNCH
    a.lo = 0; a.hi = NPHASE;
    void* args[] = {&a};
    hipError_t e = hipLaunchCooperativeKernel((const void*)mk_fwd, dim3(grid), dim3(NTHR), args, LDS_BYTES, stream);
    if (e != hipSuccess) fprintf(stderr, "cooperative launch failed: %s (grid %d)\n", hipGetErrorString(e), grid);
#else
    for (int p = 0; p < NPHASE; ++p) { a.lo = p; a.hi = p + 1; hipLaunchKernelGGL(mk_fwd, dim3(grid), dim3(NTHR), LDS_BYTES, stream, a); }
#endif
}
```

```cpp
#include <hip/hip_runtime.h>
#include <hip/hip_cooperative_groups.h>
#include <cstdio>
#include <cstdint>
#include <cmath>
namespace cg = cooperative_groups;
namespace pg8 {
#define PG8_LAS __attribute__((address_space(3)))
typedef unsigned short bf16_t;
typedef short bf16x8 __attribute__((ext_vector_type(8)));
typedef float f32x4 __attribute__((ext_vector_type(4)));
typedef unsigned u32x4 __attribute__((ext_vector_type(4)));
constexpr int BM = 256, BK = 64, HALF = 128, HTB = HALF * BK * 2  , STAGE_BYTES = 8 * HTB, NXCD = 8, WGM = 8;

__host__ __device__ __forceinline__ int lds_byte(int r, int c) { const int st = (r >> 4) * 2 + (c >> 5), rr = r & 15, cc = c & 31, ob = rr * 64 + cc * 2; return st * 1024 + (ob ^ (((ob >> 9) & 1) << 5)); }
__host__ __device__ __forceinline__ void stage_rc(int b, int& R, int& C) { const int st = b / 1024, sb = b % 1024, swz = sb ^ (((sb >> 9) & 1) << 5); R = (st >> 1) * 16 + swz / 64; C = (st & 1) * 32 + (swz % 64) / 2; }
__host__ __device__ __forceinline__ int perm32(int rho) { const int n = rho >> 4, i = rho & 15; return 8 * (i >> 2) + 4 * n + (i & 3); }

struct Unit { int pm, pn; };
struct Gemm { const bf16_t* A; const bf16_t* Bt; int M, N, K; };

struct StaticOrder {
    int nM, nN, nwg, G, c;
    __host__ __device__ void init(int M, int N, int G_, int c_) { nM = M / BM; nN = N / BM; nwg = nM * nN; G = G_; c = c_; }
    __host__ __device__ bool next(int i, Unit& u) const {
        const long L = (long)i * G + c; if (L >= nwg) return false;
        int wgid = (int)L; { const int q = nwg / NXCD, r = nwg % NXCD, xcd = wgid % NXCD, off = wgid / NXCD; wgid = (xcd < r ? xcd * (q + 1) : r * (q + 1) + (xcd - r) * q) + off; }
        const int nig = WGM * nN, gid = wgid / nig, fm = gid * WGM, gsz = (nM - fm) < WGM ? (nM - fm) : WGM;
        u.pm = fm + ((wgid % nig) % gsz); u.pn = (wgid % nig) / gsz; return true;
    }
    __device__ __forceinline__ void a_ready(const Unit&) const {}
    __device__ __forceinline__ void done(const Unit&) const {}
};

__device__ __forceinline__ unsigned cvt_pk_bf16(float lo, float hi) { unsigned r; asm volatile("v_cvt_pk_bf16_f32 %0, %1, %2" : "=v"(r) : "v"(lo), "v"(hi)); return r; }
typedef unsigned u32x2 __attribute__((ext_vector_type(2)));
struct EpiProj {
    static constexpr bool PERM = true, AFTER_DRAIN = false;
    bf16_t* O; int ldc;
    __device__ __forceinline__ void operator()(const f32x4 (&acc)[2][2][4][2], const Unit& u, int wr, int wc, int fr, int fq) const {
        const int row0 = u.pm * BM + wr * 64 + fr, col0 = u.pn * BM + wc * 32 + 8 * fq;
#pragma unroll
        for (int ai = 0; ai < 2; ++ai)
#pragma unroll
            for (int m = 0; m < 4; ++m) { bf16_t* rowp = O + (size_t)(row0 + ai * HALF + m * 16) * ldc + col0;
#pragma unroll
                for (int bj = 0; bj < 2; ++bj) { const f32x4 v0 = acc[ai][bj][m][0], v1 = acc[ai][bj][m][1];
                    u32x4 w; w.x = cvt_pk_bf16(v0[0], v0[1]); w.y = cvt_pk_bf16(v0[2], v0[3]); w.z = cvt_pk_bf16(v1[0], v1[1]); w.w = cvt_pk_bf16(v1[2], v1[3]);
                    *(u32x4*)(rowp + bj * HALF) = w; } }
    }
};
struct EpiFF1 {
    static constexpr bool PERM = true, AFTER_DRAIN = false;
    bf16_t* O; int ldc; const float* sumsq; float inv_n, eps;
    __device__ __forceinline__ void operator()(const f32x4 (&acc)[2][2][4][2], const Unit& u, int wr, int wc, int fr, int fq) const {
        const int row0 = u.pm * BM + wr * 64 + fr, col0 = u.pn * BM + wc * 32 + 8 * fq;
#pragma unroll
        for (int ai = 0; ai < 2; ++ai)
#pragma unroll
            for (int m = 0; m < 4; ++m) { const int row = row0 + ai * HALF + m * 16; bf16_t* rowp = O + (size_t)row * ldc + col0;
                const float rs = 1.0f / sqrtf(sumsq[row] * inv_n + eps);
#pragma unroll
                for (int bj = 0; bj < 2; ++bj) { f32x4 v0 = acc[ai][bj][m][0] * rs, v1 = acc[ai][bj][m][1] * rs;
#pragma unroll
                    for (int e = 0; e < 4; ++e) { const float a = fmaxf(v0[e], 0.f), b = fmaxf(v1[e], 0.f); v0[e] = a * a; v1[e] = b * b; }
                    u32x4 w; w.x = cvt_pk_bf16(v0[0], v0[1]); w.y = cvt_pk_bf16(v0[2], v0[3]); w.z = cvt_pk_bf16(v1[0], v1[1]); w.w = cvt_pk_bf16(v1[2], v1[3]);
                    *(u32x4*)(rowp + bj * HALF) = w; } }
    }
};
struct EpiRes {
    static constexpr bool PERM = false, AFTER_DRAIN = false;
    const float* base; float* out; bf16_t* hb; float* sumsq; int ldc;
    __device__ __forceinline__ void operator()(const f32x4 (&acc)[2][2][4][2], const Unit& u, int wr, int wc, int fr, int fq) const {
        const int col0 = u.pn * BM + wc * 32 + 4 * fq;
#pragma unroll
        for (int ai = 0; ai < 2; ++ai)
#pragma unroll
            for (int m = 0; m < 4; ++m) { const int row = u.pm * BM + ai * HALF + wr * 64 + m * 16 + fr; const size_t off = (size_t)row * ldc + col0; float s = 0.f;
#pragma unroll
                for (int bj = 0; bj < 2; ++bj)
#pragma unroll
                    for (int n = 0; n < 2; ++n) { const f32x4 bs = *(const f32x4*)(base + off + bj * HALF + n * 16); const f32x4 o = bs + acc[ai][bj][m][n];
                        *(f32x4*)(out + off + bj * HALF + n * 16) = o;
                        if (hb) { u32x2 w; w.x = cvt_pk_bf16(o[0], o[1]); w.y = cvt_pk_bf16(o[2], o[3]); *(u32x2*)(hb + off + bj * HALF + n * 16) = w; }
                        s += (o[0] * o[0] + o[1] * o[1]) + (o[2] * o[2] + o[3] * o[3]); }
                s += __shfl_xor(s, 16); s += __shfl_xor(s, 32);
                if (fq == 0) unsafeAtomicAdd(sumsq + row, s);
                asm volatile("" ::: "memory"); }
    }
};
template <class Epi, class Sched, bool ALIGN_EPI = false, bool SP2 = false>
__device__ __forceinline__ void gemm_phase(PG8_LAS unsigned char* lds, const Gemm g, const Sched& S, const Epi& E) {
    const int tid = threadIdx.x, wid = __builtin_amdgcn_readfirstlane(tid >> 6), lane = tid & 63, wr = wid >> 2, wc = wid & 3, fr = lane & 15, fq = lane >> 4;
    const int K = g.K, nt = K / BK;
    unsigned voffA[2], voffB[2];
#pragma unroll
    for (int i = 0; i < 2; ++i) { int R, C; stage_rc(tid * 16 + i * 8192, R, C); const int Rb = Epi::PERM ? ((R & ~31) + perm32(R & 31)) : R;
        voffA[i] = (unsigned)(R * K + C) * 2u; voffB[i] = (unsigned)(Rb * K + C) * 2u; }
    const size_t kstep = (size_t)(BK * 2);
    const size_t hstep = (size_t)HALF * K * 2;
    const size_t tstep = 2 * hstep;
    const unsigned ldsw = (unsigned)wid * 1024u;
    const int aoff = lds_byte(wr * 64 + fr, fq * 8), boff = lds_byte(wc * 32 + fr, fq * 8);
#define PG8_SA(b, h) (((b) * 2 + (h)) * HTB)
#define PG8_SB(b, h) ((4 + (b) * 2 + (h)) * HTB)
#define PG8_STAGE(bufoff, gbase, voff) do { _Pragma("unroll") for (int _i = 0; _i < 2; ++_i) \
        __builtin_amdgcn_global_load_lds((const unsigned*)((const char*)(gbase) + (voff)[_i]), (PG8_LAS unsigned*)(lds + (bufoff) + ldsw + _i * 8192), 16, 0, 0); } while (0)
#define PG8_LDA(dst, b, h) do { _Pragma("unroll") for (int m = 0; m < 4; ++m) _Pragma("unroll") for (int k = 0; k < 2; ++k) dst[m][k] = *(const PG8_LAS bf16x8*)(lds + PG8_SA(b, h) + aoff + m * 2048 + k * 1024); } while (0)
#define PG8_LDB(dst, b, h) do { _Pragma("unroll") for (int n = 0; n < 2; ++n) _Pragma("unroll") for (int k = 0; k < 2; ++k) dst[n][k] = *(const PG8_LAS bf16x8*)(lds + PG8_SB(b, h) + boff + n * 2048 + k * 1024); } while (0)
#define PG8_MMA(ai, bj, At, Bt) do { __builtin_amdgcn_s_setprio(1); _Pragma("unroll") for (int m = 0; m < 4; ++m) _Pragma("unroll") for (int n = 0; n < 2; ++n) _Pragma("unroll") for (int k = 0; k < 2; ++k) \
        acc[ai][bj][m][n] = __builtin_amdgcn_mfma_f32_16x16x32_bf16(Bt[n][k], At[m][k], acc[ai][bj][m][n], 0, 0, 0); __builtin_amdgcn_s_setprio(0); } while (0)
#define PG8_WAIT_V(n) asm volatile("s_waitcnt vmcnt(" #n ")" ::: "memory")
#define PG8_WAIT_L(n) asm volatile("s_waitcnt lgkmcnt(" #n ")" ::: "memory")
#define PG8_BAR __builtin_amdgcn_s_barrier()
#define PG8_SCHED __builtin_amdgcn_sched_barrier(0)
    Unit cur, nxt; int ui = 0;
    if (!S.next(0, cur)) return;
    f32x4 acc[2][2][4][2];
#pragma unroll
    for (int a = 0; a < 2; ++a)
#pragma unroll
        for (int b = 0; b < 2; ++b)
#pragma unroll
            for (int m = 0; m < 4; ++m)
#pragma unroll
                for (int n = 0; n < 2; ++n) acc[a][b][m][n] = (f32x4){0.f, 0.f, 0.f, 0.f};
    bf16x8 At[4][2], B0[2][2], B1[2][2];
    const char* cA = (const char*)g.A + (size_t)cur.pm * tstep; const char* cB = (const char*)g.Bt + (size_t)cur.pn * tstep;
    S.a_ready(cur);
    if constexpr (SP2) {
        PG8_STAGE(PG8_SB(0, 0), cB, voffB); PG8_STAGE(PG8_SB(0, 1), cB + hstep, voffB); PG8_STAGE(PG8_SA(0, 0), cA, voffA); PG8_STAGE(PG8_SA(0, 1), cA + hstep, voffA);
        if (wr == 1) PG8_BAR;
        PG8_WAIT_V(2); PG8_BAR;
        PG8_STAGE(PG8_SB(1, 0), cB + kstep, voffB); PG8_STAGE(PG8_SA(1, 0), cA + kstep, voffA); PG8_STAGE(PG8_SB(1, 1), cB + hstep + kstep, voffB);
        PG8_WAIT_V(6); PG8_BAR;
    } else {
        PG8_STAGE(PG8_SB(0, 0), cB, voffB); PG8_STAGE(PG8_SA(0, 0), cA, voffA); PG8_STAGE(PG8_SB(0, 1), cB + hstep, voffB); PG8_STAGE(PG8_SA(0, 1), cA + hstep, voffA);
        if (wr == 1) PG8_BAR;
        PG8_WAIT_V(4); PG8_BAR;
        PG8_STAGE(PG8_SB(1, 0), cB + kstep, voffB); PG8_STAGE(PG8_SA(1, 0), cA + kstep, voffA); PG8_STAGE(PG8_SB(1, 1), cB + hstep + kstep, voffB);
        PG8_WAIT_V(6); PG8_BAR;
    }
    for (;;) {
        const bool has_next = S.next(ui + 1, nxt);
        const char* nA = has_next ? (const char*)g.A + (size_t)nxt.pm * tstep : cA; const char* nB = has_next ? (const char*)g.Bt + (size_t)nxt.pn * tstep : cB;
        for (int t = 0; t < nt; t += 2) {
            const bool last = (t == nt - 2);
            const char* a1 = cA + (size_t)(t + 1) * kstep;
            const char* a2 = last ? nA : cA + (size_t)(t + 2) * kstep; const char* b2 = last ? nB : cB + (size_t)(t + 2) * kstep;
            const char* a3 = a2 + kstep; const char* b3 = b2 + kstep;
            if (last && has_next) S.a_ready(nxt);
            if constexpr (SP2) {
            PG8_LDB(B0, 0, 0); PG8_LDB(B1, 0, 1); PG8_SCHED; PG8_LDA(At, 0, 0); PG8_STAGE(PG8_SA(1, 1), a1 + hstep, voffA);
            PG8_WAIT_V(8); PG8_WAIT_L(0); PG8_BAR; PG8_MMA(0, 0, At, B0); PG8_MMA(0, 1, At, B1); PG8_BAR; PG8_SCHED;
            PG8_LDA(At, 0, 1); PG8_STAGE(PG8_SB(0, 0), b2, voffB); PG8_STAGE(PG8_SB(0, 1), b2 + hstep, voffB); PG8_STAGE(PG8_SA(0, 0), a2, voffA);
            PG8_WAIT_V(8); PG8_WAIT_L(0); PG8_BAR; PG8_MMA(1, 0, At, B0); PG8_MMA(1, 1, At, B1); PG8_BAR; PG8_SCHED;
            PG8_LDB(B0, 1, 0); PG8_LDB(B1, 1, 1); PG8_SCHED; PG8_LDA(At, 1, 0); PG8_STAGE(PG8_SA(0, 1), a2 + hstep, voffA);
            PG8_WAIT_V(8); PG8_WAIT_L(0); PG8_BAR; PG8_MMA(0, 0, At, B0); PG8_MMA(0, 1, At, B1); PG8_BAR; PG8_SCHED;
            PG8_LDA(At, 1, 1); PG8_STAGE(PG8_SB(1, 0), b3, voffB); PG8_STAGE(PG8_SB(1, 1), b3 + hstep, voffB); PG8_STAGE(PG8_SA(1, 0), a3, voffA);
            PG8_WAIT_V(8); PG8_WAIT_L(0); PG8_BAR; PG8_MMA(1, 0, At, B0); PG8_MMA(1, 1, At, B1); PG8_BAR; PG8_SCHED;
            } else {
            PG8_LDB(B0, 0, 0); PG8_SCHED; PG8_LDA(At, 0, 0); PG8_STAGE(PG8_SA(1, 1), a1 + hstep, voffA);
            PG8_WAIT_L(8); PG8_BAR; PG8_WAIT_L(0); PG8_MMA(0, 0, At, B0); PG8_BAR; PG8_SCHED;
            PG8_LDB(B1, 0, 1); PG8_STAGE(PG8_SB(0, 0), b2, voffB);
            PG8_BAR; PG8_WAIT_L(0); PG8_MMA(0, 1, At, B1); PG8_BAR;
            PG8_LDA(At, 0, 1); PG8_STAGE(PG8_SA(0, 0), a2, voffA);
            PG8_BAR; PG8_WAIT_L(0); PG8_MMA(1, 0, At, B0); PG8_BAR; PG8_SCHED;
            PG8_STAGE(PG8_SB(0, 1), b2 + hstep, voffB);
            PG8_WAIT_V(6); PG8_BAR; PG8_MMA(1, 1, At, B1); PG8_BAR;
            PG8_LDB(B0, 1, 0); PG8_SCHED; PG8_LDA(At, 1, 0); PG8_STAGE(PG8_SA(0, 1), a2 + hstep, voffA);
            PG8_WAIT_L(8); PG8_BAR; PG8_WAIT_L(0); PG8_MMA(0, 0, At, B0); PG8_BAR; PG8_SCHED;
            PG8_LDB(B1, 1, 1); PG8_STAGE(PG8_SB(1, 0), b3, voffB);
            PG8_BAR; PG8_WAIT_L(0); PG8_MMA(0, 1, At, B1); PG8_BAR;
            PG8_LDA(At, 1, 1); PG8_STAGE(PG8_SA(1, 0), a3, voffA);
            PG8_BAR; PG8_WAIT_L(0); PG8_MMA(1, 0, At, B0); PG8_BAR; PG8_SCHED;
            PG8_STAGE(PG8_SB(1, 1), b3 + hstep, voffB);
            PG8_WAIT_V(6); PG8_BAR; PG8_MMA(1, 1, At, B1); PG8_BAR;
            }
        }
        if constexpr (ALIGN_EPI) { if (wr == 0) PG8_BAR; }
        if constexpr (!Epi::AFTER_DRAIN) { E(acc, cur, wr, wc, fr, fq); S.done(cur); }
        if (!has_next) break;
#pragma unroll
        for (int a = 0; a < 2; ++a)
#pragma unroll
            for (int b = 0; b < 2; ++b)
#pragma unroll
                for (int m = 0; m < 4; ++m)
#pragma unroll
                    for (int n = 0; n < 2; ++n) acc[a][b][m][n] = (f32x4){0.f, 0.f, 0.f, 0.f};
        cur = nxt; cA = nA; cB = nB; ++ui;
        if constexpr (ALIGN_EPI) { if (wr == 1) PG8_BAR; }
    }
    PG8_WAIT_V(0);
    if constexpr (!ALIGN_EPI) { if (wr == 0) PG8_BAR; }
    PG8_BAR;
    if constexpr (Epi::AFTER_DRAIN) { E.fused(acc, cur, wr, wc, fr, fq, lds, wid, lane); S.done(cur); }
#undef PG8_SA
#undef PG8_SB
#undef PG8_STAGE
#undef PG8_LDA
#undef PG8_LDB
#undef PG8_MMA
#undef PG8_WAIT_V
#undef PG8_WAIT_L
#undef PG8_BAR
#undef PG8_SCHED
}
}
#define GAS __attribute__((address_space(1)))
#define LAS __attribute__((address_space(3)))
typedef unsigned short bf16;
typedef unsigned v4u __attribute__((ext_vector_type(4)));
typedef unsigned v2u __attribute__((ext_vector_type(2)));
typedef float f32x4 __attribute__((ext_vector_type(4)));
typedef short bf16x8 __attribute__((ext_vector_type(8)));
typedef short s16x4 __attribute__((ext_vector_type(4)));

constexpr int NWAVES = 8, NTHR = 512;
constexpr int T = 8192, D = 1024, M = 16384, NPROJ = 3072, DIN = 3104, FF = 4096;
constexpr float EPS = 1e-6f;
constexpr int C_QA = 0, C_KA = 512, C_VA = 1024, C_QG = 1536, C_KG = 1792, C_VG = 2048, C_RG = 2560;

constexpr size_t MiB = 1u << 20;
constexpr size_t WS_SS2 = 0, WS_SS3 = 65536, WS_BAR = 131072, WS_DEC = 262144, WS_Z = 1 * MiB;
constexpr size_t WS_WIN = 4 * MiB, WS_WO = 11 * MiB, WS_W1 = 13 * MiB, WS_W2 = 21 * MiB;
constexpr size_t WS_XN = 32 * MiB, WS_Y = 32 * MiB, WS_PROJ = 64 * MiB, WS_CON = 160 * MiB, WS_SP = 224 * MiB;
constexpr size_t WS_HB = 64 * MiB, WS_ACT = 96 * MiB, WS_END = 256 * MiB;
constexpr int LDS_BYTES = 155648;

__device__ __forceinline__ unsigned f2bf(float f) { unsigned u = __builtin_bit_cast(unsigned, f); return (u + 0x7fffu + ((u >> 16) & 1u)) >> 16; }
__device__ __forceinline__ unsigned pk2(float lo, float hi) { return f2bf(lo) | (f2bf(hi) << 16); }
__device__ __forceinline__ float bf2f(unsigned short h) { return __builtin_bit_cast(float, (unsigned)h << 16); }
__device__ __forceinline__ float wave_sum(float v) {
#pragma unroll
    for (int o = 1; o < 64; o <<= 1) v += __shfl_xor(v, o);
    return v;
}
__device__ __forceinline__ f32x4 mfma16(bf16x8 x, bf16x8 y, f32x4 c) { return __builtin_amdgcn_mfma_f32_16x16x32_bf16(x, y, c, 0, 0, 0); }
typedef short v4i16_t __attribute__((ext_vector_type(4)));
__device__ __forceinline__ s16x4 tr4(const LAS unsigned char* p) { return __builtin_bit_cast(s16x4, __builtin_amdgcn_ds_read_tr16_b64_v4i16((LAS v4i16_t*)p)); }
__device__ __forceinline__ bf16x8 cat8(s16x4 a, s16x4 b) { bf16x8 r; r[0] = a[0]; r[1] = a[1]; r[2] = a[2]; r[3] = a[3]; r[4] = b[0]; r[5] = b[1]; r[6] = b[2]; r[7] = b[3]; return r; }
__device__ __forceinline__ bf16x8 pack8(f32x4 a, f32x4 b) {
    v4u w; w.x = pg8::cvt_pk_bf16(a[0], a[1]); w.y = pg8::cvt_pk_bf16(a[2], a[3]); w.z = pg8::cvt_pk_bf16(b[0], b[1]); w.w = pg8::cvt_pk_bf16(b[2], b[3]);
    return __builtin_bit_cast(bf16x8, w);
}

struct Frame {
    LAS unsigned char* lds;
    int tid, lane, wave, vcu, G;
};

__device__ __forceinline__ void p0_transpose_item(const float* W, int K, int N, bf16* WT, const float* gk, LAS float* scr, int item, int lane) {
    const int nblk = N / 32, kb = item / nblk, nb = item % nblk, k0 = 64 * kb, n0 = 32 * nb;
#pragma unroll 8
    for (int i = 0; i < 32; ++i) { const int kk = 2 * i + (lane >> 5); float v = W[(size_t)(k0 + kk) * N + n0 + (lane & 31)]; if (gk) v *= gk[k0 + kk]; scr[kk * 33 + (lane & 31)] = v; }
    asm volatile("s_waitcnt lgkmcnt(0)" ::: "memory");
    const int c = lane & 7;
#pragma unroll
    for (int j = 0; j < 4; ++j) { const int n = (lane >> 3) + 8 * j; const LAS float* s = scr + (8 * c) * 33 + n;
        v4u o; o.x = pk2(s[0 * 33], s[1 * 33]); o.y = pk2(s[2 * 33], s[3 * 33]); o.z = pk2(s[4 * 33], s[5 * 33]); o.w = pk2(s[6 * 33], s[7 * 33]);
        *(v4u*)(WT + (size_t)(n0 + n) * K + k0 + 8 * c) = o; }
    asm volatile("s_waitcnt lgkmcnt(0)" ::: "memory");
}
__device__ __forceinline__ void phase_prologue(const Frame& F, const float* x, const float* g_mix, const float* w_in, const float* w_out, const float* g_ff, const float* w1, const float* w2, unsigned char* ws) {
    LAS float* scr = (LAS float*)(F.lds + F.wave * 16384);
    const int gw = F.vcu * NWAVES + F.wave, NGW = F.G * NWAVES;
    constexpr int I_IN = (D / 64) * (DIN / 32), I_O = (D / 64) * (D / 32), I_1 = (D / 64) * (FF / 32), I_2 = (FF / 64) * (D / 32);
    constexpr int NITEMS = I_IN + I_O + I_1 + I_2;
    for (int it = gw; it < NITEMS; it += NGW) {
        int r = it;
        if (r < I_IN) { p0_transpose_item(w_in, D, DIN, (bf16*)(ws + WS_WIN), nullptr, scr, r, F.lane); continue; } r -= I_IN;
        if (r < I_O) { p0_transpose_item(w_out, D, D, (bf16*)(ws + WS_WO), nullptr, scr, r, F.lane); continue; } r -= I_O;
        if (r < I_1) { p0_transpose_item(w1, D, FF, (bf16*)(ws + WS_W1), g_ff, scr, r, F.lane); continue; } r -= I_1;
        p0_transpose_item(w2, FF, D, (bf16*)(ws + WS_W2), nullptr, scr, r, F.lane);
    }
    { float* ss = (float*)(ws + WS_SS2); for (int i = (F.vcu * NTHR + F.tid); i < 2 * M; i += F.G * NTHR) ss[i] = 0.f; }
    bf16* XN = (bf16*)(ws + WS_XN);
    f32x4 gv[4];
#pragma unroll
    for (int j = 0; j < 4; ++j) gv[j] = ((const f32x4*)g_mix)[F.lane + 64 * j];
    for (int m = gw; m < M; m += NGW) {
        const f32x4* xr = (const f32x4*)(x + (size_t)m * D) + F.lane;
        f32x4 v[4]; float s = 0.f;
#pragma unroll
        for (int j = 0; j < 4; ++j) { v[j] = xr[64 * j]; s += (v[j].x * v[j].x + v[j].y * v[j].y) + (v[j].z * v[j].z + v[j].w * v[j].w); }
        const float rs = 1.0f / sqrtf(wave_sum(s) * (1.f / D) + EPS);
        unsigned long long* o8 = (unsigned long long*)(XN + (size_t)m * D) + F.lane;
#pragma unroll
        for (int j = 0; j < 4; ++j) { const f32x4 o = v[j] * rs * gv[j]; o8[64 * j] = (unsigned long long)pk2(o.x, o.y) | ((unsigned long long)pk2(o.z, o.w) << 32); }
    }
}

__device__ __forceinline__ void phase_z(const Frame& F, const bf16* XN, const bf16* Wz, float* Z) {
    const int fr = F.lane & 15, fq = F.lane >> 4, mt = F.wave & 3, nt = F.wave >> 2;
    for (int rb = F.vcu; rb < M / 64; rb += F.G) {
        const bf16* ap = XN + (size_t)(rb * 64 + mt * 16 + fr) * D + 8 * fq;
        const bf16* bp = Wz + (size_t)(nt * 16 + fr) * D + 8 * fq;
        f32x4 acc = {0.f, 0.f, 0.f, 0.f};
#pragma unroll 8
        for (int ks = 0; ks < D / 32; ++ks) { const bf16x8 a = *(const bf16x8*)(ap + ks * 32), b = *(const bf16x8*)(bp + ks * 32); acc = mfma16(b, a, acc); }
        *(f32x4*)(Z + (size_t)(rb * 64 + mt * 16 + fr) * 32 + nt * 16 + 4 * fq) = acc;
    }
}

constexpr int NA_STR = 144, NA_K_OFF = 0, NA_V_OFF = 512 * NA_STR, NA_RPB_OFF = 2 * 512 * NA_STR;
__device__ __forceinline__ void natten_unit(const Frame& F, const bf16* PROJ, const float* rpb, bf16* Y, int unit) {
    LAS unsigned char* lds = F.lds;
    const int r = unit & 127, h = (unit >> 7) & 7, b = unit >> 10;
    const int rs = min(max(r - 4, 0), 120);
    const size_t tokq0 = (size_t)b * T + r * 64, tokk0 = (size_t)b * T + rs * 64;
#pragma unroll
    for (int it = 0; it < 8; ++it) { const int id = F.tid + NTHR * it, key = id >> 3, ch = id & 7;
        const bf16* src = PROJ + (tokk0 + key) * NPROJ + C_KA + h * 64 + ch * 8;
        const v4u kv = *(const v4u*)src, vv = *(const v4u*)(src + (C_VA - C_KA));
        *(LAS v4u*)(lds + NA_K_OFF + key * NA_STR + ch * 16) = kv; *(LAS v4u*)(lds + NA_V_OFF + key * NA_STR + ch * 16) = vv; }
    if (F.tid < 465) ((LAS float*)(lds + NA_RPB_OFF))[F.tid] = rpb[h * 465 + F.tid];
    const int fr = F.lane & 15, fq = F.lane >> 4, jq = F.wave & 3, dh = F.wave >> 2;
    const int wc0 = (jq == 0) ? 0 : (jq == 1) ? 8 : (jq == 2) ? 24 : 32;
    bf16x8 qf[2];
    { const bf16* qp = PROJ + (tokq0 + 16 * jq + fr) * NPROJ + C_QA + h * 64 + 8 * fq; qf[0] = *(const bf16x8*)qp; qf[1] = *(const bf16x8*)(qp + 32); }
    __syncthreads();
    f32x4 s[16];
#pragma unroll
    for (int i = 0; i < 8; ++i)
#pragma unroll
        for (int ct = 0; ct < 2; ++ct) {
            const LAS unsigned char* kp = lds + NA_K_OFF + (i * 64 + wc0 + 16 * ct + fr) * NA_STR + fq * 16;
            const bf16x8 k0 = *(const LAS bf16x8*)kp, k1 = *(const LAS bf16x8*)(kp + 64);
            f32x4 a = {0.f, 0.f, 0.f, 0.f}; a = mfma16(k0, qf[0], a); a = mfma16(k1, qf[1], a); s[i * 2 + ct] = a; }
    const int cq = 16 * jq + fr, cs = min(max(cq - 8, 0), 48);
    const LAS float* rp = (const LAS float*)(lds + NA_RPB_OFF);
    float mx = -INFINITY;
#pragma unroll
    for (int i = 0; i < 8; ++i) { const int dr = rs + i - r + 7;
#pragma unroll
        for (int ct = 0; ct < 2; ++ct)
#pragma unroll
            for (int e = 0; e < 4; ++e) { const int ck = wc0 + 16 * ct + 4 * fq + e; const bool in = (ck >= cs) && (ck < cs + 16);
                const int dc = min(max(ck - cq + 15, 0), 30);
                const float v = in ? s[i * 2 + ct][e] * 0.125f + rp[dr * 31 + dc] : -INFINITY; s[i * 2 + ct][e] = v; mx = fmaxf(mx, v); } }
    mx = fmaxf(mx, __shfl_xor(mx, 16)); mx = fmaxf(mx, __shfl_xor(mx, 32));
    float l = 0.f;
#pragma unroll
    for (int t = 0; t < 16; ++t)
#pragma unroll
        for (int e = 0; e < 4; ++e) { const float p = __expf(s[t][e] - mx); s[t][e] = p; l += p; }
    l += __shfl_xor(l, 16); l += __shfl_xor(l, 32);
    f32x4 o[2] = {{0.f, 0.f, 0.f, 0.f}, {0.f, 0.f, 0.f, 0.f}};
#pragma unroll
    for (int i = 0; i < 8; ++i) { const bf16x8 pb = pack8(s[2 * i], s[2 * i + 1]);
#pragma unroll
        for (int dt = 0; dt < 2; ++dt) { const int d0 = 32 * dh + 16 * dt;
            const LAS unsigned char* vp = lds + NA_V_OFF + (i * 64 + wc0 + 4 * fq + (fr >> 2)) * NA_STR + (d0 + 4 * (fr & 3)) * 2;
            const bf16x8 x = cat8(tr4(vp), tr4(vp + 16 * NA_STR)); o[dt] = mfma16(x, pb, o[dt]); } }
    const float inv = 1.0f / l;
#pragma unroll
    for (int dt = 0; dt < 2; ++dt) { v2u w; w.x = pg8::cvt_pk_bf16(o[dt][0] * inv, o[dt][1] * inv); w.y = pg8::cvt_pk_bf16(o[dt][2] * inv, o[dt][3] * inv);
        *(v2u*)(Y + (tokq0 + 16 * jq + fr) * D + h * 64 + 32 * dh + 16 * dt + 4 * fq) = w; }
    __syncthreads();
}

constexpr int GL_Z = 0, GL_GU = 8192, GL_GB = 16384, GL_GT = 16896, GL_I0 = 20992;
constexpr int IS = 144, IMG = 64 * IS;
constexpr int VS = 272, VIMG = 64 * VS;
constexpr int GL_QF = GL_I0, GL_QB = GL_I0 + IMG, GL_KF = GL_I0 + 2 * IMG, GL_KB = GL_I0 + 3 * IMG, GL_V = GL_I0 + 4 * IMG, GL_SF = GL_V + VIMG, GL_SB = GL_SF + VIMG;
static_assert(GL_SB + VIMG <= LDS_BYTES, "GLA LDS map");
__device__ __forceinline__ float logsig(float x) { return fminf(x, 0.f) - log1pf(__expf(-fabsf(x))); }

__device__ __forceinline__ void gla_gate(const Frame& F, const float* Z, const float* guf, const float* gbf, const float* gub, const float* gbb, int h, size_t t0,
                                         float (&bf)[8], float (&bb)[8], float& totf, float& totb) {
    LAS unsigned char* lds = F.lds; const int tid = F.tid, d = tid & 63, g = F.wave;
    *(LAS f32x4*)(lds + GL_Z + tid * 16) = *(const f32x4*)(Z + t0 * 32 + tid * 4);
    { const int idx = tid * 4, dir = idx >> 10, rr = (idx >> 6) & 15, dd = idx & 63; const float* src = (dir ? gub : guf) + rr * 256 + h * 64 + dd; *(LAS f32x4*)(lds + GL_GU + idx * 4) = *(const f32x4*)src; }
    if (tid < 128) { const int dir = tid >> 6, dd = tid & 63; ((LAS float*)(lds + GL_GB))[tid] = (dir ? gbb : gbf)[h * 64 + dd]; }
    __syncthreads();
    const LAS float* Zl = (const LAS float*)(lds + GL_Z); const LAS float* GU = (const LAS float*)(lds + GL_GU); const LAS float* GB = (const LAS float*)(lds + GL_GB);
    float uf[16], ub[16];
#pragma unroll
    for (int rr = 0; rr < 16; ++rr) { uf[rr] = GU[rr * 64 + d]; ub[rr] = GU[1024 + rr * 64 + d]; }
    const float gf0 = GB[d], gb0 = GB[64 + d];
    float laf[8], lab[8];
#pragma unroll
    for (int j = 0; j < 8; ++j) { const int c = 8 * g + j; float pf = gf0, pb = gb0;
#pragma unroll
        for (int rr = 0; rr < 16; ++rr) { pf += Zl[c * 32 + rr] * uf[rr]; pb += Zl[c * 32 + 16 + rr] * ub[rr]; }
        laf[j] = logsig(pf) * (1.0f / 16.0f); lab[j] = logsig(pb) * (1.0f / 16.0f); }
    float run = 0.f;
#pragma unroll
    for (int j = 0; j < 8; ++j) { run += laf[j]; bf[j] = run; }
    float runb = 0.f;
#pragma unroll
    for (int j = 7; j >= 0; --j) { runb += lab[j]; bb[j] = runb; }
    LAS float* GT = (LAS float*)(lds + GL_GT);
    GT[g * 64 + d] = run; GT[512 + g * 64 + d] = runb;
    __syncthreads();
    float of = 0.f, ob = 0.f; totf = 0.f; totb = 0.f;
#pragma unroll
    for (int gp = 0; gp < 8; ++gp) { const float a = GT[gp * 64 + d], c = GT[512 + gp * 64 + d]; totf += a; totb += c; if (gp < g) of += a; if (gp > g) ob += c; }
#pragma unroll
    for (int j = 0; j < 8; ++j) { bf[j] += of; bb[j] += ob; }
}
__device__ __forceinline__ void stage_img128(LAS unsigned char* dst, const bf16* src, size_t row_stride, int tid) {
#pragma unroll
    for (int it = 0; it < 2; ++it) { const int id = tid + NTHR * it, row = id >> 4, ch = id & 15; *(LAS v4u*)(dst + row * VS + ch * 16) = *(const v4u*)(src + (size_t)row * row_stride + ch * 8); }
}

__device__ __forceinline__ void gla_a_unit(const Frame& F, const bf16* PROJ, const float* Z, const float* guf, const float* gbf, const float* gub, const float* gbb, float* CON, float* DEC, int unit) {
    LAS unsigned char* lds = F.lds; const int tid = F.tid, d = tid & 63, g = F.wave;
    const int n = unit & 127, bh = unit >> 7, h = bh & 3, b = bh >> 2; const size_t t0 = (size_t)b * T + 64 * n;
    unsigned short kraw[8];
#pragma unroll
    for (int j = 0; j < 8; ++j) kraw[j] = PROJ[(t0 + 8 * g + j) * NPROJ + C_KG + h * 64 + d];
    stage_img128(lds + GL_V, PROJ + t0 * NPROJ + C_VG + h * 128, NPROJ, tid);
    float bf[8], bb[8], totf, totb;
    gla_gate(F, Z, guf, gbf, gub, gbb, h, t0, bf, bb, totf, totb);
#pragma unroll
    for (int j = 0; j < 8; ++j) { const float k = bf2f(kraw[j]); const int c = 8 * g + j;
        *(LAS unsigned short*)(lds + GL_KF + c * IS + d * 2) = (unsigned short)f2bf(k * __expf(totf - bf[j]));
        *(LAS unsigned short*)(lds + GL_KB + c * IS + d * 2) = (unsigned short)f2bf(k * __expf(totb - bb[j])); }
    if (g == 0) { DEC[(size_t)unit * 64 + d] = __expf(totf); DEC[(size_t)(1024 + unit) * 64 + d] = __expf(totb); }
    __syncthreads();
    const int fr = F.lane & 15, fq = F.lane >> 4, dir = F.wave >> 2, dt = F.wave & 3;
    const LAS unsigned char* kimg = lds + (dir ? GL_KB : GL_KF);
    bf16x8 yk[2];
#pragma unroll
    for (int s = 0; s < 2; ++s) { const LAS unsigned char* p = kimg + (32 * s + 4 * fq + (fr >> 2)) * IS + (16 * dt + 4 * (fr & 3)) * 2; yk[s] = cat8(tr4(p), tr4(p + 16 * IS)); }
    float* cbase = CON + ((size_t)(dir * 1024 + unit) * 64 + 16 * dt + fr) * 128 + 4 * fq;
#pragma unroll
    for (int et = 0; et < 8; ++et) { f32x4 acc = {0.f, 0.f, 0.f, 0.f};
#pragma unroll
        for (int s = 0; s < 2; ++s) { const LAS unsigned char* p = lds + GL_V + (32 * s + 4 * fq + (fr >> 2)) * VS + (16 * et + 4 * (fr & 3)) * 2; acc = mfma16(cat8(tr4(p), tr4(p + 16 * VS)), yk[s], acc); }
        *(f32x4*)(cbase + 16 * et) = acc; }
    __syncthreads();
}

__device__ __forceinline__ void phase_scan(const Frame& F, const float* __restrict__ CON, const float* __restrict__ DEC, bf16* __restrict__ SP) {
    for (int chain = F.vcu * NTHR + F.tid; chain < 2 * 8 * 64 * 128; chain += F.G * NTHR) {
        const int e = chain & 127, d = (chain >> 7) & 63, bh = (chain >> 13) & 7, dir = chain >> 16;
        const size_t ubase = (size_t)dir * 1024 + bh * 128;
        const float* con = CON + (ubase * 64 + d) * 128 + e; const float* dec = DEC + ubase * 64 + d; bf16* sp = SP + (ubase * 64 + d) * 128 + e;
        float S = 0.f;
        for (int nb = 0; nb < 16; ++nb) { float c[8], gg[8];
#pragma unroll
            for (int u = 0; u < 8; ++u) { const int n = nb * 8 + u, ne = dir ? 127 - n : n; c[u] = con[(size_t)ne * 8192]; gg[u] = dec[ne * 64]; }
#pragma unroll
            for (int u = 0; u < 8; ++u) { const int n = nb * 8 + u, ne = dir ? 127 - n : n; sp[(size_t)ne * 8192] = (bf16)f2bf(S); S = gg[u] * S + c[u]; } }
    }
}

__device__ __forceinline__ void gla_c_unit(const Frame& F, const bf16* PROJ, const float* Z, const float* guf, const float* gbf, const float* gub, const float* gbb, const bf16* SP, const float* norm_g, bf16* Y, int unit) {
    LAS unsigned char* lds = F.lds; const int tid = F.tid, d = tid & 63, g = F.wave;
    const int n = unit & 127, bh = unit >> 7, h = bh & 3, b = bh >> 2; const size_t t0 = (size_t)b * T + 64 * n;
    unsigned short kraw[8], qraw[8];
#pragma unroll
    for (int j = 0; j < 8; ++j) { const bf16* p = PROJ + (t0 + 8 * g + j) * NPROJ + h * 64 + d; qraw[j] = p[C_QG]; kraw[j] = p[C_KG]; }
    stage_img128(lds + GL_V, PROJ + t0 * NPROJ + C_VG + h * 128, NPROJ, tid);
    stage_img128(lds + GL_SF, SP + (size_t)unit * 8192, 128, tid);
    stage_img128(lds + GL_SB, SP + (size_t)(1024 + unit) * 8192, 128, tid);
    float bf[8], bb[8], totf, totb;
    gla_gate(F, Z, guf, gbf, gub, gbb, h, t0, bf, bb, totf, totb);
#pragma unroll
    for (int j = 0; j < 8; ++j) { const float k = bf2f(kraw[j]), q = bf2f(qraw[j]) * 0.125f; const int off = (8 * g + j) * IS + d * 2;
        const float ef = __expf(bf[j]), eb = __expf(bb[j]);
        *(LAS unsigned short*)(lds + GL_QF + off) = (unsigned short)f2bf(q * ef);
        *(LAS unsigned short*)(lds + GL_KF + off) = (unsigned short)f2bf(k / ef);
        *(LAS unsigned short*)(lds + GL_QB + off) = (unsigned short)f2bf(q * eb);
        *(LAS unsigned short*)(lds + GL_KB + off) = (unsigned short)f2bf(k / eb); }
    __syncthreads();
    if (F.wave < 4) {
        const int fr = F.lane & 15, fq = F.lane >> 4, it = F.wave;
        bf16x8 yqf[2], yqb[2];
#pragma unroll
        for (int s = 0; s < 2; ++s) { const int off = (16 * it + fr) * IS + (32 * s + 8 * fq) * 2; yqf[s] = *(const LAS bf16x8*)(lds + GL_QF + off); yqb[s] = *(const LAS bf16x8*)(lds + GL_QB + off); }
        f32x4 a[4];
        const int i = 16 * it + fr;
#pragma unroll
        for (int jt = 0; jt < 4; ++jt) { f32x4 af = {0.f, 0.f, 0.f, 0.f}, ab = {0.f, 0.f, 0.f, 0.f};
#pragma unroll
            for (int s = 0; s < 2; ++s) { const int off = (16 * jt + fr) * IS + (32 * s + 8 * fq) * 2;
                af = mfma16(*(const LAS bf16x8*)(lds + GL_KF + off), yqf[s], af); ab = mfma16(*(const LAS bf16x8*)(lds + GL_KB + off), yqb[s], ab); }
#pragma unroll
            for (int e = 0; e < 4; ++e) { const int j = 16 * jt + 4 * fq + e; a[jt][e] = (j <= i) ? af[e] : ab[e]; } }
        f32x4 o[8];
#pragma unroll
        for (int et = 0; et < 8; ++et) o[et] = (f32x4){0.f, 0.f, 0.f, 0.f};
#pragma unroll
        for (int s = 0; s < 2; ++s) { const bf16x8 pb = pack8(a[2 * s], a[2 * s + 1]);
#pragma unroll
            for (int et = 0; et < 8; ++et) { const LAS unsigned char* p = lds + GL_V + (32 * s + 4 * fq + (fr >> 2)) * VS + (16 * et + 4 * (fr & 3)) * 2; o[et] = mfma16(cat8(tr4(p), tr4(p + 16 * VS)), pb, o[et]); } }
#pragma unroll
        for (int s = 0; s < 2; ++s)
#pragma unroll
            for (int et = 0; et < 8; ++et) { const int off = (32 * s + 8 * fq + (fr >> 2)) * VS + (16 * et + 4 * (fr & 3)) * 2;
                o[et] = mfma16(cat8(tr4(lds + GL_SF + off), tr4(lds + GL_SF + off + 4 * VS)), yqf[s], o[et]);
                o[et] = mfma16(cat8(tr4(lds + GL_SB + off), tr4(lds + GL_SB + off + 4 * VS)), yqb[s], o[et]); }
        float ss = 0.f;
#pragma unroll
        for (int et = 0; et < 8; ++et) ss += (o[et][0] * o[et][0] + o[et][1] * o[et][1]) + (o[et][2] * o[et][2] + o[et][3] * o[et][3]);
        ss += __shfl_xor(ss, 16); ss += __shfl_xor(ss, 32);
        const float rs = 1.0f / sqrtf(ss * (1.0f / 128.0f) + EPS);
        const bf16* rp = PROJ + (t0 + i) * NPROJ + C_RG + h * 128 + 4 * fq; bf16* yp = Y + (t0 + i) * D + 512 + h * 128 + 4 * fq;
#pragma unroll
        for (int et = 0; et < 8; ++et) { const v2u rw = *(const v2u*)(rp + 16 * et); const f32x4 gn = *(const f32x4*)(norm_g + 16 * et + 4 * fq);
            float rv[4] = {__builtin_bit_cast(float, rw.x << 16), __builtin_bit_cast(float, rw.x & 0xffff0000u), __builtin_bit_cast(float, rw.y << 16), __builtin_bit_cast(float, rw.y & 0xffff0000u)};
            float ov[4];
#pragma unroll
            for (int e = 0; e < 4; ++e) { const float sg = rv[e] / (1.0f + __expf(-rv[e])); ov[e] = o[et][e] * rs * gn[e] * sg; }
            v2u w; w.x = pg8::cvt_pk_bf16(ov[0], ov[1]); w.y = pg8::cvt_pk_bf16(ov[2], ov[3]); *(v2u*)(yp + 16 * et) = w; }
    }
    __syncthreads();
}

__device__ __forceinline__ void phase_final(const Frame& F, float* out, const float* ss, const float* g) {
    const int gw = F.vcu * NWAVES + F.wave, NGW = F.G * NWAVES;
    f32x4 gv[4];
#pragma unroll
    for (int j = 0; j < 4; ++j) gv[j] = ((const f32x4*)g)[F.lane + 64 * j];
    for (int m = gw; m < M; m += NGW) { f32x4* xr = (f32x4*)(out + (size_t)m * D) + F.lane; const float rs = 1.0f / sqrtf(ss[m] * (1.f / D) + EPS);
#pragma unroll
        for (int j = 0; j < 4; ++j) xr[64 * j] = xr[64 * j] * rs * gv[j]; }
}

#define XB_TMO      128
#define XB_XCNT(j)  (256  + 64 * (j))
#define XB_XSUB(j)  (1280 + 64 * (j))
#define XB_XGEN(j)  (2304 + 64 * (j))
#define XB_TOP      3328
#define XB_TOPGEN   3392
#define XCD_BAR_WORDS 3456
#define XB_SPIN_CAP (1u << 18)

__device__ __forceinline__ unsigned xb_ld(unsigned* p)              { return __hip_atomic_load(p, __ATOMIC_RELAXED, __HIP_MEMORY_SCOPE_AGENT); }
__device__ __forceinline__ unsigned xb_add(unsigned* p, unsigned v) { return __hip_atomic_fetch_add(p, v, __ATOMIC_RELAXED, __HIP_MEMORY_SCOPE_AGENT); }
__device__ __forceinline__ unsigned xb_xcc_id() { return (unsigned)__builtin_amdgcn_s_getreg((3 << 11) | 20) & 0xFu; }
#define XB_SPIN(cond, bar) do { unsigned _sp = 0; while (cond) { __builtin_amdgcn_s_sleep(1); \
    if ((++_sp & 255u) == 0u) { if (xb_ld(&(bar)[XB_TMO])) break; if (_sp > XB_SPIN_CAP) { atomicAdd(&(bar)[XB_TMO], 1u); break; } } } } while (0)

struct XcdBarrier {
    unsigned* bar; unsigned x;
    volatile LAS unsigned* st;
};

__device__ __forceinline__ XcdBarrier xcd_barrier_post(unsigned* bar, volatile LAS unsigned* st) {
    XcdBarrier b; b.bar = bar; b.x = xb_xcc_id(); b.st = st;
    if (threadIdx.x == 0) (void)xb_add(&bar[XB_XCNT(b.x)], 1u);
    return b;
}
__device__ __forceinline__ void xcd_barrier_complete(unsigned* bar, unsigned x, unsigned& nloc, unsigned& nx) {
    const unsigned G = gridDim.x * gridDim.y * gridDim.z;
    unsigned sum, cnt, mine, sp = 0u;
    for (;;) {
        sum = 0u; cnt = 0u; mine = 0u;
#pragma unroll
        for (unsigned j = 0; j < 16; ++j) { const unsigned c = xb_ld(&bar[XB_XCNT(j)]); sum += c; cnt += (c > 0u) ? 1u : 0u; mine = (j == x) ? c : mine; }
        if (sum == G) break;
        __builtin_amdgcn_s_sleep(1);
        if ((++sp & 255u) == 0u) { if (xb_ld(&bar[XB_TMO])) break; if (sp > XB_SPIN_CAP) { atomicAdd(&bar[XB_TMO], 1u); break; } }
    }
    nloc = mine > 0u ? mine : 1u; nx = cnt > 0u ? cnt : 1u;
}

__device__ __forceinline__ void xcd_barrier(const XcdBarrier& b) {
    asm volatile("s_waitcnt vmcnt(0)" ::: "memory");
    __syncthreads();
    if (threadIdx.x == 0) {
        unsigned* bar = b.bar;
        __builtin_amdgcn_s_waitcnt(0);
        unsigned nloc = b.st[0], nx = b.st[1];
        if (nloc == 0u) { xcd_barrier_complete(bar, b.x, nloc, nx); b.st[0] = nloc; b.st[1] = nx; }
        const unsigned old = xb_add(&bar[XB_XSUB(b.x)], 1u);
        const unsigned gen = old / nloc;
        if (old + 1u == (gen + 1u) * nloc) {
            __builtin_amdgcn_fence(__ATOMIC_RELEASE, "agent");
            asm volatile("s_waitcnt vmcnt(0)" ::: "memory");
            const unsigned og = xb_add(&bar[XB_TOP], 1u);
            const unsigned tg = og / nx;
            if (og + 1u == (tg + 1u) * nx) xb_add(&bar[XB_TOPGEN], 1u);
            else XB_SPIN(xb_ld(&bar[XB_TOPGEN]) == tg, bar);
            __builtin_amdgcn_fence(__ATOMIC_ACQUIRE, "agent");
            xb_add(&bar[XB_XGEN(b.x)], 1u);
            asm volatile("s_waitcnt vmcnt(0)" ::: "memory");
        } else {
            XB_SPIN(xb_ld(&bar[XB_XGEN(b.x)]) == gen, bar);
            __builtin_amdgcn_fence(__ATOMIC_ACQUIRE, "agent");
            asm volatile("s_waitcnt vmcnt(0)" ::: "memory");
        }
    }
    __syncthreads();
}
#ifndef MK_DUP
#define MK_DUP 0
#endif
struct Args { const float* in[14]; float* out; unsigned char* ws; int lo, hi; };
constexpr int NPHASE = 9;
__global__ void __launch_bounds__(NTHR, 2) mk_fwd(Args a) {
    extern __shared__ __attribute__((aligned(16))) unsigned char lds_raw[];
    Frame F; F.lds = (LAS unsigned char*)lds_raw; F.tid = threadIdx.x; F.lane = F.tid & 63; F.wave = __builtin_amdgcn_readfirstlane(F.tid >> 6);
    F.G = gridDim.x; { const int bx = blockIdx.x; F.vcu = (F.G % 8 == 0) ? (bx % 8) * (F.G / 8) + bx / 8 : bx; }
    unsigned char* ws = a.ws;
    const float* x = a.in[0];
    bf16* XN = (bf16*)(ws + WS_XN); bf16* Yb = (bf16*)(ws + WS_Y); bf16* PROJ = (bf16*)(ws + WS_PROJ); bf16* HB = (bf16*)(ws + WS_HB); bf16* ACT = (bf16*)(ws + WS_ACT);
    float* Z = (float*)(ws + WS_Z); float* CON = (float*)(ws + WS_CON); float* DEC = (float*)(ws + WS_DEC); bf16* SP = (bf16*)(ws + WS_SP);
    float* SS2 = (float*)(ws + WS_SS2); float* SS3 = (float*)(ws + WS_SS3);
    const int lo = a.lo, hi = a.hi;
#define IN(k) (lo <= (k) && (k) < hi)
#define SEAM(k) do { if (IN(k) && IN((k) + 1)) xcd_barrier(bar); } while (0)
    volatile LAS unsigned* MISC = (volatile LAS unsigned*)(F.lds + LDS_BYTES - 64);
    if (F.tid < 16) MISC[F.tid] = 0u;
    __syncthreads();
    unsigned* barw = (unsigned*)(ws + WS_BAR);
    if (a.lo < 0) cg::this_grid().sync();
    XcdBarrier bar; bar.bar = barw; bar.x = 0; bar.st = nullptr;
    if (hi - lo > 1) bar = xcd_barrier_post(barw, MISC + 8);
    if (IN(0)) phase_prologue(F, x, a.in[1], a.in[2], a.in[9], a.in[10], a.in[11], a.in[12], ws);
    SEAM(0);
    for (int rep_ = 0; rep_ < 1 + ((MK_DUP >> 1) & 1); ++rep_) if (IN(1)) {
        pg8::Gemm g{XN, (const bf16*)(ws + WS_WIN), M, NPROJ, D}; pg8::StaticOrder S; S.init(M, NPROJ, F.G, (int)blockIdx.x);
        pg8::EpiProj E{PROJ, NPROJ};
        pg8::gemm_phase<pg8::EpiProj, pg8::StaticOrder, true, true>(F.lds, g, S, E);
        phase_z(F, XN, (const bf16*)(ws + WS_WIN) + (size_t)NPROJ * D, Z);
    }
    SEAM(1);
    for (int rep_ = 0; rep_ < 1 + ((MK_DUP >> 2) & 1); ++rep_) if (IN(2)) {
        for (int u = F.vcu; u < 1024 + 2048; u += F.G) {
            if (u < 1024) gla_a_unit(F, PROJ, Z, a.in[4], a.in[5], a.in[6], a.in[7], CON, DEC, u);
            else natten_unit(F, PROJ, a.in[3], Yb, u - 1024);
        }
    }
    SEAM(2);
    for (int rep_ = 0; rep_ < 1 + ((MK_DUP >> 3) & 1); ++rep_) if (IN(3)) phase_scan(F, CON, DEC, SP);
    SEAM(3);
    for (int rep_ = 0; rep_ < 1 + ((MK_DUP >> 4) & 1); ++rep_) if (IN(4)) { for (int u = F.vcu; u < 1024; u += F.G) gla_c_unit(F, PROJ, Z, a.in[4], a.in[5], a.in[6], a.in[7], SP, a.in[8], Yb, u); }
    SEAM(4);
    if (IN(5)) {
        pg8::Gemm g{Yb, (const bf16*)(ws + WS_WO), M, D, D}; pg8::StaticOrder S; S.init(M, D, F.G, (int)blockIdx.x);
        pg8::EpiRes E{x, a.out, HB, SS2, D};
        pg8::gemm_phase<pg8::EpiRes, pg8::StaticOrder, false, true>(F.lds, g, S, E);
    }
    SEAM(5);
    for (int rep_ = 0; rep_ < 1 + ((MK_DUP >> 6) & 1); ++rep_) if (IN(6)) {
        pg8::Gemm g{HB, (const bf16*)(ws + WS_W1), M, FF, D}; pg8::StaticOrder S; S.init(M, FF, F.G, (int)blockIdx.x);
        pg8::EpiFF1 E{ACT, FF, SS2, 1.0f / D, EPS};
        pg8::gemm_phase<pg8::EpiFF1, pg8::StaticOrder, true, true>(F.lds, g, S, E);
    }
    SEAM(6);
    if (IN(7)) {
        pg8::Gemm g{ACT, (const bf16*)(ws + WS_W2), M, D, FF}; pg8::StaticOrder S; S.init(M, D, F.G, (int)blockIdx.x);
        pg8::EpiRes E{a.out, a.out, nullptr, SS3, D};
        pg8::gemm_phase<pg8::EpiRes, pg8::StaticOrder, false, true>(F.lds, g, S, E);
    }
    SEAM(7);
    if (IN(8)) phase_final(F, a.out, SS3, a.in[13]);
#undef IN
#undef SEAM
}

#ifndef MK_ONE_LAUNCH
#define MK_ONE_LAUNCH 1
#endif
extern "C" void kernel_launch(void* const* d_in, const int* in_sizes, int n_in, void* d_out, int out_size, void* d_ws, size_t ws_size, hipStream_t stream) {
    static int grid = 0;
    if (grid == 0) {
        if (n_in != 14 || out_size != M * D || ws_size < WS_END) { fprintf(stderr, "kernel_launch: unexpected shapes (n_in %d out %d ws %zu)\n", n_in, out_size, ws_size); grid = -1; return; }
        int dev = 0, cus = 0, per_cu = 0;
        hipGetDevice(&dev); hipDeviceGetAttribute(&cus, hipDeviceAttributeMultiprocessorCount, dev);
        if (hipFuncSetAttribute((const void*)mk_fwd, hipFuncAttributeMaxDynamicSharedMemorySize, LDS_BYTES) != hipSuccess) { fprintf(stderr, "kernel_launch: hipFuncSetAttribute failed\n"); grid = -1; return; }
        if (hipOccupancyMaxActiveBlocksPerMultiprocessor(&per_cu, (const void*)mk_fwd, NTHR, LDS_BYTES) != hipSuccess || per_cu < 1) { fprintf(stderr, "kernel_launch: occupancy query says %d\n", per_cu); per_cu = 1; }
        (void)hipGetLastError();
        grid = cus * 1;
    }
    if (grid < 0) return;
    Args a{};
    for (int i = 0; i < 14; ++i) a.in[i] = (const float*)d_in[i];
    a.out = (float*)d_out; a.ws = (unsigned char*)d_ws;
#if MK_ONE_LAUNCH
    if (hipMemsetAsync((char*)d_ws + WS_BAR, 0, XCD_BAR_WORDS * 4, stream) != hipSuccess) { fprintf(stderr, "kernel_launch: memset of the barrier words failed\n"); return; }
    a.lo = 0; a.hi = NPHASE;
    void* args[] = {&a};
    hipError_t e = hipLaunchCooperativeKernel((const void*)mk_fwd, dim3(grid), dim3(NTHR), args, LDS_BYTES, stream);
    if (e != hipSuccess) fprintf(stderr, "cooperative launch failed: %s (grid %d)\n", hipGetErrorString(e), grid);
#else
    for (int p = 0; p < NPHASE; ++p) { a.lo = p; a.hi = p + 1; hipLaunchKernelGGL(mk_fwd, dim3(grid), dim3(NTHR), LDS_BYTES, stream, a); }
#endif
}
```

```cpp
#include <hip/hip_runtime.h>
#include <hip/hip_cooperative_groups.h>
#include <cstdio>
#include <cstdint>
#include <cmath>
namespace cg = cooperative_groups;
namespace pg8 {
#define PG8_LAS __attribute__((address_space(3)))
typedef unsigned short bf16_t;
typedef short bf16x8 __attribute__((ext_vector_type(8)));
typedef float f32x4 __attribute__((ext_vector_type(4)));
typedef unsigned u32x4 __attribute__((ext_vector_type(4)));
constexpr int BM = 256, BK = 64, HALF = 128, HTB = HALF * BK * 2  , STAGE_BYTES = 8 * HTB, NXCD = 8, WGM = 8;

__host__ __device__ __forceinline__ int lds_byte(int r, int c) { const int st = (r >> 4) * 2 + (c >> 5), rr = r & 15, cc = c & 31, ob = rr * 64 + cc * 2; return st * 1024 + (ob ^ (((ob >> 9) & 1) << 5)); }
__host__ __device__ __forceinline__ void stage_rc(int b, int& R, int& C) { const int st = b / 1024, sb = b % 1024, swz = sb ^ (((sb >> 9) & 1) << 5); R = (st >> 1) * 16 + swz / 64; C = (st & 1) * 32 + (swz % 64) / 2; }
__host__ __device__ __forceinline__ int perm32(int rho) { const int n = rho >> 4, i = rho & 15; return 8 * (i >> 2) + 4 * n + (i & 3); }

struct Unit { int pm, pn; };
struct Gemm { const bf16_t* A; const bf16_t* Bt; int M, N, K; };

struct StaticOrder {
    int nM, nN, nwg, G, c;
    __host__ __device__ void init(int M, int N, int G_, int c_) { nM = M / BM; nN = N / BM; nwg = nM * nN; G = G_; c = c_; }
    __host__ __device__ bool next(int i, Unit& u) const {
        const long L = (long)i * G + c; if (L >= nwg) return false;
        int wgid = (int)L; { const int q = nwg / NXCD, r = nwg % NXCD, xcd = wgid % NXCD, off = wgid / NXCD; wgid = (xcd < r ? xcd * (q + 1) : r * (q + 1) + (xcd - r) * q) + off; }
        const int nig = WGM * nN, gid = wgid / nig, fm = gid * WGM, gsz = (nM - fm) < WGM ? (nM - fm) : WGM;
        u.pm = fm + ((wgid % nig) % gsz); u.pn = (wgid % nig) / gsz; return true;
    }
    __device__ __forceinline__ void a_ready(const Unit&) const {}
    __device__ __forceinline__ void done(const Unit&) const {}
};

__device__ __forceinline__ unsigned cvt_pk_bf16(float lo, float hi) { unsigned r; asm volatile("v_cvt_pk_bf16_f32 %0, %1, %2" : "=v"(r) : "v"(lo), "v"(hi)); return r; }
typedef unsigned u32x2 __attribute__((ext_vector_type(2)));
struct EpiProj {
    static constexpr bool PERM = true, AFTER_DRAIN = false;
    bf16_t* O; int ldc;
    __device__ __forceinline__ void operator()(const f32x4 (&acc)[2][2][4][2], const Unit& u, int wr, int wc, int fr, int fq) const {
        const int row0 = u.pm * BM + wr * 64 + fr, col0 = u.pn * BM + wc * 32 + 8 * fq;
#pragma unroll
        for (int ai = 0; ai < 2; ++ai)
#pragma unroll
            for (int m = 0; m < 4; ++m) { bf16_t* rowp = O + (size_t)(row0 + ai * HALF + m * 16) * ldc + col0;
#pragma unroll
                for (int bj = 0; bj < 2; ++bj) { const f32x4 v0 = acc[ai][bj][m][0], v1 = acc[ai][bj][m][1];
                    u32x4 w; w.x = cvt_pk_bf16(v0[0], v0[1]); w.y = cvt_pk_bf16(v0[2], v0[3]); w.z = cvt_pk_bf16(v1[0], v1[1]); w.w = cvt_pk_bf16(v1[2], v1[3]);
                    *(u32x4*)(rowp + bj * HALF) = w; } }
    }
};
struct EpiFF1 {
    static constexpr bool PERM = true, AFTER_DRAIN = false;
    bf16_t* O; int ldc; const float* sumsq; float inv_n, eps;
    __device__ __forceinline__ void operator()(const f32x4 (&acc)[2][2][4][2], const Unit& u, int wr, int wc, int fr, int fq) const {
        const int row0 = u.pm * BM + wr * 64 + fr, col0 = u.pn * BM + wc * 32 + 8 * fq;
#pragma unroll
        for (int ai = 0; ai < 2; ++ai)
#pragma unroll
            for (int m = 0; m < 4; ++m) { const int row = row0 + ai * HALF + m * 16; bf16_t* rowp = O + (size_t)row * ldc + col0;
                const float rs = 1.0f / sqrtf(sumsq[row] * inv_n + eps);
#pragma unroll
                for (int bj = 0; bj < 2; ++bj) { f32x4 v0 = acc[ai][bj][m][0] * rs, v1 = acc[ai][bj][m][1] * rs;
#pragma unroll
                    for (int e = 0; e < 4; ++e) { const float a = fmaxf(v0[e], 0.f), b = fmaxf(v1[e], 0.f); v0[e] = a * a; v1[e] = b * b; }
                    u32x4 w; w.x = cvt_pk_bf16(v0[0], v0[1]); w.y = cvt_pk_bf16(v0[2], v0[3]); w.z = cvt_pk_bf16(v1[0], v1[1]); w.w = cvt_pk_bf16(v1[2], v1[3]);
                    *(u32x4*)(rowp + bj * HALF) = w; } }
    }
};
struct EpiRes {
    static constexpr bool PERM = false, AFTER_DRAIN = false;
    const float* base; float* out; bf16_t* hb; float* sumsq; int ldc;
    __device__ __forceinline__ void operator()(const f32x4 (&acc)[2][2][4][2], const Unit& u, int wr, int wc, int fr, int fq) const {
        const int col0 = u.pn * BM + wc * 32 + 4 * fq;
#pragma unroll
        for (int ai = 0; ai < 2; ++ai)
#pragma unroll
            for (int m = 0; m < 4; ++m) { const int row = u.pm * BM + ai * HALF + wr * 64 + m * 16 + fr; const size_t off = (size_t)row * ldc + col0; float s = 0.f;
#pragma unroll
                for (int bj = 0; bj < 2; ++bj)
#pragma unroll
                    for (int n = 0; n < 2; ++n) { const f32x4 bs = *(const f32x4*)(base + off + bj * HALF + n * 16); const f32x4 o = bs + acc[ai][bj][m][n];
                        *(f32x4*)(out + off + bj * HALF + n * 16) = o;
                        if (hb) { u32x2 w; w.x = cvt_pk_bf16(o[0], o[1]); w.y = cvt_pk_bf16(o[2], o[3]); *(u32x2*)(hb + off + bj * HALF + n * 16) = w; }
                        s += (o[0] * o[0] + o[1] * o[1]) + (o[2] * o[2] + o[3] * o[3]); }
                s += __shfl_xor(s, 16); s += __shfl_xor(s, 32);
                if (fq == 0) unsafeAtomicAdd(sumsq + row, s);
                asm volatile("" ::: "memory"); }
    }
};
template <class Epi, class Sched, bool ALIGN_EPI = false, bool SP2 = false>
__device__ __forceinline__ void gemm_phase(PG8_LAS unsigned char* lds, const Gemm g, const Sched& S, const Epi& E) {
    const int tid = threadIdx.x, wid = __builtin_amdgcn_readfirstlane(tid >> 6), lane = tid & 63, wr = wid >> 2, wc = wid & 3, fr = lane & 15, fq = lane >> 4;
    const int K = g.K, nt = K / BK;
    unsigned voffA[2], voffB[2];
#pragma unroll
    for (int i = 0; i < 2; ++i) { int R, C; stage_rc(tid * 16 + i * 8192, R, C); const int Rb = Epi::PERM ? ((R & ~31) + perm32(R & 31)) : R;
        voffA[i] = (unsigned)(R * K + C) * 2u; voffB[i] = (unsigned)(Rb * K + C) * 2u; }
    const size_t kstep = (size_t)(BK * 2);
    const size_t hstep = (size_t)HALF * K * 2;
    const size_t tstep = 2 * hstep;
    const unsigned ldsw = (unsigned)wid * 1024u;
    const int aoff = lds_byte(wr * 64 + fr, fq * 8), boff = lds_byte(wc * 32 + fr, fq * 8);
#define PG8_SA(b, h) (((b) * 2 + (h)) * HTB)
#define PG8_SB(b, h) ((4 + (b) * 2 + (h)) * HTB)
#define PG8_STAGE(bufoff, gbase, voff) do { _Pragma("unroll") for (int _i = 0; _i < 2; ++_i) \
        __builtin_amdgcn_global_load_lds((const unsigned*)((const char*)(gbase) + (voff)[_i]), (PG8_LAS unsigned*)(lds + (bufoff) + ldsw + _i * 8192), 16, 0, 0); } while (0)
#define PG8_LDA(dst, b, h) do { _Pragma("unroll") for (int m = 0; m < 4; ++m) _Pragma("unroll") for (int k = 0; k < 2; ++k) dst[m][k] = *(const PG8_LAS bf16x8*)(lds + PG8_SA(b, h) + aoff + m * 2048 + k * 1024); } while (0)
#define PG8_LDB(dst, b, h) do { _Pragma("unroll") for (int n = 0; n < 2; ++n) _Pragma("unroll") for (int k = 0; k < 2; ++k) dst[n][k] = *(const PG8_LAS bf16x8*)(lds + PG8_SB(b, h) + boff + n * 2048 + k * 1024); } while (0)
#define PG8_MMA(ai, bj, At, Bt) do { __builtin_amdgcn_s_setprio(1); _Pragma("unroll") for (int m = 0; m < 4; ++m) _Pragma("unroll") for (int n = 0; n < 2; ++n) _Pragma("unroll") for (int k = 0; k < 2; ++k) \
        acc[ai][bj][m][n] = __builtin_amdgcn_mfma_f32_16x16x32_bf16(Bt[n][k], At[m][k], acc[ai][bj][m][n], 0, 0, 0); __builtin_amdgcn_s_setprio(0); } while (0)
#define PG8_WAIT_V(n) asm volatile("s_waitcnt vmcnt(" #n ")" ::: "memory")
#define PG8_WAIT_L(n) asm volatile("s_waitcnt lgkmcnt(" #n ")" ::: "memory")
#define PG8_BAR __builtin_amdgcn_s_barrier()
#define PG8_SCHED __builtin_amdgcn_sched_barrier(0)
    Unit cur, nxt; int ui = 0;
    if (!S.next(0, cur)) return;
    f32x4 acc[2][2][4][2];
#pragma unroll
    for (int a = 0; a < 2; ++a)
#pragma unroll
        for (int b = 0; b < 2; ++b)
#pragma unroll
            for (int m = 0; m < 4; ++m)
#pragma unroll
                for (int n = 0; n < 2; ++n) acc[a][b][m][n] = (f32x4){0.f, 0.f, 0.f, 0.f};
    bf16x8 At[4][2], B0[2][2], B1[2][2];
    const char* cA = (const char*)g.A + (size_t)cur.pm * tstep; const char* cB = (const char*)g.Bt + (size_t)cur.pn * tstep;
    S.a_ready(cur);
    if constexpr (SP2) {
        PG8_STAGE(PG8_SB(0, 0), cB, voffB); PG8_STAGE(PG8_SB(0, 1), cB + hstep, voffB); PG8_STAGE(PG8_SA(0, 0), cA, voffA); PG8_STAGE(PG8_SA(0, 1), cA + hstep, voffA);
        if (wr == 1) PG8_BAR;
        PG8_WAIT_V(2); PG8_BAR;
        PG8_STAGE(PG8_SB(1, 0), cB + kstep, voffB); PG8_STAGE(PG8_SA(1, 0), cA + kstep, voffA); PG8_STAGE(PG8_SB(1, 1), cB + hstep + kstep, voffB);
        PG8_WAIT_V(6); PG8_BAR;
    } else {
        PG8_STAGE(PG8_SB(0, 0), cB, voffB); PG8_STAGE(PG8_SA(0, 0), cA, voffA); PG8_STAGE(PG8_SB(0, 1), cB + hstep, voffB); PG8_STAGE(PG8_SA(0, 1), cA + hstep, voffA);
        if (wr == 1) PG8_BAR;
        PG8_WAIT_V(4); PG8_BAR;
        PG8_STAGE(PG8_SB(1, 0), cB + kstep, voffB); PG8_STAGE(PG8_SA(1, 0), cA + kstep, voffA); PG8_STAGE(PG8_SB(1, 1), cB + hstep + kstep, voffB);
        PG8_WAIT_V(6); PG8_BAR;
    }
    for (;;) {
        const bool has_next = S.next(ui + 1, nxt);
        const char* nA = has_next ? (const char*)g.A + (size_t)nxt.pm * tstep : cA; const char* nB = has_next ? (const char*)g.Bt + (size_t)nxt.pn * tstep : cB;
        for (int t = 0; t < nt; t += 2) {
            const bool last = (t == nt - 2);
            const char* a1 = cA + (size_t)(t + 1) * kstep;
            const char* a2 = last ? nA : cA + (size_t)(t + 2) * kstep; const char* b2 = last ? nB : cB + (size_t)(t + 2) * kstep;
            const char* a3 = a2 + kstep; const char* b3 = b2 + kstep;
            if (last && has_next) S.a_ready(nxt);
            if constexpr (SP2) {
            PG8_LDB(B0, 0, 0); PG8_LDB(B1, 0, 1); PG8_SCHED; PG8_LDA(At, 0, 0); PG8_STAGE(PG8_SA(1, 1), a1 + hstep, voffA);
            PG8_WAIT_V(8); PG8_WAIT_L(0); PG8_BAR; PG8_MMA(0, 0, At, B0); PG8_MMA(0, 1, At, B1); PG8_BAR; PG8_SCHED;
            PG8_LDA(At, 0, 1); PG8_STAGE(PG8_SB(0, 0), b2, voffB); PG8_STAGE(PG8_SB(0, 1), b2 + hstep, voffB); PG8_STAGE(PG8_SA(0, 0), a2, voffA);
            PG8_WAIT_V(8); PG8_WAIT_L(0); PG8_BAR; PG8_MMA(1, 0, At, B0); PG8_MMA(1, 1, At, B1); PG8_BAR; PG8_SCHED;
            PG8_LDB(B0, 1, 0); PG8_LDB(B1, 1, 1); PG8_SCHED; PG8_LDA(At, 1, 0); PG8_STAGE(PG8_SA(0, 1), a2 + hstep, voffA);
            PG8_WAIT_V(8); PG8_WAIT_L(0); PG8_BAR; PG8_MMA(0, 0, At, B0); PG8_MMA(0, 1, At, B1); PG8_BAR; PG8_SCHED;
            PG8_LDA(At, 1, 1); PG8_STAGE(PG8_SB(1, 0), b3, voffB); PG8_STAGE(PG8_SB(1, 1), b3 + hstep, voffB); PG8_STAGE(PG8_SA(1, 0), a3, voffA);
            PG8_WAIT_V(8); PG8_WAIT_L(0); PG8_BAR; PG8_MMA(1, 0, At, B0); PG8_MMA(1, 1, At, B1); PG8_BAR; PG8_SCHED;
            } else {
            PG8_LDB(B0, 0, 0); PG8_SCHED; PG8_LDA(At, 0, 0); PG8_STAGE(PG8_SA(1, 1), a1 + hstep, voffA);
            PG8_WAIT_L(8); PG8_BAR; PG8_WAIT_L(0); PG8_MMA(0, 0, At, B0); PG8_BAR; PG8_SCHED;
            PG8_LDB(B1, 0, 1); PG8_STAGE(PG8_SB(0, 0), b2, voffB);
            PG8_BAR; PG8_WAIT_L(0); PG8_MMA(0, 1, At, B1); PG8_BAR;
            PG8_LDA(At, 0, 1); PG8_STAGE(PG8_SA(0, 0), a2, voffA);
            PG8_BAR; PG8_WAIT_L(0); PG8_MMA(1, 0, At, B0); PG8_BAR; PG8_SCHED;
            PG8_STAGE(PG8_SB(0, 1), b2 + hstep, voffB);
            PG8_WAIT_V(6); PG8_BAR; PG8_MMA(1, 1, At, B1); PG8_BAR;
            PG8_LDB(B0, 1, 0); PG8_SCHED; PG8_LDA(At, 1, 0); PG8_STAGE(PG8_SA(0, 1), a2 + hstep, voffA);
            PG8_WAIT_L(8); PG8_BAR; PG8_WAIT_L(0); PG8_MMA(0, 0, At, B0); PG8_BAR; PG8_SCHED;
            PG8_LDB(B1, 1, 1); PG8_STAGE(PG8_SB(1, 0), b3, voffB);
            PG8_BAR; PG8_WAIT_L(0); PG8_MMA(0, 1, At, B1); PG8_BAR;
            PG8_LDA(At, 1, 1); PG8_STAGE(PG8_SA(1, 0), a3, voffA);
            PG8_BAR; PG8_WAIT_L(0); PG8_MMA(1, 0, At, B0); PG8_BAR; PG8_SCHED;
            PG8_STAGE(PG8_SB(1, 1), b3 + hstep, voffB);
            PG8_WAIT_V(6); PG8_BAR; PG8_MMA(1, 1, At, B1); PG8_BAR;
            }
        }
        if constexpr (ALIGN_EPI) { if (wr == 0) PG8_BAR; }
        if constexpr (!Epi::AFTER_DRAIN) { E(acc, cur, wr, wc, fr, fq); S.done(cur); }
        if (!has_next) break;
#pragma unroll
        for (int a = 0; a < 2; ++a)
#pragma unroll
            for (int b = 0; b < 2; ++b)
#pragma unroll
                for (int m = 0; m < 4; ++m)
#pragma unroll
                    for (int n = 0; n < 2; ++n) acc[a][b][m][n] = (f32x4){0.f, 0.f, 0.f, 0.f};
        cur = nxt; cA = nA; cB = nB; ++ui;
        if constexpr (ALIGN_EPI) { if (wr == 1) PG8_BAR; }
    }
    PG8_WAIT_V(0);
    if constexpr (!ALIGN_EPI) { if (wr == 0) PG8_BAR; }
    PG8_BAR;
    if constexpr (Epi::AFTER_DRAIN) { E.fused(acc, cur, wr, wc, fr, fq, lds, wid, lane); S.done(cur); }
#undef PG8_SA
#undef PG8_SB
#undef PG8_STAGE
#undef PG8_LDA
#undef PG8_LDB
#undef PG8_MMA
#undef PG8_WAIT_V
#undef PG8_WAIT_L
#undef PG8_BAR
#undef PG8_SCHED
}
}
#define GAS __attribute__((address_space(1)))
#define LAS __attribute__((address_space(3)))
typedef unsigned short bf16;
typedef unsigned v4u __attribute__((ext_vector_type(4)));
typedef unsigned v2u __attribute__((ext_vector_type(2)));
typedef float f32x4 __attribute__((ext_vector_type(4)));
typedef short bf16x8 __attribute__((ext_vector_type(8)));
typedef short s16x4 __attribute__((ext_vector_type(4)));

constexpr int NWAVES = 8, NTHR = 512;
constexpr int T = 8192, D = 1024, M = 16384, NPROJ = 3072, DIN = 3104, FF = 4096;
constexpr float EPS = 1e-6f;
constexpr int C_QA = 0, C_KA = 512, C_VA = 1024, C_QG = 1536, C_KG = 1792, C_VG = 2048, C_RG = 2560;

constexpr size_t MiB = 1u << 20;
constexpr size_t WS_SS2 = 0, WS_SS3 = 65536, WS_BAR = 131072, WS_DEC = 262144, WS_Z = 1 * MiB;
constexpr size_t WS_WIN = 4 * MiB, WS_WO = 11 * MiB, WS_W1 = 13 * MiB, WS_W2 = 21 * MiB;
constexpr size_t WS_XN = 32 * MiB, WS_Y = 32 * MiB, WS_PROJ = 64 * MiB, WS_CON = 160 * MiB, WS_SP = 224 * MiB;
constexpr size_t WS_HB = 64 * MiB, WS_ACT = 96 * MiB, WS_END = 256 * MiB;
constexpr int LDS_BYTES = 155648;

__device__ __forceinline__ unsigned f2bf(float f) { unsigned u = __builtin_bit_cast(unsigned, f); return (u + 0x7fffu + ((u >> 16) & 1u)) >> 16; }
__device__ __forceinline__ unsigned pk2(float lo, float hi) { return f2bf(lo) | (f2bf(hi) << 16); }
__device__ __forceinline__ float bf2f(unsigned short h) { return __builtin_bit_cast(float, (unsigned)h << 16); }
__device__ __forceinline__ float wave_sum(float v) {
#pragma unroll
    for (int o = 1; o < 64; o <<= 1) v += __shfl_xor(v, o);
    return v;
}
__device__ __forceinline__ f32x4 mfma16(bf16x8 x, bf16x8 y, f32x4 c) { return __builtin_amdgcn_mfma_f32_16x16x32_bf16(x, y, c, 0, 0, 0); }
typedef short v4i16_t __attribute__((ext_vector_type(4)));
__device__ __forceinline__ s16x4 tr4(const LAS unsigned char* p) { return __builtin_bit_cast(s16x4, __builtin_amdgcn_ds_read_tr16_b64_v4i16((LAS v4i16_t*)p)); }
__device__ __forceinline__ bf16x8 cat8(s16x4 a, s16x4 b) { bf16x8 r; r[0] = a[0]; r[1] = a[1]; r[2] = a[2]; r[3] = a[3]; r[4] = b[0]; r[5] = b[1]; r[6] = b[2]; r[7] = b[3]; return r; }
__device__ __forceinline__ bf16x8 pack8(f32x4 a, f32x4 b) {
    v4u w; w.x = pg8::cvt_pk_bf16(a[0], a[1]); w.y = pg8::cvt_pk_bf16(a[2], a[3]); w.z = pg8::cvt_pk_bf16(b[0], b[1]); w.w = pg8::cvt_pk_bf16(b[2], b[3]);
    return __builtin_bit_cast(bf16x8, w);
}

struct Frame {
    LAS unsigned char* lds;
    int tid, lane, wave, vcu, G;
};

__device__ __forceinline__ void p0_transpose_item(const float* W, int K, int N, bf16* WT, const float* gk, LAS float* scr, int item, int lane) {
    const int nblk = N / 32, kb = item / nblk, nb = item % nblk, k0 = 64 * kb, n0 = 32 * nb;
#pragma unroll 8
    for (int i = 0; i < 32; ++i) { const int kk = 2 * i + (lane >> 5); float v = W[(size_t)(k0 + kk) * N + n0 + (lane & 31)]; if (gk) v *= gk[k0 + kk]; scr[kk * 33 + (lane & 31)] = v; }
    asm volatile("s_waitcnt lgkmcnt(0)" ::: "memory");
    const int c = lane & 7;
#pragma unroll
    for (int j = 0; j < 4; ++j) { const int n = (lane >> 3) + 8 * j; const LAS float* s = scr + (8 * c) * 33 + n;
        v4u o; o.x = pk2(s[0 * 33], s[1 * 33]); o.y = pk2(s[2 * 33], s[3 * 33]); o.z = pk2(s[4 * 33], s[5 * 33]); o.w = pk2(s[6 * 33], s[7 * 33]);
        *(v4u*)(WT + (size_t)(n0 + n) * K + k0 + 8 * c) = o; }
    asm volatile("s_waitcnt lgkmcnt(0)" ::: "memory");
}
__device__ __forceinline__ void phase_prologue(const Frame& F, const float* x, const float* g_mix, const float* w_in, const float* w_out, const float* g_ff, const float* w1, const float* w2, unsigned char* ws) {
    LAS float* scr = (LAS float*)(F.lds + F.wave * 16384);
    const int gw = F.vcu * NWAVES + F.wave, NGW = F.G * NWAVES;
    constexpr int I_IN = (D / 64) * (DIN / 32), I_O = (D / 64) * (D / 32), I_1 = (D / 64) * (FF / 32), I_2 = (FF / 64) * (D / 32);
    constexpr int NITEMS = I_IN + I_O + I_1 + I_2;
    for (int it = gw; it < NITEMS; it += NGW) {
        int r = it;
        if (r < I_IN) { p0_transpose_item(w_in, D, DIN, (bf16*)(ws + WS_WIN), nullptr, scr, r, F.lane); continue; } r -= I_IN;
        if (r < I_O) { p0_transpose_item(w_out, D, D, (bf16*)(ws + WS_WO), nullptr, scr, r, F.lane); continue; } r -= I_O;
        if (r < I_1) { p0_transpose_item(w1, D, FF, (bf16*)(ws + WS_W1), g_ff, scr, r, F.lane); continue; } r -= I_1;
        p0_transpose_item(w2, FF, D, (bf16*)(ws + WS_W2), nullptr, scr, r, F.lane);
    }
    { float* ss = (float*)(ws + WS_SS2); for (int i = (F.vcu * NTHR + F.tid); i < 2 * M; i += F.G * NTHR) ss[i] = 0.f; }
    bf16* XN = (bf16*)(ws + WS_XN);
    f32x4 gv[4];
#pragma unroll
    for (int j = 0; j < 4; ++j) gv[j] = ((const f32x4*)g_mix)[F.lane + 64 * j];
    for (int m = gw; m < M; m += NGW) {
        const f32x4* xr = (const f32x4*)(x + (size_t)m * D) + F.lane;
        f32x4 v[4]; float s = 0.f;
#pragma unroll
        for (int j = 0; j < 4; ++j) { v[j] = xr[64 * j]; s += (v[j].x * v[j].x + v[j].y * v[j].y) + (v[j].z * v[j].z + v[j].w * v[j].w); }
        const float rs = 1.0f / sqrtf(wave_sum(s) * (1.f / D) + EPS);
        unsigned long long* o8 = (unsigned long long*)(XN + (size_t)m * D) + F.lane;
#pragma unroll
        for (int j = 0; j < 4; ++j) { const f32x4 o = v[j] * rs * gv[j]; o8[64 * j] = (unsigned long long)pk2(o.x, o.y) | ((unsigned long long)pk2(o.z, o.w) << 32); }
    }
}

__device__ __forceinline__ void phase_z(const Frame& F, const bf16* XN, const bf16* Wz, float* Z) {
    const int fr = F.lane & 15, fq = F.lane >> 4, mt = F.wave & 3, nt = F.wave >> 2;
    for (int rb = F.vcu; rb < M / 64; rb += F.G) {
        const bf16* ap = XN + (size_t)(rb * 64 + mt * 16 + fr) * D + 8 * fq;
        const bf16* bp = Wz + (size_t)(nt * 16 + fr) * D + 8 * fq;
        f32x4 acc = {0.f, 0.f, 0.f, 0.f};
#pragma unroll 8
        for (int ks = 0; ks < D / 32; ++ks) { const bf16x8 a = *(const bf16x8*)(ap + ks * 32), b = *(const bf16x8*)(bp + ks * 32); acc = mfma16(b, a, acc); }
        *(f32x4*)(Z + (size_t)(rb * 64 + mt * 16 + fr) * 32 + nt * 16 + 4 * fq) = acc;
    }
}

constexpr int NA_STR = 144, NA_K_OFF = 0, NA_V_OFF = 512 * NA_STR, NA_RPB_OFF = 2 * 512 * NA_STR;
__device__ __forceinline__ void natten_compute(const Frame& F, const bf16x8 (&qf)[2], bf16* Y, int b, int h, int r, int rs) {
    LAS unsigned char* lds = F.lds;
    const size_t tokq0 = (size_t)b * T + r * 64;
    const int fr = F.lane & 15, fq = F.lane >> 4, jq = F.wave & 3, dh = F.wave >> 2;
    const int wc0 = (jq == 0) ? 0 : (jq == 1) ? 8 : (jq == 2) ? 24 : 32;
    f32x4 s[16];
#pragma unroll
    for (int i = 0; i < 8; ++i)
#pragma unroll
        for (int ct = 0; ct < 2; ++ct) {
            const LAS unsigned char* kp = lds + NA_K_OFF + (((rs + i) & 7) * 64 + wc0 + 16 * ct + fr) * NA_STR + fq * 16;
            const bf16x8 k0 = *(const LAS bf16x8*)kp, k1 = *(const LAS bf16x8*)(kp + 64);
            f32x4 a = {0.f, 0.f, 0.f, 0.f}; a = mfma16(k0, qf[0], a); a = mfma16(k1, qf[1], a); s[i * 2 + ct] = a; }
    const int cq = 16 * jq + fr, cs = min(max(cq - 8, 0), 48);
    const LAS float* rp = (const LAS float*)(lds + NA_RPB_OFF);
    float mx = -INFINITY;
#pragma unroll
    for (int i = 0; i < 8; ++i) { const int dr = rs + i - r + 7;
#pragma unroll
        for (int ct = 0; ct < 2; ++ct)
#pragma unroll
            for (int e = 0; e < 4; ++e) { const int ck = wc0 + 16 * ct + 4 * fq + e; const bool in = (ck >= cs) && (ck < cs + 16);
                const int dc = min(max(ck - cq + 15, 0), 30);
                const float v = in ? s[i * 2 + ct][e] * 0.125f + rp[dr * 31 + dc] : -INFINITY; s[i * 2 + ct][e] = v; mx = fmaxf(mx, v); } }
    mx = fmaxf(mx, __shfl_xor(mx, 16)); mx = fmaxf(mx, __shfl_xor(mx, 32));
    float l = 0.f;
#pragma unroll
    for (int t = 0; t < 16; ++t)
#pragma unroll
        for (int e = 0; e < 4; ++e) { const float p = __expf(s[t][e] - mx); s[t][e] = p; l += p; }
    l += __shfl_xor(l, 16); l += __shfl_xor(l, 32);
    f32x4 o[2] = {{0.f, 0.f, 0.f, 0.f}, {0.f, 0.f, 0.f, 0.f}};
#pragma unroll
    for (int i = 0; i < 8; ++i) { const bf16x8 pb = pack8(s[2 * i], s[2 * i + 1]);
#pragma unroll
        for (int dt = 0; dt < 2; ++dt) { const int d0 = 32 * dh + 16 * dt;
            const LAS unsigned char* vp = lds + NA_V_OFF + (((rs + i) & 7) * 64 + wc0 + 4 * fq + (fr >> 2)) * NA_STR + (d0 + 4 * (fr & 3)) * 2;
            const bf16x8 x = cat8(tr4(vp), tr4(vp + 16 * NA_STR)); o[dt] = mfma16(x, pb, o[dt]); } }
    const float inv = 1.0f / l;
#pragma unroll
    for (int dt = 0; dt < 2; ++dt) { v2u w; w.x = pg8::cvt_pk_bf16(o[dt][0] * inv, o[dt][1] * inv); w.y = pg8::cvt_pk_bf16(o[dt][2] * inv, o[dt][3] * inv);
        *(v2u*)(Y + (tokq0 + 16 * jq + fr) * D + h * 64 + 32 * dh + 16 * dt + 4 * fq) = w; }
}
__device__ __forceinline__ void natten_wg(const Frame& F, const bf16* PROJ, const float* rpb, bf16* Y, int wgi) {
    LAS unsigned char* lds = F.lds;
    const int bh = wgi >> 4, r0 = 8 * (wgi & 15), h = bh & 7, b = bh >> 3;
    const int fr = F.lane & 15, fq = F.lane >> 4, jq = F.wave & 3;
    const bf16* qbase = PROJ + ((size_t)b * T + 16 * jq + fr) * NPROJ + C_QA + h * 64 + 8 * fq;
    bf16x8 qf[2], qn[2];
    { const bf16* qp = qbase + (size_t)r0 * 64 * NPROJ; qf[0] = *(const bf16x8*)qp; qf[1] = *(const bf16x8*)(qp + 32); }
    { const int rs0 = min(max(r0 - 4, 0), 120);
#pragma unroll
      for (int it = 0; it < 8; ++it) { const int id = F.tid + NTHR * it, key = id >> 3, ch = id & 7, row = rs0 + (key >> 6), col = key & 63;
        const bf16* src = PROJ + ((size_t)b * T + row * 64 + col) * NPROJ + C_KA + h * 64 + ch * 8;
        const v4u kv = *(const v4u*)src, vv = *(const v4u*)(src + (C_VA - C_KA));
        const int o = ((row & 7) * 64 + col) * NA_STR + ch * 16;
        *(LAS v4u*)(lds + NA_K_OFF + o) = kv; *(LAS v4u*)(lds + NA_V_OFF + o) = vv; } }
    if (F.tid < 465) ((LAS float*)(lds + NA_RPB_OFF))[F.tid] = rpb[h * 465 + F.tid];
    __syncthreads();
    for (int rr = 0; rr < 8; ++rr) {
        const int r = r0 + rr, rs = min(max(r - 4, 0), 120), rsn = min(max(r - 3, 0), 120);
        const bool more = rr < 7, slide = more && (rsn != rs);
        v4u nk = {0u, 0u, 0u, 0u}, nv = {0u, 0u, 0u, 0u};
        if (more) { const bf16* qp = qbase + (size_t)(r + 1) * 64 * NPROJ; qn[0] = *(const bf16x8*)qp; qn[1] = *(const bf16x8*)(qp + 32); }
        if (slide) { const int col = F.tid >> 3, ch = F.tid & 7; const bf16* src = PROJ + ((size_t)b * T + (rsn + 7) * 64 + col) * NPROJ + C_KA + h * 64 + ch * 8; nk = *(const v4u*)src; nv = *(const v4u*)(src + (C_VA - C_KA)); }
        natten_compute(F, qf, Y, b, h, r, rs);
        __syncthreads();
        if (slide) { const int col = F.tid >> 3, ch = F.tid & 7, o = ((((rsn + 7) & 7) * 64) + col) * NA_STR + ch * 16; *(LAS v4u*)(lds + NA_K_OFF + o) = nk; *(LAS v4u*)(lds + NA_V_OFF + o) = nv; }
        if (more) { qf[0] = qn[0]; qf[1] = qn[1]; }
        __syncthreads();
    }
}

constexpr int GL_Z = 0, GL_GU = 8192, GL_GB = 16384, GL_GT = 16896, GL_I0 = 20992;
constexpr int IS = 144, IMG = 64 * IS;
constexpr int VS = 272, VIMG = 64 * VS;
constexpr int GL_QF = GL_I0, GL_QB = GL_I0 + IMG, GL_KF = GL_I0 + 2 * IMG, GL_KB = GL_I0 + 3 * IMG, GL_V = GL_I0 + 4 * IMG, GL_SF = GL_V + VIMG, GL_SB = GL_SF + VIMG;
static_assert(GL_SB + VIMG <= LDS_BYTES, "GLA LDS map");
__device__ __forceinline__ float logsig(float x) { return fminf(x, 0.f) - __logf(1.0f + __expf(-fabsf(x))); }

__device__ __forceinline__ void gla_gate(const Frame& F, const float* Z, const float* guf, const float* gbf, const float* gub, const float* gbb, int h, size_t t0,
                                         float (&bf)[8], float (&bb)[8], float& totf, float& totb) {
    LAS unsigned char* lds = F.lds; const int tid = F.tid, d = tid & 63, g = F.wave;
    *(LAS f32x4*)(lds + GL_Z + tid * 16) = *(const f32x4*)(Z + t0 * 32 + tid * 4);
    { const int idx = tid * 4, dir = idx >> 10, rr = (idx >> 6) & 15, dd = idx & 63; const float* src = (dir ? gub : guf) + rr * 256 + h * 64 + dd; *(LAS f32x4*)(lds + GL_GU + idx * 4) = *(const f32x4*)src; }
    if (tid < 128) { const int dir = tid >> 6, dd = tid & 63; ((LAS float*)(lds + GL_GB))[tid] = (dir ? gbb : gbf)[h * 64 + dd]; }
    __syncthreads();
    const LAS float* Zl = (const LAS float*)(lds + GL_Z); const LAS float* GU = (const LAS float*)(lds + GL_GU); const LAS float* GB = (const LAS float*)(lds + GL_GB);
    float uf[16], ub[16];
#pragma unroll
    for (int rr = 0; rr < 16; ++rr) { uf[rr] = GU[rr * 64 + d]; ub[rr] = GU[1024 + rr * 64 + d]; }
    const float gf0 = GB[d], gb0 = GB[64 + d];
    float laf[8], lab[8];
#pragma unroll
    for (int j = 0; j < 8; ++j) { const int c = 8 * g + j; float pf = gf0, pb = gb0;
#pragma unroll
        for (int r4 = 0; r4 < 4; ++r4) { const f32x4 zf = *(const LAS f32x4*)(Zl + c * 32 + 4 * r4), zb = *(const LAS f32x4*)(Zl + c * 32 + 16 + 4 * r4);
#pragma unroll
            for (int e = 0; e < 4; ++e) { pf += zf[e] * uf[4 * r4 + e]; pb += zb[e] * ub[4 * r4 + e]; } }
        laf[j] = logsig(pf) * (1.0f / 16.0f); lab[j] = logsig(pb) * (1.0f / 16.0f); }
    float run = 0.f;
#pragma unroll
    for (int j = 0; j < 8; ++j) { run += laf[j]; bf[j] = run; }
    float runb = 0.f;
#pragma unroll
    for (int j = 7; j >= 0; --j) { runb += lab[j]; bb[j] = runb; }
    LAS float* GT = (LAS float*)(lds + GL_GT);
    GT[g * 64 + d] = run; GT[512 + g * 64 + d] = runb;
    __syncthreads();
    float of = 0.f, ob = 0.f; totf = 0.f; totb = 0.f;
#pragma unroll
    for (int gp = 0; gp < 8; ++gp) { const float a = GT[gp * 64 + d], c = GT[512 + gp * 64 + d]; totf += a; totb += c; if (gp < g) of += a; if (gp > g) ob += c; }
#pragma unroll
    for (int j = 0; j < 8; ++j) { bf[j] += of; bb[j] += ob; }
}
__device__ __forceinline__ void stage_img128(LAS unsigned char* dst, const bf16* src, size_t row_stride, int tid) {
#pragma unroll
    for (int it = 0; it < 2; ++it) { const int id = tid + NTHR * it, row = id >> 4, ch = id & 15; *(LAS v4u*)(dst + row * VS + ch * 16) = *(const v4u*)(src + (size_t)row * row_stride + ch * 8); }
}

__device__ __forceinline__ void gla_a_unit(const Frame& F, const bf16* PROJ, const float* Z, const float* guf, const float* gbf, const float* gub, const float* gbb, float* CON, float* DEC, bf16* IMGS, int unit) {
    LAS unsigned char* lds = F.lds; const int tid = F.tid, d = tid & 63, g = F.wave;
    const int n = unit & 127, bh = unit >> 7, h = bh & 3, b = bh >> 2; const size_t t0 = (size_t)b * T + 64 * n;
    unsigned short kraw[8], qraw[8];
#pragma unroll
    for (int j = 0; j < 8; ++j) { const bf16* p = PROJ + (t0 + 8 * g + j) * NPROJ + h * 64 + d; qraw[j] = p[C_QG]; kraw[j] = p[C_KG]; }
    stage_img128(lds + GL_V, PROJ + t0 * NPROJ + C_VG + h * 128, NPROJ, tid);
    float bf[8], bb[8], totf, totb;
    gla_gate(F, Z, guf, gbf, gub, gbb, h, t0, bf, bb, totf, totb);
    const float decf = __expf(totf), decb = __expf(totb);
    bf16* im = IMGS + (size_t)unit * 16384 + d;
#pragma unroll
    for (int j = 0; j < 8; ++j) { const float k = bf2f(kraw[j]), q = bf2f(qraw[j]) * 0.125f; const int c = 8 * g + j;
        const float ef = __expf(bf[j]), eb = __expf(bb[j]), rf = 1.0f / ef, rb = 1.0f / eb, kif = k * rf, kib = k * rb;
        *(LAS unsigned short*)(lds + GL_KF + c * IS + d * 2) = (unsigned short)f2bf(kif * decf);
        *(LAS unsigned short*)(lds + GL_KB + c * IS + d * 2) = (unsigned short)f2bf(kib * decb);
        im[c * 64] = (bf16)f2bf(q * ef); im[4096 + c * 64] = (bf16)f2bf(kif); im[8192 + c * 64] = (bf16)f2bf(q * eb); im[12288 + c * 64] = (bf16)f2bf(kib); }
    if (g == 0) { DEC[(size_t)unit * 64 + d] = decf; DEC[(size_t)(1024 + unit) * 64 + d] = decb; }
    __syncthreads();
    const int fr = F.lane & 15, fq = F.lane >> 4, dir = F.wave >> 2, dt = F.wave & 3;
    const LAS unsigned char* kimg = lds + (dir ? GL_KB : GL_KF);
    bf16x8 yk[2];
#pragma unroll
    for (int s = 0; s < 2; ++s) { const LAS unsigned char* p = kimg + (32 * s + 4 * fq + (fr >> 2)) * IS + (16 * dt + 4 * (fr & 3)) * 2; yk[s] = cat8(tr4(p), tr4(p + 16 * IS)); }
    float* cbase = CON + ((size_t)(dir * 1024 + unit) * 64 + 16 * dt + fr) * 128 + 4 * fq;
#pragma unroll
    for (int et = 0; et < 8; ++et) { f32x4 acc = {0.f, 0.f, 0.f, 0.f};
#pragma unroll
        for (int s = 0; s < 2; ++s) { const LAS unsigned char* p = lds + GL_V + (32 * s + 4 * fq + (fr >> 2)) * VS + (16 * et + 4 * (fr & 3)) * 2; acc = mfma16(cat8(tr4(p), tr4(p + 16 * VS)), yk[s], acc); }
        *(f32x4*)(cbase + 16 * et) = acc; }
    __syncthreads();
}

__device__ __forceinline__ void phase_scan(const Frame& F, const float* __restrict__ CON, const float* __restrict__ DEC, bf16* __restrict__ SP) {
    for (int chain = F.vcu * NTHR + F.tid; chain < 2 * 8 * 64 * 128; chain += F.G * NTHR) {
        const int e = chain & 127, d = (chain >> 7) & 63, bh = (chain >> 13) & 7, dir = chain >> 16;
        const size_t ubase = (size_t)dir * 1024 + bh * 128;
        const float* con = CON + (ubase * 64 + d) * 128 + e; const float* dec = DEC + ubase * 64 + d; bf16* sp = SP + (ubase * 64 + d) * 128 + e;
        float S = 0.f;
        for (int nb = 0; nb < 16; ++nb) { float c[8], gg[8];
#pragma unroll
            for (int u = 0; u < 8; ++u) { const int n = nb * 8 + u, ne = dir ? 127 - n : n; c[u] = con[(size_t)ne * 8192]; gg[u] = dec[ne * 64]; }
#pragma unroll
            for (int u = 0; u < 8; ++u) { const int n = nb * 8 + u, ne = dir ? 127 - n : n; sp[(size_t)ne * 8192] = (bf16)f2bf(S); S = gg[u] * S + c[u]; } }
    }
}

struct GlaCFetch { v4u im[4], v[2], sf[2], sb[2]; };
__device__ __forceinline__ void gla_c_fetch(GlaCFetch& R, const bf16* PROJ, const bf16* SP, const bf16* IMGS, int unit, int tid) {
    const int n = unit & 127, bh = unit >> 7, h = bh & 3, b = bh >> 2; const size_t t0 = (size_t)b * T + 64 * n;
#pragma unroll
    for (int k = 0; k < 4; ++k) R.im[k] = *(const v4u*)(IMGS + (size_t)unit * 16384 + k * 4096 + tid * 8);
#pragma unroll
    for (int it = 0; it < 2; ++it) { const int id = tid + NTHR * it, row = id >> 4, ch = id & 15;
        R.v[it] = *(const v4u*)(PROJ + (t0 + row) * NPROJ + C_VG + h * 128 + ch * 8);
        R.sf[it] = *(const v4u*)(SP + (size_t)unit * 8192 + row * 128 + ch * 8);
        R.sb[it] = *(const v4u*)(SP + (size_t)(1024 + unit) * 8192 + row * 128 + ch * 8); }
}
__device__ __forceinline__ void gla_c_commit(const GlaCFetch& R, LAS unsigned char* lds, int tid) {
    { const int row = tid >> 3, ch = tid & 7, o = row * IS + ch * 16;
      *(LAS v4u*)(lds + GL_QF + o) = R.im[0]; *(LAS v4u*)(lds + GL_KF + o) = R.im[1]; *(LAS v4u*)(lds + GL_QB + o) = R.im[2]; *(LAS v4u*)(lds + GL_KB + o) = R.im[3]; }
#pragma unroll
    for (int it = 0; it < 2; ++it) { const int id = tid + NTHR * it, row = id >> 4, ch = id & 15, o = row * VS + ch * 16;
        *(LAS v4u*)(lds + GL_V + o) = R.v[it]; *(LAS v4u*)(lds + GL_SF + o) = R.sf[it]; *(LAS v4u*)(lds + GL_SB + o) = R.sb[it]; }
}
__device__ __forceinline__ void gla_c_compute(const Frame& F, const bf16* PROJ, const float* norm_g, bf16* Y, int unit) {
    LAS unsigned char* lds = F.lds;
    const int n = unit & 127, bh = unit >> 7, h = bh & 3, b = bh >> 2; const size_t t0 = (size_t)b * T + 64 * n;
    if (F.wave < 4) {
        const int fr = F.lane & 15, fq = F.lane >> 4, it = F.wave;
        const int i = 16 * it + fr;
        const bf16* rp = PROJ + (t0 + i) * NPROJ + C_RG + h * 128 + 4 * fq; bf16* yp = Y + (t0 + i) * D + 512 + h * 128 + 4 * fq;
        v2u rw[8];
#pragma unroll
        for (int et = 0; et < 8; ++et) rw[et] = *(const v2u*)(rp + 16 * et);
        bf16x8 yqf[2], yqb[2];
#pragma unroll
        for (int s = 0; s < 2; ++s) { const int off = (16 * it + fr) * IS + (32 * s + 8 * fq) * 2; yqf[s] = *(const LAS bf16x8*)(lds + GL_QF + off); yqb[s] = *(const LAS bf16x8*)(lds + GL_QB + off); }
        f32x4 a[4];
#pragma unroll
        for (int jt = 0; jt < 4; ++jt) { f32x4 af = {0.f, 0.f, 0.f, 0.f}, ab = {0.f, 0.f, 0.f, 0.f};
#pragma unroll
            for (int s = 0; s < 2; ++s) { const int off = (16 * jt + fr) * IS + (32 * s + 8 * fq) * 2;
                af = mfma16(*(const LAS bf16x8*)(lds + GL_KF + off), yqf[s], af); ab = mfma16(*(const LAS bf16x8*)(lds + GL_KB + off), yqb[s], ab); }
#pragma unroll
            for (int e = 0; e < 4; ++e) { const int j = 16 * jt + 4 * fq + e; a[jt][e] = (j <= i) ? af[e] : ab[e]; } }
        f32x4 o[8];
#pragma unroll
        for (int et = 0; et < 8; ++et) o[et] = (f32x4){0.f, 0.f, 0.f, 0.f};
#pragma unroll
        for (int s = 0; s < 2; ++s) { const bf16x8 pb = pack8(a[2 * s], a[2 * s + 1]);
#pragma unroll
            for (int et = 0; et < 8; ++et) { const LAS unsigned char* p = lds + GL_V + (32 * s + 4 * fq + (fr >> 2)) * VS + (16 * et + 4 * (fr & 3)) * 2; o[et] = mfma16(cat8(tr4(p), tr4(p + 16 * VS)), pb, o[et]); } }
#pragma unroll
        for (int s = 0; s < 2; ++s)
#pragma unroll
            for (int et = 0; et < 8; ++et) { const int off = (32 * s + 8 * fq + (fr >> 2)) * VS + (16 * et + 4 * (fr & 3)) * 2;
                o[et] = mfma16(cat8(tr4(lds + GL_SF + off), tr4(lds + GL_SF + off + 4 * VS)), yqf[s], o[et]);
                o[et] = mfma16(cat8(tr4(lds + GL_SB + off), tr4(lds + GL_SB + off + 4 * VS)), yqb[s], o[et]); }
        float ss = 0.f;
#pragma unroll
        for (int et = 0; et < 8; ++et) ss += (o[et][0] * o[et][0] + o[et][1] * o[et][1]) + (o[et][2] * o[et][2] + o[et][3] * o[et][3]);
        ss += __shfl_xor(ss, 16); ss += __shfl_xor(ss, 32);
        const float rs = 1.0f / sqrtf(ss * (1.0f / 128.0f) + EPS);
#pragma unroll
        for (int et = 0; et < 8; ++et) { const f32x4 gn = *(const f32x4*)(norm_g + 16 * et + 4 * fq);
            float rv[4] = {__builtin_bit_cast(float, rw[et].x << 16), __builtin_bit_cast(float, rw[et].x & 0xffff0000u), __builtin_bit_cast(float, rw[et].y << 16), __builtin_bit_cast(float, rw[et].y & 0xffff0000u)};
            float ov[4];
#pragma unroll
            for (int e = 0; e < 4; ++e) { const float sg = rv[e] / (1.0f + __expf(-rv[e])); ov[e] = o[et][e] * rs * gn[e] * sg; }
            v2u w; w.x = pg8::cvt_pk_bf16(ov[0], ov[1]); w.y = pg8::cvt_pk_bf16(ov[2], ov[3]); *(v2u*)(yp + 16 * et) = w; }
    }
}
__device__ __forceinline__ void phase_gla_c(const Frame& F, const bf16* PROJ, const bf16* SP, const bf16* IMGS, const float* norm_g, bf16* Y) {
    GlaCFetch R;
    int u = F.vcu;
    if (u < 1024) gla_c_fetch(R, PROJ, SP, IMGS, u, F.tid);
    for (; u < 1024; u += F.G) {
        gla_c_commit(R, F.lds, F.tid);
        __syncthreads();
        if (u + F.G < 1024) gla_c_fetch(R, PROJ, SP, IMGS, u + F.G, F.tid);
        gla_c_compute(F, PROJ, norm_g, Y, u);
        __syncthreads();
    }
}

__device__ __forceinline__ void phase_final(const Frame& F, float* out, const float* ss, const float* g) {
    const int gw = F.vcu * NWAVES + F.wave, NGW = F.G * NWAVES;
    f32x4 gv[4];
#pragma unroll
    for (int j = 0; j < 4; ++j) gv[j] = ((const f32x4*)g)[F.lane + 64 * j];
    for (int m = gw; m < M; m += NGW) { f32x4* xr = (f32x4*)(out + (size_t)m * D) + F.lane; const float rs = 1.0f / sqrtf(ss[m] * (1.f / D) + EPS);
#pragma unroll
        for (int j = 0; j < 4; ++j) xr[64 * j] = xr[64 * j] * rs * gv[j]; }
}

#define XB_TMO      128
#define XB_XCNT(j)  (256  + 64 * (j))
#define XB_XSUB(j)  (1280 + 64 * (j))
#define XB_XGEN(j)  (2304 + 64 * (j))
#define XB_TOP      3328
#define XB_TOPGEN   3392
#define XCD_BAR_WORDS 3456
#define XB_SPIN_CAP (1u << 18)

__device__ __forceinline__ unsigned xb_ld(unsigned* p)              { return __hip_atomic_load(p, __ATOMIC_RELAXED, __HIP_MEMORY_SCOPE_AGENT); }
__device__ __forceinline__ unsigned xb_add(unsigned* p, unsigned v) { return __hip_atomic_fetch_add(p, v, __ATOMIC_RELAXED, __HIP_MEMORY_SCOPE_AGENT); }
__device__ __forceinline__ unsigned xb_xcc_id() { return (unsigned)__builtin_amdgcn_s_getreg((3 << 11) | 20) & 0xFu; }
#define XB_SPIN(cond, bar) do { unsigned _sp = 0; while (cond) { __builtin_amdgcn_s_sleep(1); \
    if ((++_sp & 255u) == 0u) { if (xb_ld(&(bar)[XB_TMO])) break; if (_sp > XB_SPIN_CAP) { atomicAdd(&(bar)[XB_TMO], 1u); break; } } } } while (0)

struct XcdBarrier {
    unsigned* bar; unsigned x;
    volatile LAS unsigned* st;
};

__device__ __forceinline__ XcdBarrier xcd_barrier_post(unsigned* bar, volatile LAS unsigned* st) {
    XcdBarrier b; b.bar = bar; b.x = xb_xcc_id(); b.st = st;
    if (threadIdx.x == 0) (void)xb_add(&bar[XB_XCNT(b.x)], 1u);
    return b;
}
__device__ __forceinline__ void xcd_barrier_complete(unsigned* bar, unsigned x, unsigned& nloc, unsigned& nx) {
    const unsigned G = gridDim.x * gridDim.y * gridDim.z;
    unsigned sum, cnt, mine, sp = 0u;
    for (;;) {
        sum = 0u; cnt = 0u; mine = 0u;
#pragma unroll
        for (unsigned j = 0; j < 16; ++j) { const unsigned c = xb_ld(&bar[XB_XCNT(j)]); sum += c; cnt += (c > 0u) ? 1u : 0u; mine = (j == x) ? c : mine; }
        if (sum == G) break;
        __builtin_amdgcn_s_sleep(1);
        if ((++sp & 255u) == 0u) { if (xb_ld(&bar[XB_TMO])) break; if (sp > XB_SPIN_CAP) { atomicAdd(&bar[XB_TMO], 1u); break; } }
    }
    nloc = mine > 0u ? mine : 1u; nx = cnt > 0u ? cnt : 1u;
}

__device__ __forceinline__ void xcd_barrier(const XcdBarrier& b) {
    asm volatile("s_waitcnt vmcnt(0)" ::: "memory");
    __syncthreads();
    if (threadIdx.x == 0) {
        unsigned* bar = b.bar;
        __builtin_amdgcn_s_waitcnt(0);
        unsigned nloc = b.st[0], nx = b.st[1];
        if (nloc == 0u) { xcd_barrier_complete(bar, b.x, nloc, nx); b.st[0] = nloc; b.st[1] = nx; }
        const unsigned old = xb_add(&bar[XB_XSUB(b.x)], 1u);
        const unsigned gen = old / nloc;
        if (old + 1u == (gen + 1u) * nloc) {
            __builtin_amdgcn_fence(__ATOMIC_RELEASE, "agent");
            asm volatile("s_waitcnt vmcnt(0)" ::: "memory");
            const unsigned og = xb_add(&bar[XB_TOP], 1u);
            const unsigned tg = og / nx;
            if (og + 1u == (tg + 1u) * nx) xb_add(&bar[XB_TOPGEN], 1u);
            else XB_SPIN(xb_ld(&bar[XB_TOPGEN]) == tg, bar);
            __builtin_amdgcn_fence(__ATOMIC_ACQUIRE, "agent");
            xb_add(&bar[XB_XGEN(b.x)], 1u);
            asm volatile("s_waitcnt vmcnt(0)" ::: "memory");
        } else {
            XB_SPIN(xb_ld(&bar[XB_XGEN(b.x)]) == gen, bar);
            __builtin_amdgcn_fence(__ATOMIC_ACQUIRE, "agent");
            asm volatile("s_waitcnt vmcnt(0)" ::: "memory");
        }
    }
    __syncthreads();
}
#ifndef MK_DUP
#define MK_DUP 0
#endif
struct Args { const float* in[14]; float* out; unsigned char* ws; int lo, hi; };
constexpr int NPHASE = 9;
__global__ void __launch_bounds__(NTHR, 2) mk_fwd(Args a) {
    extern __shared__ __attribute__((aligned(16))) unsigned char lds_raw[];
    Frame F; F.lds = (LAS unsigned char*)lds_raw; F.tid = threadIdx.x; F.lane = F.tid & 63; F.wave = __builtin_amdgcn_readfirstlane(F.tid >> 6);
    F.G = gridDim.x; { const int bx = blockIdx.x; F.vcu = (F.G % 8 == 0) ? (bx % 8) * (F.G / 8) + bx / 8 : bx; }
    unsigned char* ws = a.ws;
    const float* x = a.in[0];
    bf16* XN = (bf16*)(ws + WS_XN); bf16* Yb = (bf16*)(ws + WS_Y); bf16* PROJ = (bf16*)(ws + WS_PROJ); bf16* HB = (bf16*)(ws + WS_HB); bf16* ACT = (bf16*)(ws + WS_ACT);
    float* Z = (float*)(ws + WS_Z); float* CON = (float*)(ws + WS_CON); float* DEC = (float*)(ws + WS_DEC); bf16* SP = (bf16*)(ws + WS_SP);
    float* SS2 = (float*)(ws + WS_SS2); float* SS3 = (float*)(ws + WS_SS3);
    const int lo = a.lo, hi = a.hi;
#define IN(k) (lo <= (k) && (k) < hi)
#define SEAM(k) do { if (IN(k) && IN((k) + 1)) xcd_barrier(bar); } while (0)
    volatile LAS unsigned* MISC = (volatile LAS unsigned*)(F.lds + LDS_BYTES - 64);
    if (F.tid < 16) MISC[F.tid] = 0u;
    __syncthreads();
    unsigned* barw = (unsigned*)(ws + WS_BAR);
    if (a.lo < 0) cg::this_grid().sync();
    XcdBarrier bar; bar.bar = barw; bar.x = 0; bar.st = nullptr;
    if (hi - lo > 1) bar = xcd_barrier_post(barw, MISC + 8);
    if (IN(0)) phase_prologue(F, x, a.in[1], a.in[2], a.in[9], a.in[10], a.in[11], a.in[12], ws);
    SEAM(0);
    for (int rep_ = 0; rep_ < 1 + ((MK_DUP >> 1) & 1); ++rep_) if (IN(1)) {
        pg8::Gemm g{XN, (const bf16*)(ws + WS_WIN), M, NPROJ, D}; pg8::StaticOrder S; S.init(M, NPROJ, F.G, (int)blockIdx.x);
        pg8::EpiProj E{PROJ, NPROJ};
        pg8::gemm_phase<pg8::EpiProj, pg8::StaticOrder, true, true>(F.lds, g, S, E);
        phase_z(F, XN, (const bf16*)(ws + WS_WIN) + (size_t)NPROJ * D, Z);
    }
    SEAM(1);
    for (int rep_ = 0; rep_ < 1 + ((MK_DUP >> 2) & 1); ++rep_) if (IN(2)) {
        for (int rep2_ = 0; rep2_ < 1 + ((MK_DUP >> 9) & 1); ++rep2_)
        for (int u = F.vcu; u < 1024; u += F.G) gla_a_unit(F, PROJ, Z, a.in[4], a.in[5], a.in[6], a.in[7], CON, DEC, (bf16*)a.out, u);
        for (int rep2_ = 0; rep2_ < 1 + ((MK_DUP >> 10) & 1); ++rep2_)
        for (int w = F.vcu; w < 256; w += F.G) natten_wg(F, PROJ, a.in[3], Yb, w);
    }
    SEAM(2);
    for (int rep_ = 0; rep_ < 1 + ((MK_DUP >> 3) & 1); ++rep_) if (IN(3)) phase_scan(F, CON, DEC, SP);
    SEAM(3);
    for (int rep_ = 0; rep_ < 1 + ((MK_DUP >> 4) & 1); ++rep_) if (IN(4)) phase_gla_c(F, PROJ, SP, (const bf16*)a.out, a.in[8], Yb);
    SEAM(4);
    if (IN(5)) {
        pg8::Gemm g{Yb, (const bf16*)(ws + WS_WO), M, D, D}; pg8::StaticOrder S; S.init(M, D, F.G, (int)blockIdx.x);
        pg8::EpiRes E{x, a.out, HB, SS2, D};
        pg8::gemm_phase<pg8::EpiRes, pg8::StaticOrder, false, true>(F.lds, g, S, E);
    }
    SEAM(5);
    for (int rep_ = 0; rep_ < 1 + ((MK_DUP >> 6) & 1); ++rep_) if (IN(6)) {
        pg8::Gemm g{HB, (const bf16*)(ws + WS_W1), M, FF, D}; pg8::StaticOrder S; S.init(M, FF, F.G, (int)blockIdx.x);
        pg8::EpiFF1 E{ACT, FF, SS2, 1.0f / D, EPS};
        pg8::gemm_phase<pg8::EpiFF1, pg8::StaticOrder, true, true>(F.lds, g, S, E);
    }
    SEAM(6);
    if (IN(7)) {
        pg8::Gemm g{ACT, (const bf16*)(ws + WS_W2), M, D, FF}; pg8::StaticOrder S; S.init(M, D, F.G, (int)blockIdx.x);
        pg8::EpiRes E{a.out, a.out, nullptr, SS3, D};
        pg8::gemm_phase<pg8::EpiRes, pg8::StaticOrder, false, true>(F.lds, g, S, E);
    }
    SEAM(7);
    if (IN(8)) phase_final(F, a.out, SS3, a.in[13]);
#undef IN
#undef SEAM
}

#ifndef MK_ONE_LAUNCH
#define MK_ONE_LAUNCH 1
#endif
extern "C" void kernel_launch(void* const* d_in, const int* in_sizes, int n_in, void* d_out, int out_size, void* d_ws, size_t ws_size, hipStream_t stream) {
    static int grid = 0;
    if (grid == 0) {
        if (n_in != 14 || out_size != M * D || ws_size < WS_END) { fprintf(stderr, "kernel_launch: unexpected shapes (n_in %d out %d ws %zu)\n", n_in, out_size, ws_size); grid = -1; return; }
        int dev = 0, cus = 0, per_cu = 0;
        hipGetDevice(&dev); hipDeviceGetAttribute(&cus, hipDeviceAttributeMultiprocessorCount, dev);
        if (hipFuncSetAttribute((const void*)mk_fwd, hipFuncAttributeMaxDynamicSharedMemorySize, LDS_BYTES) != hipSuccess) { fprintf(stderr, "kernel_launch: hipFuncSetAttribute failed\n"); grid = -1; return; }
        if (hipOccupancyMaxActiveBlocksPerMultiprocessor(&per_cu, (const void*)mk_fwd, NTHR, LDS_BYTES) != hipSuccess || per_cu < 1) { fprintf(stderr, "kernel_launch: occupancy query says %d\n", per_cu); per_cu = 1; }
        (void)hipGetLastError();
        grid = cus * 1;
    }
    if (grid < 0) return;
    Args a{};
    for (int i = 0; i < 14; ++i) a.in[i] = (const float*)d_in[i];
    a.out = (float*)d_out; a.ws = (unsigned char*)d_ws;
#if MK_ONE_LAUNCH
    if (hipMemsetAsync((char*)d_ws + WS_BAR, 0, XCD_BAR_WORDS * 4, stream) != hipSuccess) { fprintf(stderr, "kernel_launch: memset of the barrier words failed\n"); return; }
    a.lo = 0; a.hi = NPHASE;
    void* args[] = {&a};
    hipError_t e = hipLaunchCooperativeKernel((const void*)mk_fwd, dim3(grid), dim3(NTHR), args, LDS_BYTES, stream);
    if (e != hipSuccess) fprintf(stderr, "cooperative launch failed: %s (grid %d)\n", hipGetErrorString(e), grid);
#else
    for (int p = 0; p < NPHASE; ++p) { a.lo = p; a.hi = p + 1; hipLaunchKernelGGL(mk_fwd, dim3(grid), dim3(NTHR), LDS_BYTES, stream, a); }
#endif
}
```

```cpp
#include <hip/hip_runtime.h>
#include <hip/hip_cooperative_groups.h>
#include <cstdio>
#include <cstdint>
#include <cmath>
namespace cg = cooperative_groups;
namespace pg8 {
#define PG8_LAS __attribute__((address_space(3)))
typedef unsigned short bf16_t;
typedef short bf16x8 __attribute__((ext_vector_type(8)));
typedef float f32x4 __attribute__((ext_vector_type(4)));
typedef unsigned u32x4 __attribute__((ext_vector_type(4)));
constexpr int BM = 256, BK = 64, HALF = 128, HTB = HALF * BK * 2  , STAGE_BYTES = 8 * HTB, NXCD = 8, WGM = 8;

__host__ __device__ __forceinline__ int lds_byte(int r, int c) { const int st = (r >> 4) * 2 + (c >> 5), rr = r & 15, cc = c & 31, ob = rr * 64 + cc * 2; return st * 1024 + (ob ^ (((ob >> 9) & 1) << 5)); }
__host__ __device__ __forceinline__ void stage_rc(int b, int& R, int& C) { const int st = b / 1024, sb = b % 1024, swz = sb ^ (((sb >> 9) & 1) << 5); R = (st >> 1) * 16 + swz / 64; C = (st & 1) * 32 + (swz % 64) / 2; }
__host__ __device__ __forceinline__ int perm32(int rho) { const int n = rho >> 4, i = rho & 15; return 8 * (i >> 2) + 4 * n + (i & 3); }

struct Unit { int pm, pn; };
struct Gemm { const bf16_t* A; const bf16_t* Bt; int M, N, K; };

struct StaticOrder {
    int nM, nN, nwg, G, c;
    __host__ __device__ void init(int M, int N, int G_, int c_) { nM = M / BM; nN = N / BM; nwg = nM * nN; G = G_; c = c_; }
    __host__ __device__ bool next(int i, Unit& u) const {
        const long L = (long)i * G + c; if (L >= nwg) return false;
        int wgid = (int)L; { const int q = nwg / NXCD, r = nwg % NXCD, xcd = wgid % NXCD, off = wgid / NXCD; wgid = (xcd < r ? xcd * (q + 1) : r * (q + 1) + (xcd - r) * q) + off; }
        const int nig = WGM * nN, gid = wgid / nig, fm = gid * WGM, gsz = (nM - fm) < WGM ? (nM - fm) : WGM;
        u.pm = fm + ((wgid % nig) % gsz); u.pn = (wgid % nig) / gsz; return true;
    }
    __device__ __forceinline__ void a_ready(const Unit&) const {}
    __device__ __forceinline__ void done(const Unit&) const {}
};

__device__ __forceinline__ unsigned cvt_pk_bf16(float lo, float hi) { unsigned r; asm volatile("v_cvt_pk_bf16_f32 %0, %1, %2" : "=v"(r) : "v"(lo), "v"(hi)); return r; }
typedef unsigned u32x2 __attribute__((ext_vector_type(2)));
struct EpiProj {
    static constexpr bool PERM = true, AFTER_DRAIN = false;
    bf16_t* O; int ldc;
    __device__ __forceinline__ void operator()(const f32x4 (&acc)[2][2][4][2], const Unit& u, int wr, int wc, int fr, int fq) const {
        const int row0 = u.pm * BM + wr * 64 + fr, col0 = u.pn * BM + wc * 32 + 8 * fq;
#pragma unroll
        for (int ai = 0; ai < 2; ++ai)
#pragma unroll
            for (int m = 0; m < 4; ++m) { bf16_t* rowp = O + (size_t)(row0 + ai * HALF + m * 16) * ldc + col0;
#pragma unroll
                for (int bj = 0; bj < 2; ++bj) { const f32x4 v0 = acc[ai][bj][m][0], v1 = acc[ai][bj][m][1];
                    u32x4 w; w.x = cvt_pk_bf16(v0[0], v0[1]); w.y = cvt_pk_bf16(v0[2], v0[3]); w.z = cvt_pk_bf16(v1[0], v1[1]); w.w = cvt_pk_bf16(v1[2], v1[3]);
                    *(u32x4*)(rowp + bj * HALF) = w; } }
    }
};
struct EpiFF1 {
    static constexpr bool PERM = true, AFTER_DRAIN = false;
    bf16_t* O; int ldc; const float* sumsq; float inv_n, eps;
    __device__ __forceinline__ void operator()(const f32x4 (&acc)[2][2][4][2], const Unit& u, int wr, int wc, int fr, int fq) const {
        const int row0 = u.pm * BM + wr * 64 + fr, col0 = u.pn * BM + wc * 32 + 8 * fq;
#pragma unroll
        for (int ai = 0; ai < 2; ++ai)
#pragma unroll
            for (int m = 0; m < 4; ++m) { const int row = row0 + ai * HALF + m * 16; bf16_t* rowp = O + (size_t)row * ldc + col0;
                const float rs = 1.0f / sqrtf(sumsq[row] * inv_n + eps);
#pragma unroll
                for (int bj = 0; bj < 2; ++bj) { f32x4 v0 = acc[ai][bj][m][0] * rs, v1 = acc[ai][bj][m][1] * rs;
#pragma unroll
                    for (int e = 0; e < 4; ++e) { const float a = fmaxf(v0[e], 0.f), b = fmaxf(v1[e], 0.f); v0[e] = a * a; v1[e] = b * b; }
                    u32x4 w; w.x = cvt_pk_bf16(v0[0], v0[1]); w.y = cvt_pk_bf16(v0[2], v0[3]); w.z = cvt_pk_bf16(v1[0], v1[1]); w.w = cvt_pk_bf16(v1[2], v1[3]);
                    *(u32x4*)(rowp + bj * HALF) = w; } }
    }
};
struct EpiRes {
    static constexpr bool PERM = false, AFTER_DRAIN = false;
    const float* base; float* out; bf16_t* hb; float* sumsq; int ldc;
    __device__ __forceinline__ void operator()(const f32x4 (&acc)[2][2][4][2], const Unit& u, int wr, int wc, int fr, int fq) const {
        const int col0 = u.pn * BM + wc * 32 + 4 * fq;
#pragma unroll
        for (int ai = 0; ai < 2; ++ai)
#pragma unroll
            for (int m = 0; m < 4; ++m) { const int row = u.pm * BM + ai * HALF + wr * 64 + m * 16 + fr; const size_t off = (size_t)row * ldc + col0; float s = 0.f;
#pragma unroll
                for (int bj = 0; bj < 2; ++bj)
#pragma unroll
                    for (int n = 0; n < 2; ++n) { const f32x4 bs = *(const f32x4*)(base + off + bj * HALF + n * 16); const f32x4 o = bs + acc[ai][bj][m][n];
                        *(f32x4*)(out + off + bj * HALF + n * 16) = o;
                        if (hb) { u32x2 w; w.x = cvt_pk_bf16(o[0], o[1]); w.y = cvt_pk_bf16(o[2], o[3]); *(u32x2*)(hb + off + bj * HALF + n * 16) = w; }
                        s += (o[0] * o[0] + o[1] * o[1]) + (o[2] * o[2] + o[3] * o[3]); }
                s += __shfl_xor(s, 16); s += __shfl_xor(s, 32);
                if (fq == 0) unsafeAtomicAdd(sumsq + row, s);
                asm volatile("" ::: "memory"); }
    }
};

struct EpiResNorm {
    static constexpr bool PERM = false, AFTER_DRAIN = true;
    const float* base; float* out; float* sumsq; unsigned* cnt; const float* g; int ldc; int fuse; unsigned want; float inv_n, eps;
    __device__ __forceinline__ void fused(f32x4 (&acc)[2][2][4][2], const Unit& u, int wr, int wc, int fr, int fq, PG8_LAS unsigned char* lds, int wid, int lane) const {
        const int col0 = u.pn * BM + wc * 32 + 4 * fq;
#pragma unroll
        for (int ai = 0; ai < 2; ++ai)
#pragma unroll
            for (int m = 0; m < 4; ++m) { const int row = u.pm * BM + ai * HALF + wr * 64 + m * 16 + fr; const size_t off = (size_t)row * ldc + col0; float s = 0.f;
#pragma unroll
                for (int bj = 0; bj < 2; ++bj)
#pragma unroll
                    for (int n = 0; n < 2; ++n) { const f32x4 bs = *(const f32x4*)(base + off + bj * HALF + n * 16); const f32x4 o = bs + acc[ai][bj][m][n]; acc[ai][bj][m][n] = o;
                        if (!fuse) *(f32x4*)(out + off + bj * HALF + n * 16) = o;
                        s += (o[0] * o[0] + o[1] * o[1]) + (o[2] * o[2] + o[3] * o[3]); }
                s += __shfl_xor(s, 16); s += __shfl_xor(s, 32);
                if (fq == 0) unsafeAtomicAdd(sumsq + row, s);
                asm volatile("" ::: "memory"); }
        if (!fuse) return;
        asm volatile("s_waitcnt vmcnt(0)" ::: "memory");
        if (lane == 0) __hip_atomic_fetch_add(cnt + 64 * u.pm, 1u, __ATOMIC_RELAXED, __HIP_MEMORY_SCOPE_AGENT);
        if (wid == 0) { while ((unsigned)__builtin_amdgcn_readfirstlane(__hip_atomic_load(cnt + 64 * u.pm, __ATOMIC_RELAXED, __HIP_MEMORY_SCOPE_AGENT)) < want) __builtin_amdgcn_s_sleep(2); }
        asm volatile("s_waitcnt vmcnt(0) lgkmcnt(0)" ::: "memory"); __builtin_amdgcn_s_barrier(); asm volatile("" ::: "memory");
        __builtin_amdgcn_fence(__ATOMIC_ACQUIRE, "agent");
        f32x4 gv[2][2];
#pragma unroll
        for (int bj = 0; bj < 2; ++bj)
#pragma unroll
            for (int n = 0; n < 2; ++n) gv[bj][n] = *(const f32x4*)(g + col0 + bj * HALF + n * 16);
#pragma unroll
        for (int ai = 0; ai < 2; ++ai)
#pragma unroll
            for (int m = 0; m < 4; ++m) { const int row = u.pm * BM + ai * HALF + wr * 64 + m * 16 + fr; const size_t off = (size_t)row * ldc + col0;
                const float ssv = __hip_atomic_load(sumsq + row, __ATOMIC_RELAXED, __HIP_MEMORY_SCOPE_AGENT); const float rs = 1.0f / sqrtf(ssv * inv_n + eps);
#pragma unroll
                for (int bj = 0; bj < 2; ++bj)
#pragma unroll
                    for (int n = 0; n < 2; ++n) *(f32x4*)(out + off + bj * HALF + n * 16) = acc[ai][bj][m][n] * rs * gv[bj][n]; }
    }
};
template <class Epi, class Sched, bool ALIGN_EPI = false, bool SP2 = false>
__device__ __forceinline__ void gemm_phase(PG8_LAS unsigned char* lds, const Gemm g, const Sched& S, const Epi& E) {
    const int tid = threadIdx.x, wid = __builtin_amdgcn_readfirstlane(tid >> 6), lane = tid & 63, wr = wid >> 2, wc = wid & 3, fr = lane & 15, fq = lane >> 4;
    const int K = g.K, nt = K / BK;
    unsigned voffA[2], voffB[2];
#pragma unroll
    for (int i = 0; i < 2; ++i) { int R, C; stage_rc(tid * 16 + i * 8192, R, C); const int Rb = Epi::PERM ? ((R & ~31) + perm32(R & 31)) : R;
        voffA[i] = (unsigned)(R * K + C) * 2u; voffB[i] = (unsigned)(Rb * K + C) * 2u; }
    const size_t kstep = (size_t)(BK * 2);
    const size_t hstep = (size_t)HALF * K * 2;
    const size_t tstep = 2 * hstep;
    const unsigned ldsw = (unsigned)wid * 1024u;
    const int aoff = lds_byte(wr * 64 + fr, fq * 8), boff = lds_byte(wc * 32 + fr, fq * 8);
#define PG8_SA(b, h) (((b) * 2 + (h)) * HTB)
#define PG8_SB(b, h) ((4 + (b) * 2 + (h)) * HTB)
#define PG8_STAGE(bufoff, gbase, voff) do { _Pragma("unroll") for (int _i = 0; _i < 2; ++_i) \
        __builtin_amdgcn_global_load_lds((const unsigned*)((const char*)(gbase) + (voff)[_i]), (PG8_LAS unsigned*)(lds + (bufoff) + ldsw + _i * 8192), 16, 0, 0); } while (0)
#define PG8_LDA(dst, b, h) do { _Pragma("unroll") for (int m = 0; m < 4; ++m) _Pragma("unroll") for (int k = 0; k < 2; ++k) dst[m][k] = *(const PG8_LAS bf16x8*)(lds + PG8_SA(b, h) + aoff + m * 2048 + k * 1024); } while (0)
#define PG8_LDB(dst, b, h) do { _Pragma("unroll") for (int n = 0; n < 2; ++n) _Pragma("unroll") for (int k = 0; k < 2; ++k) dst[n][k] = *(const PG8_LAS bf16x8*)(lds + PG8_SB(b, h) + boff + n * 2048 + k * 1024); } while (0)
#define PG8_MMA(ai, bj, At, Bt) do { __builtin_amdgcn_s_setprio(1); _Pragma("unroll") for (int m = 0; m < 4; ++m) _Pragma("unroll") for (int n = 0; n < 2; ++n) _Pragma("unroll") for (int k = 0; k < 2; ++k) \
        acc[ai][bj][m][n] = __builtin_amdgcn_mfma_f32_16x16x32_bf16(Bt[n][k], At[m][k], acc[ai][bj][m][n], 0, 0, 0); __builtin_amdgcn_s_setprio(0); } while (0)
#define PG8_WAIT_V(n) asm volatile("s_waitcnt vmcnt(" #n ")" ::: "memory")
#define PG8_WAIT_L(n) asm volatile("s_waitcnt lgkmcnt(" #n ")" ::: "memory")
#define PG8_BAR __builtin_amdgcn_s_barrier()
#define PG8_SCHED __builtin_amdgcn_sched_barrier(0)
    Unit cur, nxt; int ui = 0;
    if (!S.next(0, cur)) return;
    f32x4 acc[2][2][4][2];
#pragma unroll
    for (int a = 0; a < 2; ++a)
#pragma unroll
        for (int b = 0; b < 2; ++b)
#pragma unroll
            for (int m = 0; m < 4; ++m)
#pragma unroll
                for (int n = 0; n < 2; ++n) acc[a][b][m][n] = (f32x4){0.f, 0.f, 0.f, 0.f};
    bf16x8 At[4][2], B0[2][2], B1[2][2];
    const char* cA = (const char*)g.A + (size_t)cur.pm * tstep; const char* cB = (const char*)g.Bt + (size_t)cur.pn * tstep;
    S.a_ready(cur);
    if constexpr (SP2) {
        PG8_STAGE(PG8_SB(0, 0), cB, voffB); PG8_STAGE(PG8_SB(0, 1), cB + hstep, voffB); PG8_STAGE(PG8_SA(0, 0), cA, voffA); PG8_STAGE(PG8_SA(0, 1), cA + hstep, voffA);
        if (wr == 1) PG8_BAR;
        PG8_WAIT_V(2); PG8_BAR;
        PG8_STAGE(PG8_SB(1, 0), cB + kstep, voffB); PG8_STAGE(PG8_SA(1, 0), cA + kstep, voffA); PG8_STAGE(PG8_SB(1, 1), cB + hstep + kstep, voffB);
        PG8_WAIT_V(6); PG8_BAR;
    } else {
        PG8_STAGE(PG8_SB(0, 0), cB, voffB); PG8_STAGE(PG8_SA(0, 0), cA, voffA); PG8_STAGE(PG8_SB(0, 1), cB + hstep, voffB); PG8_STAGE(PG8_SA(0, 1), cA + hstep, voffA);
        if (wr == 1) PG8_BAR;
        PG8_WAIT_V(4); PG8_BAR;
        PG8_STAGE(PG8_SB(1, 0), cB + kstep, voffB); PG8_STAGE(PG8_SA(1, 0), cA + kstep, voffA); PG8_STAGE(PG8_SB(1, 1), cB + hstep + kstep, voffB);
        PG8_WAIT_V(6); PG8_BAR;
    }
    for (;;) {
        const bool has_next = S.next(ui + 1, nxt);
        const char* nA = has_next ? (const char*)g.A + (size_t)nxt.pm * tstep : cA; const char* nB = has_next ? (const char*)g.Bt + (size_t)nxt.pn * tstep : cB;
        for (int t = 0; t < nt; t += 2) {
            const bool last = (t == nt - 2);
            const char* a1 = cA + (size_t)(t + 1) * kstep;
            const char* a2 = last ? nA : cA + (size_t)(t + 2) * kstep; const char* b2 = last ? nB : cB + (size_t)(t + 2) * kstep;
            const char* a3 = a2 + kstep; const char* b3 = b2 + kstep;
            if (last && has_next) S.a_ready(nxt);
            if constexpr (SP2) {
            PG8_LDB(B0, 0, 0); PG8_LDB(B1, 0, 1); PG8_SCHED; PG8_LDA(At, 0, 0); PG8_STAGE(PG8_SA(1, 1), a1 + hstep, voffA);
            PG8_WAIT_V(8); PG8_WAIT_L(0); PG8_BAR; PG8_MMA(0, 0, At, B0); PG8_MMA(0, 1, At, B1); PG8_BAR; PG8_SCHED;
            PG8_LDA(At, 0, 1); PG8_STAGE(PG8_SB(0, 0), b2, voffB); PG8_STAGE(PG8_SB(0, 1), b2 + hstep, voffB); PG8_STAGE(PG8_SA(0, 0), a2, voffA);
            PG8_WAIT_V(8); PG8_WAIT_L(0); PG8_BAR; PG8_MMA(1, 0, At, B0); PG8_MMA(1, 1, At, B1); PG8_BAR; PG8_SCHED;
            PG8_LDB(B0, 1, 0); PG8_LDB(B1, 1, 1); PG8_SCHED; PG8_LDA(At, 1, 0); PG8_STAGE(PG8_SA(0, 1), a2 + hstep, voffA);
            PG8_WAIT_V(8); PG8_WAIT_L(0); PG8_BAR; PG8_MMA(0, 0, At, B0); PG8_MMA(0, 1, At, B1); PG8_BAR; PG8_SCHED;
            PG8_LDA(At, 1, 1); PG8_STAGE(PG8_SB(1, 0), b3, voffB); PG8_STAGE(PG8_SB(1, 1), b3 + hstep, voffB); PG8_STAGE(PG8_SA(1, 0), a3, voffA);
            PG8_WAIT_V(8); PG8_WAIT_L(0); PG8_BAR; PG8_MMA(1, 0, At, B0); PG8_MMA(1, 1, At, B1); PG8_BAR; PG8_SCHED;
            } else {
            PG8_LDB(B0, 0, 0); PG8_SCHED; PG8_LDA(At, 0, 0); PG8_STAGE(PG8_SA(1, 1), a1 + hstep, voffA);
            PG8_WAIT_L(8); PG8_BAR; PG8_WAIT_L(0); PG8_MMA(0, 0, At, B0); PG8_BAR; PG8_SCHED;
            PG8_LDB(B1, 0, 1); PG8_STAGE(PG8_SB(0, 0), b2, voffB);
            PG8_BAR; PG8_WAIT_L(0); PG8_MMA(0, 1, At, B1); PG8_BAR;
            PG8_LDA(At, 0, 1); PG8_STAGE(PG8_SA(0, 0), a2, voffA);
            PG8_BAR; PG8_WAIT_L(0); PG8_MMA(1, 0, At, B0); PG8_BAR; PG8_SCHED;
            PG8_STAGE(PG8_SB(0, 1), b2 + hstep, voffB);
            PG8_WAIT_V(6); PG8_BAR; PG8_MMA(1, 1, At, B1); PG8_BAR;
            PG8_LDB(B0, 1, 0); PG8_SCHED; PG8_LDA(At, 1, 0); PG8_STAGE(PG8_SA(0, 1), a2 + hstep, voffA);
            PG8_WAIT_L(8); PG8_BAR; PG8_WAIT_L(0); PG8_MMA(0, 0, At, B0); PG8_BAR; PG8_SCHED;
            PG8_LDB(B1, 1, 1); PG8_STAGE(PG8_SB(1, 0), b3, voffB);
            PG8_BAR; PG8_WAIT_L(0); PG8_MMA(0, 1, At, B1); PG8_BAR;
            PG8_LDA(At, 1, 1); PG8_STAGE(PG8_SA(1, 0), a3, voffA);
            PG8_BAR; PG8_WAIT_L(0); PG8_MMA(1, 0, At, B0); PG8_BAR; PG8_SCHED;
            PG8_STAGE(PG8_SB(1, 1), b3 + hstep, voffB);
            PG8_WAIT_V(6); PG8_BAR; PG8_MMA(1, 1, At, B1); PG8_BAR;
            }
        }
        if constexpr (ALIGN_EPI) { if (wr == 0) PG8_BAR; }
        if constexpr (!Epi::AFTER_DRAIN) { E(acc, cur, wr, wc, fr, fq); S.done(cur); }
        if (!has_next) break;
#pragma unroll
        for (int a = 0; a < 2; ++a)
#pragma unroll
            for (int b = 0; b < 2; ++b)
#pragma unroll
                for (int m = 0; m < 4; ++m)
#pragma unroll
                    for (int n = 0; n < 2; ++n) acc[a][b][m][n] = (f32x4){0.f, 0.f, 0.f, 0.f};
        cur = nxt; cA = nA; cB = nB; ++ui;
        if constexpr (ALIGN_EPI) { if (wr == 1) PG8_BAR; }
    }
    PG8_WAIT_V(0);
    if constexpr (!ALIGN_EPI) { if (wr == 0) PG8_BAR; }
    PG8_BAR;
    if constexpr (Epi::AFTER_DRAIN) { E.fused(acc, cur, wr, wc, fr, fq, lds, wid, lane); S.done(cur); }
#undef PG8_SA
#undef PG8_SB
#undef PG8_STAGE
#undef PG8_LDA
#undef PG8_LDB
#undef PG8_MMA
#undef PG8_WAIT_V
#undef PG8_WAIT_L
#undef PG8_BAR
#undef PG8_SCHED
}
}
#define GAS __attribute__((address_space(1)))
#define LAS __attribute__((address_space(3)))
typedef unsigned short bf16;
typedef unsigned v4u __attribute__((ext_vector_type(4)));
typedef unsigned v2u __attribute__((ext_vector_type(2)));
typedef float f32x4 __attribute__((ext_vector_type(4)));
typedef short bf16x8 __attribute__((ext_vector_type(8)));
typedef short s16x4 __attribute__((ext_vector_type(4)));

constexpr int NWAVES = 8, NTHR = 512;
constexpr int T = 8192, D = 1024, M = 16384, NPROJ = 3072, DIN = 3104, FF = 4096;
constexpr float EPS = 1e-6f;
constexpr int C_QA = 0, C_KA = 512, C_VA = 1024, C_QG = 1536, C_KG = 1792, C_VG = 2048, C_RG = 2560;

constexpr size_t MiB = 1u << 20;
constexpr size_t WS_SS2 = 0, WS_SS3 = 65536, WS_BAR = 131072, WS_PCNT = 131072 + 16384, WS_ZERO_BYTES = 32768, WS_DEC = 262144, WS_Z = 1 * MiB;
constexpr size_t WS_WIN = 4 * MiB, WS_WO = 11 * MiB, WS_W1 = 13 * MiB, WS_W2 = 21 * MiB;
constexpr size_t WS_XN = 32 * MiB, WS_Y = 32 * MiB, WS_PROJ = 64 * MiB, WS_CON = 160 * MiB, WS_SP = 224 * MiB;
constexpr size_t WS_HB = 64 * MiB, WS_ACT = 96 * MiB, WS_END = 256 * MiB;
constexpr int LDS_BYTES = 155648;

__device__ __forceinline__ unsigned f2bf(float f) { unsigned u = __builtin_bit_cast(unsigned, f); return (u + 0x7fffu + ((u >> 16) & 1u)) >> 16; }
__device__ __forceinline__ unsigned pk2(float lo, float hi) { return f2bf(lo) | (f2bf(hi) << 16); }
__device__ __forceinline__ float bf2f(unsigned short h) { return __builtin_bit_cast(float, (unsigned)h << 16); }
__device__ __forceinline__ float wave_sum(float v) {
#pragma unroll
    for (int o = 1; o < 64; o <<= 1) v += __shfl_xor(v, o);
    return v;
}
__device__ __forceinline__ f32x4 mfma16(bf16x8 x, bf16x8 y, f32x4 c) { return __builtin_amdgcn_mfma_f32_16x16x32_bf16(x, y, c, 0, 0, 0); }
typedef short v4i16_t __attribute__((ext_vector_type(4)));
__device__ __forceinline__ s16x4 tr4(const LAS unsigned char* p) { return __builtin_bit_cast(s16x4, __builtin_amdgcn_ds_read_tr16_b64_v4i16((LAS v4i16_t*)p)); }
__device__ __forceinline__ bf16x8 cat8(s16x4 a, s16x4 b) { bf16x8 r; r[0] = a[0]; r[1] = a[1]; r[2] = a[2]; r[3] = a[3]; r[4] = b[0]; r[5] = b[1]; r[6] = b[2]; r[7] = b[3]; return r; }
__device__ __forceinline__ bf16x8 pack8(f32x4 a, f32x4 b) {
    v4u w; w.x = pg8::cvt_pk_bf16(a[0], a[1]); w.y = pg8::cvt_pk_bf16(a[2], a[3]); w.z = pg8::cvt_pk_bf16(b[0], b[1]); w.w = pg8::cvt_pk_bf16(b[2], b[3]);
    return __builtin_bit_cast(bf16x8, w);
}

struct Frame {
    LAS unsigned char* lds;
    int tid, lane, wave, vcu, G;
};

__device__ __forceinline__ void p0_transpose_item(const float* W, int K, int N, bf16* WT, const float* gk, LAS float* scr, int item, int lane) {
    const int nblk = N / 32, kb = item / nblk, nb = item % nblk, k0 = 64 * kb, n0 = 32 * nb;
#pragma unroll 8
    for (int i = 0; i < 32; ++i) { const int kk = 2 * i + (lane >> 5); float v = W[(size_t)(k0 + kk) * N + n0 + (lane & 31)]; if (gk) v *= gk[k0 + kk]; scr[kk * 33 + (lane & 31)] = v; }
    asm volatile("s_waitcnt lgkmcnt(0)" ::: "memory");
    const int c = lane & 7;
#pragma unroll
    for (int j = 0; j < 4; ++j) { const int n = (lane >> 3) + 8 * j; const LAS float* s = scr + (8 * c) * 33 + n;
        v4u o; o.x = pk2(s[0 * 33], s[1 * 33]); o.y = pk2(s[2 * 33], s[3 * 33]); o.z = pk2(s[4 * 33], s[5 * 33]); o.w = pk2(s[6 * 33], s[7 * 33]);
        *(v4u*)(WT + (size_t)(n0 + n) * K + k0 + 8 * c) = o; }
    asm volatile("s_waitcnt lgkmcnt(0)" ::: "memory");
}
__device__ __forceinline__ void phase_prologue(const Frame& F, const float* x, const float* g_mix, const float* w_in, const float* w_out, const float* g_ff, const float* w1, const float* w2, unsigned char* ws) {
    LAS float* scr = (LAS float*)(F.lds + F.wave * 16384);
    const int gw = F.vcu * NWAVES + F.wave, NGW = F.G * NWAVES;
    constexpr int I_IN = (D / 64) * (DIN / 32), I_O = (D / 64) * (D / 32), I_1 = (D / 64) * (FF / 32), I_2 = (FF / 64) * (D / 32);
    constexpr int NITEMS = I_IN + I_O + I_1 + I_2;
    for (int it = gw; it < NITEMS; it += NGW) {
        int r = it;
        if (r < I_IN) { p0_transpose_item(w_in, D, DIN, (bf16*)(ws + WS_WIN), nullptr, scr, r, F.lane); continue; } r -= I_IN;
        if (r < I_O) { p0_transpose_item(w_out, D, D, (bf16*)(ws + WS_WO), nullptr, scr, r, F.lane); continue; } r -= I_O;
        if (r < I_1) { p0_transpose_item(w1, D, FF, (bf16*)(ws + WS_W1), g_ff, scr, r, F.lane); continue; } r -= I_1;
        p0_transpose_item(w2, FF, D, (bf16*)(ws + WS_W2), nullptr, scr, r, F.lane);
    }
    { float* ss = (float*)(ws + WS_SS2); for (int i = (F.vcu * NTHR + F.tid); i < 2 * M; i += F.G * NTHR) ss[i] = 0.f; }
    bf16* XN = (bf16*)(ws + WS_XN);
    f32x4 gv[4];
#pragma unroll
    for (int j = 0; j < 4; ++j) gv[j] = ((const f32x4*)g_mix)[F.lane + 64 * j];
    for (int m = gw; m < M; m += NGW) {
        const f32x4* xr = (const f32x4*)(x + (size_t)m * D) + F.lane;
        f32x4 v[4]; float s = 0.f;
#pragma unroll
        for (int j = 0; j < 4; ++j) { v[j] = xr[64 * j]; s += (v[j].x * v[j].x + v[j].y * v[j].y) + (v[j].z * v[j].z + v[j].w * v[j].w); }
        const float rs = 1.0f / sqrtf(wave_sum(s) * (1.f / D) + EPS);
        unsigned long long* o8 = (unsigned long long*)(XN + (size_t)m * D) + F.lane;
#pragma unroll
        for (int j = 0; j < 4; ++j) { const f32x4 o = v[j] * rs * gv[j]; o8[64 * j] = (unsigned long long)pk2(o.x, o.y) | ((unsigned long long)pk2(o.z, o.w) << 32); }
    }
}

__device__ __forceinline__ void phase_z(const Frame& F, const bf16* XN, const bf16* Wz, float* Z) {
    const int fr = F.lane & 15, fq = F.lane >> 4, mt = F.wave & 3, nt = F.wave >> 2;
    for (int rb = F.vcu; rb < M / 64; rb += F.G) {
        const bf16* ap = XN + (size_t)(rb * 64 + mt * 16 + fr) * D + 8 * fq;
        const bf16* bp = Wz + (size_t)(nt * 16 + fr) * D + 8 * fq;
        f32x4 acc = {0.f, 0.f, 0.f, 0.f};
#pragma unroll 8
        for (int ks = 0; ks < D / 32; ++ks) { const bf16x8 a = *(const bf16x8*)(ap + ks * 32), b = *(const bf16x8*)(bp + ks * 32); acc = mfma16(b, a, acc); }
        *(f32x4*)(Z + (size_t)(rb * 64 + mt * 16 + fr) * 32 + nt * 16 + 4 * fq) = acc;
    }
}

constexpr int NA_STR = 144, NA_K_OFF = 0, NA_V_OFF = 512 * NA_STR, NA_RPB_OFF = 2 * 512 * NA_STR;
__device__ __forceinline__ void natten_compute(const Frame& F, const bf16x8 (&qf)[2], bf16* Y, int b, int h, int r, int rs) {
    LAS unsigned char* lds = F.lds;
    const size_t tokq0 = (size_t)b * T + r * 64;
    const int fr = F.lane & 15, fq = F.lane >> 4, jq = F.wave & 3, dh = F.wave >> 2;
    const int wc0 = (jq == 0) ? 0 : (jq == 1) ? 8 : (jq == 2) ? 24 : 32;
    f32x4 s[16];
#pragma unroll
    for (int i = 0; i < 8; ++i)
#pragma unroll
        for (int ct = 0; ct < 2; ++ct) {
            const LAS unsigned char* kp = lds + NA_K_OFF + (((rs + i) & 7) * 64 + wc0 + 16 * ct + fr) * NA_STR + fq * 16;
            const bf16x8 k0 = *(const LAS bf16x8*)kp, k1 = *(const LAS bf16x8*)(kp + 64);
            f32x4 a = {0.f, 0.f, 0.f, 0.f}; a = mfma16(k0, qf[0], a); a = mfma16(k1, qf[1], a); s[i * 2 + ct] = a; }
    const int cq = 16 * jq + fr, cs = min(max(cq - 8, 0), 48);
    const LAS float* rp = (const LAS float*)(lds + NA_RPB_OFF);
    float mx = -INFINITY;
#pragma unroll
    for (int i = 0; i < 8; ++i) { const int dr = rs + i - r + 7;
#pragma unroll
        for (int ct = 0; ct < 2; ++ct)
#pragma unroll
            for (int e = 0; e < 4; ++e) { const int ck = wc0 + 16 * ct + 4 * fq + e; const bool in = (ck >= cs) && (ck < cs + 16);
                const int dc = min(max(ck - cq + 15, 0), 30);
                const float v = in ? s[i * 2 + ct][e] * 0.125f + rp[dr * 31 + dc] : -INFINITY; s[i * 2 + ct][e] = v; mx = fmaxf(mx, v); } }
    mx = fmaxf(mx, __shfl_xor(mx, 16)); mx = fmaxf(mx, __shfl_xor(mx, 32));
    float l = 0.f;
#pragma unroll
    for (int t = 0; t < 16; ++t)
#pragma unroll
        for (int e = 0; e < 4; ++e) { const float p = __expf(s[t][e] - mx); s[t][e] = p; l += p; }
    l += __shfl_xor(l, 16); l += __shfl_xor(l, 32);
    f32x4 o[2] = {{0.f, 0.f, 0.f, 0.f}, {0.f, 0.f, 0.f, 0.f}};
#pragma unroll
    for (int i = 0; i < 8; ++i) { const bf16x8 pb = pack8(s[2 * i], s[2 * i + 1]);
#pragma unroll
        for (int dt = 0; dt < 2; ++dt) { const int d0 = 32 * dh + 16 * dt;
            const LAS unsigned char* vp = lds + NA_V_OFF + (((rs + i) & 7) * 64 + wc0 + 4 * fq + (fr >> 2)) * NA_STR + (d0 + 4 * (fr & 3)) * 2;
            const bf16x8 x = cat8(tr4(vp), tr4(vp + 16 * NA_STR)); o[dt] = mfma16(x, pb, o[dt]); } }
    const float inv = 1.0f / l;
#pragma unroll
    for (int dt = 0; dt < 2; ++dt) { v2u w; w.x = pg8::cvt_pk_bf16(o[dt][0] * inv, o[dt][1] * inv); w.y = pg8::cvt_pk_bf16(o[dt][2] * inv, o[dt][3] * inv);
        *(v2u*)(Y + (tokq0 + 16 * jq + fr) * D + h * 64 + 32 * dh + 16 * dt + 4 * fq) = w; }
}
__device__ __forceinline__ void natten_wg(const Frame& F, const bf16* PROJ, const float* rpb, bf16* Y, int wgi) {
    LAS unsigned char* lds = F.lds;
    const int bh = wgi >> 4, r0 = 8 * (wgi & 15), h = bh & 7, b = bh >> 3;
    const int fr = F.lane & 15, fq = F.lane >> 4, jq = F.wave & 3;
    const bf16* qbase = PROJ + ((size_t)b * T + 16 * jq + fr) * NPROJ + C_QA + h * 64 + 8 * fq;
    bf16x8 qf[2], qn[2];
    { const bf16* qp = qbase + (size_t)r0 * 64 * NPROJ; qf[0] = *(const bf16x8*)qp; qf[1] = *(const bf16x8*)(qp + 32); }
    { const int rs0 = min(max(r0 - 4, 0), 120);
#pragma unroll
      for (int it = 0; it < 8; ++it) { const int id = F.tid + NTHR * it, key = id >> 3, ch = id & 7, row = rs0 + (key >> 6), col = key & 63;
        const bf16* src = PROJ + ((size_t)b * T + row * 64 + col) * NPROJ + C_KA + h * 64 + ch * 8;
        const v4u kv = *(const v4u*)src, vv = *(const v4u*)(src + (C_VA - C_KA));
        const int o = ((row & 7) * 64 + col) * NA_STR + ch * 16;
        *(LAS v4u*)(lds + NA_K_OFF + o) = kv; *(LAS v4u*)(lds + NA_V_OFF + o) = vv; } }
    if (F.tid < 465) ((LAS float*)(lds + NA_RPB_OFF))[F.tid] = rpb[h * 465 + F.tid];
    __syncthreads();
    for (int rr = 0; rr < 8; ++rr) {
        const int r = r0 + rr, rs = min(max(r - 4, 0), 120), rsn = min(max(r - 3, 0), 120);
        const bool more = rr < 7, slide = more && (rsn != rs);
        v4u nk = {0u, 0u, 0u, 0u}, nv = {0u, 0u, 0u, 0u};
        if (more) { const bf16* qp = qbase + (size_t)(r + 1) * 64 * NPROJ; qn[0] = *(const bf16x8*)qp; qn[1] = *(const bf16x8*)(qp + 32); }
        if (slide) { const int col = F.tid >> 3, ch = F.tid & 7; const bf16* src = PROJ + ((size_t)b * T + (rsn + 7) * 64 + col) * NPROJ + C_KA + h * 64 + ch * 8; nk = *(const v4u*)src; nv = *(const v4u*)(src + (C_VA - C_KA)); }
        natten_compute(F, qf, Y, b, h, r, rs);
        __syncthreads();
        if (slide) { const int col = F.tid >> 3, ch = F.tid & 7, o = ((((rsn + 7) & 7) * 64) + col) * NA_STR + ch * 16; *(LAS v4u*)(lds + NA_K_OFF + o) = nk; *(LAS v4u*)(lds + NA_V_OFF + o) = nv; }
        if (more) { qf[0] = qn[0]; qf[1] = qn[1]; }
        __syncthreads();
    }
}

constexpr int GL_Z = 0, GL_GU = 8192, GL_GB = 16384, GL_GT = 16896, GL_I0 = 20992;
constexpr int IS = 144, IMG = 64 * IS;
constexpr int VS = 272, VIMG = 64 * VS;
constexpr int GL_QF = GL_I0, GL_QB = GL_I0 + IMG, GL_KF = GL_I0 + 2 * IMG, GL_KB = GL_I0 + 3 * IMG, GL_V = GL_I0 + 4 * IMG, GL_SF = GL_V + VIMG, GL_SB = GL_SF + VIMG;
static_assert(GL_SB + VIMG <= LDS_BYTES, "GLA LDS map");
__device__ __forceinline__ float logsig(float x) { return fminf(x, 0.f) - __logf(1.0f + __expf(-fabsf(x))); }

__device__ __forceinline__ void gla_gate(const Frame& F, const float* Z, const float* guf, const float* gbf, const float* gub, const float* gbb, int h, size_t t0,
                                         float (&bf)[8], float (&bb)[8], float& totf, float& totb) {
    LAS unsigned char* lds = F.lds; const int tid = F.tid, d = tid & 63, g = F.wave;
    *(LAS f32x4*)(lds + GL_Z + tid * 16) = *(const f32x4*)(Z + t0 * 32 + tid * 4);
    { const int idx = tid * 4, dir = idx >> 10, rr = (idx >> 6) & 15, dd = idx & 63; const float* src = (dir ? gub : guf) + rr * 256 + h * 64 + dd; *(LAS f32x4*)(lds + GL_GU + idx * 4) = *(const f32x4*)src; }
    if (tid < 128) { const int dir = tid >> 6, dd = tid & 63; ((LAS float*)(lds + GL_GB))[tid] = (dir ? gbb : gbf)[h * 64 + dd]; }
    __syncthreads();
    const LAS float* Zl = (const LAS float*)(lds + GL_Z); const LAS float* GU = (const LAS float*)(lds + GL_GU); const LAS float* GB = (const LAS float*)(lds + GL_GB);
    float uf[16], ub[16];
#pragma unroll
    for (int rr = 0; rr < 16; ++rr) { uf[rr] = GU[rr * 64 + d]; ub[rr] = GU[1024 + rr * 64 + d]; }
    const float gf0 = GB[d], gb0 = GB[64 + d];
    float laf[8], lab[8];
#pragma unroll
    for (int j = 0; j < 8; ++j) { const int c = 8 * g + j; float pf = gf0, pb = gb0;
#pragma unroll
        for (int r4 = 0; r4 < 4; ++r4) { const f32x4 zf = *(const LAS f32x4*)(Zl + c * 32 + 4 * r4), zb = *(const LAS f32x4*)(Zl + c * 32 + 16 + 4 * r4);
#pragma unroll
            for (int e = 0; e < 4; ++e) { pf += zf[e] * uf[4 * r4 + e]; pb += zb[e] * ub[4 * r4 + e]; } }
        laf[j] = logsig(pf) * (1.0f / 16.0f); lab[j] = logsig(pb) * (1.0f / 16.0f); }
    float run = 0.f;
#pragma unroll
    for (int j = 0; j < 8; ++j) { run += laf[j]; bf[j] = run; }
    float runb = 0.f;
#pragma unroll
    for (int j = 7; j >= 0; --j) { runb += lab[j]; bb[j] = runb; }
    LAS float* GT = (LAS float*)(lds + GL_GT);
    GT[g * 64 + d] = run; GT[512 + g * 64 + d] = runb;
    __syncthreads();
    float of = 0.f, ob = 0.f; totf = 0.f; totb = 0.f;
#pragma unroll
    for (int gp = 0; gp < 8; ++gp) { const float a = GT[gp * 64 + d], c = GT[512 + gp * 64 + d]; totf += a; totb += c; if (gp < g) of += a; if (gp > g) ob += c; }
#pragma unroll
    for (int j = 0; j < 8; ++j) { bf[j] += of; bb[j] += ob; }
}
__device__ __forceinline__ void stage_img128(LAS unsigned char* dst, const bf16* src, size_t row_stride, int tid) {
#pragma unroll
    for (int it = 0; it < 2; ++it) { const int id = tid + NTHR * it, row = id >> 4, ch = id & 15; *(LAS v4u*)(dst + row * VS + ch * 16) = *(const v4u*)(src + (size_t)row * row_stride + ch * 8); }
}

__device__ __forceinline__ void gla_a_unit(const Frame& F, const bf16* PROJ, const float* Z, const float* guf, const float* gbf, const float* gub, const float* gbb, float* CON, float* DEC, bf16* IMGS, int unit) {
    LAS unsigned char* lds = F.lds; const int tid = F.tid, d = tid & 63, g = F.wave;
    const int n = unit & 127, bh = unit >> 7, h = bh & 3, b = bh >> 2; const size_t t0 = (size_t)b * T + 64 * n;
    unsigned short kraw[8], qraw[8];
#pragma unroll
    for (int j = 0; j < 8; ++j) { const bf16* p = PROJ + (t0 + 8 * g + j) * NPROJ + h * 64 + d; qraw[j] = p[C_QG]; kraw[j] = p[C_KG]; }
    stage_img128(lds + GL_V, PROJ + t0 * NPROJ + C_VG + h * 128, NPROJ, tid);
    float bf[8], bb[8], totf, totb;
    gla_gate(F, Z, guf, gbf, gub, gbb, h, t0, bf, bb, totf, totb);
    const float decf = __expf(totf), decb = __expf(totb);
    bf16* im = IMGS + (size_t)unit * 16384 + d;
#pragma unroll
    for (int j = 0; j < 8; ++j) { const float k = bf2f(kraw[j]), q = bf2f(qraw[j]) * 0.125f; const int c = 8 * g + j;
        const float ef = __expf(bf[j]), eb = __expf(bb[j]), rf = 1.0f / ef, rb = 1.0f / eb, kif = k * rf, kib = k * rb;
        *(LAS unsigned short*)(lds + GL_KF + c * IS + d * 2) = (unsigned short)f2bf(kif * decf);
        *(LAS unsigned short*)(lds + GL_KB + c * IS + d * 2) = (unsigned short)f2bf(kib * decb);
        im[c * 64] = (bf16)f2bf(q * ef); im[4096 + c * 64] = (bf16)f2bf(kif); im[8192 + c * 64] = (bf16)f2bf(q * eb); im[12288 + c * 64] = (bf16)f2bf(kib); }
    if (g == 0) { DEC[(size_t)unit * 64 + d] = decf; DEC[(size_t)(1024 + unit) * 64 + d] = decb; }
    __syncthreads();
    const int fr = F.lane & 15, fq = F.lane >> 4, dir = F.wave >> 2, dt = F.wave & 3;
    const LAS unsigned char* kimg = lds + (dir ? GL_KB : GL_KF);
    bf16x8 yk[2];
#pragma unroll
    for (int s = 0; s < 2; ++s) { const LAS unsigned char* p = kimg + (32 * s + 4 * fq + (fr >> 2)) * IS + (16 * dt + 4 * (fr & 3)) * 2; yk[s] = cat8(tr4(p), tr4(p + 16 * IS)); }
    float* cbase = CON + ((size_t)(dir * 1024 + unit) * 64 + 16 * dt + fr) * 128 + 4 * fq;
#pragma unroll
    for (int et = 0; et < 8; ++et) { f32x4 acc = {0.f, 0.f, 0.f, 0.f};
#pragma unroll
        for (int s = 0; s < 2; ++s) { const LAS unsigned char* p = lds + GL_V + (32 * s + 4 * fq + (fr >> 2)) * VS + (16 * et + 4 * (fr & 3)) * 2; acc = mfma16(cat8(tr4(p), tr4(p + 16 * VS)), yk[s], acc); }
        *(f32x4*)(cbase + 16 * et) = acc; }
    __syncthreads();
}

__device__ __forceinline__ void phase_scan(const Frame& F, const float* __restrict__ CON, const float* __restrict__ DEC, bf16* __restrict__ SP) {
    for (int chain = F.vcu * NTHR + F.tid; chain < 2 * 8 * 64 * 128; chain += F.G * NTHR) {
        const int e = chain & 127, d = (chain >> 7) & 63, bh = (chain >> 13) & 7, dir = chain >> 16;
        const size_t ubase = (size_t)dir * 1024 + bh * 128;
        const float* con = CON + (ubase * 64 + d) * 128 + e; const float* dec = DEC + ubase * 64 + d; bf16* sp = SP + (ubase * 64 + d) * 128 + e;
        float S = 0.f;
        for (int nb = 0; nb < 16; ++nb) { float c[8], gg[8];
#pragma unroll
            for (int u = 0; u < 8; ++u) { const int n = nb * 8 + u, ne = dir ? 127 - n : n; c[u] = con[(size_t)ne * 8192]; gg[u] = dec[ne * 64]; }
#pragma unroll
            for (int u = 0; u < 8; ++u) { const int n = nb * 8 + u, ne = dir ? 127 - n : n; sp[(size_t)ne * 8192] = (bf16)f2bf(S); S = gg[u] * S + c[u]; } }
    }
}

struct GlaCFetch { v4u im[4], v[2], sf[2], sb[2]; };
__device__ __forceinline__ void gla_c_fetch(GlaCFetch& R, const bf16* PROJ, const bf16* SP, const bf16* IMGS, int unit, int tid) {
    const int n = unit & 127, bh = unit >> 7, h = bh & 3, b = bh >> 2; const size_t t0 = (size_t)b * T + 64 * n;
#pragma unroll
    for (int k = 0; k < 4; ++k) R.im[k] = *(const v4u*)(IMGS + (size_t)unit * 16384 + k * 4096 + tid * 8);
#pragma unroll
    for (int it = 0; it < 2; ++it) { const int id = tid + NTHR * it, row = id >> 4, ch = id & 15;
        R.v[it] = *(const v4u*)(PROJ + (t0 + row) * NPROJ + C_VG + h * 128 + ch * 8);
        R.sf[it] = *(const v4u*)(SP + (size_t)unit * 8192 + row * 128 + ch * 8);
        R.sb[it] = *(const v4u*)(SP + (size_t)(1024 + unit) * 8192 + row * 128 + ch * 8); }
}
__device__ __forceinline__ void gla_c_commit(const GlaCFetch& R, LAS unsigned char* lds, int tid) {
    { const int row = tid >> 3, ch = tid & 7, o = row * IS + ch * 16;
      *(LAS v4u*)(lds + GL_QF + o) = R.im[0]; *(LAS v4u*)(lds + GL_KF + o) = R.im[1]; *(LAS v4u*)(lds + GL_QB + o) = R.im[2]; *(LAS v4u*)(lds + GL_KB + o) = R.im[3]; }
#pragma unroll
    for (int it = 0; it < 2; ++it) { const int id = tid + NTHR * it, row = id >> 4, ch = id & 15, o = row * VS + ch * 16;
        *(LAS v4u*)(lds + GL_V + o) = R.v[it]; *(LAS v4u*)(lds + GL_SF + o) = R.sf[it]; *(LAS v4u*)(lds + GL_SB + o) = R.sb[it]; }
}
__device__ __forceinline__ void gla_c_compute(const Frame& F, const bf16* PROJ, const float* norm_g, bf16* Y, int unit) {
    LAS unsigned char* lds = F.lds;
    const int n = unit & 127, bh = unit >> 7, h = bh & 3, b = bh >> 2; const size_t t0 = (size_t)b * T + 64 * n;
    if (F.wave < 4) {
        const int fr = F.lane & 15, fq = F.lane >> 4, it = F.wave;
        const int i = 16 * it + fr;
        const bf16* rp = PROJ + (t0 + i) * NPROJ + C_RG + h * 128 + 4 * fq; bf16* yp = Y + (t0 + i) * D + 512 + h * 128 + 4 * fq;
        v2u rw[8];
#pragma unroll
        for (int et = 0; et < 8; ++et) rw[et] = *(const v2u*)(rp + 16 * et);
        bf16x8 yqf[2], yqb[2];
#pragma unroll
        for (int s = 0; s < 2; ++s) { const int off = (16 * it + fr) * IS + (32 * s + 8 * fq) * 2; yqf[s] = *(const LAS bf16x8*)(lds + GL_QF + off); yqb[s] = *(const LAS bf16x8*)(lds + GL_QB + off); }
        f32x4 a[4];
#pragma unroll
        for (int jt = 0; jt < 4; ++jt) { f32x4 af = {0.f, 0.f, 0.f, 0.f}, ab = {0.f, 0.f, 0.f, 0.f};
#pragma unroll
            for (int s = 0; s < 2; ++s) { const int off = (16 * jt + fr) * IS + (32 * s + 8 * fq) * 2;
                af = mfma16(*(const LAS bf16x8*)(lds + GL_KF + off), yqf[s], af); ab = mfma16(*(const LAS bf16x8*)(lds + GL_KB + off), yqb[s], ab); }
#pragma unroll
            for (int e = 0; e < 4; ++e) { const int j = 16 * jt + 4 * fq + e; a[jt][e] = (j <= i) ? af[e] : ab[e]; } }
        f32x4 o[8];
#pragma unroll
        for (int et = 0; et < 8; ++et) o[et] = (f32x4){0.f, 0.f, 0.f, 0.f};
#pragma unroll
        for (int s = 0; s < 2; ++s) { const bf16x8 pb = pack8(a[2 * s], a[2 * s + 1]);
#pragma unroll
            for (int et = 0; et < 8; ++et) { const LAS unsigned char* p = lds + GL_V + (32 * s + 4 * fq + (fr >> 2)) * VS + (16 * et + 4 * (fr & 3)) * 2; o[et] = mfma16(cat8(tr4(p), tr4(p + 16 * VS)), pb, o[et]); } }
#pragma unroll
        for (int s = 0; s < 2; ++s)
#pragma unroll
            for (int et = 0; et < 8; ++et) { const int off = (32 * s + 8 * fq + (fr >> 2)) * VS + (16 * et + 4 * (fr & 3)) * 2;
                o[et] = mfma16(cat8(tr4(lds + GL_SF + off), tr4(lds + GL_SF + off + 4 * VS)), yqf[s], o[et]);
                o[et] = mfma16(cat8(tr4(lds + GL_SB + off), tr4(lds + GL_SB + off + 4 * VS)), yqb[s], o[et]); }
        float ss = 0.f;
#pragma unroll
        for (int et = 0; et < 8; ++et) ss += (o[et][0] * o[et][0] + o[et][1] * o[et][1]) + (o[et][2] * o[et][2] + o[et][3] * o[et][3]);
        ss += __shfl_xor(ss, 16); ss += __shfl_xor(ss, 32);
        const float rs = 1.0f / sqrtf(ss * (1.0f / 128.0f) + EPS);
#pragma unroll
        for (int et = 0; et < 8; ++et) { const f32x4 gn = *(const f32x4*)(norm_g + 16 * et + 4 * fq);
            float rv[4] = {__builtin_bit_cast(float, rw[et].x << 16), __builtin_bit_cast(float, rw[et].x & 0xffff0000u), __builtin_bit_cast(float, rw[et].y << 16), __builtin_bit_cast(float, rw[et].y & 0xffff0000u)};
            float ov[4];
#pragma unroll
            for (int e = 0; e < 4; ++e) { const float sg = rv[e] / (1.0f + __expf(-rv[e])); ov[e] = o[et][e] * rs * gn[e] * sg; }
            v2u w; w.x = pg8::cvt_pk_bf16(ov[0], ov[1]); w.y = pg8::cvt_pk_bf16(ov[2], ov[3]); *(v2u*)(yp + 16 * et) = w; }
    }
}
__device__ __forceinline__ void phase_gla_c(const Frame& F, const bf16* PROJ, const bf16* SP, const bf16* IMGS, const float* norm_g, bf16* Y) {
    GlaCFetch R;
    int u = F.vcu;
    if (u < 1024) gla_c_fetch(R, PROJ, SP, IMGS, u, F.tid);
    for (; u < 1024; u += F.G) {
        gla_c_commit(R, F.lds, F.tid);
        __syncthreads();
        if (u + F.G < 1024) gla_c_fetch(R, PROJ, SP, IMGS, u + F.G, F.tid);
        gla_c_compute(F, PROJ, norm_g, Y, u);
        __syncthreads();
    }
}

__device__ __forceinline__ void phase_final(const Frame& F, float* out, const float* ss, const float* g) {
    const int gw = F.vcu * NWAVES + F.wave, NGW = F.G * NWAVES;
    f32x4 gv[4];
#pragma unroll
    for (int j = 0; j < 4; ++j) gv[j] = ((const f32x4*)g)[F.lane + 64 * j];
    for (int m = gw; m < M; m += NGW) { f32x4* xr = (f32x4*)(out + (size_t)m * D) + F.lane; const float rs = 1.0f / sqrtf(ss[m] * (1.f / D) + EPS);
#pragma unroll
        for (int j = 0; j < 4; ++j) xr[64 * j] = xr[64 * j] * rs * gv[j]; }
}

#define XB_TMO      128
#define XB_XCNT(j)  (256  + 64 * (j))
#define XB_XSUB(j)  (1280 + 64 * (j))
#define XB_XGEN(j)  (2304 + 64 * (j))
#define XB_TOP      3328
#define XB_TOPGEN   3392
#define XCD_BAR_WORDS 3456
#define XB_SPIN_CAP (1u << 18)

__device__ __forceinline__ unsigned xb_ld(unsigned* p)              { return __hip_atomic_load(p, __ATOMIC_RELAXED, __HIP_MEMORY_SCOPE_AGENT); }
__device__ __forceinline__ unsigned xb_add(unsigned* p, unsigned v) { return __hip_atomic_fetch_add(p, v, __ATOMIC_RELAXED, __HIP_MEMORY_SCOPE_AGENT); }
__device__ __forceinline__ unsigned xb_xcc_id() { return (unsigned)__builtin_amdgcn_s_getreg((3 << 11) | 20) & 0xFu; }
#define XB_SPIN(cond, bar) do { unsigned _sp = 0; while (cond) { __builtin_amdgcn_s_sleep(1); \
    if ((++_sp & 255u) == 0u) { if (xb_ld(&(bar)[XB_TMO])) break; if (_sp > XB_SPIN_CAP) { atomicAdd(&(bar)[XB_TMO], 1u); break; } } } } while (0)

struct XcdBarrier {
    unsigned* bar; unsigned x;
    volatile LAS unsigned* st;
};

__device__ __forceinline__ XcdBarrier xcd_barrier_post(unsigned* bar, volatile LAS unsigned* st) {
    XcdBarrier b; b.bar = bar; b.x = xb_xcc_id(); b.st = st;
    if (threadIdx.x == 0) (void)xb_add(&bar[XB_XCNT(b.x)], 1u);
    return b;
}
__device__ __forceinline__ void xcd_barrier_complete(unsigned* bar, unsigned x, unsigned& nloc, unsigned& nx) {
    const unsigned G = gridDim.x * gridDim.y * gridDim.z;
    unsigned sum, cnt, mine, sp = 0u;
    for (;;) {
        sum = 0u; cnt = 0u; mine = 0u;
#pragma unroll
        for (unsigned j = 0; j < 16; ++j) { const unsigned c = xb_ld(&bar[XB_XCNT(j)]); sum += c; cnt += (c > 0u) ? 1u : 0u; mine = (j == x) ? c : mine; }
        if (sum == G) break;
        __builtin_amdgcn_s_sleep(1);
        if ((++sp & 255u) == 0u) { if (xb_ld(&bar[XB_TMO])) break; if (sp > XB_SPIN_CAP) { atomicAdd(&bar[XB_TMO], 1u); break; } }
    }
    nloc = mine > 0u ? mine : 1u; nx = cnt > 0u ? cnt : 1u;
}

__device__ __forceinline__ void xcd_barrier(const XcdBarrier& b) {
    asm volatile("s_waitcnt vmcnt(0)" ::: "memory");
    __syncthreads();
    if (threadIdx.x == 0) {
        unsigned* bar = b.bar;
        __builtin_amdgcn_s_waitcnt(0);
        unsigned nloc = b.st[0], nx = b.st[1];
        if (nloc == 0u) { xcd_barrier_complete(bar, b.x, nloc, nx); b.st[0] = nloc; b.st[1] = nx; }
        const unsigned old = xb_add(&bar[XB_XSUB(b.x)], 1u);
        const unsigned gen = old / nloc;
        if (old + 1u == (gen + 1u) * nloc) {
            __builtin_amdgcn_fence(__ATOMIC_RELEASE, "agent");
            asm volatile("s_waitcnt vmcnt(0)" ::: "memory");
            const unsigned og = xb_add(&bar[XB_TOP], 1u);
            const unsigned tg = og / nx;
            if (og + 1u == (tg + 1u) * nx) xb_add(&bar[XB_TOPGEN], 1u);
            else XB_SPIN(xb_ld(&bar[XB_TOPGEN]) == tg, bar);
            __builtin_amdgcn_fence(__ATOMIC_ACQUIRE, "agent");
            xb_add(&bar[XB_XGEN(b.x)], 1u);
            asm volatile("s_waitcnt vmcnt(0)" ::: "memory");
        } else {
            XB_SPIN(xb_ld(&bar[XB_XGEN(b.x)]) == gen, bar);
            __builtin_amdgcn_fence(__ATOMIC_ACQUIRE, "agent");
            asm volatile("s_waitcnt vmcnt(0)" ::: "memory");
        }
    }
    __syncthreads();
}
#ifndef MK_DUP
#define MK_DUP 0
#endif
struct Args { const float* in[14]; float* out; unsigned char* ws; int lo, hi; };
constexpr int NPHASE = 9;
__global__ void __launch_bounds__(NTHR, 2) mk_fwd(Args a) {
    extern __shared__ __attribute__((aligned(16))) unsigned char lds_raw[];
    Frame F; F.lds = (LAS unsigned char*)lds_raw; F.tid = threadIdx.x; F.lane = F.tid & 63; F.wave = __builtin_amdgcn_readfirstlane(F.tid >> 6);
    F.G = gridDim.x; { const int bx = blockIdx.x; F.vcu = (F.G % 8 == 0) ? (bx % 8) * (F.G / 8) + bx / 8 : bx; }
    unsigned char* ws = a.ws;
    const float* x = a.in[0];
    bf16* XN = (bf16*)(ws + WS_XN); bf16* Yb = (bf16*)(ws + WS_Y); bf16* PROJ = (bf16*)(ws + WS_PROJ); bf16* HB = (bf16*)(ws + WS_HB); bf16* ACT = (bf16*)(ws + WS_ACT);
    float* Z = (float*)(ws + WS_Z); float* CON = (float*)(ws + WS_CON); float* DEC = (float*)(ws + WS_DEC); bf16* SP = (bf16*)(ws + WS_SP);
    float* SS2 = (float*)(ws + WS_SS2); float* SS3 = (float*)(ws + WS_SS3);
    const int lo = a.lo, hi = a.hi;
#define IN(k) (lo <= (k) && (k) < hi)
#define SEAM(k) do { if (IN(k) && IN((k) + 1)) xcd_barrier(bar); } while (0)
    volatile LAS unsigned* MISC = (volatile LAS unsigned*)(F.lds + LDS_BYTES - 64);
    if (F.tid < 16) MISC[F.tid] = 0u;
    __syncthreads();
    unsigned* barw = (unsigned*)(ws + WS_BAR);
    if (a.lo < 0) cg::this_grid().sync();
    XcdBarrier bar; bar.bar = barw; bar.x = 0; bar.st = nullptr;
    if (hi - lo > 1) bar = xcd_barrier_post(barw, MISC + 8);
    if (IN(0)) phase_prologue(F, x, a.in[1], a.in[2], a.in[9], a.in[10], a.in[11], a.in[12], ws);
    SEAM(0);
    for (int rep_ = 0; rep_ < 1 + ((MK_DUP >> 1) & 1); ++rep_) if (IN(1)) {
        pg8::Gemm g{XN, (const bf16*)(ws + WS_WIN), M, NPROJ, D}; pg8::StaticOrder S; S.init(M, NPROJ, F.G, (int)blockIdx.x);
        pg8::EpiProj E{PROJ, NPROJ};
        pg8::gemm_phase<pg8::EpiProj, pg8::StaticOrder, true, true>(F.lds, g, S, E);
        phase_z(F, XN, (const bf16*)(ws + WS_WIN) + (size_t)NPROJ * D, Z);
    }
    SEAM(1);
    for (int rep_ = 0; rep_ < 1 + ((MK_DUP >> 2) & 1); ++rep_) if (IN(2)) {
        for (int rep2_ = 0; rep2_ < 1 + ((MK_DUP >> 9) & 1); ++rep2_)
        for (int u = F.vcu; u < 1024; u += F.G) gla_a_unit(F, PROJ, Z, a.in[4], a.in[5], a.in[6], a.in[7], CON, DEC, (bf16*)a.out, u);
        for (int rep2_ = 0; rep2_ < 1 + ((MK_DUP >> 10) & 1); ++rep2_)
        for (int w = F.vcu; w < 256; w += F.G) natten_wg(F, PROJ, a.in[3], Yb, w);
    }
    SEAM(2);
    for (int rep_ = 0; rep_ < 1 + ((MK_DUP >> 3) & 1); ++rep_) if (IN(3)) phase_scan(F, CON, DEC, SP);
    SEAM(3);
    for (int rep_ = 0; rep_ < 1 + ((MK_DUP >> 4) & 1); ++rep_) if (IN(4)) phase_gla_c(F, PROJ, SP, (const bf16*)a.out, a.in[8], Yb);
    SEAM(4);
    if (IN(5)) {
        pg8::Gemm g{Yb, (const bf16*)(ws + WS_WO), M, D, D}; pg8::StaticOrder S; S.init(M, D, F.G, (int)blockIdx.x);
        pg8::EpiRes E{x, a.out, HB, SS2, D};
        pg8::gemm_phase<pg8::EpiRes, pg8::StaticOrder, false, true>(F.lds, g, S, E);
    }
    SEAM(5);
    for (int rep_ = 0; rep_ < 1 + ((MK_DUP >> 6) & 1); ++rep_) if (IN(6)) {
        pg8::Gemm g{HB, (const bf16*)(ws + WS_W1), M, FF, D}; pg8::StaticOrder S; S.init(M, FF, F.G, (int)blockIdx.x);
        pg8::EpiFF1 E{ACT, FF, SS2, 1.0f / D, EPS};
        pg8::gemm_phase<pg8::EpiFF1, pg8::StaticOrder, true, true>(F.lds, g, S, E);
    }
    SEAM(6);
    if (IN(7)) {
        pg8::Gemm g{ACT, (const bf16*)(ws + WS_W2), M, D, FF}; pg8::StaticOrder S; S.init(M, D, F.G, (int)blockIdx.x);
        const int fuse = (F.G == 256 && hi - lo > 1) ? 1 : 0;
        pg8::EpiResNorm E{a.out, a.out, SS3, (unsigned*)(ws + WS_PCNT), a.in[13], D, fuse, 8u * (D / 256), 1.0f / D, EPS};
        pg8::gemm_phase<pg8::EpiResNorm, pg8::StaticOrder, false, true>(F.lds, g, S, E);
    }
    if (!(F.G == 256 && hi - lo > 1)) {
        SEAM(7);
        if (IN(8)) phase_final(F, a.out, SS3, a.in[13]);
    }
#undef IN
#undef SEAM
}

#ifndef MK_ONE_LAUNCH
#define MK_ONE_LAUNCH 1
#endif
extern "C" void kernel_launch(void* const* d_in, const int* in_sizes, int n_in, void* d_out, int out_size, void* d_ws, size_t ws_size, hipStream_t stream) {
    static int grid = 0;
    if (grid == 0) {
        if (n_in != 14 || out_size != M * D || ws_size < WS_END) { fprintf(stderr, "kernel_launch: unexpected shapes (n_in %d out %d ws %zu)\n", n_in, out_size, ws_size); grid = -1; return; }
        int dev = 0, cus = 0, per_cu = 0;
        hipGetDevice(&dev); hipDeviceGetAttribute(&cus, hipDeviceAttributeMultiprocessorCount, dev);
        if (hipFuncSetAttribute((const void*)mk_fwd, hipFuncAttributeMaxDynamicSharedMemorySize, LDS_BYTES) != hipSuccess) { fprintf(stderr, "kernel_launch: hipFuncSetAttribute failed\n"); grid = -1; return; }
        if (hipOccupancyMaxActiveBlocksPerMultiprocessor(&per_cu, (const void*)mk_fwd, NTHR, LDS_BYTES) != hipSuccess || per_cu < 1) { fprintf(stderr, "kernel_launch: occupancy query says %d\n", per_cu); per_cu = 1; }
        (void)hipGetLastError();
        grid = cus * 1;
    }
    if (grid < 0) return;
    Args a{};
    for (int i = 0; i < 14; ++i) a.in[i] = (const float*)d_in[i];
    a.out = (float*)d_out; a.ws = (unsigned char*)d_ws;
#if MK_ONE_LAUNCH
    if (hipMemsetAsync((char*)d_ws + WS_BAR, 0, WS_ZERO_BYTES, stream) != hipSuccess) { fprintf(stderr, "kernel_launch: memset of the barrier words failed\n"); return; }
    a.lo = 0; a.hi = NPHASE;
    void* args[] = {&a};
    hipError_t e = hipLaunchCooperativeKernel((const void*)mk_fwd, dim3(grid), dim3(NTHR), args, LDS_BYTES, stream);
    if (e != hipSuccess) fprintf(stderr, "cooperative launch failed: %s (grid %d)\n", hipGetErrorString(e), grid);
#else
    for (int p = 0; p < NPHASE; ++p) { a.lo = p; a.hi = p + 1; hipLaunchKernelGGL(mk_fwd, dim3(grid), dim3(NTHR), LDS_BYTES, stream, a); }
#endif
}
```

```cpp
#include <hip/hip_runtime.h>
#include <hip/hip_cooperative_groups.h>
#include <cstdio>
#include <cstdint>
#include <cmath>
namespace cg = cooperative_groups;
namespace pg8 {
#define PG8_LAS __attribute__((address_space(3)))
typedef unsigned short bf16_t;
typedef short bf16x8 __attribute__((ext_vector_type(8)));
typedef float f32x4 __attribute__((ext_vector_type(4)));
typedef unsigned u32x4 __attribute__((ext_vector_type(4)));
constexpr int BM = 256, BK = 64, HALF = 128, HTB = HALF * BK * 2  , STAGE_BYTES = 8 * HTB, NXCD = 8, WGM = 8;

__host__ __device__ __forceinline__ int lds_byte(int r, int c) { const int st = (r >> 4) * 2 + (c >> 5), rr = r & 15, cc = c & 31, ob = rr * 64 + cc * 2; return st * 1024 + (ob ^ (((ob >> 9) & 1) << 5)); }
__host__ __device__ __forceinline__ void stage_rc(int b, int& R, int& C) { const int st = b / 1024, sb = b % 1024, swz = sb ^ (((sb >> 9) & 1) << 5); R = (st >> 1) * 16 + swz / 64; C = (st & 1) * 32 + (swz % 64) / 2; }
__host__ __device__ __forceinline__ int perm32(int rho) { const int n = rho >> 4, i = rho & 15; return 8 * (i >> 2) + 4 * n + (i & 3); }

struct Unit { int pm, pn; };
struct Gemm { const bf16_t* A; const bf16_t* Bt; int M, N, K; };

struct StaticOrder {
    int nM, nN, nwg, G, c;
    __host__ __device__ void init(int M, int N, int G_, int c_) { nM = M / BM; nN = N / BM; nwg = nM * nN; G = G_; c = c_; }
    __host__ __device__ bool next(int i, Unit& u) const {
        const long L = (long)i * G + c; if (L >= nwg) return false;
        int wgid = (int)L; { const int q = nwg / NXCD, r = nwg % NXCD, xcd = wgid % NXCD, off = wgid / NXCD; wgid = (xcd < r ? xcd * (q + 1) : r * (q + 1) + (xcd - r) * q) + off; }
        const int nig = WGM * nN, gid = wgid / nig, fm = gid * WGM, gsz = (nM - fm) < WGM ? (nM - fm) : WGM;
        u.pm = fm + ((wgid % nig) % gsz); u.pn = (wgid % nig) / gsz; return true;
    }
    __device__ __forceinline__ void a_ready(const Unit&) const {}
    __device__ __forceinline__ void done(const Unit&) const {}
};

__device__ __forceinline__ unsigned cvt_pk_bf16(float lo, float hi) { unsigned r; asm volatile("v_cvt_pk_bf16_f32 %0, %1, %2" : "=v"(r) : "v"(lo), "v"(hi)); return r; }
typedef unsigned u32x2 __attribute__((ext_vector_type(2)));
struct EpiProj {
    static constexpr bool PERM = true, AFTER_DRAIN = false;
    bf16_t* O; int ldc;
    __device__ __forceinline__ void operator()(const f32x4 (&acc)[2][2][4][2], const Unit& u, int wr, int wc, int fr, int fq) const {
        const int row0 = u.pm * BM + wr * 64 + fr, col0 = u.pn * BM + wc * 32 + 8 * fq;
#pragma unroll
        for (int ai = 0; ai < 2; ++ai)
#pragma unroll
            for (int m = 0; m < 4; ++m) { bf16_t* rowp = O + (size_t)(row0 + ai * HALF + m * 16) * ldc + col0;
#pragma unroll
                for (int bj = 0; bj < 2; ++bj) { const f32x4 v0 = acc[ai][bj][m][0], v1 = acc[ai][bj][m][1];
                    u32x4 w; w.x = cvt_pk_bf16(v0[0], v0[1]); w.y = cvt_pk_bf16(v0[2], v0[3]); w.z = cvt_pk_bf16(v1[0], v1[1]); w.w = cvt_pk_bf16(v1[2], v1[3]);
                    *(u32x4*)(rowp + bj * HALF) = w; } }
    }
};
struct EpiFF1 {
    static constexpr bool PERM = true, AFTER_DRAIN = false;
    bf16_t* O; int ldc; const float* sumsq; float inv_n, eps;
    __device__ __forceinline__ void operator()(const f32x4 (&acc)[2][2][4][2], const Unit& u, int wr, int wc, int fr, int fq) const {
        const int row0 = u.pm * BM + wr * 64 + fr, col0 = u.pn * BM + wc * 32 + 8 * fq;
#pragma unroll
        for (int ai = 0; ai < 2; ++ai)
#pragma unroll
            for (int m = 0; m < 4; ++m) { const int row = row0 + ai * HALF + m * 16; bf16_t* rowp = O + (size_t)row * ldc + col0;
                const float rs = 1.0f / sqrtf(sumsq[row] * inv_n + eps);
#pragma unroll
                for (int bj = 0; bj < 2; ++bj) { f32x4 v0 = acc[ai][bj][m][0] * rs, v1 = acc[ai][bj][m][1] * rs;
#pragma unroll
                    for (int e = 0; e < 4; ++e) { const float a = fmaxf(v0[e], 0.f), b = fmaxf(v1[e], 0.f); v0[e] = a * a; v1[e] = b * b; }
                    u32x4 w; w.x = cvt_pk_bf16(v0[0], v0[1]); w.y = cvt_pk_bf16(v0[2], v0[3]); w.z = cvt_pk_bf16(v1[0], v1[1]); w.w = cvt_pk_bf16(v1[2], v1[3]);
                    *(u32x4*)(rowp + bj * HALF) = w; } }
    }
};
struct EpiRes {
    static constexpr bool PERM = false, AFTER_DRAIN = false;
    const float* base; float* out; bf16_t* hb; float* sumsq; int ldc;
    __device__ __forceinline__ void operator()(const f32x4 (&acc)[2][2][4][2], const Unit& u, int wr, int wc, int fr, int fq) const {
        const int col0 = u.pn * BM + wc * 32 + 4 * fq;
#pragma unroll
        for (int ai = 0; ai < 2; ++ai)
#pragma unroll
            for (int m = 0; m < 4; ++m) { const int row = u.pm * BM + ai * HALF + wr * 64 + m * 16 + fr; const size_t off = (size_t)row * ldc + col0; float s = 0.f;
#pragma unroll
                for (int bj = 0; bj < 2; ++bj)
#pragma unroll
                    for (int n = 0; n < 2; ++n) { const f32x4 bs = *(const f32x4*)(base + off + bj * HALF + n * 16); const f32x4 o = bs + acc[ai][bj][m][n];
                        *(f32x4*)(out + off + bj * HALF + n * 16) = o;
                        if (hb) { u32x2 w; w.x = cvt_pk_bf16(o[0], o[1]); w.y = cvt_pk_bf16(o[2], o[3]); *(u32x2*)(hb + off + bj * HALF + n * 16) = w; }
                        s += (o[0] * o[0] + o[1] * o[1]) + (o[2] * o[2] + o[3] * o[3]); }
                s += __shfl_xor(s, 16); s += __shfl_xor(s, 32);
                if (fq == 0) unsafeAtomicAdd(sumsq + row, s);
                asm volatile("" ::: "memory"); }
    }
};

struct EpiResNorm {
    static constexpr bool PERM = false, AFTER_DRAIN = true;
    const float* base; float* out; float* sumsq; unsigned* cnt; const float* g; int ldc; int fuse; unsigned want; float inv_n, eps;
    __device__ __forceinline__ void fused(f32x4 (&acc)[2][2][4][2], const Unit& u, int wr, int wc, int fr, int fq, PG8_LAS unsigned char* lds, int wid, int lane) const {
        const int col0 = u.pn * BM + wc * 32 + 4 * fq;
#pragma unroll
        for (int ai = 0; ai < 2; ++ai)
#pragma unroll
            for (int m = 0; m < 4; ++m) { const int row = u.pm * BM + ai * HALF + wr * 64 + m * 16 + fr; const size_t off = (size_t)row * ldc + col0; float s = 0.f;
#pragma unroll
                for (int bj = 0; bj < 2; ++bj)
#pragma unroll
                    for (int n = 0; n < 2; ++n) { const f32x4 bs = *(const f32x4*)(base + off + bj * HALF + n * 16); const f32x4 o = bs + acc[ai][bj][m][n]; acc[ai][bj][m][n] = o;
                        if (!fuse) *(f32x4*)(out + off + bj * HALF + n * 16) = o;
                        s += (o[0] * o[0] + o[1] * o[1]) + (o[2] * o[2] + o[3] * o[3]); }
                s += __shfl_xor(s, 16); s += __shfl_xor(s, 32);
                if (fq == 0) unsafeAtomicAdd(sumsq + row, s);
                asm volatile("" ::: "memory"); }
        if (!fuse) return;
        asm volatile("s_waitcnt vmcnt(0)" ::: "memory");
        if (lane == 0) __hip_atomic_fetch_add(cnt + 64 * u.pm, 1u, __ATOMIC_RELAXED, __HIP_MEMORY_SCOPE_AGENT);
        if (wid == 0) { while ((unsigned)__builtin_amdgcn_readfirstlane(__hip_atomic_load(cnt + 64 * u.pm, __ATOMIC_RELAXED, __HIP_MEMORY_SCOPE_AGENT)) < want) __builtin_amdgcn_s_sleep(2); }
        asm volatile("s_waitcnt vmcnt(0) lgkmcnt(0)" ::: "memory"); __builtin_amdgcn_s_barrier(); asm volatile("" ::: "memory");
        __builtin_amdgcn_fence(__ATOMIC_ACQUIRE, "agent");
        f32x4 gv[2][2];
#pragma unroll
        for (int bj = 0; bj < 2; ++bj)
#pragma unroll
            for (int n = 0; n < 2; ++n) gv[bj][n] = *(const f32x4*)(g + col0 + bj * HALF + n * 16);
#pragma unroll
        for (int ai = 0; ai < 2; ++ai)
#pragma unroll
            for (int m = 0; m < 4; ++m) { const int row = u.pm * BM + ai * HALF + wr * 64 + m * 16 + fr; const size_t off = (size_t)row * ldc + col0;
                const float ssv = __hip_atomic_load(sumsq + row, __ATOMIC_RELAXED, __HIP_MEMORY_SCOPE_AGENT); const float rs = 1.0f / sqrtf(ssv * inv_n + eps);
#pragma unroll
                for (int bj = 0; bj < 2; ++bj)
#pragma unroll
                    for (int n = 0; n < 2; ++n) *(f32x4*)(out + off + bj * HALF + n * 16) = acc[ai][bj][m][n] * rs * gv[bj][n]; }
    }
};

struct EpiResB {
    static constexpr bool PERM = true, AFTER_DRAIN = false;
    const float* base; bf16_t* hb; float* sumsq; int ldc;
    __device__ __forceinline__ void operator()(const f32x4 (&acc)[2][2][4][2], const Unit& u, int wr, int wc, int fr, int fq) const {
        const int col0 = u.pn * BM + wc * 32 + 8 * fq;
#pragma unroll
        for (int ai = 0; ai < 2; ++ai)
#pragma unroll
            for (int m = 0; m < 4; ++m) { const int row = u.pm * BM + ai * HALF + wr * 64 + m * 16 + fr; const size_t off = (size_t)row * ldc + col0; float s = 0.f;
#pragma unroll
                for (int bj = 0; bj < 2; ++bj) { const f32x4 b0 = *(const f32x4*)(base + off + bj * HALF), b1 = *(const f32x4*)(base + off + bj * HALF + 4);
                    const f32x4 o0 = b0 + acc[ai][bj][m][0], o1 = b1 + acc[ai][bj][m][1];
                    u32x4 w; w.x = cvt_pk_bf16(o0[0], o0[1]); w.y = cvt_pk_bf16(o0[2], o0[3]); w.z = cvt_pk_bf16(o1[0], o1[1]); w.w = cvt_pk_bf16(o1[2], o1[3]);
                    *(u32x4*)(hb + off + bj * HALF) = w;
                    s += (o0[0] * o0[0] + o0[1] * o0[1]) + (o0[2] * o0[2] + o0[3] * o0[3]) + (o1[0] * o1[0] + o1[1] * o1[1]) + (o1[2] * o1[2] + o1[3] * o1[3]); }
                s += __shfl_xor(s, 16); s += __shfl_xor(s, 32);
                if (fq == 0) unsafeAtomicAdd(sumsq + row, s);
                asm volatile("" ::: "memory"); }
    }
};
struct EpiResNormB {
    static constexpr bool PERM = true, AFTER_DRAIN = true;
    const bf16_t* hb; float* out; float* sumsq; unsigned* cnt; const float* g; int ldc; int fuse; unsigned want; float inv_n, eps;
    __device__ __forceinline__ void fused(f32x4 (&acc)[2][2][4][2], const Unit& u, int wr, int wc, int fr, int fq, PG8_LAS unsigned char* lds, int wid, int lane) const {
        const int col0 = u.pn * BM + wc * 32 + 8 * fq;
#pragma unroll
        for (int ai = 0; ai < 2; ++ai)
#pragma unroll
            for (int m = 0; m < 4; ++m) { const int row = u.pm * BM + ai * HALF + wr * 64 + m * 16 + fr; const size_t off = (size_t)row * ldc + col0; float s = 0.f;
#pragma unroll
                for (int bj = 0; bj < 2; ++bj) { const u32x4 w = *(const u32x4*)(hb + off + bj * HALF);
                    const f32x4 b0 = {__builtin_bit_cast(float, w.x << 16), __builtin_bit_cast(float, w.x & 0xffff0000u), __builtin_bit_cast(float, w.y << 16), __builtin_bit_cast(float, w.y & 0xffff0000u)};
                    const f32x4 b1 = {__builtin_bit_cast(float, w.z << 16), __builtin_bit_cast(float, w.z & 0xffff0000u), __builtin_bit_cast(float, w.w << 16), __builtin_bit_cast(float, w.w & 0xffff0000u)};
                    const f32x4 o0 = b0 + acc[ai][bj][m][0], o1 = b1 + acc[ai][bj][m][1]; acc[ai][bj][m][0] = o0; acc[ai][bj][m][1] = o1;
                    if (!fuse) { *(f32x4*)(out + off + bj * HALF) = o0; *(f32x4*)(out + off + bj * HALF + 4) = o1; }
                    s += (o0[0] * o0[0] + o0[1] * o0[1]) + (o0[2] * o0[2] + o0[3] * o0[3]) + (o1[0] * o1[0] + o1[1] * o1[1]) + (o1[2] * o1[2] + o1[3] * o1[3]); }
                s += __shfl_xor(s, 16); s += __shfl_xor(s, 32);
                if (fq == 0) unsafeAtomicAdd(sumsq + row, s);
                asm volatile("" ::: "memory"); }
        if (!fuse) return;
        asm volatile("s_waitcnt vmcnt(0)" ::: "memory");
        if (lane == 0) __hip_atomic_fetch_add(cnt + 64 * u.pm, 1u, __ATOMIC_RELAXED, __HIP_MEMORY_SCOPE_AGENT);
        if (wid == 0) { while ((unsigned)__builtin_amdgcn_readfirstlane(__hip_atomic_load(cnt + 64 * u.pm, __ATOMIC_RELAXED, __HIP_MEMORY_SCOPE_AGENT)) < want) __builtin_amdgcn_s_sleep(2); }
        asm volatile("s_waitcnt vmcnt(0) lgkmcnt(0)" ::: "memory"); __builtin_amdgcn_s_barrier(); asm volatile("" ::: "memory");
        __builtin_amdgcn_fence(__ATOMIC_ACQUIRE, "agent");
        f32x4 gv[2][2];
#pragma unroll
        for (int bj = 0; bj < 2; ++bj)
#pragma unroll
            for (int n = 0; n < 2; ++n) gv[bj][n] = *(const f32x4*)(g + col0 + bj * HALF + n * 4);
#pragma unroll
        for (int ai = 0; ai < 2; ++ai)
#pragma unroll
            for (int m = 0; m < 4; ++m) { const int row = u.pm * BM + ai * HALF + wr * 64 + m * 16 + fr; const size_t off = (size_t)row * ldc + col0;
                const float ssv = __hip_atomic_load(sumsq + row, __ATOMIC_RELAXED, __HIP_MEMORY_SCOPE_AGENT); const float rs = 1.0f / sqrtf(ssv * inv_n + eps);
#pragma unroll
                for (int bj = 0; bj < 2; ++bj)
#pragma unroll
                    for (int n = 0; n < 2; ++n) *(f32x4*)(out + off + bj * HALF + n * 4) = acc[ai][bj][m][n] * rs * gv[bj][n]; }
    }
};
template <class Epi, class Sched, bool ALIGN_EPI = false, bool SP2 = false>
__device__ __forceinline__ void gemm_phase(PG8_LAS unsigned char* lds, const Gemm g, const Sched& S, const Epi& E) {
    const int tid = threadIdx.x, wid = __builtin_amdgcn_readfirstlane(tid >> 6), lane = tid & 63, wr = wid >> 2, wc = wid & 3, fr = lane & 15, fq = lane >> 4;
    const int K = g.K, nt = K / BK;
    unsigned voffA[2], voffB[2];
#pragma unroll
    for (int i = 0; i < 2; ++i) { int R, C; stage_rc(tid * 16 + i * 8192, R, C); const int Rb = Epi::PERM ? ((R & ~31) + perm32(R & 31)) : R;
        voffA[i] = (unsigned)(R * K + C) * 2u; voffB[i] = (unsigned)(Rb * K + C) * 2u; }
    const size_t kstep = (size_t)(BK * 2);
    const size_t hstep = (size_t)HALF * K * 2;
    const size_t tstep = 2 * hstep;
    const unsigned ldsw = (unsigned)wid * 1024u;
    const int aoff = lds_byte(wr * 64 + fr, fq * 8), boff = lds_byte(wc * 32 + fr, fq * 8);
#define PG8_SA(b, h) (((b) * 2 + (h)) * HTB)
#define PG8_SB(b, h) ((4 + (b) * 2 + (h)) * HTB)
#define PG8_STAGE(bufoff, gbase, voff) do { _Pragma("unroll") for (int _i = 0; _i < 2; ++_i) \
        __builtin_amdgcn_global_load_lds((const unsigned*)((const char*)(gbase) + (voff)[_i]), (PG8_LAS unsigned*)(lds + (bufoff) + ldsw + _i * 8192), 16, 0, 0); } while (0)
#define PG8_LDA(dst, b, h) do { _Pragma("unroll") for (int m = 0; m < 4; ++m) _Pragma("unroll") for (int k = 0; k < 2; ++k) dst[m][k] = *(const PG8_LAS bf16x8*)(lds + PG8_SA(b, h) + aoff + m * 2048 + k * 1024); } while (0)
#define PG8_LDB(dst, b, h) do { _Pragma("unroll") for (int n = 0; n < 2; ++n) _Pragma("unroll") for (int k = 0; k < 2; ++k) dst[n][k] = *(const PG8_LAS bf16x8*)(lds + PG8_SB(b, h) + boff + n * 2048 + k * 1024); } while (0)
#define PG8_MMA(ai, bj, At, Bt) do { __builtin_amdgcn_s_setprio(1); _Pragma("unroll") for (int m = 0; m < 4; ++m) _Pragma("unroll") for (int n = 0; n < 2; ++n) _Pragma("unroll") for (int k = 0; k < 2; ++k) \
        acc[ai][bj][m][n] = __builtin_amdgcn_mfma_f32_16x16x32_bf16(Bt[n][k], At[m][k], acc[ai][bj][m][n], 0, 0, 0); __builtin_amdgcn_s_setprio(0); } while (0)
#define PG8_WAIT_V(n) asm volatile("s_waitcnt vmcnt(" #n ")" ::: "memory")
#define PG8_WAIT_L(n) asm volatile("s_waitcnt lgkmcnt(" #n ")" ::: "memory")
#define PG8_BAR __builtin_amdgcn_s_barrier()
#define PG8_SCHED __builtin_amdgcn_sched_barrier(0)
    Unit cur, nxt; int ui = 0;
    if (!S.next(0, cur)) return;
    f32x4 acc[2][2][4][2];
#pragma unroll
    for (int a = 0; a < 2; ++a)
#pragma unroll
        for (int b = 0; b < 2; ++b)
#pragma unroll
            for (int m = 0; m < 4; ++m)
#pragma unroll
                for (int n = 0; n < 2; ++n) acc[a][b][m][n] = (f32x4){0.f, 0.f, 0.f, 0.f};
    bf16x8 At[4][2], B0[2][2], B1[2][2];
    const char* cA = (const char*)g.A + (size_t)cur.pm * tstep; const char* cB = (const char*)g.Bt + (size_t)cur.pn * tstep;
    S.a_ready(cur);
    if constexpr (SP2) {
        PG8_STAGE(PG8_SB(0, 0), cB, voffB); PG8_STAGE(PG8_SB(0, 1), cB + hstep, voffB); PG8_STAGE(PG8_SA(0, 0), cA, voffA); PG8_STAGE(PG8_SA(0, 1), cA + hstep, voffA);
        if (wr == 1) PG8_BAR;
        PG8_WAIT_V(2); PG8_BAR;
        PG8_STAGE(PG8_SB(1, 0), cB + kstep, voffB); PG8_STAGE(PG8_SA(1, 0), cA + kstep, voffA); PG8_STAGE(PG8_SB(1, 1), cB + hstep + kstep, voffB);
        PG8_WAIT_V(6); PG8_BAR;
    } else {
        PG8_STAGE(PG8_SB(0, 0), cB, voffB); PG8_STAGE(PG8_SA(0, 0), cA, voffA); PG8_STAGE(PG8_SB(0, 1), cB + hstep, voffB); PG8_STAGE(PG8_SA(0, 1), cA + hstep, voffA);
        if (wr == 1) PG8_BAR;
        PG8_WAIT_V(4); PG8_BAR;
        PG8_STAGE(PG8_SB(1, 0), cB + kstep, voffB); PG8_STAGE(PG8_SA(1, 0), cA + kstep, voffA); PG8_STAGE(PG8_SB(1, 1), cB + hstep + kstep, voffB);
        PG8_WAIT_V(6); PG8_BAR;
    }
    for (;;) {
        const bool has_next = S.next(ui + 1, nxt);
        const char* nA = has_next ? (const char*)g.A + (size_t)nxt.pm * tstep : cA; const char* nB = has_next ? (const char*)g.Bt + (size_t)nxt.pn * tstep : cB;
        for (int t = 0; t < nt; t += 2) {
            const bool last = (t == nt - 2);
            const char* a1 = cA + (size_t)(t + 1) * kstep;
            const char* a2 = last ? nA : cA + (size_t)(t + 2) * kstep; const char* b2 = last ? nB : cB + (size_t)(t + 2) * kstep;
            const char* a3 = a2 + kstep; const char* b3 = b2 + kstep;
            if (last && has_next) S.a_ready(nxt);
            if constexpr (SP2) {
            PG8_LDB(B0, 0, 0); PG8_LDB(B1, 0, 1); PG8_SCHED; PG8_LDA(At, 0, 0); PG8_STAGE(PG8_SA(1, 1), a1 + hstep, voffA);
            PG8_WAIT_V(8); PG8_WAIT_L(0); PG8_BAR; PG8_MMA(0, 0, At, B0); PG8_MMA(0, 1, At, B1); PG8_BAR; PG8_SCHED;
            PG8_LDA(At, 0, 1); PG8_STAGE(PG8_SB(0, 0), b2, voffB); PG8_STAGE(PG8_SB(0, 1), b2 + hstep, voffB); PG8_STAGE(PG8_SA(0, 0), a2, voffA);
            PG8_WAIT_V(8); PG8_WAIT_L(0); PG8_BAR; PG8_MMA(1, 0, At, B0); PG8_MMA(1, 1, At, B1); PG8_BAR; PG8_SCHED;
            PG8_LDB(B0, 1, 0); PG8_LDB(B1, 1, 1); PG8_SCHED; PG8_LDA(At, 1, 0); PG8_STAGE(PG8_SA(0, 1), a2 + hstep, voffA);
            PG8_WAIT_V(8); PG8_WAIT_L(0); PG8_BAR; PG8_MMA(0, 0, At, B0); PG8_MMA(0, 1, At, B1); PG8_BAR; PG8_SCHED;
            PG8_LDA(At, 1, 1); PG8_STAGE(PG8_SB(1, 0), b3, voffB); PG8_STAGE(PG8_SB(1, 1), b3 + hstep, voffB); PG8_STAGE(PG8_SA(1, 0), a3, voffA);
            PG8_WAIT_V(8); PG8_WAIT_L(0); PG8_BAR; PG8_MMA(1, 0, At, B0); PG8_MMA(1, 1, At, B1); PG8_BAR; PG8_SCHED;
            } else {
            PG8_LDB(B0, 0, 0); PG8_SCHED; PG8_LDA(At, 0, 0); PG8_STAGE(PG8_SA(1, 1), a1 + hstep, voffA);
            PG8_WAIT_L(8); PG8_BAR; PG8_WAIT_L(0); PG8_MMA(0, 0, At, B0); PG8_BAR; PG8_SCHED;
            PG8_LDB(B1, 0, 1); PG8_STAGE(PG8_SB(0, 0), b2, voffB);
            PG8_BAR; PG8_WAIT_L(0); PG8_MMA(0, 1, At, B1); PG8_BAR;
            PG8_LDA(At, 0, 1); PG8_STAGE(PG8_SA(0, 0), a2, voffA);
            PG8_BAR; PG8_WAIT_L(0); PG8_MMA(1, 0, At, B0); PG8_BAR; PG8_SCHED;
            PG8_STAGE(PG8_SB(0, 1), b2 + hstep, voffB);
            PG8_WAIT_V(6); PG8_BAR; PG8_MMA(1, 1, At, B1); PG8_BAR;
            PG8_LDB(B0, 1, 0); PG8_SCHED; PG8_LDA(At, 1, 0); PG8_STAGE(PG8_SA(0, 1), a2 + hstep, voffA);
            PG8_WAIT_L(8); PG8_BAR; PG8_WAIT_L(0); PG8_MMA(0, 0, At, B0); PG8_BAR; PG8_SCHED;
            PG8_LDB(B1, 1, 1); PG8_STAGE(PG8_SB(1, 0), b3, voffB);
            PG8_BAR; PG8_WAIT_L(0); PG8_MMA(0, 1, At, B1); PG8_BAR;
            PG8_LDA(At, 1, 1); PG8_STAGE(PG8_SA(1, 0), a3, voffA);
            PG8_BAR; PG8_WAIT_L(0); PG8_MMA(1, 0, At, B0); PG8_BAR; PG8_SCHED;
            PG8_STAGE(PG8_SB(1, 1), b3 + hstep, voffB);
            PG8_WAIT_V(6); PG8_BAR; PG8_MMA(1, 1, At, B1); PG8_BAR;
            }
        }
        if constexpr (ALIGN_EPI) { if (wr == 0) PG8_BAR; }
        if constexpr (!Epi::AFTER_DRAIN) { E(acc, cur, wr, wc, fr, fq); S.done(cur); }
        if (!has_next) break;
#pragma unroll
        for (int a = 0; a < 2; ++a)
#pragma unroll
            for (int b = 0; b < 2; ++b)
#pragma unroll
                for (int m = 0; m < 4; ++m)
#pragma unroll
                    for (int n = 0; n < 2; ++n) acc[a][b][m][n] = (f32x4){0.f, 0.f, 0.f, 0.f};
        cur = nxt; cA = nA; cB = nB; ++ui;
        if constexpr (ALIGN_EPI) { if (wr == 1) PG8_BAR; }
    }
    PG8_WAIT_V(0);
    if constexpr (!ALIGN_EPI) { if (wr == 0) PG8_BAR; }
    PG8_BAR;
    if constexpr (Epi::AFTER_DRAIN) { E.fused(acc, cur, wr, wc, fr, fq, lds, wid, lane); S.done(cur); }
#undef PG8_SA
#undef PG8_SB
#undef PG8_STAGE
#undef PG8_LDA
#undef PG8_LDB
#undef PG8_MMA
#undef PG8_WAIT_V
#undef PG8_WAIT_L
#undef PG8_BAR
#undef PG8_SCHED
}
}
#define GAS __attribute__((address_space(1)))
#define LAS __attribute__((address_space(3)))
typedef unsigned short bf16;
typedef unsigned v4u __attribute__((ext_vector_type(4)));
typedef unsigned v2u __attribute__((ext_vector_type(2)));
typedef float f32x4 __attribute__((ext_vector_type(4)));
typedef short bf16x8 __attribute__((ext_vector_type(8)));
typedef short s16x4 __attribute__((ext_vector_type(4)));

constexpr int NWAVES = 8, NTHR = 512;
constexpr int T = 8192, D = 1024, M = 16384, NPROJ = 3072, DIN = 3104, FF = 4096;
constexpr float EPS = 1e-6f;
constexpr int C_QA = 0, C_KA = 512, C_VA = 1024, C_QG = 1536, C_KG = 1792, C_VG = 2048, C_RG = 2560;

constexpr size_t MiB = 1u << 20;
constexpr size_t WS_SS2 = 0, WS_SS3 = 65536, WS_BAR = 131072, WS_PCNT = 131072 + 16384, WS_ZERO_BYTES = 32768, WS_DEC = 262144, WS_Z = 1 * MiB;
constexpr size_t WS_WIN = 4 * MiB, WS_WO = 11 * MiB, WS_W1 = 13 * MiB, WS_W2 = 21 * MiB;
constexpr size_t WS_XN = 32 * MiB, WS_Y = 32 * MiB, WS_PROJ = 64 * MiB, WS_CON = 160 * MiB, WS_SP = 224 * MiB;
constexpr size_t WS_HB = 64 * MiB, WS_ACT = 96 * MiB, WS_END = 256 * MiB;
constexpr int LDS_BYTES = 155648;

__device__ __forceinline__ unsigned f2bf(float f) { unsigned u = __builtin_bit_cast(unsigned, f); return (u + 0x7fffu + ((u >> 16) & 1u)) >> 16; }
__device__ __forceinline__ unsigned pk2(float lo, float hi) { return f2bf(lo) | (f2bf(hi) << 16); }
__device__ __forceinline__ float bf2f(unsigned short h) { return __builtin_bit_cast(float, (unsigned)h << 16); }
__device__ __forceinline__ float wave_sum(float v) {
#pragma unroll
    for (int o = 1; o < 64; o <<= 1) v += __shfl_xor(v, o);
    return v;
}
__device__ __forceinline__ f32x4 mfma16(bf16x8 x, bf16x8 y, f32x4 c) { return __builtin_amdgcn_mfma_f32_16x16x32_bf16(x, y, c, 0, 0, 0); }
typedef short v4i16_t __attribute__((ext_vector_type(4)));
__device__ __forceinline__ s16x4 tr4(const LAS unsigned char* p) { return __builtin_bit_cast(s16x4, __builtin_amdgcn_ds_read_tr16_b64_v4i16((LAS v4i16_t*)p)); }
__device__ __forceinline__ bf16x8 cat8(s16x4 a, s16x4 b) { bf16x8 r; r[0] = a[0]; r[1] = a[1]; r[2] = a[2]; r[3] = a[3]; r[4] = b[0]; r[5] = b[1]; r[6] = b[2]; r[7] = b[3]; return r; }
__device__ __forceinline__ bf16x8 pack8(f32x4 a, f32x4 b) {
    v4u w; w.x = pg8::cvt_pk_bf16(a[0], a[1]); w.y = pg8::cvt_pk_bf16(a[2], a[3]); w.z = pg8::cvt_pk_bf16(b[0], b[1]); w.w = pg8::cvt_pk_bf16(b[2], b[3]);
    return __builtin_bit_cast(bf16x8, w);
}

struct Frame {
    LAS unsigned char* lds;
    int tid, lane, wave, vcu, G;
};

__device__ __forceinline__ void p0_transpose_item(const float* W, int K, int N, bf16* WT, const float* gk, LAS float* scr, int item, int lane) {
    const int nblk = N / 32, kb = item / nblk, nb = item % nblk, k0 = 64 * kb, n0 = 32 * nb;
#pragma unroll 8
    for (int i = 0; i < 32; ++i) { const int kk = 2 * i + (lane >> 5); float v = W[(size_t)(k0 + kk) * N + n0 + (lane & 31)]; if (gk) v *= gk[k0 + kk]; scr[kk * 33 + (lane & 31)] = v; }
    asm volatile("s_waitcnt lgkmcnt(0)" ::: "memory");
    const int c = lane & 7;
#pragma unroll
    for (int j = 0; j < 4; ++j) { const int n = (lane >> 3) + 8 * j; const LAS float* s = scr + (8 * c) * 33 + n;
        v4u o; o.x = pk2(s[0 * 33], s[1 * 33]); o.y = pk2(s[2 * 33], s[3 * 33]); o.z = pk2(s[4 * 33], s[5 * 33]); o.w = pk2(s[6 * 33], s[7 * 33]);
        *(v4u*)(WT + (size_t)(n0 + n) * K + k0 + 8 * c) = o; }
    asm volatile("s_waitcnt lgkmcnt(0)" ::: "memory");
}
__device__ __forceinline__ void phase_prologue(const Frame& F, const float* x, const float* g_mix, const float* w_in, const float* w_out, const float* g_ff, const float* w1, const float* w2, unsigned char* ws) {
    LAS float* scr = (LAS float*)(F.lds + F.wave * 16384);
    const int gw = F.vcu * NWAVES + F.wave, NGW = F.G * NWAVES;
    constexpr int I_IN = (D / 64) * (DIN / 32), I_O = (D / 64) * (D / 32), I_1 = (D / 64) * (FF / 32), I_2 = (FF / 64) * (D / 32);
    constexpr int NITEMS = I_IN + I_O + I_1 + I_2;
    for (int it = gw; it < NITEMS; it += NGW) {
        int r = it;
        if (r < I_IN) { p0_transpose_item(w_in, D, DIN, (bf16*)(ws + WS_WIN), nullptr, scr, r, F.lane); continue; } r -= I_IN;
        if (r < I_O) { p0_transpose_item(w_out, D, D, (bf16*)(ws + WS_WO), nullptr, scr, r, F.lane); continue; } r -= I_O;
        if (r < I_1) { p0_transpose_item(w1, D, FF, (bf16*)(ws + WS_W1), g_ff, scr, r, F.lane); continue; } r -= I_1;
        p0_transpose_item(w2, FF, D, (bf16*)(ws + WS_W2), nullptr, scr, r, F.lane);
    }
    { float* ss = (float*)(ws + WS_SS2); for (int i = (F.vcu * NTHR + F.tid); i < 2 * M; i += F.G * NTHR) ss[i] = 0.f; }
    bf16* XN = (bf16*)(ws + WS_XN);
    f32x4 gv[4];
#pragma unroll
    for (int j = 0; j < 4; ++j) gv[j] = ((const f32x4*)g_mix)[F.lane + 64 * j];
    for (int m = gw; m < M; m += NGW) {
        const f32x4* xr = (const f32x4*)(x + (size_t)m * D) + F.lane;
        f32x4 v[4]; float s = 0.f;
#pragma unroll
        for (int j = 0; j < 4; ++j) { v[j] = xr[64 * j]; s += (v[j].x * v[j].x + v[j].y * v[j].y) + (v[j].z * v[j].z + v[j].w * v[j].w); }
        const float rs = 1.0f / sqrtf(wave_sum(s) * (1.f / D) + EPS);
        unsigned long long* o8 = (unsigned long long*)(XN + (size_t)m * D) + F.lane;
#pragma unroll
        for (int j = 0; j < 4; ++j) { const f32x4 o = v[j] * rs * gv[j]; o8[64 * j] = (unsigned long long)pk2(o.x, o.y) | ((unsigned long long)pk2(o.z, o.w) << 32); }
    }
}

__device__ __forceinline__ void phase_z(const Frame& F, const bf16* XN, const bf16* Wz, float* Z) {
    const int fr = F.lane & 15, fq = F.lane >> 4, mt = F.wave & 3, nt = F.wave >> 2;
    for (int rb = F.vcu; rb < M / 64; rb += F.G) {
        const bf16* ap = XN + (size_t)(rb * 64 + mt * 16 + fr) * D + 8 * fq;
        const bf16* bp = Wz + (size_t)(nt * 16 + fr) * D + 8 * fq;
        f32x4 acc = {0.f, 0.f, 0.f, 0.f};
#pragma unroll 8
        for (int ks = 0; ks < D / 32; ++ks) { const bf16x8 a = *(const bf16x8*)(ap + ks * 32), b = *(const bf16x8*)(bp + ks * 32); acc = mfma16(b, a, acc); }
        *(f32x4*)(Z + (size_t)(rb * 64 + mt * 16 + fr) * 32 + nt * 16 + 4 * fq) = acc;
    }
}

constexpr int NA_STR = 144, NA_K_OFF = 0, NA_V_OFF = 512 * NA_STR, NA_RPB_OFF = 2 * 512 * NA_STR;
__device__ __forceinline__ void natten_compute(const Frame& F, const bf16x8 (&qf)[2], bf16* Y, int b, int h, int r, int rs) {
    LAS unsigned char* lds = F.lds;
    const size_t tokq0 = (size_t)b * T + r * 64;
    const int fr = F.lane & 15, fq = F.lane >> 4, jq = F.wave & 3, dh = F.wave >> 2;
    const int wc0 = (jq == 0) ? 0 : (jq == 1) ? 8 : (jq == 2) ? 24 : 32;
    f32x4 s[16];
#pragma unroll
    for (int i = 0; i < 8; ++i)
#pragma unroll
        for (int ct = 0; ct < 2; ++ct) {
            const LAS unsigned char* kp = lds + NA_K_OFF + (((rs + i) & 7) * 64 + wc0 + 16 * ct + fr) * NA_STR + fq * 16;
            const bf16x8 k0 = *(const LAS bf16x8*)kp, k1 = *(const LAS bf16x8*)(kp + 64);
            f32x4 a = {0.f, 0.f, 0.f, 0.f}; a = mfma16(k0, qf[0], a); a = mfma16(k1, qf[1], a); s[i * 2 + ct] = a; }
    const int cq = 16 * jq + fr, cs = min(max(cq - 8, 0), 48);
    const LAS float* rp = (const LAS float*)(lds + NA_RPB_OFF);
    float mx = -INFINITY;
#pragma unroll
    for (int i = 0; i < 8; ++i) { const int dr = rs + i - r + 7;
#pragma unroll
        for (int ct = 0; ct < 2; ++ct)
#pragma unroll
            for (int e = 0; e < 4; ++e) { const int ck = wc0 + 16 * ct + 4 * fq + e; const bool in = (ck >= cs) && (ck < cs + 16);
                const int dc = min(max(ck - cq + 15, 0), 30);
                const float v = in ? s[i * 2 + ct][e] * 0.125f + rp[dr * 31 + dc] : -INFINITY; s[i * 2 + ct][e] = v; mx = fmaxf(mx, v); } }
    mx = fmaxf(mx, __shfl_xor(mx, 16)); mx = fmaxf(mx, __shfl_xor(mx, 32));
    float l = 0.f;
#pragma unroll
    for (int t = 0; t < 16; ++t)
#pragma unroll
        for (int e = 0; e < 4; ++e) { const float p = __expf(s[t][e] - mx); s[t][e] = p; l += p; }
    l += __shfl_xor(l, 16); l += __shfl_xor(l, 32);
    f32x4 o[2] = {{0.f, 0.f, 0.f, 0.f}, {0.f, 0.f, 0.f, 0.f}};
#pragma unroll
    for (int i = 0; i < 8; ++i) { const bf16x8 pb = pack8(s[2 * i], s[2 * i + 1]);
#pragma unroll
        for (int dt = 0; dt < 2; ++dt) { const int d0 = 32 * dh + 16 * dt;
            const LAS unsigned char* vp = lds + NA_V_OFF + (((rs + i) & 7) * 64 + wc0 + 4 * fq + (fr >> 2)) * NA_STR + (d0 + 4 * (fr & 3)) * 2;
            const bf16x8 x = cat8(tr4(vp), tr4(vp + 16 * NA_STR)); o[dt] = mfma16(x, pb, o[dt]); } }
    const float inv = 1.0f / l;
#pragma unroll
    for (int dt = 0; dt < 2; ++dt) { v2u w; w.x = pg8::cvt_pk_bf16(o[dt][0] * inv, o[dt][1] * inv); w.y = pg8::cvt_pk_bf16(o[dt][2] * inv, o[dt][3] * inv);
        *(v2u*)(Y + (tokq0 + 16 * jq + fr) * D + h * 64 + 32 * dh + 16 * dt + 4 * fq) = w; }
}
__device__ __forceinline__ void natten_wg(const Frame& F, const bf16* PROJ, const float* rpb, bf16* Y, int wgi) {
    LAS unsigned char* lds = F.lds;
    const int bh = wgi >> 4, r0 = 8 * (wgi & 15), h = bh & 7, b = bh >> 3;
    const int fr = F.lane & 15, fq = F.lane >> 4, jq = F.wave & 3;
    const bf16* qbase = PROJ + ((size_t)b * T + 16 * jq + fr) * NPROJ + C_QA + h * 64 + 8 * fq;
    bf16x8 qf[2], qn[2];
    { const bf16* qp = qbase + (size_t)r0 * 64 * NPROJ; qf[0] = *(const bf16x8*)qp; qf[1] = *(const bf16x8*)(qp + 32); }
    { const int rs0 = min(max(r0 - 4, 0), 120);
#pragma unroll
      for (int it = 0; it < 8; ++it) { const int id = F.tid + NTHR * it, key = id >> 3, ch = id & 7, row = rs0 + (key >> 6), col = key & 63;
        const bf16* src = PROJ + ((size_t)b * T + row * 64 + col) * NPROJ + C_KA + h * 64 + ch * 8;
        const v4u kv = *(const v4u*)src, vv = *(const v4u*)(src + (C_VA - C_KA));
        const int o = ((row & 7) * 64 + col) * NA_STR + ch * 16;
        *(LAS v4u*)(lds + NA_K_OFF + o) = kv; *(LAS v4u*)(lds + NA_V_OFF + o) = vv; } }
    if (F.tid < 465) ((LAS float*)(lds + NA_RPB_OFF))[F.tid] = rpb[h * 465 + F.tid];
    __syncthreads();
    for (int rr = 0; rr < 8; ++rr) {
        const int r = r0 + rr, rs = min(max(r - 4, 0), 120), rsn = min(max(r - 3, 0), 120);
        const bool more = rr < 7, slide = more && (rsn != rs);
        v4u nk = {0u, 0u, 0u, 0u}, nv = {0u, 0u, 0u, 0u};
        if (more) { const bf16* qp = qbase + (size_t)(r + 1) * 64 * NPROJ; qn[0] = *(const bf16x8*)qp; qn[1] = *(const bf16x8*)(qp + 32); }
        if (slide) { const int col = F.tid >> 3, ch = F.tid & 7; const bf16* src = PROJ + ((size_t)b * T + (rsn + 7) * 64 + col) * NPROJ + C_KA + h * 64 + ch * 8; nk = *(const v4u*)src; nv = *(const v4u*)(src + (C_VA - C_KA)); }
        natten_compute(F, qf, Y, b, h, r, rs);
        __syncthreads();
        if (slide) { const int col = F.tid >> 3, ch = F.tid & 7, o = ((((rsn + 7) & 7) * 64) + col) * NA_STR + ch * 16; *(LAS v4u*)(lds + NA_K_OFF + o) = nk; *(LAS v4u*)(lds + NA_V_OFF + o) = nv; }
        if (more) { qf[0] = qn[0]; qf[1] = qn[1]; }
        __syncthreads();
    }
}

constexpr int GL_Z = 0, GL_GU = 8192, GL_GB = 16384, GL_GT = 16896, GL_I0 = 20992;
constexpr int IS = 144, IMG = 64 * IS;
constexpr int VS = 272, VIMG = 64 * VS;
constexpr int GL_QF = GL_I0, GL_QB = GL_I0 + IMG, GL_KF = GL_I0 + 2 * IMG, GL_KB = GL_I0 + 3 * IMG, GL_V = GL_I0 + 4 * IMG, GL_SF = GL_V + VIMG, GL_SB = GL_SF + VIMG;
static_assert(GL_SB + VIMG <= LDS_BYTES, "GLA LDS map");
__device__ __forceinline__ float logsig(float x) { return fminf(x, 0.f) - __logf(1.0f + __expf(-fabsf(x))); }

__device__ __forceinline__ void gla_gate(const Frame& F, const float* Z, const float* guf, const float* gbf, const float* gub, const float* gbb, int h, size_t t0,
                                         float (&bf)[8], float (&bb)[8], float& totf, float& totb) {
    LAS unsigned char* lds = F.lds; const int tid = F.tid, d = tid & 63, g = F.wave;
    *(LAS f32x4*)(lds + GL_Z + tid * 16) = *(const f32x4*)(Z + t0 * 32 + tid * 4);
    { const int idx = tid * 4, dir = idx >> 10, rr = (idx >> 6) & 15, dd = idx & 63; const float* src = (dir ? gub : guf) + rr * 256 + h * 64 + dd; *(LAS f32x4*)(lds + GL_GU + idx * 4) = *(const f32x4*)src; }
    if (tid < 128) { const int dir = tid >> 6, dd = tid & 63; ((LAS float*)(lds + GL_GB))[tid] = (dir ? gbb : gbf)[h * 64 + dd]; }
    __syncthreads();
    const LAS float* Zl = (const LAS float*)(lds + GL_Z); const LAS float* GU = (const LAS float*)(lds + GL_GU); const LAS float* GB = (const LAS float*)(lds + GL_GB);
    float uf[16], ub[16];
#pragma unroll
    for (int rr = 0; rr < 16; ++rr) { uf[rr] = GU[rr * 64 + d]; ub[rr] = GU[1024 + rr * 64 + d]; }
    const float gf0 = GB[d], gb0 = GB[64 + d];
    float laf[8], lab[8];
#pragma unroll
    for (int j = 0; j < 8; ++j) { const int c = 8 * g + j; float pf = gf0, pb = gb0;
#pragma unroll
        for (int r4 = 0; r4 < 4; ++r4) { const f32x4 zf = *(const LAS f32x4*)(Zl + c * 32 + 4 * r4), zb = *(const LAS f32x4*)(Zl + c * 32 + 16 + 4 * r4);
#pragma unroll
            for (int e = 0; e < 4; ++e) { pf += zf[e] * uf[4 * r4 + e]; pb += zb[e] * ub[4 * r4 + e]; } }
        laf[j] = logsig(pf) * (1.0f / 16.0f); lab[j] = logsig(pb) * (1.0f / 16.0f); }
    float run = 0.f;
#pragma unroll
    for (int j = 0; j < 8; ++j) { run += laf[j]; bf[j] = run; }
    float runb = 0.f;
#pragma unroll
    for (int j = 7; j >= 0; --j) { runb += lab[j]; bb[j] = runb; }
    LAS float* GT = (LAS float*)(lds + GL_GT);
    GT[g * 64 + d] = run; GT[512 + g * 64 + d] = runb;
    __syncthreads();
    float of = 0.f, ob = 0.f; totf = 0.f; totb = 0.f;
#pragma unroll
    for (int gp = 0; gp < 8; ++gp) { const float a = GT[gp * 64 + d], c = GT[512 + gp * 64 + d]; totf += a; totb += c; if (gp < g) of += a; if (gp > g) ob += c; }
#pragma unroll
    for (int j = 0; j < 8; ++j) { bf[j] += of; bb[j] += ob; }
}
__device__ __forceinline__ void stage_img128(LAS unsigned char* dst, const bf16* src, size_t row_stride, int tid) {
#pragma unroll
    for (int it = 0; it < 2; ++it) { const int id = tid + NTHR * it, row = id >> 4, ch = id & 15; *(LAS v4u*)(dst + row * VS + ch * 16) = *(const v4u*)(src + (size_t)row * row_stride + ch * 8); }
}

__device__ __forceinline__ void gla_a_unit(const Frame& F, const bf16* PROJ, const float* Z, const float* guf, const float* gbf, const float* gub, const float* gbb, float* CON, float* DEC, bf16* IMGS, int unit) {
    LAS unsigned char* lds = F.lds; const int tid = F.tid, d = tid & 63, g = F.wave;
    const int n = unit & 127, bh = unit >> 7, h = bh & 3, b = bh >> 2; const size_t t0 = (size_t)b * T + 64 * n;
    unsigned short kraw[8], qraw[8];
#pragma unroll
    for (int j = 0; j < 8; ++j) { const bf16* p = PROJ + (t0 + 8 * g + j) * NPROJ + h * 64 + d; qraw[j] = p[C_QG]; kraw[j] = p[C_KG]; }
    stage_img128(lds + GL_V, PROJ + t0 * NPROJ + C_VG + h * 128, NPROJ, tid);
    float bf[8], bb[8], totf, totb;
    gla_gate(F, Z, guf, gbf, gub, gbb, h, t0, bf, bb, totf, totb);
    const float decf = __expf(totf), decb = __expf(totb);
    bf16* im = IMGS + (size_t)unit * 16384 + d;
#pragma unroll
    for (int j = 0; j < 8; ++j) { const float k = bf2f(kraw[j]), q = bf2f(qraw[j]) * 0.125f; const int c = 8 * g + j;
        const float ef = __expf(bf[j]), eb = __expf(bb[j]), rf = 1.0f / ef, rb = 1.0f / eb, kif = k * rf, kib = k * rb;
        *(LAS unsigned short*)(lds + GL_KF + c * IS + d * 2) = (unsigned short)f2bf(kif * decf);
        *(LAS unsigned short*)(lds + GL_KB + c * IS + d * 2) = (unsigned short)f2bf(kib * decb);
        im[c * 64] = (bf16)f2bf(q * ef); im[4096 + c * 64] = (bf16)f2bf(kif); im[8192 + c * 64] = (bf16)f2bf(q * eb); im[12288 + c * 64] = (bf16)f2bf(kib); }
    if (g == 0) { DEC[(size_t)unit * 64 + d] = decf; DEC[(size_t)(1024 + unit) * 64 + d] = decb; }
    __syncthreads();
    const int fr = F.lane & 15, fq = F.lane >> 4, dir = F.wave >> 2, dt = F.wave & 3;
    const LAS unsigned char* kimg = lds + (dir ? GL_KB : GL_KF);
    bf16x8 yk[2];
#pragma unroll
    for (int s = 0; s < 2; ++s) { const LAS unsigned char* p = kimg + (32 * s + 4 * fq + (fr >> 2)) * IS + (16 * dt + 4 * (fr & 3)) * 2; yk[s] = cat8(tr4(p), tr4(p + 16 * IS)); }
    float* cbase = CON + ((size_t)(dir * 1024 + unit) * 64 + 16 * dt + fr) * 128 + 4 * fq;
#pragma unroll
    for (int et = 0; et < 8; ++et) { f32x4 acc = {0.f, 0.f, 0.f, 0.f};
#pragma unroll
        for (int s = 0; s < 2; ++s) { const LAS unsigned char* p = lds + GL_V + (32 * s + 4 * fq + (fr >> 2)) * VS + (16 * et + 4 * (fr & 3)) * 2; acc = mfma16(cat8(tr4(p), tr4(p + 16 * VS)), yk[s], acc); }
        *(f32x4*)(cbase + 16 * et) = acc; }
    __syncthreads();
}

__device__ __forceinline__ void phase_scan(const Frame& F, const float* __restrict__ CON, const float* __restrict__ DEC, bf16* __restrict__ SP) {
    for (int chain = F.vcu * NTHR + F.tid; chain < 2 * 8 * 64 * 128; chain += F.G * NTHR) {
        const int e = chain & 127, d = (chain >> 7) & 63, bh = (chain >> 13) & 7, dir = chain >> 16;
        const size_t ubase = (size_t)dir * 1024 + bh * 128;
        const float* con = CON + (ubase * 64 + d) * 128 + e; const float* dec = DEC + ubase * 64 + d; bf16* sp = SP + (ubase * 64 + d) * 128 + e;
        float S = 0.f;
        for (int nb = 0; nb < 16; ++nb) { float c[8], gg[8];
#pragma unroll
            for (int u = 0; u < 8; ++u) { const int n = nb * 8 + u, ne = dir ? 127 - n : n; c[u] = con[(size_t)ne * 8192]; gg[u] = dec[ne * 64]; }
#pragma unroll
            for (int u = 0; u < 8; ++u) { const int n = nb * 8 + u, ne = dir ? 127 - n : n; sp[(size_t)ne * 8192] = (bf16)f2bf(S); S = gg[u] * S + c[u]; } }
    }
}

struct GlaCFetch { v4u im[4], v[2], sf[2], sb[2]; };
__device__ __forceinline__ void gla_c_fetch(GlaCFetch& R, const bf16* PROJ, const bf16* SP, const bf16* IMGS, int unit, int tid) {
    const int n = unit & 127, bh = unit >> 7, h = bh & 3, b = bh >> 2; const size_t t0 = (size_t)b * T + 64 * n;
#pragma unroll
    for (int k = 0; k < 4; ++k) R.im[k] = *(const v4u*)(IMGS + (size_t)unit * 16384 + k * 4096 + tid * 8);
#pragma unroll
    for (int it = 0; it < 2; ++it) { const int id = tid + NTHR * it, row = id >> 4, ch = id & 15;
        R.v[it] = *(const v4u*)(PROJ + (t0 + row) * NPROJ + C_VG + h * 128 + ch * 8);
        R.sf[it] = *(const v4u*)(SP + (size_t)unit * 8192 + row * 128 + ch * 8);
        R.sb[it] = *(const v4u*)(SP + (size_t)(1024 + unit) * 8192 + row * 128 + ch * 8); }
}
__device__ __forceinline__ void gla_c_commit(const GlaCFetch& R, LAS unsigned char* lds, int tid) {
    { const int row = tid >> 3, ch = tid & 7, o = row * IS + ch * 16;
      *(LAS v4u*)(lds + GL_QF + o) = R.im[0]; *(LAS v4u*)(lds + GL_KF + o) = R.im[1]; *(LAS v4u*)(lds + GL_QB + o) = R.im[2]; *(LAS v4u*)(lds + GL_KB + o) = R.im[3]; }
#pragma unroll
    for (int it = 0; it < 2; ++it) { const int id = tid + NTHR * it, row = id >> 4, ch = id & 15, o = row * VS + ch * 16;
        *(LAS v4u*)(lds + GL_V + o) = R.v[it]; *(LAS v4u*)(lds + GL_SF + o) = R.sf[it]; *(LAS v4u*)(lds + GL_SB + o) = R.sb[it]; }
}
__device__ __forceinline__ void gla_c_compute(const Frame& F, const bf16* PROJ, const float* norm_g, bf16* Y, int unit) {
    LAS unsigned char* lds = F.lds;
    const int n = unit & 127, bh = unit >> 7, h = bh & 3, b = bh >> 2; const size_t t0 = (size_t)b * T + 64 * n;
    if (F.wave < 4) {
        const int fr = F.lane & 15, fq = F.lane >> 4, it = F.wave;
        const int i = 16 * it + fr;
        const bf16* rp = PROJ + (t0 + i) * NPROJ + C_RG + h * 128 + 4 * fq; bf16* yp = Y + (t0 + i) * D + 512 + h * 128 + 4 * fq;
        v2u rw[8];
#pragma unroll
        for (int et = 0; et < 8; ++et) rw[et] = *(const v2u*)(rp + 16 * et);
        bf16x8 yqf[2], yqb[2];
#pragma unroll
        for (int s = 0; s < 2; ++s) { const int off = (16 * it + fr) * IS + (32 * s + 8 * fq) * 2; yqf[s] = *(const LAS bf16x8*)(lds + GL_QF + off); yqb[s] = *(const LAS bf16x8*)(lds + GL_QB + off); }
        f32x4 a[4];
#pragma unroll
        for (int jt = 0; jt < 4; ++jt) { f32x4 af = {0.f, 0.f, 0.f, 0.f}, ab = {0.f, 0.f, 0.f, 0.f};
#pragma unroll
            for (int s = 0; s < 2; ++s) { const int off = (16 * jt + fr) * IS + (32 * s + 8 * fq) * 2;
                af = mfma16(*(const LAS bf16x8*)(lds + GL_KF + off), yqf[s], af); ab = mfma16(*(const LAS bf16x8*)(lds + GL_KB + off), yqb[s], ab); }
#pragma unroll
            for (int e = 0; e < 4; ++e) { const int j = 16 * jt + 4 * fq + e; a[jt][e] = (j <= i) ? af[e] : ab[e]; } }
        f32x4 o[8];
#pragma unroll
        for (int et = 0; et < 8; ++et) o[et] = (f32x4){0.f, 0.f, 0.f, 0.f};
#pragma unroll
        for (int s = 0; s < 2; ++s) { const bf16x8 pb = pack8(a[2 * s], a[2 * s + 1]);
#pragma unroll
            for (int et = 0; et < 8; ++et) { const LAS unsigned char* p = lds + GL_V + (32 * s + 4 * fq + (fr >> 2)) * VS + (16 * et + 4 * (fr & 3)) * 2; o[et] = mfma16(cat8(tr4(p), tr4(p + 16 * VS)), pb, o[et]); } }
#pragma unroll
        for (int s = 0; s < 2; ++s)
#pragma unroll
            for (int et = 0; et < 8; ++et) { const int off = (32 * s + 8 * fq + (fr >> 2)) * VS + (16 * et + 4 * (fr & 3)) * 2;
                o[et] = mfma16(cat8(tr4(lds + GL_SF + off), tr4(lds + GL_SF + off + 4 * VS)), yqf[s], o[et]);
                o[et] = mfma16(cat8(tr4(lds + GL_SB + off), tr4(lds + GL_SB + off + 4 * VS)), yqb[s], o[et]); }
        float ss = 0.f;
#pragma unroll
        for (int et = 0; et < 8; ++et) ss += (o[et][0] * o[et][0] + o[et][1] * o[et][1]) + (o[et][2] * o[et][2] + o[et][3] * o[et][3]);
        ss += __shfl_xor(ss, 16); ss += __shfl_xor(ss, 32);
        const float rs = 1.0f / sqrtf(ss * (1.0f / 128.0f) + EPS);
#pragma unroll
        for (int et = 0; et < 8; ++et) { const f32x4 gn = *(const f32x4*)(norm_g + 16 * et + 4 * fq);
            float rv[4] = {__builtin_bit_cast(float, rw[et].x << 16), __builtin_bit_cast(float, rw[et].x & 0xffff0000u), __builtin_bit_cast(float, rw[et].y << 16), __builtin_bit_cast(float, rw[et].y & 0xffff0000u)};
            float ov[4];
#pragma unroll
            for (int e = 0; e < 4; ++e) { const float sg = rv[e] / (1.0f + __expf(-rv[e])); ov[e] = o[et][e] * rs * gn[e] * sg; }
            v2u w; w.x = pg8::cvt_pk_bf16(ov[0], ov[1]); w.y = pg8::cvt_pk_bf16(ov[2], ov[3]); *(v2u*)(yp + 16 * et) = w; }
    }
}
__device__ __forceinline__ void phase_gla_c(const Frame& F, const bf16* PROJ, const bf16* SP, const bf16* IMGS, const float* norm_g, bf16* Y) {
    GlaCFetch R;
    int u = F.vcu;
    if (u < 1024) gla_c_fetch(R, PROJ, SP, IMGS, u, F.tid);
    for (; u < 1024; u += F.G) {
        gla_c_commit(R, F.lds, F.tid);
        __syncthreads();
        if (u + F.G < 1024) gla_c_fetch(R, PROJ, SP, IMGS, u + F.G, F.tid);
        gla_c_compute(F, PROJ, norm_g, Y, u);
        __syncthreads();
    }
}

__device__ __forceinline__ void phase_final(const Frame& F, float* out, const float* ss, const float* g) {
    const int gw = F.vcu * NWAVES + F.wave, NGW = F.G * NWAVES;
    f32x4 gv[4];
#pragma unroll
    for (int j = 0; j < 4; ++j) gv[j] = ((const f32x4*)g)[F.lane + 64 * j];
    for (int m = gw; m < M; m += NGW) { f32x4* xr = (f32x4*)(out + (size_t)m * D) + F.lane; const float rs = 1.0f / sqrtf(ss[m] * (1.f / D) + EPS);
#pragma unroll
        for (int j = 0; j < 4; ++j) xr[64 * j] = xr[64 * j] * rs * gv[j]; }
}

#define XB_TMO      128
#define XB_XCNT(j)  (256  + 64 * (j))
#define XB_XSUB(j)  (1280 + 64 * (j))
#define XB_XGEN(j)  (2304 + 64 * (j))
#define XB_TOP      3328
#define XB_TOPGEN   3392
#define XCD_BAR_WORDS 3456
#define XB_SPIN_CAP (1u << 18)

__device__ __forceinline__ unsigned xb_ld(unsigned* p)              { return __hip_atomic_load(p, __ATOMIC_RELAXED, __HIP_MEMORY_SCOPE_AGENT); }
__device__ __forceinline__ unsigned xb_add(unsigned* p, unsigned v) { return __hip_atomic_fetch_add(p, v, __ATOMIC_RELAXED, __HIP_MEMORY_SCOPE_AGENT); }
__device__ __forceinline__ unsigned xb_xcc_id() { return (unsigned)__builtin_amdgcn_s_getreg((3 << 11) | 20) & 0xFu; }
#define XB_SPIN(cond, bar) do { unsigned _sp = 0; while (cond) { __builtin_amdgcn_s_sleep(1); \
    if ((++_sp & 255u) == 0u) { if (xb_ld(&(bar)[XB_TMO])) break; if (_sp > XB_SPIN_CAP) { atomicAdd(&(bar)[XB_TMO], 1u); break; } } } } while (0)

struct XcdBarrier {
    unsigned* bar; unsigned x;
    volatile LAS unsigned* st;
};

__device__ __forceinline__ XcdBarrier xcd_barrier_post(unsigned* bar, volatile LAS unsigned* st) {
    XcdBarrier b; b.bar = bar; b.x = xb_xcc_id(); b.st = st;
    if (threadIdx.x == 0) (void)xb_add(&bar[XB_XCNT(b.x)], 1u);
    return b;
}
__device__ __forceinline__ void xcd_barrier_complete(unsigned* bar, unsigned x, unsigned& nloc, unsigned& nx) {
    const unsigned G = gridDim.x * gridDim.y * gridDim.z;
    unsigned sum, cnt, mine, sp = 0u;
    for (;;) {
        sum = 0u; cnt = 0u; mine = 0u;
#pragma unroll
        for (unsigned j = 0; j < 16; ++j) { const unsigned c = xb_ld(&bar[XB_XCNT(j)]); sum += c; cnt += (c > 0u) ? 1u : 0u; mine = (j == x) ? c : mine; }
        if (sum == G) break;
        __builtin_amdgcn_s_sleep(1);
        if ((++sp & 255u) == 0u) { if (xb_ld(&bar[XB_TMO])) break; if (sp > XB_SPIN_CAP) { atomicAdd(&bar[XB_TMO], 1u); break; } }
    }
    nloc = mine > 0u ? mine : 1u; nx = cnt > 0u ? cnt : 1u;
}

__device__ __forceinline__ void xcd_barrier(const XcdBarrier& b) {
    asm volatile("s_waitcnt vmcnt(0)" ::: "memory");
    __syncthreads();
    if (threadIdx.x == 0) {
        unsigned* bar = b.bar;
        __builtin_amdgcn_s_waitcnt(0);
        unsigned nloc = b.st[0], nx = b.st[1];
        if (nloc == 0u) { xcd_barrier_complete(bar, b.x, nloc, nx); b.st[0] = nloc; b.st[1] = nx; }
        const unsigned old = xb_add(&bar[XB_XSUB(b.x)], 1u);
        const unsigned gen = old / nloc;
        if (old + 1u == (gen + 1u) * nloc) {
            __builtin_amdgcn_fence(__ATOMIC_RELEASE, "agent");
            asm volatile("s_waitcnt vmcnt(0)" ::: "memory");
            const unsigned og = xb_add(&bar[XB_TOP], 1u);
            const unsigned tg = og / nx;
            if (og + 1u == (tg + 1u) * nx) xb_add(&bar[XB_TOPGEN], 1u);
            else XB_SPIN(xb_ld(&bar[XB_TOPGEN]) == tg, bar);
            __builtin_amdgcn_fence(__ATOMIC_ACQUIRE, "agent");
            xb_add(&bar[XB_XGEN(b.x)], 1u);
            asm volatile("s_waitcnt vmcnt(0)" ::: "memory");
        } else {
            XB_SPIN(xb_ld(&bar[XB_XGEN(b.x)]) == gen, bar);
            __builtin_amdgcn_fence(__ATOMIC_ACQUIRE, "agent");
            asm volatile("s_waitcnt vmcnt(0)" ::: "memory");
        }
    }
    __syncthreads();
}
#ifndef MK_DUP
#define MK_DUP 0
#endif
struct Args { const float* in[14]; float* out; unsigned char* ws; int lo, hi; };
constexpr int NPHASE = 9;
__global__ void __launch_bounds__(NTHR, 2) mk_fwd(Args a) {
    extern __shared__ __attribute__((aligned(16))) unsigned char lds_raw[];
    Frame F; F.lds = (LAS unsigned char*)lds_raw; F.tid = threadIdx.x; F.lane = F.tid & 63; F.wave = __builtin_amdgcn_readfirstlane(F.tid >> 6);
    F.G = gridDim.x; { const int bx = blockIdx.x; F.vcu = (F.G % 8 == 0) ? (bx % 8) * (F.G / 8) + bx / 8 : bx; }
    unsigned char* ws = a.ws;
    const float* x = a.in[0];
    bf16* XN = (bf16*)(ws + WS_XN); bf16* Yb = (bf16*)(ws + WS_Y); bf16* PROJ = (bf16*)(ws + WS_PROJ); bf16* HB = (bf16*)(ws + WS_HB); bf16* ACT = (bf16*)(ws + WS_ACT);
    float* Z = (float*)(ws + WS_Z); float* CON = (float*)(ws + WS_CON); float* DEC = (float*)(ws + WS_DEC); bf16* SP = (bf16*)(ws + WS_SP);
    float* SS2 = (float*)(ws + WS_SS2); float* SS3 = (float*)(ws + WS_SS3);
    const int lo = a.lo, hi = a.hi;
#define IN(k) (lo <= (k) && (k) < hi)
#define SEAM(k) do { if (IN(k) && IN((k) + 1)) xcd_barrier(bar); } while (0)
    volatile LAS unsigned* MISC = (volatile LAS unsigned*)(F.lds + LDS_BYTES - 64);
    if (F.tid < 16) MISC[F.tid] = 0u;
    __syncthreads();
    unsigned* barw = (unsigned*)(ws + WS_BAR);
    if (a.lo < 0) cg::this_grid().sync();
    XcdBarrier bar; bar.bar = barw; bar.x = 0; bar.st = nullptr;
    if (hi - lo > 1) bar = xcd_barrier_post(barw, MISC + 8);
    if (IN(0)) phase_prologue(F, x, a.in[1], a.in[2], a.in[9], a.in[10], a.in[11], a.in[12], ws);
    SEAM(0);
    for (int rep_ = 0; rep_ < 1 + ((MK_DUP >> 1) & 1); ++rep_) if (IN(1)) {
        pg8::Gemm g{XN, (const bf16*)(ws + WS_WIN), M, NPROJ, D}; pg8::StaticOrder S; S.init(M, NPROJ, F.G, (int)blockIdx.x);
        pg8::EpiProj E{PROJ, NPROJ};
        pg8::gemm_phase<pg8::EpiProj, pg8::StaticOrder, true, true>(F.lds, g, S, E);
        phase_z(F, XN, (const bf16*)(ws + WS_WIN) + (size_t)NPROJ * D, Z);
    }
    SEAM(1);
    for (int rep_ = 0; rep_ < 1 + ((MK_DUP >> 2) & 1); ++rep_) if (IN(2)) {
        for (int rep2_ = 0; rep2_ < 1 + ((MK_DUP >> 9) & 1); ++rep2_)
        for (int u = F.vcu; u < 1024; u += F.G) gla_a_unit(F, PROJ, Z, a.in[4], a.in[5], a.in[6], a.in[7], CON, DEC, (bf16*)a.out, u);
        for (int rep2_ = 0; rep2_ < 1 + ((MK_DUP >> 10) & 1); ++rep2_)
        for (int w = F.vcu; w < 256; w += F.G) natten_wg(F, PROJ, a.in[3], Yb, w);
    }
    SEAM(2);
    for (int rep_ = 0; rep_ < 1 + ((MK_DUP >> 3) & 1); ++rep_) if (IN(3)) phase_scan(F, CON, DEC, SP);
    SEAM(3);
    for (int rep_ = 0; rep_ < 1 + ((MK_DUP >> 4) & 1); ++rep_) if (IN(4)) phase_gla_c(F, PROJ, SP, (const bf16*)a.out, a.in[8], Yb);
    SEAM(4);
    if (IN(5)) {
        pg8::Gemm g{Yb, (const bf16*)(ws + WS_WO), M, D, D}; pg8::StaticOrder S; S.init(M, D, F.G, (int)blockIdx.x);
        pg8::EpiResB E{x, HB, SS2, D};
        pg8::gemm_phase<pg8::EpiResB, pg8::StaticOrder, false, true>(F.lds, g, S, E);
    }
    SEAM(5);
    for (int rep_ = 0; rep_ < 1 + ((MK_DUP >> 6) & 1); ++rep_) if (IN(6)) {
        pg8::Gemm g{HB, (const bf16*)(ws + WS_W1), M, FF, D}; pg8::StaticOrder S; S.init(M, FF, F.G, (int)blockIdx.x);
        pg8::EpiFF1 E{ACT, FF, SS2, 1.0f / D, EPS};
        pg8::gemm_phase<pg8::EpiFF1, pg8::StaticOrder, true, true>(F.lds, g, S, E);
    }
    SEAM(6);
    if (IN(7)) {
        pg8::Gemm g{ACT, (const bf16*)(ws + WS_W2), M, D, FF}; pg8::StaticOrder S; S.init(M, D, F.G, (int)blockIdx.x);
        const int fuse = (F.G == 256 && hi - lo > 1) ? 1 : 0;
        pg8::EpiResNormB E{HB, a.out, SS3, (unsigned*)(ws + WS_PCNT), a.in[13], D, fuse, 8u * (D / 256), 1.0f / D, EPS};
        pg8::gemm_phase<pg8::EpiResNormB, pg8::StaticOrder, false, true>(F.lds, g, S, E);
    }
    if (!(F.G == 256 && hi - lo > 1)) {
        SEAM(7);
        if (IN(8)) phase_final(F, a.out, SS3, a.in[13]);
    }
#undef IN
#undef SEAM
}

#ifndef MK_ONE_LAUNCH
#define MK_ONE_LAUNCH 1
#endif
extern "C" void kernel_launch(void* const* d_in, const int* in_sizes, int n_in, void* d_out, int out_size, void* d_ws, size_t ws_size, hipStream_t stream) {
    static int grid = 0;
    if (grid == 0) {
        if (n_in != 14 || out_size != M * D || ws_size < WS_END) { fprintf(stderr, "kernel_launch: unexpected shapes (n_in %d out %d ws %zu)\n", n_in, out_size, ws_size); grid = -1; return; }
        int dev = 0, cus = 0, per_cu = 0;
        hipGetDevice(&dev); hipDeviceGetAttribute(&cus, hipDeviceAttributeMultiprocessorCount, dev);
        if (hipFuncSetAttribute((const void*)mk_fwd, hipFuncAttributeMaxDynamicSharedMemorySize, LDS_BYTES) != hipSuccess) { fprintf(stderr, "kernel_launch: hipFuncSetAttribute failed\n"); grid = -1; return; }
        if (hipOccupancyMaxActiveBlocksPerMultiprocessor(&per_cu, (const void*)mk_fwd, NTHR, LDS_BYTES) != hipSuccess || per_cu < 1) { fprintf(stderr, "kernel_launch: occupancy query says %d\n", per_cu); per_cu = 1; }
        (void)hipGetLastError();
        grid = cus * 1;
    }
    if (grid < 0) return;
    Args a{};
    for (int i = 0; i < 14; ++i) a.in[i] = (const float*)d_in[i];
    a.out = (float*)d_out; a.ws = (unsigned char*)d_ws;
#if MK_ONE_LAUNCH
    if (hipMemsetAsync((char*)d_ws + WS_BAR, 0, WS_ZERO_BYTES, stream) != hipSuccess) { fprintf(stderr, "kernel_launch: memset of the barrier words failed\n"); return; }
    a.lo = 0; a.hi = NPHASE;
    void* args[] = {&a};
    hipError_t e = hipLaunchCooperativeKernel((const void*)mk_fwd, dim3(grid), dim3(NTHR), args, LDS_BYTES, stream);
    if (e != hipSuccess) fprintf(stderr, "cooperative launch failed: %s (grid %d)\n", hipGetErrorString(e), grid);
#else
    for (int p = 0; p < NPHASE; ++p) { a.lo = p; a.hi = p + 1; hipLaunchKernelGGL(mk_fwd, dim3(grid), dim3(NTHR), LDS_BYTES, stream, a); }
#endif
}
```

```cpp
#include <hip/hip_runtime.h>
#include <hip/hip_cooperative_groups.h>
#include <cstdio>
#include <cstdint>
#include <cmath>
namespace cg = cooperative_groups;
namespace pg8 {
#define PG8_LAS __attribute__((address_space(3)))
typedef unsigned short bf16_t;
typedef short bf16x8 __attribute__((ext_vector_type(8)));
typedef float f32x4 __attribute__((ext_vector_type(4)));
typedef unsigned u32x4 __attribute__((ext_vector_type(4)));
constexpr int BM = 256, BK = 64, HALF = 128, HTB = HALF * BK * 2  , STAGE_BYTES = 8 * HTB, NXCD = 8, WGM = 8;

__host__ __device__ __forceinline__ int lds_byte(int r, int c) { const int st = (r >> 4) * 2 + (c >> 5), rr = r & 15, cc = c & 31, ob = rr * 64 + cc * 2; return st * 1024 + (ob ^ (((ob >> 9) & 1) << 5)); }
__host__ __device__ __forceinline__ void stage_rc(int b, int& R, int& C) { const int st = b / 1024, sb = b % 1024, swz = sb ^ (((sb >> 9) & 1) << 5); R = (st >> 1) * 16 + swz / 64; C = (st & 1) * 32 + (swz % 64) / 2; }
__host__ __device__ __forceinline__ int perm32(int rho) { const int n = rho >> 4, i = rho & 15; return 8 * (i >> 2) + 4 * n + (i & 3); }

struct Unit { int pm, pn; };
struct Gemm { const bf16_t* A; const bf16_t* Bt; int M, N, K; };

struct StaticOrder {
    int nM, nN, nwg, G, c;
    __host__ __device__ void init(int M, int N, int G_, int c_) { nM = M / BM; nN = N / BM; nwg = nM * nN; G = G_; c = c_; }
    __host__ __device__ bool next(int i, Unit& u) const {
        const long L = (long)i * G + c; if (L >= nwg) return false;
        int wgid = (int)L; { const int q = nwg / NXCD, r = nwg % NXCD, xcd = wgid % NXCD, off = wgid / NXCD; wgid = (xcd < r ? xcd * (q + 1) : r * (q + 1) + (xcd - r) * q) + off; }
        const int nig = WGM * nN, gid = wgid / nig, fm = gid * WGM, gsz = (nM - fm) < WGM ? (nM - fm) : WGM;
        u.pm = fm + ((wgid % nig) % gsz); u.pn = (wgid % nig) / gsz; return true;
    }
    __device__ __forceinline__ void a_ready(const Unit&) const {}
    __device__ __forceinline__ void done(const Unit&) const {}
};

__device__ __forceinline__ unsigned cvt_pk_bf16(float lo, float hi) { unsigned r; asm volatile("v_cvt_pk_bf16_f32 %0, %1, %2" : "=v"(r) : "v"(lo), "v"(hi)); return r; }
typedef unsigned u32x2 __attribute__((ext_vector_type(2)));
struct EpiProj {
    static constexpr bool PERM = true, AFTER_DRAIN = false;
    bf16_t* O; int ldc;
    __device__ __forceinline__ void operator()(const f32x4 (&acc)[2][2][4][2], const Unit& u, int wr, int wc, int fr, int fq) const {
        const int row0 = u.pm * BM + wr * 64 + fr, col0 = u.pn * BM + wc * 32 + 8 * fq;
#pragma unroll
        for (int ai = 0; ai < 2; ++ai)
#pragma unroll
            for (int m = 0; m < 4; ++m) { bf16_t* rowp = O + (size_t)(row0 + ai * HALF + m * 16) * ldc + col0;
#pragma unroll
                for (int bj = 0; bj < 2; ++bj) { const f32x4 v0 = acc[ai][bj][m][0], v1 = acc[ai][bj][m][1];
                    u32x4 w; w.x = cvt_pk_bf16(v0[0], v0[1]); w.y = cvt_pk_bf16(v0[2], v0[3]); w.z = cvt_pk_bf16(v1[0], v1[1]); w.w = cvt_pk_bf16(v1[2], v1[3]);
                    *(u32x4*)(rowp + bj * HALF) = w; } }
    }
};
struct EpiFF1 {
    static constexpr bool PERM = true, AFTER_DRAIN = false;
    bf16_t* O; int ldc; const float* sumsq; float inv_n, eps;
    __device__ __forceinline__ void operator()(const f32x4 (&acc)[2][2][4][2], const Unit& u, int wr, int wc, int fr, int fq) const {
        const int row0 = u.pm * BM + wr * 64 + fr, col0 = u.pn * BM + wc * 32 + 8 * fq;
#pragma unroll
        for (int ai = 0; ai < 2; ++ai)
#pragma unroll
            for (int m = 0; m < 4; ++m) { const int row = row0 + ai * HALF + m * 16; bf16_t* rowp = O + (size_t)row * ldc + col0;
                const float rs = 1.0f / sqrtf(sumsq[row] * inv_n + eps);
#pragma unroll
                for (int bj = 0; bj < 2; ++bj) { f32x4 v0 = acc[ai][bj][m][0] * rs, v1 = acc[ai][bj][m][1] * rs;
#pragma unroll
                    for (int e = 0; e < 4; ++e) { const float a = fmaxf(v0[e], 0.f), b = fmaxf(v1[e], 0.f); v0[e] = a * a; v1[e] = b * b; }
                    u32x4 w; w.x = cvt_pk_bf16(v0[0], v0[1]); w.y = cvt_pk_bf16(v0[2], v0[3]); w.z = cvt_pk_bf16(v1[0], v1[1]); w.w = cvt_pk_bf16(v1[2], v1[3]);
                    *(u32x4*)(rowp + bj * HALF) = w; } }
    }
};
struct EpiRes {
    static constexpr bool PERM = false, AFTER_DRAIN = false;
    const float* base; float* out; bf16_t* hb; float* sumsq; int ldc;
    __device__ __forceinline__ void operator()(const f32x4 (&acc)[2][2][4][2], const Unit& u, int wr, int wc, int fr, int fq) const {
        const int col0 = u.pn * BM + wc * 32 + 4 * fq;
#pragma unroll
        for (int ai = 0; ai < 2; ++ai)
#pragma unroll
            for (int m = 0; m < 4; ++m) { const int row = u.pm * BM + ai * HALF + wr * 64 + m * 16 + fr; const size_t off = (size_t)row * ldc + col0; float s = 0.f;
#pragma unroll
                for (int bj = 0; bj < 2; ++bj)
#pragma unroll
                    for (int n = 0; n < 2; ++n) { const f32x4 bs = *(const f32x4*)(base + off + bj * HALF + n * 16); const f32x4 o = bs + acc[ai][bj][m][n];
                        *(f32x4*)(out + off + bj * HALF + n * 16) = o;
                        if (hb) { u32x2 w; w.x = cvt_pk_bf16(o[0], o[1]); w.y = cvt_pk_bf16(o[2], o[3]); *(u32x2*)(hb + off + bj * HALF + n * 16) = w; }
                        s += (o[0] * o[0] + o[1] * o[1]) + (o[2] * o[2] + o[3] * o[3]); }
                s += __shfl_xor(s, 16); s += __shfl_xor(s, 32);
                if (fq == 0) unsafeAtomicAdd(sumsq + row, s);
                asm volatile("" ::: "memory"); }
    }
};

struct EpiResNorm {
    static constexpr bool PERM = false, AFTER_DRAIN = true;
    const float* base; float* out; float* sumsq; unsigned* cnt; const float* g; int ldc; int fuse; unsigned want; float inv_n, eps;
    __device__ __forceinline__ void fused(f32x4 (&acc)[2][2][4][2], const Unit& u, int wr, int wc, int fr, int fq, PG8_LAS unsigned char* lds, int wid, int lane) const {
        const int col0 = u.pn * BM + wc * 32 + 4 * fq;
#pragma unroll
        for (int ai = 0; ai < 2; ++ai)
#pragma unroll
            for (int m = 0; m < 4; ++m) { const int row = u.pm * BM + ai * HALF + wr * 64 + m * 16 + fr; const size_t off = (size_t)row * ldc + col0; float s = 0.f;
#pragma unroll
                for (int bj = 0; bj < 2; ++bj)
#pragma unroll
                    for (int n = 0; n < 2; ++n) { const f32x4 bs = *(const f32x4*)(base + off + bj * HALF + n * 16); const f32x4 o = bs + acc[ai][bj][m][n]; acc[ai][bj][m][n] = o;
                        if (!fuse) *(f32x4*)(out + off + bj * HALF + n * 16) = o;
                        s += (o[0] * o[0] + o[1] * o[1]) + (o[2] * o[2] + o[3] * o[3]); }
                s += __shfl_xor(s, 16); s += __shfl_xor(s, 32);
                if (fq == 0) unsafeAtomicAdd(sumsq + row, s);
                asm volatile("" ::: "memory"); }
        if (!fuse) return;
        asm volatile("s_waitcnt vmcnt(0)" ::: "memory");
        if (lane == 0) __hip_atomic_fetch_add(cnt + 64 * u.pm, 1u, __ATOMIC_RELAXED, __HIP_MEMORY_SCOPE_AGENT);
        if (wid == 0) { while ((unsigned)__builtin_amdgcn_readfirstlane(__hip_atomic_load(cnt + 64 * u.pm, __ATOMIC_RELAXED, __HIP_MEMORY_SCOPE_AGENT)) < want) __builtin_amdgcn_s_sleep(2); }
        asm volatile("s_waitcnt vmcnt(0) lgkmcnt(0)" ::: "memory"); __builtin_amdgcn_s_barrier(); asm volatile("" ::: "memory");
        __builtin_amdgcn_fence(__ATOMIC_ACQUIRE, "agent");
        f32x4 gv[2][2];
#pragma unroll
        for (int bj = 0; bj < 2; ++bj)
#pragma unroll
            for (int n = 0; n < 2; ++n) gv[bj][n] = *(const f32x4*)(g + col0 + bj * HALF + n * 16);
#pragma unroll
        for (int ai = 0; ai < 2; ++ai)
#pragma unroll
            for (int m = 0; m < 4; ++m) { const int row = u.pm * BM + ai * HALF + wr * 64 + m * 16 + fr; const size_t off = (size_t)row * ldc + col0;
                const float ssv = __hip_atomic_load(sumsq + row, __ATOMIC_RELAXED, __HIP_MEMORY_SCOPE_AGENT); const float rs = 1.0f / sqrtf(ssv * inv_n + eps);
#pragma unroll
                for (int bj = 0; bj < 2; ++bj)
#pragma unroll
                    for (int n = 0; n < 2; ++n) *(f32x4*)(out + off + bj * HALF + n * 16) = acc[ai][bj][m][n] * rs * gv[bj][n]; }
    }
};

struct EpiResB {
    static constexpr bool PERM = true, AFTER_DRAIN = false;
    const float* base; bf16_t* hb; float* sumsq; int ldc;
    __device__ __forceinline__ void operator()(const f32x4 (&acc)[2][2][4][2], const Unit& u, int wr, int wc, int fr, int fq) const {
        const int col0 = u.pn * BM + wc * 32 + 8 * fq;
#pragma unroll
        for (int ai = 0; ai < 2; ++ai)
#pragma unroll
            for (int m = 0; m < 4; ++m) { const int row = u.pm * BM + ai * HALF + wr * 64 + m * 16 + fr; const size_t off = (size_t)row * ldc + col0; float s = 0.f;
#pragma unroll
                for (int bj = 0; bj < 2; ++bj) { const f32x4 b0 = *(const f32x4*)(base + off + bj * HALF), b1 = *(const f32x4*)(base + off + bj * HALF + 4);
                    const f32x4 o0 = b0 + acc[ai][bj][m][0], o1 = b1 + acc[ai][bj][m][1];
                    u32x4 w; w.x = cvt_pk_bf16(o0[0], o0[1]); w.y = cvt_pk_bf16(o0[2], o0[3]); w.z = cvt_pk_bf16(o1[0], o1[1]); w.w = cvt_pk_bf16(o1[2], o1[3]);
                    *(u32x4*)(hb + off + bj * HALF) = w;
                    s += (o0[0] * o0[0] + o0[1] * o0[1]) + (o0[2] * o0[2] + o0[3] * o0[3]) + (o1[0] * o1[0] + o1[1] * o1[1]) + (o1[2] * o1[2] + o1[3] * o1[3]); }
                s += __shfl_xor(s, 16); s += __shfl_xor(s, 32);
                if (fq == 0) unsafeAtomicAdd(sumsq + row, s);
                asm volatile("" ::: "memory"); }
    }
};
struct EpiResNormB {
    static constexpr bool PERM = true, AFTER_DRAIN = true;
    const bf16_t* hb; float* out; float* sumsq; unsigned* cnt; const float* g; int ldc; int fuse; unsigned want; float inv_n, eps;
    __device__ __forceinline__ void fused(f32x4 (&acc)[2][2][4][2], const Unit& u, int wr, int wc, int fr, int fq, PG8_LAS unsigned char* lds, int wid, int lane) const {
        const int col0 = u.pn * BM + wc * 32 + 8 * fq;
#pragma unroll
        for (int ai = 0; ai < 2; ++ai)
#pragma unroll
            for (int m = 0; m < 4; ++m) { const int row = u.pm * BM + ai * HALF + wr * 64 + m * 16 + fr; const size_t off = (size_t)row * ldc + col0; float s = 0.f;
#pragma unroll
                for (int bj = 0; bj < 2; ++bj) { const u32x4 w = *(const u32x4*)(hb + off + bj * HALF);
                    const f32x4 b0 = {__builtin_bit_cast(float, w.x << 16), __builtin_bit_cast(float, w.x & 0xffff0000u), __builtin_bit_cast(float, w.y << 16), __builtin_bit_cast(float, w.y & 0xffff0000u)};
                    const f32x4 b1 = {__builtin_bit_cast(float, w.z << 16), __builtin_bit_cast(float, w.z & 0xffff0000u), __builtin_bit_cast(float, w.w << 16), __builtin_bit_cast(float, w.w & 0xffff0000u)};
                    const f32x4 o0 = b0 + acc[ai][bj][m][0], o1 = b1 + acc[ai][bj][m][1]; acc[ai][bj][m][0] = o0; acc[ai][bj][m][1] = o1;
                    if (!fuse) { *(f32x4*)(out + off + bj * HALF) = o0; *(f32x4*)(out + off + bj * HALF + 4) = o1; }
                    s += (o0[0] * o0[0] + o0[1] * o0[1]) + (o0[2] * o0[2] + o0[3] * o0[3]) + (o1[0] * o1[0] + o1[1] * o1[1]) + (o1[2] * o1[2] + o1[3] * o1[3]); }
                s += __shfl_xor(s, 16); s += __shfl_xor(s, 32);
                if (fq == 0) unsafeAtomicAdd(sumsq + row, s);
                asm volatile("" ::: "memory"); }
        if (!fuse) return;
        asm volatile("s_waitcnt vmcnt(0)" ::: "memory");
        if (lane == 0) __hip_atomic_fetch_add(cnt + 64 * u.pm, 1u, __ATOMIC_RELAXED, __HIP_MEMORY_SCOPE_AGENT);
        if (wid == 0) { while ((unsigned)__builtin_amdgcn_readfirstlane(__hip_atomic_load(cnt + 64 * u.pm, __ATOMIC_RELAXED, __HIP_MEMORY_SCOPE_AGENT)) < want) __builtin_amdgcn_s_sleep(2); }
        asm volatile("s_waitcnt vmcnt(0) lgkmcnt(0)" ::: "memory"); __builtin_amdgcn_s_barrier(); asm volatile("" ::: "memory");
        __builtin_amdgcn_fence(__ATOMIC_ACQUIRE, "agent");
        f32x4 gv[2][2];
#pragma unroll
        for (int bj = 0; bj < 2; ++bj)
#pragma unroll
            for (int n = 0; n < 2; ++n) gv[bj][n] = *(const f32x4*)(g + col0 + bj * HALF + n * 4);
#pragma unroll
        for (int ai = 0; ai < 2; ++ai)
#pragma unroll
            for (int m = 0; m < 4; ++m) { const int row = u.pm * BM + ai * HALF + wr * 64 + m * 16 + fr; const size_t off = (size_t)row * ldc + col0;
                const float ssv = __hip_atomic_load(sumsq + row, __ATOMIC_RELAXED, __HIP_MEMORY_SCOPE_AGENT); const float rs = 1.0f / sqrtf(ssv * inv_n + eps);
#pragma unroll
                for (int bj = 0; bj < 2; ++bj)
#pragma unroll
                    for (int n = 0; n < 2; ++n) *(f32x4*)(out + off + bj * HALF + n * 4) = acc[ai][bj][m][n] * rs * gv[bj][n]; }
    }
};
template <class Epi, class Sched, bool ALIGN_EPI = false, bool SP2 = false>
__device__ __forceinline__ void gemm_phase(PG8_LAS unsigned char* lds, const Gemm g, const Sched& S, const Epi& E) {
    const int tid = threadIdx.x, wid = __builtin_amdgcn_readfirstlane(tid >> 6), lane = tid & 63, wr = wid >> 2, wc = wid & 3, fr = lane & 15, fq = lane >> 4;
    const int K = g.K, nt = K / BK;
    unsigned voffA[2], voffB[2];
#pragma unroll
    for (int i = 0; i < 2; ++i) { int R, C; stage_rc(tid * 16 + i * 8192, R, C); const int Rb = Epi::PERM ? ((R & ~31) + perm32(R & 31)) : R;
        voffA[i] = (unsigned)(R * K + C) * 2u; voffB[i] = (unsigned)(Rb * K + C) * 2u; }
    const size_t kstep = (size_t)(BK * 2);
    const size_t hstep = (size_t)HALF * K * 2;
    const size_t tstep = 2 * hstep;
    const unsigned ldsw = (unsigned)wid * 1024u;
    const int aoff = lds_byte(wr * 64 + fr, fq * 8), boff = lds_byte(wc * 32 + fr, fq * 8);
#define PG8_SA(b, h) (((b) * 2 + (h)) * HTB)
#define PG8_SB(b, h) ((4 + (b) * 2 + (h)) * HTB)
#define PG8_STAGE(bufoff, gbase, voff) do { _Pragma("unroll") for (int _i = 0; _i < 2; ++_i) \
        __builtin_amdgcn_global_load_lds((const unsigned*)((const char*)(gbase) + (voff)[_i]), (PG8_LAS unsigned*)(lds + (bufoff) + ldsw + _i * 8192), 16, 0, 0); } while (0)
#define PG8_LDA(dst, b, h) do { _Pragma("unroll") for (int m = 0; m < 4; ++m) _Pragma("unroll") for (int k = 0; k < 2; ++k) dst[m][k] = *(const PG8_LAS bf16x8*)(lds + PG8_SA(b, h) + aoff + m * 2048 + k * 1024); } while (0)
#define PG8_LDB(dst, b, h) do { _Pragma("unroll") for (int n = 0; n < 2; ++n) _Pragma("unroll") for (int k = 0; k < 2; ++k) dst[n][k] = *(const PG8_LAS bf16x8*)(lds + PG8_SB(b, h) + boff + n * 2048 + k * 1024); } while (0)
#define PG8_MMA(ai, bj, At, Bt) do { __builtin_amdgcn_s_setprio(1); _Pragma("unroll") for (int m = 0; m < 4; ++m) _Pragma("unroll") for (int n = 0; n < 2; ++n) _Pragma("unroll") for (int k = 0; k < 2; ++k) \
        acc[ai][bj][m][n] = __builtin_amdgcn_mfma_f32_16x16x32_bf16(Bt[n][k], At[m][k], acc[ai][bj][m][n], 0, 0, 0); __builtin_amdgcn_s_setprio(0); } while (0)
#define PG8_WAIT_V(n) asm volatile("s_waitcnt vmcnt(" #n ")" ::: "memory")
#define PG8_WAIT_L(n) asm volatile("s_waitcnt lgkmcnt(" #n ")" ::: "memory")
#define PG8_BAR __builtin_amdgcn_s_barrier()
#define PG8_SCHED __builtin_amdgcn_sched_barrier(0)
    Unit cur, nxt; int ui = 0;
    if (!S.next(0, cur)) return;
    f32x4 acc[2][2][4][2];
#pragma unroll
    for (int a = 0; a < 2; ++a)
#pragma unroll
        for (int b = 0; b < 2; ++b)
#pragma unroll
            for (int m = 0; m < 4; ++m)
#pragma unroll
                for (int n = 0; n < 2; ++n) acc[a][b][m][n] = (f32x4){0.f, 0.f, 0.f, 0.f};
    bf16x8 At[4][2], B0[2][2], B1[2][2];
    const char* cA = (const char*)g.A + (size_t)cur.pm * tstep; const char* cB = (const char*)g.Bt + (size_t)cur.pn * tstep;
    S.a_ready(cur);
    if constexpr (SP2) {
        PG8_STAGE(PG8_SB(0, 0), cB, voffB); PG8_STAGE(PG8_SB(0, 1), cB + hstep, voffB); PG8_STAGE(PG8_SA(0, 0), cA, voffA); PG8_STAGE(PG8_SA(0, 1), cA + hstep, voffA);
        if (wr == 1) PG8_BAR;
        PG8_WAIT_V(2); PG8_BAR;
        PG8_STAGE(PG8_SB(1, 0), cB + kstep, voffB); PG8_STAGE(PG8_SA(1, 0), cA + kstep, voffA); PG8_STAGE(PG8_SB(1, 1), cB + hstep + kstep, voffB);
        PG8_WAIT_V(6); PG8_BAR;
    } else {
        PG8_STAGE(PG8_SB(0, 0), cB, voffB); PG8_STAGE(PG8_SA(0, 0), cA, voffA); PG8_STAGE(PG8_SB(0, 1), cB + hstep, voffB); PG8_STAGE(PG8_SA(0, 1), cA + hstep, voffA);
        if (wr == 1) PG8_BAR;
        PG8_WAIT_V(4); PG8_BAR;
        PG8_STAGE(PG8_SB(1, 0), cB + kstep, voffB); PG8_STAGE(PG8_SA(1, 0), cA + kstep, voffA); PG8_STAGE(PG8_SB(1, 1), cB + hstep + kstep, voffB);
        PG8_WAIT_V(6); PG8_BAR;
    }
    for (;;) {
        const bool has_next = S.next(ui + 1, nxt);
        const char* nA = has_next ? (const char*)g.A + (size_t)nxt.pm * tstep : cA; const char* nB = has_next ? (const char*)g.Bt + (size_t)nxt.pn * tstep : cB;
        for (int t = 0; t < nt; t += 2) {
            const bool last = (t == nt - 2);
            const char* a1 = cA + (size_t)(t + 1) * kstep;
            const char* a2 = last ? nA : cA + (size_t)(t + 2) * kstep; const char* b2 = last ? nB : cB + (size_t)(t + 2) * kstep;
            const char* a3 = a2 + kstep; const char* b3 = b2 + kstep;
            if (last && has_next) S.a_ready(nxt);
            if constexpr (SP2) {
            PG8_LDB(B0, 0, 0); PG8_LDB(B1, 0, 1); PG8_SCHED; PG8_LDA(At, 0, 0); PG8_STAGE(PG8_SA(1, 1), a1 + hstep, voffA);
            PG8_WAIT_V(8); PG8_WAIT_L(0); PG8_BAR; PG8_MMA(0, 0, At, B0); PG8_MMA(0, 1, At, B1); PG8_BAR; PG8_SCHED;
            PG8_LDA(At, 0, 1); PG8_STAGE(PG8_SB(0, 0), b2, voffB); PG8_STAGE(PG8_SB(0, 1), b2 + hstep, voffB); PG8_STAGE(PG8_SA(0, 0), a2, voffA);
            PG8_WAIT_V(8); PG8_WAIT_L(0); PG8_BAR; PG8_MMA(1, 0, At, B0); PG8_MMA(1, 1, At, B1); PG8_BAR; PG8_SCHED;
            PG8_LDB(B0, 1, 0); PG8_LDB(B1, 1, 1); PG8_SCHED; PG8_LDA(At, 1, 0); PG8_STAGE(PG8_SA(0, 1), a2 + hstep, voffA);
            PG8_WAIT_V(8); PG8_WAIT_L(0); PG8_BAR; PG8_MMA(0, 0, At, B0); PG8_MMA(0, 1, At, B1); PG8_BAR; PG8_SCHED;
            PG8_LDA(At, 1, 1); PG8_STAGE(PG8_SB(1, 0), b3, voffB); PG8_STAGE(PG8_SB(1, 1), b3 + hstep, voffB); PG8_STAGE(PG8_SA(1, 0), a3, voffA);
            PG8_WAIT_V(8); PG8_WAIT_L(0); PG8_BAR; PG8_MMA(1, 0, At, B0); PG8_MMA(1, 1, At, B1); PG8_BAR; PG8_SCHED;
            } else {
            PG8_LDB(B0, 0, 0); PG8_SCHED; PG8_LDA(At, 0, 0); PG8_STAGE(PG8_SA(1, 1), a1 + hstep, voffA);
            PG8_WAIT_L(8); PG8_BAR; PG8_WAIT_L(0); PG8_MMA(0, 0, At, B0); PG8_BAR; PG8_SCHED;
            PG8_LDB(B1, 0, 1); PG8_STAGE(PG8_SB(0, 0), b2, voffB);
            PG8_BAR; PG8_WAIT_L(0); PG8_MMA(0, 1, At, B1); PG8_BAR;
            PG8_LDA(At, 0, 1); PG8_STAGE(PG8_SA(0, 0), a2, voffA);
            PG8_BAR; PG8_WAIT_L(0); PG8_MMA(1, 0, At, B0); PG8_BAR; PG8_SCHED;
            PG8_STAGE(PG8_SB(0, 1), b2 + hstep, voffB);
            PG8_WAIT_V(6); PG8_BAR; PG8_MMA(1, 1, At, B1); PG8_BAR;
            PG8_LDB(B0, 1, 0); PG8_SCHED; PG8_LDA(At, 1, 0); PG8_STAGE(PG8_SA(0, 1), a2 + hstep, voffA);
            PG8_WAIT_L(8); PG8_BAR; PG8_WAIT_L(0); PG8_MMA(0, 0, At, B0); PG8_BAR; PG8_SCHED;
            PG8_LDB(B1, 1, 1); PG8_STAGE(PG8_SB(1, 0), b3, voffB);
            PG8_BAR; PG8_WAIT_L(0); PG8_MMA(0, 1, At, B1); PG8_BAR;
            PG8_LDA(At, 1, 1); PG8_STAGE(PG8_SA(1, 0), a3, voffA);
            PG8_BAR; PG8_WAIT_L(0); PG8_MMA(1, 0, At, B0); PG8_BAR; PG8_SCHED;
            PG8_STAGE(PG8_SB(1, 1), b3 + hstep, voffB);
            PG8_WAIT_V(6); PG8_BAR; PG8_MMA(1, 1, At, B1); PG8_BAR;
            }
        }
        if constexpr (ALIGN_EPI) { if (wr == 0) PG8_BAR; }
        if constexpr (!Epi::AFTER_DRAIN) { E(acc, cur, wr, wc, fr, fq); S.done(cur); }
        if (!has_next) break;
#pragma unroll
        for (int a = 0; a < 2; ++a)
#pragma unroll
            for (int b = 0; b < 2; ++b)
#pragma unroll
                for (int m = 0; m < 4; ++m)
#pragma unroll
                    for (int n = 0; n < 2; ++n) acc[a][b][m][n] = (f32x4){0.f, 0.f, 0.f, 0.f};
        cur = nxt; cA = nA; cB = nB; ++ui;
        if constexpr (ALIGN_EPI) { if (wr == 1) PG8_BAR; }
    }
    PG8_WAIT_V(0);
    if constexpr (!ALIGN_EPI) { if (wr == 0) PG8_BAR; }
    PG8_BAR;
    if constexpr (Epi::AFTER_DRAIN) { E.fused(acc, cur, wr, wc, fr, fq, lds, wid, lane); S.done(cur); }
#undef PG8_SA
#undef PG8_SB
#undef PG8_STAGE
#undef PG8_LDA
#undef PG8_LDB
#undef PG8_MMA
#undef PG8_WAIT_V
#undef PG8_WAIT_L
#undef PG8_BAR
#undef PG8_SCHED
}
}
#define GAS __attribute__((address_space(1)))
#define LAS __attribute__((address_space(3)))
typedef unsigned short bf16;
typedef unsigned v4u __attribute__((ext_vector_type(4)));
typedef unsigned v2u __attribute__((ext_vector_type(2)));
typedef float f32x4 __attribute__((ext_vector_type(4)));
typedef short bf16x8 __attribute__((ext_vector_type(8)));
typedef short s16x4 __attribute__((ext_vector_type(4)));

constexpr int NWAVES = 8, NTHR = 512;
constexpr int T = 8192, D = 1024, M = 16384, NPROJ = 3072, DIN = 3104, FF = 4096;
constexpr float EPS = 1e-6f;
constexpr int C_QA = 0, C_KA = 512, C_VA = 1024, C_QG = 1536, C_KG = 1792, C_VG = 2048, C_RG = 2560;

constexpr size_t MiB = 1u << 20;
constexpr size_t WS_SS2 = 0, WS_SS3 = 65536, WS_BAR = 131072, WS_PCNT = 131072 + 16384, WS_ZERO_BYTES = 32768, WS_DEC = 262144, WS_Z = 1 * MiB;
constexpr size_t WS_WIN = 4 * MiB, WS_WO = 11 * MiB, WS_W1 = 13 * MiB, WS_W2 = 21 * MiB;
constexpr size_t WS_XN = 32 * MiB, WS_Y = 32 * MiB, WS_PROJ = 64 * MiB, WS_CON = 160 * MiB, WS_SP = 224 * MiB;
constexpr size_t WS_HB = 64 * MiB, WS_ACT = 96 * MiB, WS_END = 256 * MiB;
constexpr int LDS_BYTES = 163840;

__device__ __forceinline__ unsigned f2bf(float f) { unsigned u = __builtin_bit_cast(unsigned, f); return (u + 0x7fffu + ((u >> 16) & 1u)) >> 16; }
__device__ __forceinline__ unsigned pk2(float lo, float hi) { return f2bf(lo) | (f2bf(hi) << 16); }
__device__ __forceinline__ float bf2f(unsigned short h) { return __builtin_bit_cast(float, (unsigned)h << 16); }
__device__ __forceinline__ float wave_sum(float v) {
#pragma unroll
    for (int o = 1; o < 64; o <<= 1) v += __shfl_xor(v, o);
    return v;
}
__device__ __forceinline__ f32x4 mfma16(bf16x8 x, bf16x8 y, f32x4 c) { return __builtin_amdgcn_mfma_f32_16x16x32_bf16(x, y, c, 0, 0, 0); }
typedef short v4i16_t __attribute__((ext_vector_type(4)));
__device__ __forceinline__ s16x4 tr4(const LAS unsigned char* p) { return __builtin_bit_cast(s16x4, __builtin_amdgcn_ds_read_tr16_b64_v4i16((LAS v4i16_t*)p)); }
__device__ __forceinline__ bf16x8 cat8(s16x4 a, s16x4 b) { bf16x8 r; r[0] = a[0]; r[1] = a[1]; r[2] = a[2]; r[3] = a[3]; r[4] = b[0]; r[5] = b[1]; r[6] = b[2]; r[7] = b[3]; return r; }
__device__ __forceinline__ bf16x8 pack8(f32x4 a, f32x4 b) {
    v4u w; w.x = pg8::cvt_pk_bf16(a[0], a[1]); w.y = pg8::cvt_pk_bf16(a[2], a[3]); w.z = pg8::cvt_pk_bf16(b[0], b[1]); w.w = pg8::cvt_pk_bf16(b[2], b[3]);
    return __builtin_bit_cast(bf16x8, w);
}

struct Frame {
    LAS unsigned char* lds;
    int tid, lane, wave, vcu, G;
};

__device__ __forceinline__ void p0_transpose_item(const float* W, int K, int N, bf16* WT, const float* gk, LAS float* scr, int item, int lane) {
    const int nblk = N / 32, kb = item / nblk, nb = item % nblk, k0 = 64 * kb, n0 = 32 * nb;
#pragma unroll 8
    for (int i = 0; i < 32; ++i) { const int kk = 2 * i + (lane >> 5); float v = W[(size_t)(k0 + kk) * N + n0 + (lane & 31)]; if (gk) v *= gk[k0 + kk]; scr[kk * 33 + (lane & 31)] = v; }
    asm volatile("s_waitcnt lgkmcnt(0)" ::: "memory");
    const int c = lane & 7;
#pragma unroll
    for (int j = 0; j < 4; ++j) { const int n = (lane >> 3) + 8 * j; const LAS float* s = scr + (8 * c) * 33 + n;
        v4u o; o.x = pk2(s[0 * 33], s[1 * 33]); o.y = pk2(s[2 * 33], s[3 * 33]); o.z = pk2(s[4 * 33], s[5 * 33]); o.w = pk2(s[6 * 33], s[7 * 33]);
        *(v4u*)(WT + (size_t)(n0 + n) * K + k0 + 8 * c) = o; }
    asm volatile("s_waitcnt lgkmcnt(0)" ::: "memory");
}
__device__ __forceinline__ void phase_prologue(const Frame& F, const float* x, const float* g_mix, const float* w_in, const float* w_out, const float* g_ff, const float* w1, const float* w2, unsigned char* ws) {
    LAS float* scr = (LAS float*)(F.lds + F.wave * 16384);
    const int gw = F.vcu * NWAVES + F.wave, NGW = F.G * NWAVES;
    constexpr int I_IN = (D / 64) * (DIN / 32), I_O = (D / 64) * (D / 32), I_1 = (D / 64) * (FF / 32), I_2 = (FF / 64) * (D / 32);
    constexpr int NITEMS = I_IN + I_O + I_1 + I_2;
    for (int it = gw; it < NITEMS; it += NGW) {
        int r = it;
        if (r < I_IN) { p0_transpose_item(w_in, D, DIN, (bf16*)(ws + WS_WIN), nullptr, scr, r, F.lane); continue; } r -= I_IN;
        if (r < I_O) { p0_transpose_item(w_out, D, D, (bf16*)(ws + WS_WO), nullptr, scr, r, F.lane); continue; } r -= I_O;
        if (r < I_1) { p0_transpose_item(w1, D, FF, (bf16*)(ws + WS_W1), g_ff, scr, r, F.lane); continue; } r -= I_1;
        p0_transpose_item(w2, FF, D, (bf16*)(ws + WS_W2), nullptr, scr, r, F.lane);
    }
    { float* ss = (float*)(ws + WS_SS2); for (int i = (F.vcu * NTHR + F.tid); i < 2 * M; i += F.G * NTHR) ss[i] = 0.f; }
    bf16* XN = (bf16*)(ws + WS_XN);
    f32x4 gv[4];
#pragma unroll
    for (int j = 0; j < 4; ++j) gv[j] = ((const f32x4*)g_mix)[F.lane + 64 * j];
    for (int m = gw; m < M; m += NGW) {
        const f32x4* xr = (const f32x4*)(x + (size_t)m * D) + F.lane;
        f32x4 v[4]; float s = 0.f;
#pragma unroll
        for (int j = 0; j < 4; ++j) { v[j] = xr[64 * j]; s += (v[j].x * v[j].x + v[j].y * v[j].y) + (v[j].z * v[j].z + v[j].w * v[j].w); }
        const float rs = 1.0f / sqrtf(wave_sum(s) * (1.f / D) + EPS);
        unsigned long long* o8 = (unsigned long long*)(XN + (size_t)m * D) + F.lane;
#pragma unroll
        for (int j = 0; j < 4; ++j) { const f32x4 o = v[j] * rs * gv[j]; o8[64 * j] = (unsigned long long)pk2(o.x, o.y) | ((unsigned long long)pk2(o.z, o.w) << 32); }
    }
}

__device__ __forceinline__ void phase_z(const Frame& F, const bf16* XN, const bf16* Wz, float* Z) {
    const int fr = F.lane & 15, fq = F.lane >> 4, mt = F.wave & 3, nt = F.wave >> 2;
    for (int rb = F.vcu; rb < M / 64; rb += F.G) {
        const bf16* ap = XN + (size_t)(rb * 64 + mt * 16 + fr) * D + 8 * fq;
        const bf16* bp = Wz + (size_t)(nt * 16 + fr) * D + 8 * fq;
        f32x4 acc = {0.f, 0.f, 0.f, 0.f};
#pragma unroll 8
        for (int ks = 0; ks < D / 32; ++ks) { const bf16x8 a = *(const bf16x8*)(ap + ks * 32), b = *(const bf16x8*)(bp + ks * 32); acc = mfma16(b, a, acc); }
        *(f32x4*)(Z + (size_t)(rb * 64 + mt * 16 + fr) * 32 + nt * 16 + 4 * fq) = acc;
    }
}

constexpr int NA_STR = 144, NA_VSTR = 136, NA_K_OFF = 0, NA_V_OFF = 512 * NA_STR, NA_RPB_OFF = NA_V_OFF + 512 * NA_VSTR, NA_X_OFF = NA_RPB_OFF + 1872, NA_X_PAIR = 18 * 256;
static_assert(NA_X_OFF + 4 * NA_X_PAIR <= LDS_BYTES - 64, "natten LDS map");
__device__ __forceinline__ void natten_compute(const Frame& F, const bf16x8 (&qf)[2], bf16* Y, int b, int h, int r, int rs) {
    LAS unsigned char* lds = F.lds;
    const size_t tokq0 = (size_t)b * T + r * 64;
    const int fr = F.lane & 15, fq = F.lane >> 4, jq = F.wave & 3, kh = F.wave >> 2;
    const int wc0 = (jq == 0) ? 0 : (jq == 1) ? 8 : (jq == 2) ? 24 : 32;
    f32x4 s[8];
#pragma unroll
    for (int il = 0; il < 4; ++il)
#pragma unroll
        for (int ct = 0; ct < 2; ++ct) {
            const LAS unsigned char* kp = lds + NA_K_OFF + (((rs + 4 * kh + il) & 7) * 64 + wc0 + 16 * ct + fr) * NA_STR + fq * 16;
            const bf16x8 k0 = *(const LAS bf16x8*)kp, k1 = *(const LAS bf16x8*)(kp + 64);
            f32x4 a = {0.f, 0.f, 0.f, 0.f}; a = mfma16(k0, qf[0], a); a = mfma16(k1, qf[1], a); s[il * 2 + ct] = a; }
    const int cq = 16 * jq + fr, cs = min(max(cq - 8, 0), 48);
    const LAS float* rp = (const LAS float*)(lds + NA_RPB_OFF);
    float mx = -INFINITY;
#pragma unroll
    for (int il = 0; il < 4; ++il) { const int dr = rs + 4 * kh + il - r + 7;
#pragma unroll
        for (int ct = 0; ct < 2; ++ct)
#pragma unroll
            for (int e = 0; e < 4; ++e) { const int ck = wc0 + 16 * ct + 4 * fq + e; const bool in = (ck >= cs) && (ck < cs + 16);
                const int dc = min(max(ck - cq + 15, 0), 30);
                const float v = in ? s[il * 2 + ct][e] * 0.125f + rp[dr * 31 + dc] : -INFINITY; s[il * 2 + ct][e] = v; mx = fmaxf(mx, v); } }
    mx = fmaxf(mx, __shfl_xor(mx, 16)); mx = fmaxf(mx, __shfl_xor(mx, 32));
    float l = 0.f;
#pragma unroll
    for (int t = 0; t < 8; ++t)
#pragma unroll
        for (int e = 0; e < 4; ++e) { const float p = __expf(s[t][e] - mx); s[t][e] = p; l += p; }
    l += __shfl_xor(l, 16); l += __shfl_xor(l, 32);
    f32x4 o[4];
#pragma unroll
    for (int dt = 0; dt < 4; ++dt) o[dt] = (f32x4){0.f, 0.f, 0.f, 0.f};
#pragma unroll
    for (int il = 0; il < 4; ++il) { const bf16x8 pb = pack8(s[2 * il], s[2 * il + 1]);
#pragma unroll
        for (int dt = 0; dt < 4; ++dt) {
            const LAS unsigned char* vp = lds + NA_V_OFF + (((rs + 4 * kh + il) & 7) * 64 + wc0 + 4 * fq + (fr >> 2)) * NA_VSTR + (16 * dt + 4 * (fr & 3)) * 2;
            const bf16x8 x = cat8(tr4(vp), tr4(vp + 16 * NA_VSTR)); o[dt] = mfma16(x, pb, o[dt]); } }
    LAS float* xch = (LAS float*)(lds + NA_X_OFF + jq * NA_X_PAIR) + F.lane;
    if (kh == 1) {
#pragma unroll
        for (int dt = 0; dt < 4; ++dt)
#pragma unroll
            for (int e = 0; e < 4; ++e) xch[(dt * 4 + e) * 64] = o[dt][e];
        xch[16 * 64] = mx; xch[17 * 64] = l;
    }
    __syncthreads();
    if (kh == 0) {
        const float m1 = xch[16 * 64], l1 = xch[17 * 64], m = fmaxf(mx, m1), a0 = __expf(mx - m), a1 = __expf(m1 - m), inv = 1.0f / (a0 * l + a1 * l1), c0 = a0 * inv, c1 = a1 * inv;
#pragma unroll
        for (int dt = 0; dt < 4; ++dt) { float ov[4];
#pragma unroll
            for (int e = 0; e < 4; ++e) ov[e] = o[dt][e] * c0 + xch[(dt * 4 + e) * 64] * c1;
            v2u w; w.x = pg8::cvt_pk_bf16(ov[0], ov[1]); w.y = pg8::cvt_pk_bf16(ov[2], ov[3]);
            *(v2u*)(Y + (tokq0 + 16 * jq + fr) * D + h * 64 + 16 * dt + 4 * fq) = w; }
    }
}
__device__ __forceinline__ void natten_wg(const Frame& F, const bf16* PROJ, const float* rpb, bf16* Y, int wgi) {
    LAS unsigned char* lds = F.lds;
    const int bh = wgi >> 4, r0 = 8 * (wgi & 15), h = bh & 7, b = bh >> 3;
    const int fr = F.lane & 15, fq = F.lane >> 4, jq = F.wave & 3;
    const bf16* qbase = PROJ + ((size_t)b * T + 16 * jq + fr) * NPROJ + C_QA + h * 64 + 8 * fq;
    bf16x8 qf[2], qn[2];
    { const bf16* qp = qbase + (size_t)r0 * 64 * NPROJ; qf[0] = *(const bf16x8*)qp; qf[1] = *(const bf16x8*)(qp + 32); }
    { const int rs0 = min(max(r0 - 4, 0), 120);
#pragma unroll
      for (int it = 0; it < 8; ++it) { const int id = F.tid + NTHR * it, key = id >> 3, ch = id & 7, row = rs0 + (key >> 6), col = key & 63;
        const bf16* src = PROJ + ((size_t)b * T + row * 64 + col) * NPROJ + C_KA + h * 64 + ch * 8;
        const v4u kv = *(const v4u*)src, vv = *(const v4u*)(src + (C_VA - C_KA));
        const int kk = (row & 7) * 64 + col;
        *(LAS v4u*)(lds + NA_K_OFF + kk * NA_STR + ch * 16) = kv; *(LAS v2u*)(lds + NA_V_OFF + kk * NA_VSTR + ch * 16) = (v2u){vv.x, vv.y}; *(LAS v2u*)(lds + NA_V_OFF + kk * NA_VSTR + ch * 16 + 8) = (v2u){vv.z, vv.w}; } }
    if (F.tid < 465) ((LAS float*)(lds + NA_RPB_OFF))[F.tid] = rpb[h * 465 + F.tid];
    __syncthreads();
    for (int rr = 0; rr < 8; ++rr) {
        const int r = r0 + rr, rs = min(max(r - 4, 0), 120), rsn = min(max(r - 3, 0), 120);
        const bool more = rr < 7, slide = more && (rsn != rs);
        v4u nk = {0u, 0u, 0u, 0u}, nv = {0u, 0u, 0u, 0u};
        if (more) { const bf16* qp = qbase + (size_t)(r + 1) * 64 * NPROJ; qn[0] = *(const bf16x8*)qp; qn[1] = *(const bf16x8*)(qp + 32); }
        if (slide) { const int col = F.tid >> 3, ch = F.tid & 7; const bf16* src = PROJ + ((size_t)b * T + (rsn + 7) * 64 + col) * NPROJ + C_KA + h * 64 + ch * 8; nk = *(const v4u*)src; nv = *(const v4u*)(src + (C_VA - C_KA)); }
        natten_compute(F, qf, Y, b, h, r, rs);
        __syncthreads();
        if (slide) { const int col = F.tid >> 3, ch = F.tid & 7, kk = (((rsn + 7) & 7) * 64) + col; *(LAS v4u*)(lds + NA_K_OFF + kk * NA_STR + ch * 16) = nk;
            *(LAS v2u*)(lds + NA_V_OFF + kk * NA_VSTR + ch * 16) = (v2u){nv.x, nv.y}; *(LAS v2u*)(lds + NA_V_OFF + kk * NA_VSTR + ch * 16 + 8) = (v2u){nv.z, nv.w}; }
        if (more) { qf[0] = qn[0]; qf[1] = qn[1]; }
        __syncthreads();
    }
}

constexpr int GL_Z = 0, GL_GU = 8192, GL_GB = 16384, GL_GT = 16896, GL_I0 = 20992;
constexpr int IS = 144, IMG = 64 * IS;
constexpr int VS = 272, VIMG = 64 * VS;
constexpr int GL_QF = GL_I0, GL_QB = GL_I0 + IMG, GL_KF = GL_I0 + 2 * IMG, GL_KB = GL_I0 + 3 * IMG, GL_V = GL_I0 + 4 * IMG, GL_SF = GL_V + VIMG, GL_SB = GL_SF + VIMG;
static_assert(GL_SB + VIMG <= LDS_BYTES, "GLA LDS map");
__device__ __forceinline__ float logsig(float x) { return fminf(x, 0.f) - __logf(1.0f + __expf(-fabsf(x))); }

__device__ __forceinline__ void gla_gate(const Frame& F, const float* Z, const float* guf, const float* gbf, const float* gub, const float* gbb, int h, size_t t0,
                                         float (&bf)[8], float (&bb)[8], float& totf, float& totb) {
    LAS unsigned char* lds = F.lds; const int tid = F.tid, d = tid & 63, g = F.wave;
    *(LAS f32x4*)(lds + GL_Z + tid * 16) = *(const f32x4*)(Z + t0 * 32 + tid * 4);
    { const int idx = tid * 4, dir = idx >> 10, rr = (idx >> 6) & 15, dd = idx & 63; const float* src = (dir ? gub : guf) + rr * 256 + h * 64 + dd; *(LAS f32x4*)(lds + GL_GU + idx * 4) = *(const f32x4*)src; }
    if (tid < 128) { const int dir = tid >> 6, dd = tid & 63; ((LAS float*)(lds + GL_GB))[tid] = (dir ? gbb : gbf)[h * 64 + dd]; }
    __syncthreads();
    const LAS float* Zl = (const LAS float*)(lds + GL_Z); const LAS float* GU = (const LAS float*)(lds + GL_GU); const LAS float* GB = (const LAS float*)(lds + GL_GB);
    float uf[16], ub[16];
#pragma unroll
    for (int rr = 0; rr < 16; ++rr) { uf[rr] = GU[rr * 64 + d]; ub[rr] = GU[1024 + rr * 64 + d]; }
    const float gf0 = GB[d], gb0 = GB[64 + d];
    float laf[8], lab[8];
#pragma unroll
    for (int j = 0; j < 8; ++j) { const int c = 8 * g + j; float pf = gf0, pb = gb0;
#pragma unroll
        for (int r4 = 0; r4 < 4; ++r4) { const f32x4 zf = *(const LAS f32x4*)(Zl + c * 32 + 4 * r4), zb = *(const LAS f32x4*)(Zl + c * 32 + 16 + 4 * r4);
#pragma unroll
            for (int e = 0; e < 4; ++e) { pf += zf[e] * uf[4 * r4 + e]; pb += zb[e] * ub[4 * r4 + e]; } }
        laf[j] = logsig(pf) * (1.0f / 16.0f); lab[j] = logsig(pb) * (1.0f / 16.0f); }
    float run = 0.f;
#pragma unroll
    for (int j = 0; j < 8; ++j) { run += laf[j]; bf[j] = run; }
    float runb = 0.f;
#pragma unroll
    for (int j = 7; j >= 0; --j) { runb += lab[j]; bb[j] = runb; }
    LAS float* GT = (LAS float*)(lds + GL_GT);
    GT[g * 64 + d] = run; GT[512 + g * 64 + d] = runb;
    __syncthreads();
    float of = 0.f, ob = 0.f; totf = 0.f; totb = 0.f;
#pragma unroll
    for (int gp = 0; gp < 8; ++gp) { const float a = GT[gp * 64 + d], c = GT[512 + gp * 64 + d]; totf += a; totb += c; if (gp < g) of += a; if (gp > g) ob += c; }
#pragma unroll
    for (int j = 0; j < 8; ++j) { bf[j] += of; bb[j] += ob; }
}
__device__ __forceinline__ void stage_img128(LAS unsigned char* dst, const bf16* src, size_t row_stride, int tid) {
#pragma unroll
    for (int it = 0; it < 2; ++it) { const int id = tid + NTHR * it, row = id >> 4, ch = id & 15; *(LAS v4u*)(dst + row * VS + ch * 16) = *(const v4u*)(src + (size_t)row * row_stride + ch * 8); }
}

__device__ __forceinline__ void gla_a_unit(const Frame& F, const bf16* PROJ, const float* Z, const float* guf, const float* gbf, const float* gub, const float* gbb, float* CON, float* DEC, bf16* IMGS, int unit) {
    LAS unsigned char* lds = F.lds; const int tid = F.tid, d = tid & 63, g = F.wave;
    const int n = unit & 127, bh = unit >> 7, h = bh & 3, b = bh >> 2; const size_t t0 = (size_t)b * T + 64 * n;
    unsigned short kraw[8], qraw[8];
#pragma unroll
    for (int j = 0; j < 8; ++j) { const bf16* p = PROJ + (t0 + 8 * g + j) * NPROJ + h * 64 + d; qraw[j] = p[C_QG]; kraw[j] = p[C_KG]; }
    stage_img128(lds + GL_V, PROJ + t0 * NPROJ + C_VG + h * 128, NPROJ, tid);
    float bf[8], bb[8], totf, totb;
    gla_gate(F, Z, guf, gbf, gub, gbb, h, t0, bf, bb, totf, totb);
    const float decf = __expf(totf), decb = __expf(totb);
    bf16* im = IMGS + (size_t)unit * 16384 + d;
#pragma unroll
    for (int j = 0; j < 8; ++j) { const float k = bf2f(kraw[j]), q = bf2f(qraw[j]) * 0.125f; const int c = 8 * g + j;
        const float ef = __expf(bf[j]), eb = __expf(bb[j]), rf = 1.0f / ef, rb = 1.0f / eb, kif = k * rf, kib = k * rb;
        *(LAS unsigned short*)(lds + GL_KF + c * IS + d * 2) = (unsigned short)f2bf(kif * decf);
        *(LAS unsigned short*)(lds + GL_KB + c * IS + d * 2) = (unsigned short)f2bf(kib * decb);
        im[c * 64] = (bf16)f2bf(q * ef); im[4096 + c * 64] = (bf16)f2bf(kif); im[8192 + c * 64] = (bf16)f2bf(q * eb); im[12288 + c * 64] = (bf16)f2bf(kib); }
    if (g == 0) { DEC[(size_t)unit * 64 + d] = decf; DEC[(size_t)(1024 + unit) * 64 + d] = decb; }
    __syncthreads();
    const int fr = F.lane & 15, fq = F.lane >> 4, dir = F.wave >> 2, dt = F.wave & 3;
    const LAS unsigned char* kimg = lds + (dir ? GL_KB : GL_KF);
    bf16x8 yk[2];
#pragma unroll
    for (int s = 0; s < 2; ++s) { const LAS unsigned char* p = kimg + (32 * s + 4 * fq + (fr >> 2)) * IS + (16 * dt + 4 * (fr & 3)) * 2; yk[s] = cat8(tr4(p), tr4(p + 16 * IS)); }
    float* cbase = CON + ((size_t)(dir * 1024 + unit) * 64 + 16 * dt + fr) * 128 + 4 * fq;
#pragma unroll
    for (int et = 0; et < 8; ++et) { f32x4 acc = {0.f, 0.f, 0.f, 0.f};
#pragma unroll
        for (int s = 0; s < 2; ++s) { const LAS unsigned char* p = lds + GL_V + (32 * s + 4 * fq + (fr >> 2)) * VS + (16 * et + 4 * (fr & 3)) * 2; acc = mfma16(cat8(tr4(p), tr4(p + 16 * VS)), yk[s], acc); }
        *(f32x4*)(cbase + 16 * et) = acc; }
    __syncthreads();
}

__device__ __forceinline__ void phase_scan(const Frame& F, const float* __restrict__ CON, const float* __restrict__ DEC, bf16* __restrict__ SP) {
    for (int chain = F.vcu * NTHR + F.tid; chain < 2 * 8 * 64 * 128; chain += F.G * NTHR) {
        const int e = chain & 127, d = (chain >> 7) & 63, bh = (chain >> 13) & 7, dir = chain >> 16;
        const size_t ubase = (size_t)dir * 1024 + bh * 128;
        const float* con = CON + (ubase * 64 + d) * 128 + e; const float* dec = DEC + ubase * 64 + d; bf16* sp = SP + (ubase * 64 + d) * 128 + e;
        float S = 0.f;
        for (int nb = 0; nb < 16; ++nb) { float c[8], gg[8];
#pragma unroll
            for (int u = 0; u < 8; ++u) { const int n = nb * 8 + u, ne = dir ? 127 - n : n; c[u] = con[(size_t)ne * 8192]; gg[u] = dec[ne * 64]; }
#pragma unroll
            for (int u = 0; u < 8; ++u) { const int n = nb * 8 + u, ne = dir ? 127 - n : n; sp[(size_t)ne * 8192] = (bf16)f2bf(S); S = gg[u] * S + c[u]; } }
    }
}

struct GlaCFetch { v4u im[4], v[2], sf[2], sb[2]; };
__device__ __forceinline__ void gla_c_fetch(GlaCFetch& R, const bf16* PROJ, const bf16* SP, const bf16* IMGS, int unit, int tid) {
    const int n = unit & 127, bh = unit >> 7, h = bh & 3, b = bh >> 2; const size_t t0 = (size_t)b * T + 64 * n;
#pragma unroll
    for (int k = 0; k < 4; ++k) R.im[k] = *(const v4u*)(IMGS + (size_t)unit * 16384 + k * 4096 + tid * 8);
#pragma unroll
    for (int it = 0; it < 2; ++it) { const int id = tid + NTHR * it, row = id >> 4, ch = id & 15;
        R.v[it] = *(const v4u*)(PROJ + (t0 + row) * NPROJ + C_VG + h * 128 + ch * 8);
        R.sf[it] = *(const v4u*)(SP + (size_t)unit * 8192 + row * 128 + ch * 8);
        R.sb[it] = *(const v4u*)(SP + (size_t)(1024 + unit) * 8192 + row * 128 + ch * 8); }
}
__device__ __forceinline__ void gla_c_commit(const GlaCFetch& R, LAS unsigned char* lds, int tid) {
    { const int row = tid >> 3, ch = tid & 7, o = row * IS + ch * 16;
      *(LAS v4u*)(lds + GL_QF + o) = R.im[0]; *(LAS v4u*)(lds + GL_KF + o) = R.im[1]; *(LAS v4u*)(lds + GL_QB + o) = R.im[2]; *(LAS v4u*)(lds + GL_KB + o) = R.im[3]; }
#pragma unroll
    for (int it = 0; it < 2; ++it) { const int id = tid + NTHR * it, row = id >> 4, ch = id & 15, o = row * VS + ch * 16;
        *(LAS v4u*)(lds + GL_V + o) = R.v[it]; *(LAS v4u*)(lds + GL_SF + o) = R.sf[it]; *(LAS v4u*)(lds + GL_SB + o) = R.sb[it]; }
}
__device__ __forceinline__ void gla_c_compute(const Frame& F, const bf16* PROJ, const float* norm_g, bf16* Y, int unit) {
    LAS unsigned char* lds = F.lds;
    const int n = unit & 127, bh = unit >> 7, h = bh & 3, b = bh >> 2; const size_t t0 = (size_t)b * T + 64 * n;
    if (F.wave < 4) {
        const int fr = F.lane & 15, fq = F.lane >> 4, it = F.wave;
        const int i = 16 * it + fr;
        const bf16* rp = PROJ + (t0 + i) * NPROJ + C_RG + h * 128 + 4 * fq; bf16* yp = Y + (t0 + i) * D + 512 + h * 128 + 4 * fq;
        v2u rw[8];
#pragma unroll
        for (int et = 0; et < 8; ++et) rw[et] = *(const v2u*)(rp + 16 * et);
        bf16x8 yqf[2], yqb[2];
#pragma unroll
        for (int s = 0; s < 2; ++s) { const int off = (16 * it + fr) * IS + (32 * s + 8 * fq) * 2; yqf[s] = *(const LAS bf16x8*)(lds + GL_QF + off); yqb[s] = *(const LAS bf16x8*)(lds + GL_QB + off); }
        f32x4 a[4];
#pragma unroll
        for (int jt = 0; jt < 4; ++jt) { f32x4 af = {0.f, 0.f, 0.f, 0.f}, ab = {0.f, 0.f, 0.f, 0.f};
#pragma unroll
            for (int s = 0; s < 2; ++s) { const int off = (16 * jt + fr) * IS + (32 * s + 8 * fq) * 2;
                af = mfma16(*(const LAS bf16x8*)(lds + GL_KF + off), yqf[s], af); ab = mfma16(*(const LAS bf16x8*)(lds + GL_KB + off), yqb[s], ab); }
#pragma unroll
            for (int e = 0; e < 4; ++e) { const int j = 16 * jt + 4 * fq + e; a[jt][e] = (j <= i) ? af[e] : ab[e]; } }
        f32x4 o[8];
#pragma unroll
        for (int et = 0; et < 8; ++et) o[et] = (f32x4){0.f, 0.f, 0.f, 0.f};
#pragma unroll
        for (int s = 0; s < 2; ++s) { const bf16x8 pb = pack8(a[2 * s], a[2 * s + 1]);
#pragma unroll
            for (int et = 0; et < 8; ++et) { const LAS unsigned char* p = lds + GL_V + (32 * s + 4 * fq + (fr >> 2)) * VS + (16 * et + 4 * (fr & 3)) * 2; o[et] = mfma16(cat8(tr4(p), tr4(p + 16 * VS)), pb, o[et]); } }
#pragma unroll
        for (int s = 0; s < 2; ++s)
#pragma unroll
            for (int et = 0; et < 8; ++et) { const int off = (32 * s + 8 * fq + (fr >> 2)) * VS + (16 * et + 4 * (fr & 3)) * 2;
                o[et] = mfma16(cat8(tr4(lds + GL_SF + off), tr4(lds + GL_SF + off + 4 * VS)), yqf[s], o[et]);
                o[et] = mfma16(cat8(tr4(lds + GL_SB + off), tr4(lds + GL_SB + off + 4 * VS)), yqb[s], o[et]); }
        float ss = 0.f;
#pragma unroll
        for (int et = 0; et < 8; ++et) ss += (o[et][0] * o[et][0] + o[et][1] * o[et][1]) + (o[et][2] * o[et][2] + o[et][3] * o[et][3]);
        ss += __shfl_xor(ss, 16); ss += __shfl_xor(ss, 32);
        const float rs = 1.0f / sqrtf(ss * (1.0f / 128.0f) + EPS);
#pragma unroll
        for (int et = 0; et < 8; ++et) { const f32x4 gn = *(const f32x4*)(norm_g + 16 * et + 4 * fq);
            float rv[4] = {__builtin_bit_cast(float, rw[et].x << 16), __builtin_bit_cast(float, rw[et].x & 0xffff0000u), __builtin_bit_cast(float, rw[et].y << 16), __builtin_bit_cast(float, rw[et].y & 0xffff0000u)};
            float ov[4];
#pragma unroll
            for (int e = 0; e < 4; ++e) { const float sg = rv[e] / (1.0f + __expf(-rv[e])); ov[e] = o[et][e] * rs * gn[e] * sg; }
            v2u w; w.x = pg8::cvt_pk_bf16(ov[0], ov[1]); w.y = pg8::cvt_pk_bf16(ov[2], ov[3]); *(v2u*)(yp + 16 * et) = w; }
    }
}
__device__ __forceinline__ void phase_gla_c(const Frame& F, const bf16* PROJ, const bf16* SP, const bf16* IMGS, const float* norm_g, bf16* Y) {
    GlaCFetch R;
    int u = F.vcu;
    if (u < 1024) gla_c_fetch(R, PROJ, SP, IMGS, u, F.tid);
    for (; u < 1024; u += F.G) {
        gla_c_commit(R, F.lds, F.tid);
        __syncthreads();
        if (u + F.G < 1024) gla_c_fetch(R, PROJ, SP, IMGS, u + F.G, F.tid);
        gla_c_compute(F, PROJ, norm_g, Y, u);
        __syncthreads();
    }
}

__device__ __forceinline__ void phase_final(const Frame& F, float* out, const float* ss, const float* g) {
    const int gw = F.vcu * NWAVES + F.wave, NGW = F.G * NWAVES;
    f32x4 gv[4];
#pragma unroll
    for (int j = 0; j < 4; ++j) gv[j] = ((const f32x4*)g)[F.lane + 64 * j];
    for (int m = gw; m < M; m += NGW) { f32x4* xr = (f32x4*)(out + (size_t)m * D) + F.lane; const float rs = 1.0f / sqrtf(ss[m] * (1.f / D) + EPS);
#pragma unroll
        for (int j = 0; j < 4; ++j) xr[64 * j] = xr[64 * j] * rs * gv[j]; }
}

#define XB_TMO      128
#define XB_XCNT(j)  (256  + 64 * (j))
#define XB_XSUB(j)  (1280 + 64 * (j))
#define XB_XGEN(j)  (2304 + 64 * (j))
#define XB_TOP      3328
#define XB_TOPGEN   3392
#define XCD_BAR_WORDS 3456
#define XB_SPIN_CAP (1u << 18)

__device__ __forceinline__ unsigned xb_ld(unsigned* p)              { return __hip_atomic_load(p, __ATOMIC_RELAXED, __HIP_MEMORY_SCOPE_AGENT); }
__device__ __forceinline__ unsigned xb_add(unsigned* p, unsigned v) { return __hip_atomic_fetch_add(p, v, __ATOMIC_RELAXED, __HIP_MEMORY_SCOPE_AGENT); }
__device__ __forceinline__ unsigned xb_xcc_id() { return (unsigned)__builtin_amdgcn_s_getreg((3 << 11) | 20) & 0xFu; }
#define XB_SPIN(cond, bar) do { unsigned _sp = 0; while (cond) { __builtin_amdgcn_s_sleep(1); \
    if ((++_sp & 255u) == 0u) { if (xb_ld(&(bar)[XB_TMO])) break; if (_sp > XB_SPIN_CAP) { atomicAdd(&(bar)[XB_TMO], 1u); break; } } } } while (0)

struct XcdBarrier {
    unsigned* bar; unsigned x;
    volatile LAS unsigned* st;
};

__device__ __forceinline__ XcdBarrier xcd_barrier_post(unsigned* bar, volatile LAS unsigned* st) {
    XcdBarrier b; b.bar = bar; b.x = xb_xcc_id(); b.st = st;
    if (threadIdx.x == 0) (void)xb_add(&bar[XB_XCNT(b.x)], 1u);
    return b;
}
__device__ __forceinline__ void xcd_barrier_complete(unsigned* bar, unsigned x, unsigned& nloc, unsigned& nx) {
    const unsigned G = gridDim.x * gridDim.y * gridDim.z;
    unsigned sum, cnt, mine, sp = 0u;
    for (;;) {
        sum = 0u; cnt = 0u; mine = 0u;
#pragma unroll
        for (unsigned j = 0; j < 16; ++j) { const unsigned c = xb_ld(&bar[XB_XCNT(j)]); sum += c; cnt += (c > 0u) ? 1u : 0u; mine = (j == x) ? c : mine; }
        if (sum == G) break;
        __builtin_amdgcn_s_sleep(1);
        if ((++sp & 255u) == 0u) { if (xb_ld(&bar[XB_TMO])) break; if (sp > XB_SPIN_CAP) { atomicAdd(&bar[XB_TMO], 1u); break; } }
    }
    nloc = mine > 0u ? mine : 1u; nx = cnt > 0u ? cnt : 1u;
}

__device__ __forceinline__ void xcd_barrier(const XcdBarrier& b) {
    asm volatile("s_waitcnt vmcnt(0)" ::: "memory");
    __syncthreads();
    if (threadIdx.x == 0) {
        unsigned* bar = b.bar;
        __builtin_amdgcn_s_waitcnt(0);
        unsigned nloc = b.st[0], nx = b.st[1];
        if (nloc == 0u) { xcd_barrier_complete(bar, b.x, nloc, nx); b.st[0] = nloc; b.st[1] = nx; }
        const unsigned old = xb_add(&bar[XB_XSUB(b.x)], 1u);
        const unsigned gen = old / nloc;
        if (old + 1u == (gen + 1u) * nloc) {
            __builtin_amdgcn_fence(__ATOMIC_RELEASE, "agent");
            asm volatile("s_waitcnt vmcnt(0)" ::: "memory");
            const unsigned og = xb_add(&bar[XB_TOP], 1u);
            const unsigned tg = og / nx;
            if (og + 1u == (tg + 1u) * nx) xb_add(&bar[XB_TOPGEN], 1u);
            else XB_SPIN(xb_ld(&bar[XB_TOPGEN]) == tg, bar);
            __builtin_amdgcn_fence(__ATOMIC_ACQUIRE, "agent");
            xb_add(&bar[XB_XGEN(b.x)], 1u);
            asm volatile("s_waitcnt vmcnt(0)" ::: "memory");
        } else {
            XB_SPIN(xb_ld(&bar[XB_XGEN(b.x)]) == gen, bar);
            __builtin_amdgcn_fence(__ATOMIC_ACQUIRE, "agent");
            asm volatile("s_waitcnt vmcnt(0)" ::: "memory");
        }
    }
    __syncthreads();
}
#ifndef MK_DUP
#define MK_DUP 0
#endif
struct Args { const float* in[14]; float* out; unsigned char* ws; int lo, hi; };
constexpr int NPHASE = 9;
__global__ void __launch_bounds__(NTHR, 2) mk_fwd(Args a) {
    extern __shared__ __attribute__((aligned(16))) unsigned char lds_raw[];
    Frame F; F.lds = (LAS unsigned char*)lds_raw; F.tid = threadIdx.x; F.lane = F.tid & 63; F.wave = __builtin_amdgcn_readfirstlane(F.tid >> 6);
    F.G = gridDim.x; { const int bx = blockIdx.x; F.vcu = (F.G % 8 == 0) ? (bx % 8) * (F.G / 8) + bx / 8 : bx; }
    unsigned char* ws = a.ws;
    const float* x = a.in[0];
    bf16* XN = (bf16*)(ws + WS_XN); bf16* Yb = (bf16*)(ws + WS_Y); bf16* PROJ = (bf16*)(ws + WS_PROJ); bf16* HB = (bf16*)(ws + WS_HB); bf16* ACT = (bf16*)(ws + WS_ACT);
    float* Z = (float*)(ws + WS_Z); float* CON = (float*)(ws + WS_CON); float* DEC = (float*)(ws + WS_DEC); bf16* SP = (bf16*)(ws + WS_SP);
    float* SS2 = (float*)(ws + WS_SS2); float* SS3 = (float*)(ws + WS_SS3);
    const int lo = a.lo, hi = a.hi;
#define IN(k) (lo <= (k) && (k) < hi)
#define SEAM(k) do { if (IN(k) && IN((k) + 1)) xcd_barrier(bar); } while (0)
    volatile LAS unsigned* MISC = (volatile LAS unsigned*)(F.lds + LDS_BYTES - 64);
    if (F.tid < 16) MISC[F.tid] = 0u;
    __syncthreads();
    unsigned* barw = (unsigned*)(ws + WS_BAR);
    if (a.lo < 0) cg::this_grid().sync();
    XcdBarrier bar; bar.bar = barw; bar.x = 0; bar.st = nullptr;
    if (hi - lo > 1) bar = xcd_barrier_post(barw, MISC + 8);
    for (int rep_ = 0; rep_ < 1 + (MK_DUP & 1); ++rep_) if (IN(0)) phase_prologue(F, x, a.in[1], a.in[2], a.in[9], a.in[10], a.in[11], a.in[12], ws);
    SEAM(0);
    if (IN(1)) {
        pg8::Gemm g{XN, (const bf16*)(ws + WS_WIN), M, NPROJ, D}; pg8::StaticOrder S; S.init(M, NPROJ, F.G, (int)blockIdx.x);
        pg8::EpiProj E{PROJ, NPROJ};
        pg8::gemm_phase<pg8::EpiProj, pg8::StaticOrder, true, true>(F.lds, g, S, E);
        phase_z(F, XN, (const bf16*)(ws + WS_WIN) + (size_t)NPROJ * D, Z);
    }
#if (MK_DUP >> 1) & 1
    if (IN(1)) {
        pg8::Gemm g{XN, (const bf16*)(ws + WS_WIN), M, NPROJ, D}; pg8::StaticOrder S; S.init(M, NPROJ, F.G, (int)blockIdx.x);
        pg8::EpiProj E{PROJ, NPROJ};
        pg8::gemm_phase<pg8::EpiProj, pg8::StaticOrder, true, true>(F.lds, g, S, E);
        phase_z(F, XN, (const bf16*)(ws + WS_WIN) + (size_t)NPROJ * D, Z);
    }
#endif
    SEAM(1);
    for (int rep_ = 0; rep_ < 1 + ((MK_DUP >> 2) & 1); ++rep_) if (IN(2)) {
        for (int rep2_ = 0; rep2_ < 1 + ((MK_DUP >> 9) & 1); ++rep2_)
        for (int u = F.vcu; u < 1024; u += F.G) gla_a_unit(F, PROJ, Z, a.in[4], a.in[5], a.in[6], a.in[7], CON, DEC, (bf16*)a.out, u);
        for (int rep2_ = 0; rep2_ < 1 + ((MK_DUP >> 10) & 1); ++rep2_)
        for (int w = F.vcu; w < 256; w += F.G) natten_wg(F, PROJ, a.in[3], Yb, w);
    }
    SEAM(2);
    for (int rep_ = 0; rep_ < 1 + ((MK_DUP >> 3) & 1); ++rep_) if (IN(3)) phase_scan(F, CON, DEC, SP);
    SEAM(3);
    for (int rep_ = 0; rep_ < 1 + ((MK_DUP >> 4) & 1); ++rep_) if (IN(4)) phase_gla_c(F, PROJ, SP, (const bf16*)a.out, a.in[8], Yb);
    SEAM(4);
    if (IN(5)) {
        pg8::Gemm g{Yb, (const bf16*)(ws + WS_WO), M, D, D}; pg8::StaticOrder S; S.init(M, D, F.G, (int)blockIdx.x);
#if (MK_DUP >> 5) & 1
        { pg8::EpiResB E0{x, HB, (float*)(ws + WS_DEC), D}; pg8::gemm_phase<pg8::EpiResB, pg8::StaticOrder, false, true>(F.lds, g, S, E0); }
#endif
        pg8::EpiResB E{x, HB, SS2, D};
        pg8::gemm_phase<pg8::EpiResB, pg8::StaticOrder, false, true>(F.lds, g, S, E);
    }
    SEAM(5);
    if (IN(6)) {
        pg8::Gemm g{HB, (const bf16*)(ws + WS_W1), M, FF, D}; pg8::StaticOrder S; S.init(M, FF, F.G, (int)blockIdx.x);
        pg8::EpiFF1 E{ACT, FF, SS2, 1.0f / D, EPS};
        pg8::gemm_phase<pg8::EpiFF1, pg8::StaticOrder, true, true>(F.lds, g, S, E);
    }
#if (MK_DUP >> 6) & 1
    if (IN(6)) {
        pg8::Gemm g{HB, (const bf16*)(ws + WS_W1), M, FF, D}; pg8::StaticOrder S; S.init(M, FF, F.G, (int)blockIdx.x);
        pg8::EpiFF1 E{ACT, FF, SS2, 1.0f / D, EPS};
        pg8::gemm_phase<pg8::EpiFF1, pg8::StaticOrder, true, true>(F.lds, g, S, E);
    }
#endif
    SEAM(6);
#if (MK_DUP >> 11) & 1
    for (int k_ = 0; k_ < 8; ++k_) xcd_barrier(bar);
#endif
    if (IN(7)) {
        pg8::Gemm g{ACT, (const bf16*)(ws + WS_W2), M, D, FF}; pg8::StaticOrder S; S.init(M, D, F.G, (int)blockIdx.x);
        const int fuse = (F.G == 256 && hi - lo > 1) ? 1 : 0;
#if (MK_DUP >> 7) & 1
        { pg8::EpiResNormB E0{HB, a.out, (float*)(ws + WS_DEC), (unsigned*)(ws + WS_PCNT), a.in[13], D, 0, 8u * (D / 256), 1.0f / D, EPS}; pg8::gemm_phase<pg8::EpiResNormB, pg8::StaticOrder, false, true>(F.lds, g, S, E0); }
#endif
        pg8::EpiResNormB E{HB, a.out, SS3, (unsigned*)(ws + WS_PCNT), a.in[13], D, fuse, 8u * (D / 256), 1.0f / D, EPS};
        pg8::gemm_phase<pg8::EpiResNormB, pg8::StaticOrder, false, true>(F.lds, g, S, E);
    }
    if (!(F.G == 256 && hi - lo > 1)) {
        SEAM(7);
        if (IN(8)) phase_final(F, a.out, SS3, a.in[13]);
    }
#undef IN
#undef SEAM
}

#ifndef MK_ONE_LAUNCH
#define MK_ONE_LAUNCH 1
#endif
extern "C" void kernel_launch(void* const* d_in, const int* in_sizes, int n_in, void* d_out, int out_size, void* d_ws, size_t ws_size, hipStream_t stream) {
    static int grid = 0;
    if (grid == 0) {
        if (n_in != 14 || out_size != M * D || ws_size < WS_END) { fprintf(stderr, "kernel_launch: unexpected shapes (n_in %d out %d ws %zu)\n", n_in, out_size, ws_size); grid = -1; return; }
        int dev = 0, cus = 0, per_cu = 0;
        hipGetDevice(&dev); hipDeviceGetAttribute(&cus, hipDeviceAttributeMultiprocessorCount, dev);
        if (hipFuncSetAttribute((const void*)mk_fwd, hipFuncAttributeMaxDynamicSharedMemorySize, LDS_BYTES) != hipSuccess) { fprintf(stderr, "kernel_launch: hipFuncSetAttribute failed\n"); grid = -1; return; }
        if (hipOccupancyMaxActiveBlocksPerMultiprocessor(&per_cu, (const void*)mk_fwd, NTHR, LDS_BYTES) != hipSuccess || per_cu < 1) { fprintf(stderr, "kernel_launch: occupancy query says %d\n", per_cu); per_cu = 1; }
        (void)hipGetLastError();
        grid = cus * 1;
    }
    if (grid < 0) return;
    Args a{};
    for (int i = 0; i < 14; ++i) a.in[i] = (const float*)d_in[i];
    a.out = (float*)d_out; a.ws = (unsigned char*)d_ws;
#if MK_ONE_LAUNCH
    if (hipMemsetAsync((char*)d_ws + WS_BAR, 0, WS_ZERO_BYTES, stream) != hipSuccess) { fprintf(stderr, "kernel_launch: memset of the barrier words failed\n"); return; }
    a.lo = 0; a.hi = NPHASE;
    void* args[] = {&a};
    hipError_t e = hipLaunchCooperativeKernel((const void*)mk_fwd, dim3(grid), dim3(NTHR), args, LDS_BYTES, stream);
    if (e != hipSuccess) fprintf(stderr, "cooperative launch failed: %s (grid %d)\n", hipGetErrorString(e), grid);
#else
    for (int p = 0; p < NPHASE; ++p) { a.lo = p; a.hi = p + 1; hipLaunchKernelGGL(mk_fwd, dim3(grid), dim3(NTHR), LDS_BYTES, stream, a); }
#endif
}
```

```cpp
#include <hip/hip_runtime.h>
#include <hip/hip_cooperative_groups.h>
#include <cstdio>
#include <cstdint>
#include <cmath>
namespace cg = cooperative_groups;
namespace pg8 {
#define PG8_LAS __attribute__((address_space(3)))
typedef unsigned short bf16_t;
typedef short bf16x8 __attribute__((ext_vector_type(8)));
typedef float f32x4 __attribute__((ext_vector_type(4)));
typedef unsigned u32x4 __attribute__((ext_vector_type(4)));
constexpr int BM = 256, BK = 64, HALF = 128, HTB = HALF * BK * 2  , STAGE_BYTES = 8 * HTB, NXCD = 8, WGM = 8;

__host__ __device__ __forceinline__ int lds_byte(int r, int c) { const int st = (r >> 4) * 2 + (c >> 5), rr = r & 15, cc = c & 31, ob = rr * 64 + cc * 2; return st * 1024 + (ob ^ (((ob >> 9) & 1) << 5)); }
__host__ __device__ __forceinline__ void stage_rc(int b, int& R, int& C) { const int st = b / 1024, sb = b % 1024, swz = sb ^ (((sb >> 9) & 1) << 5); R = (st >> 1) * 16 + swz / 64; C = (st & 1) * 32 + (swz % 64) / 2; }
__host__ __device__ __forceinline__ int perm32(int rho) { const int n = rho >> 4, i = rho & 15; return 8 * (i >> 2) + 4 * n + (i & 3); }

struct Unit { int pm, pn; };
struct Gemm { const bf16_t* A; const bf16_t* Bt; int M, N, K; };

struct StaticOrder {
    int nM, nN, nwg, G, c;
    __host__ __device__ void init(int M, int N, int G_, int c_) { nM = M / BM; nN = N / BM; nwg = nM * nN; G = G_; c = c_; }
    __host__ __device__ bool next(int i, Unit& u) const {
        const long L = (long)i * G + c; if (L >= nwg) return false;
        int wgid = (int)L; { const int q = nwg / NXCD, r = nwg % NXCD, xcd = wgid % NXCD, off = wgid / NXCD; wgid = (xcd < r ? xcd * (q + 1) : r * (q + 1) + (xcd - r) * q) + off; }
        const int nig = WGM * nN, gid = wgid / nig, fm = gid * WGM, gsz = (nM - fm) < WGM ? (nM - fm) : WGM;
        u.pm = fm + ((wgid % nig) % gsz); u.pn = (wgid % nig) / gsz; return true;
    }
    __device__ __forceinline__ void a_ready(const Unit&) const {}
    __device__ __forceinline__ void done(const Unit&) const {}
};

__device__ __forceinline__ unsigned cvt_pk_bf16(float lo, float hi) { unsigned r; asm volatile("v_cvt_pk_bf16_f32 %0, %1, %2" : "=v"(r) : "v"(lo), "v"(hi)); return r; }
typedef unsigned u32x2 __attribute__((ext_vector_type(2)));
struct EpiProj {
    static constexpr bool PERM = true, AFTER_DRAIN = false;
    bf16_t* O; int ldc;
    __device__ __forceinline__ void operator()(const f32x4 (&acc)[2][2][4][2], const Unit& u, int wr, int wc, int fr, int fq) const {
        const int row0 = u.pm * BM + wr * 64 + fr, col0 = u.pn * BM + wc * 32 + 8 * fq;
#pragma unroll
        for (int ai = 0; ai < 2; ++ai)
#pragma unroll
            for (int m = 0; m < 4; ++m) { bf16_t* rowp = O + (size_t)(row0 + ai * HALF + m * 16) * ldc + col0;
#pragma unroll
                for (int bj = 0; bj < 2; ++bj) { const f32x4 v0 = acc[ai][bj][m][0], v1 = acc[ai][bj][m][1];
                    u32x4 w; w.x = cvt_pk_bf16(v0[0], v0[1]); w.y = cvt_pk_bf16(v0[2], v0[3]); w.z = cvt_pk_bf16(v1[0], v1[1]); w.w = cvt_pk_bf16(v1[2], v1[3]);
                    *(u32x4*)(rowp + bj * HALF) = w; } }
    }
};
struct EpiFF1 {
    static constexpr bool PERM = true, AFTER_DRAIN = false;
    bf16_t* O; int ldc; const float* sumsq; float inv_n, eps;
    __device__ __forceinline__ void operator()(const f32x4 (&acc)[2][2][4][2], const Unit& u, int wr, int wc, int fr, int fq) const {
        const int row0 = u.pm * BM + wr * 64 + fr, col0 = u.pn * BM + wc * 32 + 8 * fq;
#pragma unroll
        for (int ai = 0; ai < 2; ++ai)
#pragma unroll
            for (int m = 0; m < 4; ++m) { const int row = row0 + ai * HALF + m * 16; bf16_t* rowp = O + (size_t)row * ldc + col0;
                const float rs = 1.0f / sqrtf(sumsq[row] * inv_n + eps);
#pragma unroll
                for (int bj = 0; bj < 2; ++bj) { f32x4 v0 = acc[ai][bj][m][0] * rs, v1 = acc[ai][bj][m][1] * rs;
#pragma unroll
                    for (int e = 0; e < 4; ++e) { const float a = fmaxf(v0[e], 0.f), b = fmaxf(v1[e], 0.f); v0[e] = a * a; v1[e] = b * b; }
                    u32x4 w; w.x = cvt_pk_bf16(v0[0], v0[1]); w.y = cvt_pk_bf16(v0[2], v0[3]); w.z = cvt_pk_bf16(v1[0], v1[1]); w.w = cvt_pk_bf16(v1[2], v1[3]);
                    *(u32x4*)(rowp + bj * HALF) = w; } }
    }
};
struct EpiRes {
    static constexpr bool PERM = false, AFTER_DRAIN = false;
    const float* base; float* out; bf16_t* hb; float* sumsq; int ldc;
    __device__ __forceinline__ void operator()(const f32x4 (&acc)[2][2][4][2], const Unit& u, int wr, int wc, int fr, int fq) const {
        const int col0 = u.pn * BM + wc * 32 + 4 * fq;
#pragma unroll
        for (int ai = 0; ai < 2; ++ai)
#pragma unroll
            for (int m = 0; m < 4; ++m) { const int row = u.pm * BM + ai * HALF + wr * 64 + m * 16 + fr; const size_t off = (size_t)row * ldc + col0; float s = 0.f;
#pragma unroll
                for (int bj = 0; bj < 2; ++bj)
#pragma unroll
                    for (int n = 0; n < 2; ++n) { const f32x4 bs = *(const f32x4*)(base + off + bj * HALF + n * 16); const f32x4 o = bs + acc[ai][bj][m][n];
                        *(f32x4*)(out + off + bj * HALF + n * 16) = o;
                        if (hb) { u32x2 w; w.x = cvt_pk_bf16(o[0], o[1]); w.y = cvt_pk_bf16(o[2], o[3]); *(u32x2*)(hb + off + bj * HALF + n * 16) = w; }
                        s += (o[0] * o[0] + o[1] * o[1]) + (o[2] * o[2] + o[3] * o[3]); }
                s += __shfl_xor(s, 16); s += __shfl_xor(s, 32);
                if (fq == 0) unsafeAtomicAdd(sumsq + row, s);
                asm volatile("" ::: "memory"); }
    }
};

struct EpiResNorm {
    static constexpr bool PERM = false, AFTER_DRAIN = true;
    const float* base; float* out; float* sumsq; unsigned* cnt; const float* g; int ldc; int fuse; unsigned want; float inv_n, eps;
    __device__ __forceinline__ void fused(f32x4 (&acc)[2][2][4][2], const Unit& u, int wr, int wc, int fr, int fq, PG8_LAS unsigned char* lds, int wid, int lane) const {
        const int col0 = u.pn * BM + wc * 32 + 4 * fq;
#pragma unroll
        for (int ai = 0; ai < 2; ++ai)
#pragma unroll
            for (int m = 0; m < 4; ++m) { const int row = u.pm * BM + ai * HALF + wr * 64 + m * 16 + fr; const size_t off = (size_t)row * ldc + col0; float s = 0.f;
#pragma unroll
                for (int bj = 0; bj < 2; ++bj)
#pragma unroll
                    for (int n = 0; n < 2; ++n) { const f32x4 bs = *(const f32x4*)(base + off + bj * HALF + n * 16); const f32x4 o = bs + acc[ai][bj][m][n]; acc[ai][bj][m][n] = o;
                        if (!fuse) *(f32x4*)(out + off + bj * HALF + n * 16) = o;
                        s += (o[0] * o[0] + o[1] * o[1]) + (o[2] * o[2] + o[3] * o[3]); }
                s += __shfl_xor(s, 16); s += __shfl_xor(s, 32);
                if (fq == 0) unsafeAtomicAdd(sumsq + row, s);
                asm volatile("" ::: "memory"); }
        if (!fuse) return;
        asm volatile("s_waitcnt vmcnt(0)" ::: "memory");
        if (lane == 0) __hip_atomic_fetch_add(cnt + 64 * u.pm, 1u, __ATOMIC_RELAXED, __HIP_MEMORY_SCOPE_AGENT);
        if (wid == 0) { while ((unsigned)__builtin_amdgcn_readfirstlane(__hip_atomic_load(cnt + 64 * u.pm, __ATOMIC_RELAXED, __HIP_MEMORY_SCOPE_AGENT)) < want) __builtin_amdgcn_s_sleep(2); }
        asm volatile("s_waitcnt vmcnt(0) lgkmcnt(0)" ::: "memory"); __builtin_amdgcn_s_barrier(); asm volatile("" ::: "memory");
        __builtin_amdgcn_fence(__ATOMIC_ACQUIRE, "agent");
        f32x4 gv[2][2];
#pragma unroll
        for (int bj = 0; bj < 2; ++bj)
#pragma unroll
            for (int n = 0; n < 2; ++n) gv[bj][n] = *(const f32x4*)(g + col0 + bj * HALF + n * 16);
#pragma unroll
        for (int ai = 0; ai < 2; ++ai)
#pragma unroll
            for (int m = 0; m < 4; ++m) { const int row = u.pm * BM + ai * HALF + wr * 64 + m * 16 + fr; const size_t off = (size_t)row * ldc + col0;
                const float ssv = __hip_atomic_load(sumsq + row, __ATOMIC_RELAXED, __HIP_MEMORY_SCOPE_AGENT); const float rs = 1.0f / sqrtf(ssv * inv_n + eps);
#pragma unroll
                for (int bj = 0; bj < 2; ++bj)
#pragma unroll
                    for (int n = 0; n < 2; ++n) *(f32x4*)(out + off + bj * HALF + n * 16) = acc[ai][bj][m][n] * rs * gv[bj][n]; }
    }
};

struct EpiResB {
    static constexpr bool PERM = true, AFTER_DRAIN = false;
    const float* base; bf16_t* hb; float* sumsq; int ldc;
    __device__ __forceinline__ void operator()(const f32x4 (&acc)[2][2][4][2], const Unit& u, int wr, int wc, int fr, int fq) const {
        const int col0 = u.pn * BM + wc * 32 + 8 * fq;
#pragma unroll
        for (int ai = 0; ai < 2; ++ai)
#pragma unroll
            for (int m = 0; m < 4; ++m) { const int row = u.pm * BM + ai * HALF + wr * 64 + m * 16 + fr; const size_t off = (size_t)row * ldc + col0; float s = 0.f;
#pragma unroll
                for (int bj = 0; bj < 2; ++bj) { const f32x4 b0 = *(const f32x4*)(base + off + bj * HALF), b1 = *(const f32x4*)(base + off + bj * HALF + 4);
                    const f32x4 o0 = b0 + acc[ai][bj][m][0], o1 = b1 + acc[ai][bj][m][1];
                    u32x4 w; w.x = cvt_pk_bf16(o0[0], o0[1]); w.y = cvt_pk_bf16(o0[2], o0[3]); w.z = cvt_pk_bf16(o1[0], o1[1]); w.w = cvt_pk_bf16(o1[2], o1[3]);
                    *(u32x4*)(hb + off + bj * HALF) = w;
                    s += (o0[0] * o0[0] + o0[1] * o0[1]) + (o0[2] * o0[2] + o0[3] * o0[3]) + (o1[0] * o1[0] + o1[1] * o1[1]) + (o1[2] * o1[2] + o1[3] * o1[3]); }
                s += __shfl_xor(s, 16); s += __shfl_xor(s, 32);
                if (fq == 0) unsafeAtomicAdd(sumsq + row, s);
                asm volatile("" ::: "memory"); }
    }
};
struct EpiResNormB {
    static constexpr bool PERM = true, AFTER_DRAIN = true;
    const bf16_t* hb; float* out; float* sumsq; unsigned* cnt; const float* g; int ldc; int fuse; unsigned want; float inv_n, eps;
    __device__ __forceinline__ void fused(f32x4 (&acc)[2][2][4][2], const Unit& u, int wr, int wc, int fr, int fq, PG8_LAS unsigned char* lds, int wid, int lane) const {
        const int col0 = u.pn * BM + wc * 32 + 8 * fq;
#pragma unroll
        for (int ai = 0; ai < 2; ++ai)
#pragma unroll
            for (int m = 0; m < 4; ++m) { const int row = u.pm * BM + ai * HALF + wr * 64 + m * 16 + fr; const size_t off = (size_t)row * ldc + col0; float s = 0.f;
#pragma unroll
                for (int bj = 0; bj < 2; ++bj) { const u32x4 w = *(const u32x4*)(hb + off + bj * HALF);
                    const f32x4 b0 = {__builtin_bit_cast(float, w.x << 16), __builtin_bit_cast(float, w.x & 0xffff0000u), __builtin_bit_cast(float, w.y << 16), __builtin_bit_cast(float, w.y & 0xffff0000u)};
                    const f32x4 b1 = {__builtin_bit_cast(float, w.z << 16), __builtin_bit_cast(float, w.z & 0xffff0000u), __builtin_bit_cast(float, w.w << 16), __builtin_bit_cast(float, w.w & 0xffff0000u)};
                    const f32x4 o0 = b0 + acc[ai][bj][m][0], o1 = b1 + acc[ai][bj][m][1]; acc[ai][bj][m][0] = o0; acc[ai][bj][m][1] = o1;
                    if (!fuse) { *(f32x4*)(out + off + bj * HALF) = o0; *(f32x4*)(out + off + bj * HALF + 4) = o1; }
                    s += (o0[0] * o0[0] + o0[1] * o0[1]) + (o0[2] * o0[2] + o0[3] * o0[3]) + (o1[0] * o1[0] + o1[1] * o1[1]) + (o1[2] * o1[2] + o1[3] * o1[3]); }
                s += __shfl_xor(s, 16); s += __shfl_xor(s, 32);
                if (fq == 0) unsafeAtomicAdd(sumsq + row, s);
                asm volatile("" ::: "memory"); }
        if (!fuse) return;
        asm volatile("s_waitcnt vmcnt(0)" ::: "memory");
        if (lane == 0) __hip_atomic_fetch_add(cnt + 64 * u.pm, 1u, __ATOMIC_RELAXED, __HIP_MEMORY_SCOPE_AGENT);
        if (wid == 0) { while ((unsigned)__builtin_amdgcn_readfirstlane(__hip_atomic_load(cnt + 64 * u.pm, __ATOMIC_RELAXED, __HIP_MEMORY_SCOPE_AGENT)) < want) __builtin_amdgcn_s_sleep(2); }
        asm volatile("s_waitcnt vmcnt(0) lgkmcnt(0)" ::: "memory"); __builtin_amdgcn_s_barrier(); asm volatile("" ::: "memory");
        __builtin_amdgcn_fence(__ATOMIC_ACQUIRE, "agent");
        f32x4 gv[2][2];
#pragma unroll
        for (int bj = 0; bj < 2; ++bj)
#pragma unroll
            for (int n = 0; n < 2; ++n) gv[bj][n] = *(const f32x4*)(g + col0 + bj * HALF + n * 4);
#pragma unroll
        for (int ai = 0; ai < 2; ++ai)
#pragma unroll
            for (int m = 0; m < 4; ++m) { const int row = u.pm * BM + ai * HALF + wr * 64 + m * 16 + fr; const size_t off = (size_t)row * ldc + col0;
                const float ssv = __hip_atomic_load(sumsq + row, __ATOMIC_RELAXED, __HIP_MEMORY_SCOPE_AGENT); const float rs = 1.0f / sqrtf(ssv * inv_n + eps);
#pragma unroll
                for (int bj = 0; bj < 2; ++bj)
#pragma unroll
                    for (int n = 0; n < 2; ++n) *(f32x4*)(out + off + bj * HALF + n * 4) = acc[ai][bj][m][n] * rs * gv[bj][n]; }
    }
};
template <class Epi, class Sched, bool ALIGN_EPI = false, bool SP2 = false>
__device__ __forceinline__ void gemm_phase(PG8_LAS unsigned char* lds, const Gemm g, const Sched& S, const Epi& E) {
    const int tid = threadIdx.x, wid = __builtin_amdgcn_readfirstlane(tid >> 6), lane = tid & 63, wr = wid >> 2, wc = wid & 3, fr = lane & 15, fq = lane >> 4;
    const int K = g.K, nt = K / BK;
    unsigned voffA[2], voffB[2];
#pragma unroll
    for (int i = 0; i < 2; ++i) { int R, C; stage_rc(tid * 16 + i * 8192, R, C); const int Rb = Epi::PERM ? ((R & ~31) + perm32(R & 31)) : R;
        voffA[i] = (unsigned)(R * K + C) * 2u; voffB[i] = (unsigned)(Rb * K + C) * 2u; }
    const size_t kstep = (size_t)(BK * 2);
    const size_t hstep = (size_t)HALF * K * 2;
    const size_t tstep = 2 * hstep;
    const unsigned ldsw = (unsigned)wid * 1024u;
    const int aoff = lds_byte(wr * 64 + fr, fq * 8), boff = lds_byte(wc * 32 + fr, fq * 8);
#define PG8_SA(b, h) (((b) * 2 + (h)) * HTB)
#define PG8_SB(b, h) ((4 + (b) * 2 + (h)) * HTB)
#define PG8_STAGE(bufoff, gbase, voff) do { _Pragma("unroll") for (int _i = 0; _i < 2; ++_i) \
        __builtin_amdgcn_global_load_lds((const unsigned*)((const char*)(gbase) + (voff)[_i]), (PG8_LAS unsigned*)(lds + (bufoff) + ldsw + _i * 8192), 16, 0, 0); } while (0)
#define PG8_LDA(dst, b, h) do { _Pragma("unroll") for (int m = 0; m < 4; ++m) _Pragma("unroll") for (int k = 0; k < 2; ++k) dst[m][k] = *(const PG8_LAS bf16x8*)(lds + PG8_SA(b, h) + aoff + m * 2048 + k * 1024); } while (0)
#define PG8_LDB(dst, b, h) do { _Pragma("unroll") for (int n = 0; n < 2; ++n) _Pragma("unroll") for (int k = 0; k < 2; ++k) dst[n][k] = *(const PG8_LAS bf16x8*)(lds + PG8_SB(b, h) + boff + n * 2048 + k * 1024); } while (0)
#define PG8_MMA(ai, bj, At, Bt) do { __builtin_amdgcn_s_setprio(1); _Pragma("unroll") for (int m = 0; m < 4; ++m) _Pragma("unroll") for (int n = 0; n < 2; ++n) _Pragma("unroll") for (int k = 0; k < 2; ++k) \
        acc[ai][bj][m][n] = __builtin_amdgcn_mfma_f32_16x16x32_bf16(Bt[n][k], At[m][k], acc[ai][bj][m][n], 0, 0, 0); __builtin_amdgcn_s_setprio(0); } while (0)
#define PG8_WAIT_V(n) asm volatile("s_waitcnt vmcnt(" #n ")" ::: "memory")
#define PG8_WAIT_L(n) asm volatile("s_waitcnt lgkmcnt(" #n ")" ::: "memory")
#define PG8_BAR __builtin_amdgcn_s_barrier()
#define PG8_SCHED __builtin_amdgcn_sched_barrier(0)
    Unit cur, nxt; int ui = 0;
    if (!S.next(0, cur)) return;
    f32x4 acc[2][2][4][2];
#pragma unroll
    for (int a = 0; a < 2; ++a)
#pragma unroll
        for (int b = 0; b < 2; ++b)
#pragma unroll
            for (int m = 0; m < 4; ++m)
#pragma unroll
                for (int n = 0; n < 2; ++n) acc[a][b][m][n] = (f32x4){0.f, 0.f, 0.f, 0.f};
    bf16x8 At[4][2], B0[2][2], B1[2][2];
    const char* cA = (const char*)g.A + (size_t)cur.pm * tstep; const char* cB = (const char*)g.Bt + (size_t)cur.pn * tstep;
    S.a_ready(cur);
    if constexpr (SP2) {
        PG8_STAGE(PG8_SB(0, 0), cB, voffB); PG8_STAGE(PG8_SB(0, 1), cB + hstep, voffB); PG8_STAGE(PG8_SA(0, 0), cA, voffA); PG8_STAGE(PG8_SA(0, 1), cA + hstep, voffA);
        if (wr == 1) PG8_BAR;
        PG8_WAIT_V(2); PG8_BAR;
        PG8_STAGE(PG8_SB(1, 0), cB + kstep, voffB); PG8_STAGE(PG8_SA(1, 0), cA + kstep, voffA); PG8_STAGE(PG8_SB(1, 1), cB + hstep + kstep, voffB);
        PG8_WAIT_V(6); PG8_BAR;
    } else {
        PG8_STAGE(PG8_SB(0, 0), cB, voffB); PG8_STAGE(PG8_SA(0, 0), cA, voffA); PG8_STAGE(PG8_SB(0, 1), cB + hstep, voffB); PG8_STAGE(PG8_SA(0, 1), cA + hstep, voffA);
        if (wr == 1) PG8_BAR;
        PG8_WAIT_V(4); PG8_BAR;
        PG8_STAGE(PG8_SB(1, 0), cB + kstep, voffB); PG8_STAGE(PG8_SA(1, 0), cA + kstep, voffA); PG8_STAGE(PG8_SB(1, 1), cB + hstep + kstep, voffB);
        PG8_WAIT_V(6); PG8_BAR;
    }
    for (;;) {
        const bool has_next = S.next(ui + 1, nxt);
        const char* nA = has_next ? (const char*)g.A + (size_t)nxt.pm * tstep : cA; const char* nB = has_next ? (const char*)g.Bt + (size_t)nxt.pn * tstep : cB;
        for (int t = 0; t < nt; t += 2) {
            const bool last = (t == nt - 2);
            const char* a1 = cA + (size_t)(t + 1) * kstep;
            const char* a2 = last ? nA : cA + (size_t)(t + 2) * kstep; const char* b2 = last ? nB : cB + (size_t)(t + 2) * kstep;
            const char* a3 = a2 + kstep; const char* b3 = b2 + kstep;
            if (last && has_next) S.a_ready(nxt);
            if constexpr (SP2) {
            PG8_LDB(B0, 0, 0); PG8_LDB(B1, 0, 1); PG8_SCHED; PG8_LDA(At, 0, 0); PG8_STAGE(PG8_SA(1, 1), a1 + hstep, voffA);
            PG8_WAIT_V(8); PG8_WAIT_L(0); PG8_BAR; PG8_MMA(0, 0, At, B0); PG8_MMA(0, 1, At, B1); PG8_BAR; PG8_SCHED;
            PG8_LDA(At, 0, 1); PG8_STAGE(PG8_SB(0, 0), b2, voffB); PG8_STAGE(PG8_SB(0, 1), b2 + hstep, voffB); PG8_STAGE(PG8_SA(0, 0), a2, voffA);
            PG8_WAIT_V(8); PG8_WAIT_L(0); PG8_BAR; PG8_MMA(1, 0, At, B0); PG8_MMA(1, 1, At, B1); PG8_BAR; PG8_SCHED;
            PG8_LDB(B0, 1, 0); PG8_LDB(B1, 1, 1); PG8_SCHED; PG8_LDA(At, 1, 0); PG8_STAGE(PG8_SA(0, 1), a2 + hstep, voffA);
            PG8_WAIT_V(8); PG8_WAIT_L(0); PG8_BAR; PG8_MMA(0, 0, At, B0); PG8_MMA(0, 1, At, B1); PG8_BAR; PG8_SCHED;
            PG8_LDA(At, 1, 1); PG8_STAGE(PG8_SB(1, 0), b3, voffB); PG8_STAGE(PG8_SB(1, 1), b3 + hstep, voffB); PG8_STAGE(PG8_SA(1, 0), a3, voffA);
            PG8_WAIT_V(8); PG8_WAIT_L(0); PG8_BAR; PG8_MMA(1, 0, At, B0); PG8_MMA(1, 1, At, B1); PG8_BAR; PG8_SCHED;
            } else {
            PG8_LDB(B0, 0, 0); PG8_SCHED; PG8_LDA(At, 0, 0); PG8_STAGE(PG8_SA(1, 1), a1 + hstep, voffA);
            PG8_WAIT_L(8); PG8_BAR; PG8_WAIT_L(0); PG8_MMA(0, 0, At, B0); PG8_BAR; PG8_SCHED;
            PG8_LDB(B1, 0, 1); PG8_STAGE(PG8_SB(0, 0), b2, voffB);
            PG8_BAR; PG8_WAIT_L(0); PG8_MMA(0, 1, At, B1); PG8_BAR;
            PG8_LDA(At, 0, 1); PG8_STAGE(PG8_SA(0, 0), a2, voffA);
            PG8_BAR; PG8_WAIT_L(0); PG8_MMA(1, 0, At, B0); PG8_BAR; PG8_SCHED;
            PG8_STAGE(PG8_SB(0, 1), b2 + hstep, voffB);
            PG8_WAIT_V(6); PG8_BAR; PG8_MMA(1, 1, At, B1); PG8_BAR;
            PG8_LDB(B0, 1, 0); PG8_SCHED; PG8_LDA(At, 1, 0); PG8_STAGE(PG8_SA(0, 1), a2 + hstep, voffA);
            PG8_WAIT_L(8); PG8_BAR; PG8_WAIT_L(0); PG8_MMA(0, 0, At, B0); PG8_BAR; PG8_SCHED;
            PG8_LDB(B1, 1, 1); PG8_STAGE(PG8_SB(1, 0), b3, voffB);
            PG8_BAR; PG8_WAIT_L(0); PG8_MMA(0, 1, At, B1); PG8_BAR;
            PG8_LDA(At, 1, 1); PG8_STAGE(PG8_SA(1, 0), a3, voffA);
            PG8_BAR; PG8_WAIT_L(0); PG8_MMA(1, 0, At, B0); PG8_BAR; PG8_SCHED;
            PG8_STAGE(PG8_SB(1, 1), b3 + hstep, voffB);
            PG8_WAIT_V(6); PG8_BAR; PG8_MMA(1, 1, At, B1); PG8_BAR;
            }
        }
        if constexpr (ALIGN_EPI) { if (wr == 0) PG8_BAR; }
        if constexpr (!Epi::AFTER_DRAIN) { E(acc, cur, wr, wc, fr, fq); S.done(cur); }
        if (!has_next) break;
#pragma unroll
        for (int a = 0; a < 2; ++a)
#pragma unroll
            for (int b = 0; b < 2; ++b)
#pragma unroll
                for (int m = 0; m < 4; ++m)
#pragma unroll
                    for (int n = 0; n < 2; ++n) acc[a][b][m][n] = (f32x4){0.f, 0.f, 0.f, 0.f};
        cur = nxt; cA = nA; cB = nB; ++ui;
        if constexpr (ALIGN_EPI) { if (wr == 1) PG8_BAR; }
    }
    PG8_WAIT_V(0);
    if constexpr (!ALIGN_EPI) { if (wr == 0) PG8_BAR; }
    PG8_BAR;
    if constexpr (Epi::AFTER_DRAIN) { E.fused(acc, cur, wr, wc, fr, fq, lds, wid, lane); S.done(cur); }
#undef PG8_SA
#undef PG8_SB
#undef PG8_STAGE
#undef PG8_LDA
#undef PG8_LDB
#undef PG8_MMA
#undef PG8_WAIT_V
#undef PG8_WAIT_L
#undef PG8_BAR
#undef PG8_SCHED
}
}
#define GAS __attribute__((address_space(1)))
#define LAS __attribute__((address_space(3)))
typedef unsigned short bf16;
typedef unsigned v4u __attribute__((ext_vector_type(4)));
typedef unsigned v2u __attribute__((ext_vector_type(2)));
typedef float f32x4 __attribute__((ext_vector_type(4)));
typedef short bf16x8 __attribute__((ext_vector_type(8)));
typedef short s16x4 __attribute__((ext_vector_type(4)));

constexpr int NWAVES = 8, NTHR = 512;
constexpr int T = 8192, D = 1024, M = 16384, NPROJ = 3072, DIN = 3104, FF = 4096;
constexpr float EPS = 1e-6f;
constexpr int C_QA = 0, C_KA = 512, C_VA = 1024, C_QG = 1536, C_KG = 1792, C_VG = 2048, C_RG = 2560;

constexpr size_t MiB = 1u << 20;
constexpr size_t WS_SS2 = 0, WS_SS3 = 65536, WS_BAR = 131072, WS_PCNT = 131072 + 16384, WS_ZERO_BYTES = 32768, WS_DEC = 262144, WS_Z = 1 * MiB;
constexpr size_t WS_WIN = 4 * MiB, WS_WO = 11 * MiB, WS_W1 = 13 * MiB, WS_W2 = 21 * MiB;
constexpr size_t WS_XN = 32 * MiB, WS_Y = 32 * MiB, WS_PROJ = 64 * MiB, WS_CON = 160 * MiB, WS_SP = 224 * MiB;
constexpr size_t WS_HB = 64 * MiB, WS_ACT = 96 * MiB, WS_END = 256 * MiB;
constexpr int LDS_BYTES = 163840;

__device__ __forceinline__ unsigned f2bf(float f) { unsigned u = __builtin_bit_cast(unsigned, f); return (u + 0x7fffu + ((u >> 16) & 1u)) >> 16; }
__device__ __forceinline__ unsigned pk2(float lo, float hi) { return f2bf(lo) | (f2bf(hi) << 16); }
__device__ __forceinline__ float bf2f(unsigned short h) { return __builtin_bit_cast(float, (unsigned)h << 16); }
__device__ __forceinline__ float wave_sum(float v) {
#pragma unroll
    for (int o = 1; o < 64; o <<= 1) v += __shfl_xor(v, o);
    return v;
}
__device__ __forceinline__ f32x4 mfma16(bf16x8 x, bf16x8 y, f32x4 c) { return __builtin_amdgcn_mfma_f32_16x16x32_bf16(x, y, c, 0, 0, 0); }
typedef short v4i16_t __attribute__((ext_vector_type(4)));
__device__ __forceinline__ s16x4 tr4(const LAS unsigned char* p) { return __builtin_bit_cast(s16x4, __builtin_amdgcn_ds_read_tr16_b64_v4i16((LAS v4i16_t*)p)); }
__device__ __forceinline__ bf16x8 cat8(s16x4 a, s16x4 b) { bf16x8 r; r[0] = a[0]; r[1] = a[1]; r[2] = a[2]; r[3] = a[3]; r[4] = b[0]; r[5] = b[1]; r[6] = b[2]; r[7] = b[3]; return r; }
__device__ __forceinline__ bf16x8 pack8(f32x4 a, f32x4 b) {
    v4u w; w.x = pg8::cvt_pk_bf16(a[0], a[1]); w.y = pg8::cvt_pk_bf16(a[2], a[3]); w.z = pg8::cvt_pk_bf16(b[0], b[1]); w.w = pg8::cvt_pk_bf16(b[2], b[3]);
    return __builtin_bit_cast(bf16x8, w);
}

struct Frame {
    LAS unsigned char* lds;
    int tid, lane, wave, vcu, G;
};

__device__ __forceinline__ void p0_transpose_item(const float* W, int K, int N, bf16* WT, const float* gk, LAS float* scr, int item, int lane) {
    const int nblk = N / 32, kb = item / nblk, nb = item % nblk, k0 = 64 * kb, n0 = 32 * nb;
#pragma unroll 8
    for (int i = 0; i < 32; ++i) { const int kk = 2 * i + (lane >> 5); float v = W[(size_t)(k0 + kk) * N + n0 + (lane & 31)]; if (gk) v *= gk[k0 + kk]; scr[kk * 33 + (lane & 31)] = v; }
    asm volatile("s_waitcnt lgkmcnt(0)" ::: "memory");
    const int c = lane & 7;
#pragma unroll
    for (int j = 0; j < 4; ++j) { const int n = (lane >> 3) + 8 * j; const LAS float* s = scr + (8 * c) * 33 + n;
        v4u o; o.x = pk2(s[0 * 33], s[1 * 33]); o.y = pk2(s[2 * 33], s[3 * 33]); o.z = pk2(s[4 * 33], s[5 * 33]); o.w = pk2(s[6 * 33], s[7 * 33]);
        *(v4u*)(WT + (size_t)(n0 + n) * K + k0 + 8 * c) = o; }
    asm volatile("s_waitcnt lgkmcnt(0)" ::: "memory");
}
__device__ __forceinline__ void phase_prologue(const Frame& F, const float* x, const float* g_mix, const float* w_in, const float* w_out, const float* g_ff, const float* w1, const float* w2, unsigned char* ws) {
    LAS float* scr = (LAS float*)(F.lds + F.wave * 16384);
    const int gw = F.vcu * NWAVES + F.wave, NGW = F.G * NWAVES;
    constexpr int I_IN = (D / 64) * (DIN / 32), I_O = (D / 64) * (D / 32), I_1 = (D / 64) * (FF / 32), I_2 = (FF / 64) * (D / 32);
    constexpr int NITEMS = I_IN + I_O + I_1 + I_2;
    for (int it = gw; it < NITEMS; it += NGW) {
        int r = it;
        if (r < I_IN) { p0_transpose_item(w_in, D, DIN, (bf16*)(ws + WS_WIN), nullptr, scr, r, F.lane); continue; } r -= I_IN;
        if (r < I_O) { p0_transpose_item(w_out, D, D, (bf16*)(ws + WS_WO), nullptr, scr, r, F.lane); continue; } r -= I_O;
        if (r < I_1) { p0_transpose_item(w1, D, FF, (bf16*)(ws + WS_W1), g_ff, scr, r, F.lane); continue; } r -= I_1;
        p0_transpose_item(w2, FF, D, (bf16*)(ws + WS_W2), nullptr, scr, r, F.lane);
    }
    { float* ss = (float*)(ws + WS_SS2); for (int i = (F.vcu * NTHR + F.tid); i < 2 * M; i += F.G * NTHR) ss[i] = 0.f; }
    bf16* XN = (bf16*)(ws + WS_XN);
    f32x4 gv[4];
#pragma unroll
    for (int j = 0; j < 4; ++j) gv[j] = ((const f32x4*)g_mix)[F.lane + 64 * j];
    for (int m = gw; m < M; m += NGW) {
        const f32x4* xr = (const f32x4*)(x + (size_t)m * D) + F.lane;
        f32x4 v[4]; float s = 0.f;
#pragma unroll
        for (int j = 0; j < 4; ++j) { v[j] = xr[64 * j]; s += (v[j].x * v[j].x + v[j].y * v[j].y) + (v[j].z * v[j].z + v[j].w * v[j].w); }
        const float rs = 1.0f / sqrtf(wave_sum(s) * (1.f / D) + EPS);
        unsigned long long* o8 = (unsigned long long*)(XN + (size_t)m * D) + F.lane;
#pragma unroll
        for (int j = 0; j < 4; ++j) { const f32x4 o = v[j] * rs * gv[j]; o8[64 * j] = (unsigned long long)pk2(o.x, o.y) | ((unsigned long long)pk2(o.z, o.w) << 32); }
    }
}

__device__ __forceinline__ void phase_z(const Frame& F, const bf16* XN, const bf16* Wz, float* Z) {
    const int fr = F.lane & 15, fq = F.lane >> 4, mt = F.wave & 3, nt = F.wave >> 2;
    for (int rb = F.vcu; rb < M / 64; rb += F.G) {
        const bf16* ap = XN + (size_t)(rb * 64 + mt * 16 + fr) * D + 8 * fq;
        const bf16* bp = Wz + (size_t)(nt * 16 + fr) * D + 8 * fq;
        f32x4 acc = {0.f, 0.f, 0.f, 0.f};
#pragma unroll 8
        for (int ks = 0; ks < D / 32; ++ks) { const bf16x8 a = *(const bf16x8*)(ap + ks * 32), b = *(const bf16x8*)(bp + ks * 32); acc = mfma16(b, a, acc); }
        *(f32x4*)(Z + (size_t)(rb * 64 + mt * 16 + fr) * 32 + nt * 16 + 4 * fq) = acc;
    }
}

constexpr int NA_STR = 144, NA_VSTR = 136, NA_K_OFF = 0, NA_V_OFF = 512 * NA_STR, NA_RPB_OFF = NA_V_OFF + 512 * NA_VSTR, NA_X_OFF = NA_RPB_OFF + 1872, NA_X_PAIR = 18 * 256;
static_assert(NA_X_OFF + 4 * NA_X_PAIR <= LDS_BYTES - 64, "natten LDS map");
__device__ __forceinline__ void natten_compute(const Frame& F, const bf16x8 (&qf)[2], bf16* Y, int b, int h, int r, int rs) {
    LAS unsigned char* lds = F.lds;
    const size_t tokq0 = (size_t)b * T + r * 64;
    const int fr = F.lane & 15, fq = F.lane >> 4, jq = F.wave & 3, kh = F.wave >> 2;
    const int wc0 = (jq == 0) ? 0 : (jq == 1) ? 8 : (jq == 2) ? 24 : 32;
    f32x4 s[8];
#pragma unroll
    for (int il = 0; il < 4; ++il)
#pragma unroll
        for (int ct = 0; ct < 2; ++ct) {
            const LAS unsigned char* kp = lds + NA_K_OFF + (((rs + 4 * kh + il) & 7) * 64 + wc0 + 16 * ct + fr) * NA_STR + fq * 16;
            const bf16x8 k0 = *(const LAS bf16x8*)kp, k1 = *(const LAS bf16x8*)(kp + 64);
            f32x4 a = {0.f, 0.f, 0.f, 0.f}; a = mfma16(k0, qf[0], a); a = mfma16(k1, qf[1], a); s[il * 2 + ct] = a; }
    const int cq = 16 * jq + fr, cs = min(max(cq - 8, 0), 48);
    const LAS float* rp = (const LAS float*)(lds + NA_RPB_OFF);
    float mx = -INFINITY;
#pragma unroll
    for (int il = 0; il < 4; ++il) { const int dr = rs + 4 * kh + il - r + 7;
#pragma unroll
        for (int ct = 0; ct < 2; ++ct)
#pragma unroll
            for (int e = 0; e < 4; ++e) { const int ck = wc0 + 16 * ct + 4 * fq + e; const bool in = (ck >= cs) && (ck < cs + 16);
                const int dc = min(max(ck - cq + 15, 0), 30);
                const float v = in ? s[il * 2 + ct][e] * 0.125f + rp[dr * 31 + dc] : -INFINITY; s[il * 2 + ct][e] = v; mx = fmaxf(mx, v); } }
    mx = fmaxf(mx, __shfl_xor(mx, 16)); mx = fmaxf(mx, __shfl_xor(mx, 32));
    float l = 0.f;
#pragma unroll
    for (int t = 0; t < 8; ++t)
#pragma unroll
        for (int e = 0; e < 4; ++e) { const float p = __expf(s[t][e] - mx); s[t][e] = p; l += p; }
    l += __shfl_xor(l, 16); l += __shfl_xor(l, 32);
    f32x4 o[4];
#pragma unroll
    for (int dt = 0; dt < 4; ++dt) o[dt] = (f32x4){0.f, 0.f, 0.f, 0.f};
#pragma unroll
    for (int il = 0; il < 4; ++il) { const bf16x8 pb = pack8(s[2 * il], s[2 * il + 1]);
#pragma unroll
        for (int dt = 0; dt < 4; ++dt) {
            const LAS unsigned char* vp = lds + NA_V_OFF + (((rs + 4 * kh + il) & 7) * 64 + wc0 + 4 * fq + (fr >> 2)) * NA_VSTR + (16 * dt + 4 * (fr & 3)) * 2;
            const bf16x8 x = cat8(tr4(vp), tr4(vp + 16 * NA_VSTR)); o[dt] = mfma16(x, pb, o[dt]); } }
    LAS float* xch = (LAS float*)(lds + NA_X_OFF + jq * NA_X_PAIR) + F.lane;
    if (kh == 1) {
#pragma unroll
        for (int dt = 0; dt < 4; ++dt)
#pragma unroll
            for (int e = 0; e < 4; ++e) xch[(dt * 4 + e) * 64] = o[dt][e];
        xch[16 * 64] = mx; xch[17 * 64] = l;
    }
    __syncthreads();
    if (kh == 0) {
        const float m1 = xch[16 * 64], l1 = xch[17 * 64], m = fmaxf(mx, m1), a0 = __expf(mx - m), a1 = __expf(m1 - m), inv = 1.0f / (a0 * l + a1 * l1), c0 = a0 * inv, c1 = a1 * inv;
#pragma unroll
        for (int dt = 0; dt < 4; ++dt) { float ov[4];
#pragma unroll
            for (int e = 0; e < 4; ++e) ov[e] = o[dt][e] * c0 + xch[(dt * 4 + e) * 64] * c1;
            v2u w; w.x = pg8::cvt_pk_bf16(ov[0], ov[1]); w.y = pg8::cvt_pk_bf16(ov[2], ov[3]);
            *(v2u*)(Y + (tokq0 + 16 * jq + fr) * D + h * 64 + 16 * dt + 4 * fq) = w; }
    }
}
__device__ __forceinline__ void natten_wg(const Frame& F, const bf16* PROJ, const float* rpb, bf16* Y, int wgi) {
    LAS unsigned char* lds = F.lds;
    const int bh = wgi >> 4, r0 = 8 * (wgi & 15), h = bh & 7, b = bh >> 3;
    const int fr = F.lane & 15, fq = F.lane >> 4, jq = F.wave & 3;
    const bf16* qbase = PROJ + ((size_t)b * T + 16 * jq + fr) * NPROJ + C_QA + h * 64 + 8 * fq;
    bf16x8 qf[2], qn[2];
    { const bf16* qp = qbase + (size_t)r0 * 64 * NPROJ; qf[0] = *(const bf16x8*)qp; qf[1] = *(const bf16x8*)(qp + 32); }
    { const int rs0 = min(max(r0 - 4, 0), 120);
#pragma unroll
      for (int it = 0; it < 8; ++it) { const int id = F.tid + NTHR * it, key = id >> 3, ch = id & 7, row = rs0 + (key >> 6), col = key & 63;
        const bf16* src = PROJ + ((size_t)b * T + row * 64 + col) * NPROJ + C_KA + h * 64 + ch * 8;
        const v4u kv = *(const v4u*)src, vv = *(const v4u*)(src + (C_VA - C_KA));
        const int kk = (row & 7) * 64 + col;
        *(LAS v4u*)(lds + NA_K_OFF + kk * NA_STR + ch * 16) = kv; *(LAS v2u*)(lds + NA_V_OFF + kk * NA_VSTR + ch * 16) = (v2u){vv.x, vv.y}; *(LAS v2u*)(lds + NA_V_OFF + kk * NA_VSTR + ch * 16 + 8) = (v2u){vv.z, vv.w}; } }
    if (F.tid < 465) ((LAS float*)(lds + NA_RPB_OFF))[F.tid] = rpb[h * 465 + F.tid];
    __syncthreads();
    for (int rr = 0; rr < 8; ++rr) {
        const int r = r0 + rr, rs = min(max(r - 4, 0), 120), rsn = min(max(r - 3, 0), 120);
        const bool more = rr < 7, slide = more && (rsn != rs);
        v4u nk = {0u, 0u, 0u, 0u}, nv = {0u, 0u, 0u, 0u};
        if (more) { const bf16* qp = qbase + (size_t)(r + 1) * 64 * NPROJ; qn[0] = *(const bf16x8*)qp; qn[1] = *(const bf16x8*)(qp + 32); }
        if (slide) { const int col = F.tid >> 3, ch = F.tid & 7; const bf16* src = PROJ + ((size_t)b * T + (rsn + 7) * 64 + col) * NPROJ + C_KA + h * 64 + ch * 8; nk = *(const v4u*)src; nv = *(const v4u*)(src + (C_VA - C_KA)); }
        natten_compute(F, qf, Y, b, h, r, rs);
        __syncthreads();
        if (slide) { const int col = F.tid >> 3, ch = F.tid & 7, kk = (((rsn + 7) & 7) * 64) + col; *(LAS v4u*)(lds + NA_K_OFF + kk * NA_STR + ch * 16) = nk;
            *(LAS v2u*)(lds + NA_V_OFF + kk * NA_VSTR + ch * 16) = (v2u){nv.x, nv.y}; *(LAS v2u*)(lds + NA_V_OFF + kk * NA_VSTR + ch * 16 + 8) = (v2u){nv.z, nv.w}; }
        if (more) { qf[0] = qn[0]; qf[1] = qn[1]; }
        __syncthreads();
    }
}

constexpr int GL_Z = 0, GL_GU = 8192, GL_GB = 16384, GL_GT = 16896, GL_I0 = 20992;
constexpr int IS = 144, IMG = 64 * IS;
constexpr int VS = 272, VIMG = 64 * VS;
constexpr int GL_QF = GL_I0, GL_QB = GL_I0 + IMG, GL_KF = GL_I0 + 2 * IMG, GL_KB = GL_I0 + 3 * IMG, GL_V = GL_I0 + 4 * IMG, GL_SF = GL_V + VIMG, GL_SB = GL_SF + VIMG;
static_assert(GL_SB + VIMG <= LDS_BYTES, "GLA LDS map");
__device__ __forceinline__ float logsig(float x) { return fminf(x, 0.f) - __logf(1.0f + __expf(-fabsf(x))); }

__device__ __forceinline__ void gla_gate_core(const Frame& F, float (&bf)[8], float (&bb)[8], float& totf, float& totb) {
    LAS unsigned char* lds = F.lds; const int tid = F.tid, d = tid & 63, g = F.wave;
    const LAS float* Zl = (const LAS float*)(lds + GL_Z); const LAS float* GU = (const LAS float*)(lds + GL_GU); const LAS float* GB = (const LAS float*)(lds + GL_GB);
    float uf[16], ub[16];
#pragma unroll
    for (int rr = 0; rr < 16; ++rr) { uf[rr] = GU[rr * 64 + d]; ub[rr] = GU[1024 + rr * 64 + d]; }
    const float gf0 = GB[d], gb0 = GB[64 + d];
    float laf[8], lab[8];
#pragma unroll
    for (int j = 0; j < 8; ++j) { const int c = 8 * g + j; float pf = gf0, pb = gb0;
#pragma unroll
        for (int r4 = 0; r4 < 4; ++r4) { const f32x4 zf = *(const LAS f32x4*)(Zl + c * 32 + 4 * r4), zb = *(const LAS f32x4*)(Zl + c * 32 + 16 + 4 * r4);
#pragma unroll
            for (int e = 0; e < 4; ++e) { pf += zf[e] * uf[4 * r4 + e]; pb += zb[e] * ub[4 * r4 + e]; } }
        laf[j] = logsig(pf) * (1.0f / 16.0f); lab[j] = logsig(pb) * (1.0f / 16.0f); }
    float run = 0.f;
#pragma unroll
    for (int j = 0; j < 8; ++j) { run += laf[j]; bf[j] = run; }
    float runb = 0.f;
#pragma unroll
    for (int j = 7; j >= 0; --j) { runb += lab[j]; bb[j] = runb; }
    LAS float* GT = (LAS float*)(lds + GL_GT);
    GT[g * 64 + d] = run; GT[512 + g * 64 + d] = runb;
    __syncthreads();
    float of = 0.f, ob = 0.f; totf = 0.f; totb = 0.f;
#pragma unroll
    for (int gp = 0; gp < 8; ++gp) { const float a = GT[gp * 64 + d], c = GT[512 + gp * 64 + d]; totf += a; totb += c; if (gp < g) of += a; if (gp > g) ob += c; }
#pragma unroll
    for (int j = 0; j < 8; ++j) { bf[j] += of; bb[j] += ob; }
}
__device__ __forceinline__ void stage_img128(LAS unsigned char* dst, const bf16* src, size_t row_stride, int tid) {
#pragma unroll
    for (int it = 0; it < 2; ++it) { const int id = tid + NTHR * it, row = id >> 4, ch = id & 15; *(LAS v4u*)(dst + row * VS + ch * 16) = *(const v4u*)(src + (size_t)row * row_stride + ch * 8); }
}

struct GlaAFetch { unsigned short kraw[8], qraw[8]; v4u v[2]; f32x4 z, gu; float gb; };
__device__ __forceinline__ void gla_a_fetch(GlaAFetch& R, const Frame& F, const bf16* PROJ, const float* Z, const float* guf, const float* gbf, const float* gub, const float* gbb, int unit) {
    const int tid = F.tid, d = tid & 63, g = F.wave;
    const int n = unit & 127, bh = unit >> 7, h = bh & 3, b = bh >> 2; const size_t t0 = (size_t)b * T + 64 * n;
#pragma unroll
    for (int j = 0; j < 8; ++j) { const bf16* p = PROJ + (t0 + 8 * g + j) * NPROJ + h * 64 + d; R.qraw[j] = p[C_QG]; R.kraw[j] = p[C_KG]; }
#pragma unroll
    for (int it = 0; it < 2; ++it) { const int id = tid + NTHR * it, row = id >> 4, ch = id & 15; R.v[it] = *(const v4u*)(PROJ + (t0 + row) * NPROJ + C_VG + h * 128 + ch * 8); }
    R.z = *(const f32x4*)(Z + t0 * 32 + tid * 4);
    { const int idx = tid * 4, dir = idx >> 10, rr = (idx >> 6) & 15, dd = idx & 63; R.gu = *(const f32x4*)((dir ? gub : guf) + rr * 256 + h * 64 + dd); }
    R.gb = (tid < 128) ? ((tid >> 6) ? gbb : gbf)[h * 64 + (tid & 63)] : 0.f;
}
__device__ __forceinline__ void phase_gla_a(const Frame& F, const bf16* PROJ, const float* Z, const float* guf, const float* gbf, const float* gub, const float* gbb, float* CON, float* DEC, bf16* IMGS) {
    LAS unsigned char* lds = F.lds; const int tid = F.tid, d = tid & 63, g = F.wave;
    GlaAFetch R;
    int unit = F.vcu;
    if (unit < 1024) gla_a_fetch(R, F, PROJ, Z, guf, gbf, gub, gbb, unit);
    for (; unit < 1024; unit += F.G) {
        unsigned short kraw[8], qraw[8];
#pragma unroll
        for (int j = 0; j < 8; ++j) { kraw[j] = R.kraw[j]; qraw[j] = R.qraw[j]; }
#pragma unroll
        for (int it = 0; it < 2; ++it) { const int id = tid + NTHR * it, row = id >> 4, ch = id & 15; *(LAS v4u*)(lds + GL_V + row * VS + ch * 16) = R.v[it]; }
        *(LAS f32x4*)(lds + GL_Z + tid * 16) = R.z; *(LAS f32x4*)(lds + GL_GU + tid * 16) = R.gu;
        if (tid < 128) ((LAS float*)(lds + GL_GB))[tid] = R.gb;
        __syncthreads();
        if (unit + F.G < 1024) gla_a_fetch(R, F, PROJ, Z, guf, gbf, gub, gbb, unit + F.G);
        float bf[8], bb[8], totf, totb;
        gla_gate_core(F, bf, bb, totf, totb);
        const float decf = __expf(totf), decb = __expf(totb);
        bf16* im = IMGS + (size_t)unit * 16384 + d;
#pragma unroll
        for (int j = 0; j < 8; ++j) { const float k = bf2f(kraw[j]), q = bf2f(qraw[j]) * 0.125f; const int c = 8 * g + j;
            const float ef = __expf(bf[j]), eb = __expf(bb[j]), rf = 1.0f / ef, rb = 1.0f / eb, kif = k * rf, kib = k * rb;
            *(LAS unsigned short*)(lds + GL_KF + c * IS + d * 2) = (unsigned short)f2bf(kif * decf);
            *(LAS unsigned short*)(lds + GL_KB + c * IS + d * 2) = (unsigned short)f2bf(kib * decb);
            im[c * 64] = (bf16)f2bf(q * ef); im[4096 + c * 64] = (bf16)f2bf(kif); im[8192 + c * 64] = (bf16)f2bf(q * eb); im[12288 + c * 64] = (bf16)f2bf(kib); }
        if (g == 0) { DEC[(size_t)unit * 64 + d] = decf; DEC[(size_t)(1024 + unit) * 64 + d] = decb; }
        __syncthreads();
        const int fr = F.lane & 15, fq = F.lane >> 4, dir = F.wave >> 2, dt = F.wave & 3;
        const LAS unsigned char* kimg = lds + (dir ? GL_KB : GL_KF);
        bf16x8 yk[2];
#pragma unroll
        for (int s = 0; s < 2; ++s) { const LAS unsigned char* p = kimg + (32 * s + 4 * fq + (fr >> 2)) * IS + (16 * dt + 4 * (fr & 3)) * 2; yk[s] = cat8(tr4(p), tr4(p + 16 * IS)); }
        float* cbase = CON + ((size_t)(dir * 1024 + unit) * 64 + 16 * dt + fr) * 128 + 4 * fq;
#pragma unroll
        for (int et = 0; et < 8; ++et) { f32x4 acc = {0.f, 0.f, 0.f, 0.f};
#pragma unroll
            for (int s = 0; s < 2; ++s) { const LAS unsigned char* p = lds + GL_V + (32 * s + 4 * fq + (fr >> 2)) * VS + (16 * et + 4 * (fr & 3)) * 2; acc = mfma16(cat8(tr4(p), tr4(p + 16 * VS)), yk[s], acc); }
            *(f32x4*)(cbase + 16 * et) = acc; }
        __syncthreads();
    }
}

__device__ __forceinline__ void phase_scan(const Frame& F, const float* __restrict__ CON, const float* __restrict__ DEC, bf16* __restrict__ SP) {
    for (int chain = F.vcu * NTHR + F.tid; chain < 2 * 8 * 64 * 128; chain += F.G * NTHR) {
        const int e = chain & 127, d = (chain >> 7) & 63, bh = (chain >> 13) & 7, dir = chain >> 16;
        const size_t ubase = (size_t)dir * 1024 + bh * 128;
        const float* con = CON + (ubase * 64 + d) * 128 + e; const float* dec = DEC + ubase * 64 + d; bf16* sp = SP + (ubase * 64 + d) * 128 + e;
        float S = 0.f;
        for (int nb = 0; nb < 16; ++nb) { float c[8], gg[8];
#pragma unroll
            for (int u = 0; u < 8; ++u) { const int n = nb * 8 + u, ne = dir ? 127 - n : n; c[u] = con[(size_t)ne * 8192]; gg[u] = dec[ne * 64]; }
#pragma unroll
            for (int u = 0; u < 8; ++u) { const int n = nb * 8 + u, ne = dir ? 127 - n : n; sp[(size_t)ne * 8192] = (bf16)f2bf(S); S = gg[u] * S + c[u]; } }
    }
}

struct GlaCFetch { v4u im[4], v[2], sf[2], sb[2]; };
__device__ __forceinline__ void gla_c_fetch(GlaCFetch& R, const bf16* PROJ, const bf16* SP, const bf16* IMGS, int unit, int tid) {
    const int n = unit & 127, bh = unit >> 7, h = bh & 3, b = bh >> 2; const size_t t0 = (size_t)b * T + 64 * n;
#pragma unroll
    for (int k = 0; k < 4; ++k) R.im[k] = *(const v4u*)(IMGS + (size_t)unit * 16384 + k * 4096 + tid * 8);
#pragma unroll
    for (int it = 0; it < 2; ++it) { const int id = tid + NTHR * it, row = id >> 4, ch = id & 15;
        R.v[it] = *(const v4u*)(PROJ + (t0 + row) * NPROJ + C_VG + h * 128 + ch * 8);
        R.sf[it] = *(const v4u*)(SP + (size_t)unit * 8192 + row * 128 + ch * 8);
        R.sb[it] = *(const v4u*)(SP + (size_t)(1024 + unit) * 8192 + row * 128 + ch * 8); }
}
__device__ __forceinline__ void gla_c_commit(const GlaCFetch& R, LAS unsigned char* lds, int tid) {
    { const int row = tid >> 3, ch = tid & 7, o = row * IS + ch * 16;
      *(LAS v4u*)(lds + GL_QF + o) = R.im[0]; *(LAS v4u*)(lds + GL_KF + o) = R.im[1]; *(LAS v4u*)(lds + GL_QB + o) = R.im[2]; *(LAS v4u*)(lds + GL_KB + o) = R.im[3]; }
#pragma unroll
    for (int it = 0; it < 2; ++it) { const int id = tid + NTHR * it, row = id >> 4, ch = id & 15, o = row * VS + ch * 16;
        *(LAS v4u*)(lds + GL_V + o) = R.v[it]; *(LAS v4u*)(lds + GL_SF + o) = R.sf[it]; *(LAS v4u*)(lds + GL_SB + o) = R.sb[it]; }
}
__device__ __forceinline__ void gla_c_compute(const Frame& F, const bf16* PROJ, const float* norm_g, bf16* Y, int unit) {
    LAS unsigned char* lds = F.lds;
    const int n = unit & 127, bh = unit >> 7, h = bh & 3, b = bh >> 2; const size_t t0 = (size_t)b * T + 64 * n;
    if (F.wave < 4) {
        const int fr = F.lane & 15, fq = F.lane >> 4, it = F.wave;
        const int i = 16 * it + fr;
        const bf16* rp = PROJ + (t0 + i) * NPROJ + C_RG + h * 128 + 4 * fq; bf16* yp = Y + (t0 + i) * D + 512 + h * 128 + 4 * fq;
        v2u rw[8];
#pragma unroll
        for (int et = 0; et < 8; ++et) rw[et] = *(const v2u*)(rp + 16 * et);
        bf16x8 yqf[2], yqb[2];
#pragma unroll
        for (int s = 0; s < 2; ++s) { const int off = (16 * it + fr) * IS + (32 * s + 8 * fq) * 2; yqf[s] = *(const LAS bf16x8*)(lds + GL_QF + off); yqb[s] = *(const LAS bf16x8*)(lds + GL_QB + off); }
        f32x4 a[4];
#pragma unroll
        for (int jt = 0; jt < 4; ++jt) { f32x4 af = {0.f, 0.f, 0.f, 0.f}, ab = {0.f, 0.f, 0.f, 0.f};
#pragma unroll
            for (int s = 0; s < 2; ++s) { const int off = (16 * jt + fr) * IS + (32 * s + 8 * fq) * 2;
                af = mfma16(*(const LAS bf16x8*)(lds + GL_KF + off), yqf[s], af); ab = mfma16(*(const LAS bf16x8*)(lds + GL_KB + off), yqb[s], ab); }
#pragma unroll
            for (int e = 0; e < 4; ++e) { const int j = 16 * jt + 4 * fq + e; a[jt][e] = (j <= i) ? af[e] : ab[e]; } }
        f32x4 o[8];
#pragma unroll
        for (int et = 0; et < 8; ++et) o[et] = (f32x4){0.f, 0.f, 0.f, 0.f};
#pragma unroll
        for (int s = 0; s < 2; ++s) { const bf16x8 pb = pack8(a[2 * s], a[2 * s + 1]);
#pragma unroll
            for (int et = 0; et < 8; ++et) { const LAS unsigned char* p = lds + GL_V + (32 * s + 4 * fq + (fr >> 2)) * VS + (16 * et + 4 * (fr & 3)) * 2; o[et] = mfma16(cat8(tr4(p), tr4(p + 16 * VS)), pb, o[et]); } }
#pragma unroll
        for (int s = 0; s < 2; ++s)
#pragma unroll
            for (int et = 0; et < 8; ++et) { const int off = (32 * s + 8 * fq + (fr >> 2)) * VS + (16 * et + 4 * (fr & 3)) * 2;
                o[et] = mfma16(cat8(tr4(lds + GL_SF + off), tr4(lds + GL_SF + off + 4 * VS)), yqf[s], o[et]);
                o[et] = mfma16(cat8(tr4(lds + GL_SB + off), tr4(lds + GL_SB + off + 4 * VS)), yqb[s], o[et]); }
        float ss = 0.f;
#pragma unroll
        for (int et = 0; et < 8; ++et) ss += (o[et][0] * o[et][0] + o[et][1] * o[et][1]) + (o[et][2] * o[et][2] + o[et][3] * o[et][3]);
        ss += __shfl_xor(ss, 16); ss += __shfl_xor(ss, 32);
        const float rs = 1.0f / sqrtf(ss * (1.0f / 128.0f) + EPS);
#pragma unroll
        for (int et = 0; et < 8; ++et) { const f32x4 gn = *(const f32x4*)(norm_g + 16 * et + 4 * fq);
            float rv[4] = {__builtin_bit_cast(float, rw[et].x << 16), __builtin_bit_cast(float, rw[et].x & 0xffff0000u), __builtin_bit_cast(float, rw[et].y << 16), __builtin_bit_cast(float, rw[et].y & 0xffff0000u)};
            float ov[4];
#pragma unroll
            for (int e = 0; e < 4; ++e) { const float sg = rv[e] / (1.0f + __expf(-rv[e])); ov[e] = o[et][e] * rs * gn[e] * sg; }
            v2u w; w.x = pg8::cvt_pk_bf16(ov[0], ov[1]); w.y = pg8::cvt_pk_bf16(ov[2], ov[3]); *(v2u*)(yp + 16 * et) = w; }
    }
}
__device__ __forceinline__ void phase_gla_c(const Frame& F, const bf16* PROJ, const bf16* SP, const bf16* IMGS, const float* norm_g, bf16* Y) {
    GlaCFetch R;
    int u = F.vcu;
    if (u < 1024) gla_c_fetch(R, PROJ, SP, IMGS, u, F.tid);
    for (; u < 1024; u += F.G) {
        gla_c_commit(R, F.lds, F.tid);
        __syncthreads();
        if (u + F.G < 1024) gla_c_fetch(R, PROJ, SP, IMGS, u + F.G, F.tid);
        gla_c_compute(F, PROJ, norm_g, Y, u);
        __syncthreads();
    }
}

__device__ __forceinline__ void phase_final(const Frame& F, float* out, const float* ss, const float* g) {
    const int gw = F.vcu * NWAVES + F.wave, NGW = F.G * NWAVES;
    f32x4 gv[4];
#pragma unroll
    for (int j = 0; j < 4; ++j) gv[j] = ((const f32x4*)g)[F.lane + 64 * j];
    for (int m = gw; m < M; m += NGW) { f32x4* xr = (f32x4*)(out + (size_t)m * D) + F.lane; const float rs = 1.0f / sqrtf(ss[m] * (1.f / D) + EPS);
#pragma unroll
        for (int j = 0; j < 4; ++j) xr[64 * j] = xr[64 * j] * rs * gv[j]; }
}

#define XB_TMO      128
#define XB_XCNT(j)  (256  + 64 * (j))
#define XB_XSUB(j)  (1280 + 64 * (j))
#define XB_XGEN(j)  (2304 + 64 * (j))
#define XB_TOP      3328
#define XB_TOPGEN   3392
#define XCD_BAR_WORDS 3456
#define XB_SPIN_CAP (1u << 18)

__device__ __forceinline__ unsigned xb_ld(unsigned* p)              { return __hip_atomic_load(p, __ATOMIC_RELAXED, __HIP_MEMORY_SCOPE_AGENT); }
__device__ __forceinline__ unsigned xb_add(unsigned* p, unsigned v) { return __hip_atomic_fetch_add(p, v, __ATOMIC_RELAXED, __HIP_MEMORY_SCOPE_AGENT); }
__device__ __forceinline__ unsigned xb_xcc_id() { return (unsigned)__builtin_amdgcn_s_getreg((3 << 11) | 20) & 0xFu; }
#define XB_SPIN(cond, bar) do { unsigned _sp = 0; while (cond) { __builtin_amdgcn_s_sleep(1); \
    if ((++_sp & 255u) == 0u) { if (xb_ld(&(bar)[XB_TMO])) break; if (_sp > XB_SPIN_CAP) { atomicAdd(&(bar)[XB_TMO], 1u); break; } } } } while (0)

struct XcdBarrier {
    unsigned* bar; unsigned x;
    volatile LAS unsigned* st;
};

__device__ __forceinline__ XcdBarrier xcd_barrier_post(unsigned* bar, volatile LAS unsigned* st) {
    XcdBarrier b; b.bar = bar; b.x = xb_xcc_id(); b.st = st;
    if (threadIdx.x == 0) (void)xb_add(&bar[XB_XCNT(b.x)], 1u);
    return b;
}
__device__ __forceinline__ void xcd_barrier_complete(unsigned* bar, unsigned x, unsigned& nloc, unsigned& nx) {
    const unsigned G = gridDim.x * gridDim.y * gridDim.z;
    unsigned sum, cnt, mine, sp = 0u;
    for (;;) {
        sum = 0u; cnt = 0u; mine = 0u;
#pragma unroll
        for (unsigned j = 0; j < 16; ++j) { const unsigned c = xb_ld(&bar[XB_XCNT(j)]); sum += c; cnt += (c > 0u) ? 1u : 0u; mine = (j == x) ? c : mine; }
        if (sum == G) break;
        __builtin_amdgcn_s_sleep(1);
        if ((++sp & 255u) == 0u) { if (xb_ld(&bar[XB_TMO])) break; if (sp > XB_SPIN_CAP) { atomicAdd(&bar[XB_TMO], 1u); break; } }
    }
    nloc = mine > 0u ? mine : 1u; nx = cnt > 0u ? cnt : 1u;
}

__device__ __forceinline__ void xcd_barrier(const XcdBarrier& b) {
    asm volatile("s_waitcnt vmcnt(0)" ::: "memory");
    __syncthreads();
    if (threadIdx.x == 0) {
        unsigned* bar = b.bar;
        __builtin_amdgcn_s_waitcnt(0);
        unsigned nloc = b.st[0], nx = b.st[1];
        if (nloc == 0u) { xcd_barrier_complete(bar, b.x, nloc, nx); b.st[0] = nloc; b.st[1] = nx; }
        const unsigned old = xb_add(&bar[XB_XSUB(b.x)], 1u);
        const unsigned gen = old / nloc;
        if (old + 1u == (gen + 1u) * nloc) {
            __builtin_amdgcn_fence(__ATOMIC_RELEASE, "agent");
            asm volatile("s_waitcnt vmcnt(0)" ::: "memory");
            const unsigned og = xb_add(&bar[XB_TOP], 1u);
            const unsigned tg = og / nx;
            if (og + 1u == (tg + 1u) * nx) xb_add(&bar[XB_TOPGEN], 1u);
            else XB_SPIN(xb_ld(&bar[XB_TOPGEN]) == tg, bar);
            __builtin_amdgcn_fence(__ATOMIC_ACQUIRE, "agent");
            xb_add(&bar[XB_XGEN(b.x)], 1u);
            asm volatile("s_waitcnt vmcnt(0)" ::: "memory");
        } else {
            XB_SPIN(xb_ld(&bar[XB_XGEN(b.x)]) == gen, bar);
            __builtin_amdgcn_fence(__ATOMIC_ACQUIRE, "agent");
            asm volatile("s_waitcnt vmcnt(0)" ::: "memory");
        }
    }
    __syncthreads();
}
#ifndef MK_DUP
#define MK_DUP 0
#endif
struct Args { const float* in[14]; float* out; unsigned char* ws; int lo, hi; };
constexpr int NPHASE = 9;
__global__ void __launch_bounds__(NTHR, 2) mk_fwd(Args a) {
    extern __shared__ __attribute__((aligned(16))) unsigned char lds_raw[];
    Frame F; F.lds = (LAS unsigned char*)lds_raw; F.tid = threadIdx.x; F.lane = F.tid & 63; F.wave = __builtin_amdgcn_readfirstlane(F.tid >> 6);
    F.G = gridDim.x; { const int bx = blockIdx.x; F.vcu = (F.G % 8 == 0) ? (bx % 8) * (F.G / 8) + bx / 8 : bx; }
    unsigned char* ws = a.ws;
    const float* x = a.in[0];
    bf16* XN = (bf16*)(ws + WS_XN); bf16* Yb = (bf16*)(ws + WS_Y); bf16* PROJ = (bf16*)(ws + WS_PROJ); bf16* HB = (bf16*)(ws + WS_HB); bf16* ACT = (bf16*)(ws + WS_ACT);
    float* Z = (float*)(ws + WS_Z); float* CON = (float*)(ws + WS_CON); float* DEC = (float*)(ws + WS_DEC); bf16* SP = (bf16*)(ws + WS_SP);
    float* SS2 = (float*)(ws + WS_SS2); float* SS3 = (float*)(ws + WS_SS3);
    const int lo = a.lo, hi = a.hi;
#define IN(k) (lo <= (k) && (k) < hi)
#define SEAM(k) do { if (IN(k) && IN((k) + 1)) xcd_barrier(bar); } while (0)
    volatile LAS unsigned* MISC = (volatile LAS unsigned*)(F.lds + LDS_BYTES - 64);
    if (F.tid < 16) MISC[F.tid] = 0u;
    __syncthreads();
    unsigned* barw = (unsigned*)(ws + WS_BAR);
    if (a.lo < 0) cg::this_grid().sync();
    XcdBarrier bar; bar.bar = barw; bar.x = 0; bar.st = nullptr;
    if (hi - lo > 1) bar = xcd_barrier_post(barw, MISC + 8);
    for (int rep_ = 0; rep_ < 1 + (MK_DUP & 1); ++rep_) if (IN(0)) phase_prologue(F, x, a.in[1], a.in[2], a.in[9], a.in[10], a.in[11], a.in[12], ws);
    SEAM(0);
    if (IN(1)) {
        pg8::Gemm g{XN, (const bf16*)(ws + WS_WIN), M, NPROJ, D}; pg8::StaticOrder S; S.init(M, NPROJ, F.G, (int)blockIdx.x);
        pg8::EpiProj E{PROJ, NPROJ};
        pg8::gemm_phase<pg8::EpiProj, pg8::StaticOrder, true, true>(F.lds, g, S, E);
        phase_z(F, XN, (const bf16*)(ws + WS_WIN) + (size_t)NPROJ * D, Z);
    }
#if (MK_DUP >> 1) & 1
    if (IN(1)) {
        pg8::Gemm g{XN, (const bf16*)(ws + WS_WIN), M, NPROJ, D}; pg8::StaticOrder S; S.init(M, NPROJ, F.G, (int)blockIdx.x);
        pg8::EpiProj E{PROJ, NPROJ};
        pg8::gemm_phase<pg8::EpiProj, pg8::StaticOrder, true, true>(F.lds, g, S, E);
        phase_z(F, XN, (const bf16*)(ws + WS_WIN) + (size_t)NPROJ * D, Z);
    }
#endif
    SEAM(1);
    for (int rep_ = 0; rep_ < 1 + ((MK_DUP >> 2) & 1); ++rep_) if (IN(2)) {
        for (int rep2_ = 0; rep2_ < 1 + ((MK_DUP >> 9) & 1); ++rep2_)
        phase_gla_a(F, PROJ, Z, a.in[4], a.in[5], a.in[6], a.in[7], CON, DEC, (bf16*)a.out);
        for (int rep2_ = 0; rep2_ < 1 + ((MK_DUP >> 10) & 1); ++rep2_)
        for (int w = F.vcu; w < 256; w += F.G) natten_wg(F, PROJ, a.in[3], Yb, w);
    }
    SEAM(2);
    for (int rep_ = 0; rep_ < 1 + ((MK_DUP >> 3) & 1); ++rep_) if (IN(3)) phase_scan(F, CON, DEC, SP);
    SEAM(3);
    for (int rep_ = 0; rep_ < 1 + ((MK_DUP >> 4) & 1); ++rep_) if (IN(4)) phase_gla_c(F, PROJ, SP, (const bf16*)a.out, a.in[8], Yb);
    SEAM(4);
    if (IN(5)) {
        pg8::Gemm g{Yb, (const bf16*)(ws + WS_WO), M, D, D}; pg8::StaticOrder S; S.init(M, D, F.G, (int)blockIdx.x);
#if (MK_DUP >> 5) & 1
        { pg8::EpiResB E0{x, HB, (float*)(ws + WS_DEC), D}; pg8::gemm_phase<pg8::EpiResB, pg8::StaticOrder, false, true>(F.lds, g, S, E0); }
#endif
        pg8::EpiResB E{x, HB, SS2, D};
        pg8::gemm_phase<pg8::EpiResB, pg8::StaticOrder, false, true>(F.lds, g, S, E);
    }
    SEAM(5);
    if (IN(6)) {
        pg8::Gemm g{HB, (const bf16*)(ws + WS_W1), M, FF, D}; pg8::StaticOrder S; S.init(M, FF, F.G, (int)blockIdx.x);
        pg8::EpiFF1 E{ACT, FF, SS2, 1.0f / D, EPS};
        pg8::gemm_phase<pg8::EpiFF1, pg8::StaticOrder, true, true>(F.lds, g, S, E);
    }
#if (MK_DUP >> 6) & 1
    if (IN(6)) {
        pg8::Gemm g{HB, (const bf16*)(ws + WS_W1), M, FF, D}; pg8::StaticOrder S; S.init(M, FF, F.G, (int)blockIdx.x);
        pg8::EpiFF1 E{ACT, FF, SS2, 1.0f / D, EPS};
        pg8::gemm_phase<pg8::EpiFF1, pg8::StaticOrder, true, true>(F.lds, g, S, E);
    }
#endif
    SEAM(6);
#if (MK_DUP >> 11) & 1
    for (int k_ = 0; k_ < 8; ++k_) xcd_barrier(bar);
#endif
    if (IN(7)) {
        pg8::Gemm g{ACT, (const bf16*)(ws + WS_W2), M, D, FF}; pg8::StaticOrder S; S.init(M, D, F.G, (int)blockIdx.x);
        const int fuse = (F.G == 256 && hi - lo > 1) ? 1 : 0;
#if (MK_DUP >> 7) & 1
        { pg8::EpiResNormB E0{HB, a.out, (float*)(ws + WS_DEC), (unsigned*)(ws + WS_PCNT), a.in[13], D, 0, 8u * (D / 256), 1.0f / D, EPS}; pg8::gemm_phase<pg8::EpiResNormB, pg8::StaticOrder, false, true>(F.lds, g, S, E0); }
#endif
        pg8::EpiResNormB E{HB, a.out, SS3, (unsigned*)(ws + WS_PCNT), a.in[13], D, fuse, 8u * (D / 256), 1.0f / D, EPS};
        pg8::gemm_phase<pg8::EpiResNormB, pg8::StaticOrder, false, true>(F.lds, g, S, E);
    }
    if (!(F.G == 256 && hi - lo > 1)) {
        SEAM(7);
        if (IN(8)) phase_final(F, a.out, SS3, a.in[13]);
    }
#undef IN
#undef SEAM
}

#ifndef MK_ONE_LAUNCH
#define MK_ONE_LAUNCH 1
#endif
extern "C" void kernel_launch(void* const* d_in, const int* in_sizes, int n_in, void* d_out, int out_size, void* d_ws, size_t ws_size, hipStream_t stream) {
    static int grid = 0;
    if (grid == 0) {
        if (n_in != 14 || out_size != M * D || ws_size < WS_END) { fprintf(stderr, "kernel_launch: unexpected shapes (n_in %d out %d ws %zu)\n", n_in, out_size, ws_size); grid = -1; return; }
        int dev = 0, cus = 0, per_cu = 0;
        hipGetDevice(&dev); hipDeviceGetAttribute(&cus, hipDeviceAttributeMultiprocessorCount, dev);
        if (hipFuncSetAttribute((const void*)mk_fwd, hipFuncAttributeMaxDynamicSharedMemorySize, LDS_BYTES) != hipSuccess) { fprintf(stderr, "kernel_launch: hipFuncSetAttribute failed\n"); grid = -1; return; }
        if (hipOccupancyMaxActiveBlocksPerMultiprocessor(&per_cu, (const void*)mk_fwd, NTHR, LDS_BYTES) != hipSuccess || per_cu < 1) { fprintf(stderr, "kernel_launch: occupancy query says %d\n", per_cu); per_cu = 1; }
        (void)hipGetLastError();
        grid = cus * 1;
    }
    if (grid < 0) return;
    Args a{};
    for (int i = 0; i < 14; ++i) a.in[i] = (const float*)d_in[i];
    a.out = (float*)d_out; a.ws = (unsigned char*)d_ws;
#if MK_ONE_LAUNCH
    if (hipMemsetAsync((char*)d_ws + WS_BAR, 0, WS_ZERO_BYTES, stream) != hipSuccess) { fprintf(stderr, "kernel_launch: memset of the barrier words failed\n"); return; }
    a.lo = 0; a.hi = NPHASE;
    void* args[] = {&a};
    hipError_t e = hipLaunchCooperativeKernel((const void*)mk_fwd, dim3(grid), dim3(NTHR), args, LDS_BYTES, stream);
    if (e != hipSuccess) fprintf(stderr, "cooperative launch failed: %s (grid %d)\n", hipGetErrorString(e), grid);
#else
    for (int p = 0; p < NPHASE; ++p) { a.lo = p; a.hi = p + 1; hipLaunchKernelGGL(mk_fwd, dim3(grid), dim3(NTHR), LDS_BYTES, stream, a); }
#endif
}
```

```cpp
#include <hip/hip_runtime.h>
#include <hip/hip_cooperative_groups.h>
#include <cstdio>
#include <cstdint>
#include <cmath>
namespace cg = cooperative_groups;
namespace pg8 {
#define PG8_LAS __attribute__((address_space(3)))
typedef unsigned short bf16_t;
typedef short bf16x8 __attribute__((ext_vector_type(8)));
typedef float f32x4 __attribute__((ext_vector_type(4)));
typedef unsigned u32x4 __attribute__((ext_vector_type(4)));
constexpr int BM = 256, BK = 64, HALF = 128, HTB = HALF * BK * 2  , STAGE_BYTES = 8 * HTB, NXCD = 8, WGM = 8;

__host__ __device__ __forceinline__ int lds_byte(int r, int c) { const int st = (r >> 4) * 2 + (c >> 5), rr = r & 15, cc = c & 31, ob = rr * 64 + cc * 2; return st * 1024 + (ob ^ (((ob >> 9) & 1) << 5)); }
__host__ __device__ __forceinline__ void stage_rc(int b, int& R, int& C) { const int st = b / 1024, sb = b % 1024, swz = sb ^ (((sb >> 9) & 1) << 5); R = (st >> 1) * 16 + swz / 64; C = (st & 1) * 32 + (swz % 64) / 2; }
__host__ __device__ __forceinline__ int perm32(int rho) { const int n = rho >> 4, i = rho & 15; return 8 * (i >> 2) + 4 * n + (i & 3); }

struct Unit { int pm, pn; };
struct Gemm { const bf16_t* A; const bf16_t* Bt; int M, N, K; };

struct StaticOrder {
    int nM, nN, nwg, G, c;
    __host__ __device__ void init(int M, int N, int G_, int c_) { nM = M / BM; nN = N / BM; nwg = nM * nN; G = G_; c = c_; }
    __host__ __device__ bool next(int i, Unit& u) const {
        const long L = (long)i * G + c; if (L >= nwg) return false;
        int wgid = (int)L; { const int q = nwg / NXCD, r = nwg % NXCD, xcd = wgid % NXCD, off = wgid / NXCD; wgid = (xcd < r ? xcd * (q + 1) : r * (q + 1) + (xcd - r) * q) + off; }
        const int nig = WGM * nN, gid = wgid / nig, fm = gid * WGM, gsz = (nM - fm) < WGM ? (nM - fm) : WGM;
        u.pm = fm + ((wgid % nig) % gsz); u.pn = (wgid % nig) / gsz; return true;
    }
    __device__ __forceinline__ void a_ready(const Unit&) const {}
    __device__ __forceinline__ void done(const Unit&) const {}
};

__device__ __forceinline__ unsigned cvt_pk_bf16(float lo, float hi) { unsigned r; asm volatile("v_cvt_pk_bf16_f32 %0, %1, %2" : "=v"(r) : "v"(lo), "v"(hi)); return r; }
typedef unsigned u32x2 __attribute__((ext_vector_type(2)));
struct EpiProj {
    static constexpr bool PERM = true, AFTER_DRAIN = false;
    bf16_t* O; int ldc;
    __device__ __forceinline__ void operator()(const f32x4 (&acc)[2][2][4][2], const Unit& u, int wr, int wc, int fr, int fq) const {
        const int row0 = u.pm * BM + wr * 64 + fr, col0 = u.pn * BM + wc * 32 + 8 * fq;
#pragma unroll
        for (int ai = 0; ai < 2; ++ai)
#pragma unroll
            for (int m = 0; m < 4; ++m) { bf16_t* rowp = O + (size_t)(row0 + ai * HALF + m * 16) * ldc + col0;
#pragma unroll
                for (int bj = 0; bj < 2; ++bj) { const f32x4 v0 = acc[ai][bj][m][0], v1 = acc[ai][bj][m][1];
                    u32x4 w; w.x = cvt_pk_bf16(v0[0], v0[1]); w.y = cvt_pk_bf16(v0[2], v0[3]); w.z = cvt_pk_bf16(v1[0], v1[1]); w.w = cvt_pk_bf16(v1[2], v1[3]);
                    *(u32x4*)(rowp + bj * HALF) = w; } }
    }
};
struct EpiFF1 {
    static constexpr bool PERM = true, AFTER_DRAIN = false;
    bf16_t* O; int ldc; const float* sumsq; float inv_n, eps;
    __device__ __forceinline__ void operator()(const f32x4 (&acc)[2][2][4][2], const Unit& u, int wr, int wc, int fr, int fq) const {
        const int row0 = u.pm * BM + wr * 64 + fr, col0 = u.pn * BM + wc * 32 + 8 * fq;
#pragma unroll
        for (int ai = 0; ai < 2; ++ai)
#pragma unroll
            for (int m = 0; m < 4; ++m) { const int row = row0 + ai * HALF + m * 16; bf16_t* rowp = O + (size_t)row * ldc + col0;
                const float rs = 1.0f / sqrtf(sumsq[row] * inv_n + eps);
#pragma unroll
                for (int bj = 0; bj < 2; ++bj) { f32x4 v0 = acc[ai][bj][m][0] * rs, v1 = acc[ai][bj][m][1] * rs;
#pragma unroll
                    for (int e = 0; e < 4; ++e) { const float a = fmaxf(v0[e], 0.f), b = fmaxf(v1[e], 0.f); v0[e] = a * a; v1[e] = b * b; }
                    u32x4 w; w.x = cvt_pk_bf16(v0[0], v0[1]); w.y = cvt_pk_bf16(v0[2], v0[3]); w.z = cvt_pk_bf16(v1[0], v1[1]); w.w = cvt_pk_bf16(v1[2], v1[3]);
                    *(u32x4*)(rowp + bj * HALF) = w; } }
    }
};
struct EpiRes {
    static constexpr bool PERM = false, AFTER_DRAIN = false;
    const float* base; float* out; bf16_t* hb; float* sumsq; int ldc;
    __device__ __forceinline__ void operator()(const f32x4 (&acc)[2][2][4][2], const Unit& u, int wr, int wc, int fr, int fq) const {
        const int col0 = u.pn * BM + wc * 32 + 4 * fq;
#pragma unroll
        for (int ai = 0; ai < 2; ++ai)
#pragma unroll
            for (int m = 0; m < 4; ++m) { const int row = u.pm * BM + ai * HALF + wr * 64 + m * 16 + fr; const size_t off = (size_t)row * ldc + col0; float s = 0.f;
#pragma unroll
                for (int bj = 0; bj < 2; ++bj)
#pragma unroll
                    for (int n = 0; n < 2; ++n) { const f32x4 bs = *(const f32x4*)(base + off + bj * HALF + n * 16); const f32x4 o = bs + acc[ai][bj][m][n];
                        *(f32x4*)(out + off + bj * HALF + n * 16) = o;
                        if (hb) { u32x2 w; w.x = cvt_pk_bf16(o[0], o[1]); w.y = cvt_pk_bf16(o[2], o[3]); *(u32x2*)(hb + off + bj * HALF + n * 16) = w; }
                        s += (o[0] * o[0] + o[1] * o[1]) + (o[2] * o[2] + o[3] * o[3]); }
                s += __shfl_xor(s, 16); s += __shfl_xor(s, 32);
                if (fq == 0) unsafeAtomicAdd(sumsq + row, s);
                asm volatile("" ::: "memory"); }
    }
};

struct EpiResNorm {
    static constexpr bool PERM = false, AFTER_DRAIN = true;
    const float* base; float* out; float* sumsq; unsigned* cnt; const float* g; int ldc; int fuse; unsigned want; float inv_n, eps;
    __device__ __forceinline__ void fused(f32x4 (&acc)[2][2][4][2], const Unit& u, int wr, int wc, int fr, int fq, PG8_LAS unsigned char* lds, int wid, int lane) const {
        const int col0 = u.pn * BM + wc * 32 + 4 * fq;
#pragma unroll
        for (int ai = 0; ai < 2; ++ai)
#pragma unroll
            for (int m = 0; m < 4; ++m) { const int row = u.pm * BM + ai * HALF + wr * 64 + m * 16 + fr; const size_t off = (size_t)row * ldc + col0; float s = 0.f;
#pragma unroll
                for (int bj = 0; bj < 2; ++bj)
#pragma unroll
                    for (int n = 0; n < 2; ++n) { const f32x4 bs = *(const f32x4*)(base + off + bj * HALF + n * 16); const f32x4 o = bs + acc[ai][bj][m][n]; acc[ai][bj][m][n] = o;
                        if (!fuse) *(f32x4*)(out + off + bj * HALF + n * 16) = o;
                        s += (o[0] * o[0] + o[1] * o[1]) + (o[2] * o[2] + o[3] * o[3]); }
                s += __shfl_xor(s, 16); s += __shfl_xor(s, 32);
                if (fq == 0) unsafeAtomicAdd(sumsq + row, s);
                asm volatile("" ::: "memory"); }
        if (!fuse) return;
        asm volatile("s_waitcnt vmcnt(0)" ::: "memory");
        if (lane == 0) __hip_atomic_fetch_add(cnt + 64 * u.pm, 1u, __ATOMIC_RELAXED, __HIP_MEMORY_SCOPE_AGENT);
        if (wid == 0) { while ((unsigned)__builtin_amdgcn_readfirstlane(__hip_atomic_load(cnt + 64 * u.pm, __ATOMIC_RELAXED, __HIP_MEMORY_SCOPE_AGENT)) < want) __builtin_amdgcn_s_sleep(2); }
        asm volatile("s_waitcnt vmcnt(0) lgkmcnt(0)" ::: "memory"); __builtin_amdgcn_s_barrier(); asm volatile("" ::: "memory");
        __builtin_amdgcn_fence(__ATOMIC_ACQUIRE, "agent");
        f32x4 gv[2][2];
#pragma unroll
        for (int bj = 0; bj < 2; ++bj)
#pragma unroll
            for (int n = 0; n < 2; ++n) gv[bj][n] = *(const f32x4*)(g + col0 + bj * HALF + n * 16);
#pragma unroll
        for (int ai = 0; ai < 2; ++ai)
#pragma unroll
            for (int m = 0; m < 4; ++m) { const int row = u.pm * BM + ai * HALF + wr * 64 + m * 16 + fr; const size_t off = (size_t)row * ldc + col0;
                const float ssv = __hip_atomic_load(sumsq + row, __ATOMIC_RELAXED, __HIP_MEMORY_SCOPE_AGENT); const float rs = 1.0f / sqrtf(ssv * inv_n + eps);
#pragma unroll
                for (int bj = 0; bj < 2; ++bj)
#pragma unroll
                    for (int n = 0; n < 2; ++n) *(f32x4*)(out + off + bj * HALF + n * 16) = acc[ai][bj][m][n] * rs * gv[bj][n]; }
    }
};

struct EpiResB {
    static constexpr bool PERM = true, AFTER_DRAIN = false;
    const float* base; bf16_t* hb; float* sumsq; int ldc;
    __device__ __forceinline__ void operator()(const f32x4 (&acc)[2][2][4][2], const Unit& u, int wr, int wc, int fr, int fq) const {
        const int col0 = u.pn * BM + wc * 32 + 8 * fq;
#pragma unroll
        for (int ai = 0; ai < 2; ++ai)
#pragma unroll
            for (int m = 0; m < 4; ++m) { const int row = u.pm * BM + ai * HALF + wr * 64 + m * 16 + fr; const size_t off = (size_t)row * ldc + col0; float s = 0.f;
#pragma unroll
                for (int bj = 0; bj < 2; ++bj) { const f32x4 b0 = *(const f32x4*)(base + off + bj * HALF), b1 = *(const f32x4*)(base + off + bj * HALF + 4);
                    const f32x4 o0 = b0 + acc[ai][bj][m][0], o1 = b1 + acc[ai][bj][m][1];
                    u32x4 w; w.x = cvt_pk_bf16(o0[0], o0[1]); w.y = cvt_pk_bf16(o0[2], o0[3]); w.z = cvt_pk_bf16(o1[0], o1[1]); w.w = cvt_pk_bf16(o1[2], o1[3]);
                    *(u32x4*)(hb + off + bj * HALF) = w;
                    s += (o0[0] * o0[0] + o0[1] * o0[1]) + (o0[2] * o0[2] + o0[3] * o0[3]) + (o1[0] * o1[0] + o1[1] * o1[1]) + (o1[2] * o1[2] + o1[3] * o1[3]); }
                s += __shfl_xor(s, 16); s += __shfl_xor(s, 32);
                if (fq == 0) unsafeAtomicAdd(sumsq + row, s);
                asm volatile("" ::: "memory"); }
    }
};
struct EpiResNormB {
    static constexpr bool PERM = true, AFTER_DRAIN = true;
    const bf16_t* hb; float* out; float* sumsq; unsigned* cnt; const float* g; int ldc; int fuse; unsigned want; float inv_n, eps;
    __device__ __forceinline__ void fused(f32x4 (&acc)[2][2][4][2], const Unit& u, int wr, int wc, int fr, int fq, PG8_LAS unsigned char* lds, int wid, int lane) const {
        const int col0 = u.pn * BM + wc * 32 + 8 * fq;
#pragma unroll
        for (int ai = 0; ai < 2; ++ai)
#pragma unroll
            for (int m = 0; m < 4; ++m) { const int row = u.pm * BM + ai * HALF + wr * 64 + m * 16 + fr; const size_t off = (size_t)row * ldc + col0; float s = 0.f;
#pragma unroll
                for (int bj = 0; bj < 2; ++bj) { const u32x4 w = *(const u32x4*)(hb + off + bj * HALF);
                    const f32x4 b0 = {__builtin_bit_cast(float, w.x << 16), __builtin_bit_cast(float, w.x & 0xffff0000u), __builtin_bit_cast(float, w.y << 16), __builtin_bit_cast(float, w.y & 0xffff0000u)};
                    const f32x4 b1 = {__builtin_bit_cast(float, w.z << 16), __builtin_bit_cast(float, w.z & 0xffff0000u), __builtin_bit_cast(float, w.w << 16), __builtin_bit_cast(float, w.w & 0xffff0000u)};
                    const f32x4 o0 = b0 + acc[ai][bj][m][0], o1 = b1 + acc[ai][bj][m][1]; acc[ai][bj][m][0] = o0; acc[ai][bj][m][1] = o1;
                    if (!fuse) { *(f32x4*)(out + off + bj * HALF) = o0; *(f32x4*)(out + off + bj * HALF + 4) = o1; }
                    s += (o0[0] * o0[0] + o0[1] * o0[1]) + (o0[2] * o0[2] + o0[3] * o0[3]) + (o1[0] * o1[0] + o1[1] * o1[1]) + (o1[2] * o1[2] + o1[3] * o1[3]); }
                s += __shfl_xor(s, 16); s += __shfl_xor(s, 32);
                if (fq == 0) unsafeAtomicAdd(sumsq + row, s);
                asm volatile("" ::: "memory"); }
        if (!fuse) return;
        asm volatile("s_waitcnt vmcnt(0)" ::: "memory");
        if (lane == 0) __hip_atomic_fetch_add(cnt + 64 * u.pm, 1u, __ATOMIC_RELAXED, __HIP_MEMORY_SCOPE_AGENT);
        if (wid == 0) { while ((unsigned)__builtin_amdgcn_readfirstlane(__hip_atomic_load(cnt + 64 * u.pm, __ATOMIC_RELAXED, __HIP_MEMORY_SCOPE_AGENT)) < want) __builtin_amdgcn_s_sleep(2); }
        asm volatile("s_waitcnt vmcnt(0) lgkmcnt(0)" ::: "memory"); __builtin_amdgcn_s_barrier(); asm volatile("" ::: "memory");
        __builtin_amdgcn_fence(__ATOMIC_ACQUIRE, "agent");
        f32x4 gv[2][2];
#pragma unroll
        for (int bj = 0; bj < 2; ++bj)
#pragma unroll
            for (int n = 0; n < 2; ++n) gv[bj][n] = *(const f32x4*)(g + col0 + bj * HALF + n * 4);
#pragma unroll
        for (int ai = 0; ai < 2; ++ai)
#pragma unroll
            for (int m = 0; m < 4; ++m) { const int row = u.pm * BM + ai * HALF + wr * 64 + m * 16 + fr; const size_t off = (size_t)row * ldc + col0;
                const float ssv = __hip_atomic_load(sumsq + row, __ATOMIC_RELAXED, __HIP_MEMORY_SCOPE_AGENT); const float rs = 1.0f / sqrtf(ssv * inv_n + eps);
#pragma unroll
                for (int bj = 0; bj < 2; ++bj)
#pragma unroll
                    for (int n = 0; n < 2; ++n) *(f32x4*)(out + off + bj * HALF + n * 4) = acc[ai][bj][m][n] * rs * gv[bj][n]; }
    }
};
template <class Epi, class Sched, bool ALIGN_EPI = false, bool SP2 = false>
__device__ __forceinline__ void gemm_phase(PG8_LAS unsigned char* lds, const Gemm g, const Sched& S, const Epi& E) {
    const int tid = threadIdx.x, wid = __builtin_amdgcn_readfirstlane(tid >> 6), lane = tid & 63, wr = wid >> 2, wc = wid & 3, fr = lane & 15, fq = lane >> 4;
    const int K = g.K, nt = K / BK;
    unsigned voffA[2], voffB[2];
#pragma unroll
    for (int i = 0; i < 2; ++i) { int R, C; stage_rc(tid * 16 + i * 8192, R, C); const int Rb = Epi::PERM ? ((R & ~31) + perm32(R & 31)) : R;
        voffA[i] = (unsigned)(R * K + C) * 2u; voffB[i] = (unsigned)(Rb * K + C) * 2u; }
    const size_t kstep = (size_t)(BK * 2);
    const size_t hstep = (size_t)HALF * K * 2;
    const size_t tstep = 2 * hstep;
    const unsigned ldsw = (unsigned)wid * 1024u;
    const int aoff = lds_byte(wr * 64 + fr, fq * 8), boff = lds_byte(wc * 32 + fr, fq * 8);
#define PG8_SA(b, h) (((b) * 2 + (h)) * HTB)
#define PG8_SB(b, h) ((4 + (b) * 2 + (h)) * HTB)
#define PG8_STAGE(bufoff, gbase, voff) do { _Pragma("unroll") for (int _i = 0; _i < 2; ++_i) \
        __builtin_amdgcn_global_load_lds((const unsigned*)((const char*)(gbase) + (voff)[_i]), (PG8_LAS unsigned*)(lds + (bufoff) + ldsw + _i * 8192), 16, 0, 0); } while (0)
#define PG8_LDA(dst, b, h) do { _Pragma("unroll") for (int m = 0; m < 4; ++m) _Pragma("unroll") for (int k = 0; k < 2; ++k) dst[m][k] = *(const PG8_LAS bf16x8*)(lds + PG8_SA(b, h) + aoff + m * 2048 + k * 1024); } while (0)
#define PG8_LDB(dst, b, h) do { _Pragma("unroll") for (int n = 0; n < 2; ++n) _Pragma("unroll") for (int k = 0; k < 2; ++k) dst[n][k] = *(const PG8_LAS bf16x8*)(lds + PG8_SB(b, h) + boff + n * 2048 + k * 1024); } while (0)
#define PG8_MMA(ai, bj, At, Bt) do { __builtin_amdgcn_s_setprio(1); _Pragma("unroll") for (int m = 0; m < 4; ++m) _Pragma("unroll") for (int n = 0; n < 2; ++n) _Pragma("unroll") for (int k = 0; k < 2; ++k) \
        acc[ai][bj][m][n] = __builtin_amdgcn_mfma_f32_16x16x32_bf16(Bt[n][k], At[m][k], acc[ai][bj][m][n], 0, 0, 0); __builtin_amdgcn_s_setprio(0); } while (0)
#define PG8_WAIT_V(n) asm volatile("s_waitcnt vmcnt(" #n ")" ::: "memory")
#define PG8_WAIT_L(n) asm volatile("s_waitcnt lgkmcnt(" #n ")" ::: "memory")
#define PG8_BAR __builtin_amdgcn_s_barrier()
#define PG8_SCHED __builtin_amdgcn_sched_barrier(0)
    Unit cur, nxt; int ui = 0;
    if (!S.next(0, cur)) return;
    f32x4 acc[2][2][4][2];
#pragma unroll
    for (int a = 0; a < 2; ++a)
#pragma unroll
        for (int b = 0; b < 2; ++b)
#pragma unroll
            for (int m = 0; m < 4; ++m)
#pragma unroll
                for (int n = 0; n < 2; ++n) acc[a][b][m][n] = (f32x4){0.f, 0.f, 0.f, 0.f};
    bf16x8 At[4][2], B0[2][2], B1[2][2];
    const char* cA = (const char*)g.A + (size_t)cur.pm * tstep; const char* cB = (const char*)g.Bt + (size_t)cur.pn * tstep;
    S.a_ready(cur);
    if constexpr (SP2) {
        PG8_STAGE(PG8_SB(0, 0), cB, voffB); PG8_STAGE(PG8_SB(0, 1), cB + hstep, voffB); PG8_STAGE(PG8_SA(0, 0), cA, voffA); PG8_STAGE(PG8_SA(0, 1), cA + hstep, voffA);
        if (wr == 1) PG8_BAR;
        PG8_WAIT_V(2); PG8_BAR;
        PG8_STAGE(PG8_SB(1, 0), cB + kstep, voffB); PG8_STAGE(PG8_SA(1, 0), cA + kstep, voffA); PG8_STAGE(PG8_SB(1, 1), cB + hstep + kstep, voffB);
        PG8_WAIT_V(6); PG8_BAR;
    } else {
        PG8_STAGE(PG8_SB(0, 0), cB, voffB); PG8_STAGE(PG8_SA(0, 0), cA, voffA); PG8_STAGE(PG8_SB(0, 1), cB + hstep, voffB); PG8_STAGE(PG8_SA(0, 1), cA + hstep, voffA);
        if (wr == 1) PG8_BAR;
        PG8_WAIT_V(4); PG8_BAR;
        PG8_STAGE(PG8_SB(1, 0), cB + kstep, voffB); PG8_STAGE(PG8_SA(1, 0), cA + kstep, voffA); PG8_STAGE(PG8_SB(1, 1), cB + hstep + kstep, voffB);
        PG8_WAIT_V(6); PG8_BAR;
    }
    for (;;) {
        const bool has_next = S.next(ui + 1, nxt);
        const char* nA = has_next ? (const char*)g.A + (size_t)nxt.pm * tstep : cA; const char* nB = has_next ? (const char*)g.Bt + (size_t)nxt.pn * tstep : cB;
        for (int t = 0; t < nt; t += 2) {
            const bool last = (t == nt - 2);
            const char* a1 = cA + (size_t)(t + 1) * kstep;
            const char* a2 = last ? nA : cA + (size_t)(t + 2) * kstep; const char* b2 = last ? nB : cB + (size_t)(t + 2) * kstep;
            const char* a3 = a2 + kstep; const char* b3 = b2 + kstep;
            if (last && has_next) S.a_ready(nxt);
            if constexpr (SP2) {
            PG8_LDB(B0, 0, 0); PG8_LDB(B1, 0, 1); PG8_SCHED; PG8_LDA(At, 0, 0); PG8_STAGE(PG8_SA(1, 1), a1 + hstep, voffA);
            PG8_WAIT_V(8); PG8_WAIT_L(0); PG8_BAR; PG8_MMA(0, 0, At, B0); PG8_MMA(0, 1, At, B1); PG8_BAR; PG8_SCHED;
            PG8_LDA(At, 0, 1); PG8_STAGE(PG8_SB(0, 0), b2, voffB); PG8_STAGE(PG8_SB(0, 1), b2 + hstep, voffB); PG8_STAGE(PG8_SA(0, 0), a2, voffA);
            PG8_WAIT_V(8); PG8_WAIT_L(0); PG8_BAR; PG8_MMA(1, 0, At, B0); PG8_MMA(1, 1, At, B1); PG8_BAR; PG8_SCHED;
            PG8_LDB(B0, 1, 0); PG8_LDB(B1, 1, 1); PG8_SCHED; PG8_LDA(At, 1, 0); PG8_STAGE(PG8_SA(0, 1), a2 + hstep, voffA);
            PG8_WAIT_V(8); PG8_WAIT_L(0); PG8_BAR; PG8_MMA(0, 0, At, B0); PG8_MMA(0, 1, At, B1); PG8_BAR; PG8_SCHED;
            PG8_LDA(At, 1, 1); PG8_STAGE(PG8_SB(1, 0), b3, voffB); PG8_STAGE(PG8_SB(1, 1), b3 + hstep, voffB); PG8_STAGE(PG8_SA(1, 0), a3, voffA);
            PG8_WAIT_V(8); PG8_WAIT_L(0); PG8_BAR; PG8_MMA(1, 0, At, B0); PG8_MMA(1, 1, At, B1); PG8_BAR; PG8_SCHED;
            } else {
            PG8_LDB(B0, 0, 0); PG8_SCHED; PG8_LDA(At, 0, 0); PG8_STAGE(PG8_SA(1, 1), a1 + hstep, voffA);
            PG8_WAIT_L(8); PG8_BAR; PG8_WAIT_L(0); PG8_MMA(0, 0, At, B0); PG8_BAR; PG8_SCHED;
            PG8_LDB(B1, 0, 1); PG8_STAGE(PG8_SB(0, 0), b2, voffB);
            PG8_BAR; PG8_WAIT_L(0); PG8_MMA(0, 1, At, B1); PG8_BAR;
            PG8_LDA(At, 0, 1); PG8_STAGE(PG8_SA(0, 0), a2, voffA);
            PG8_BAR; PG8_WAIT_L(0); PG8_MMA(1, 0, At, B0); PG8_BAR; PG8_SCHED;
            PG8_STAGE(PG8_SB(0, 1), b2 + hstep, voffB);
            PG8_WAIT_V(6); PG8_BAR; PG8_MMA(1, 1, At, B1); PG8_BAR;
            PG8_LDB(B0, 1, 0); PG8_SCHED; PG8_LDA(At, 1, 0); PG8_STAGE(PG8_SA(0, 1), a2 + hstep, voffA);
            PG8_WAIT_L(8); PG8_BAR; PG8_WAIT_L(0); PG8_MMA(0, 0, At, B0); PG8_BAR; PG8_SCHED;
            PG8_LDB(B1, 1, 1); PG8_STAGE(PG8_SB(1, 0), b3, voffB);
            PG8_BAR; PG8_WAIT_L(0); PG8_MMA(0, 1, At, B1); PG8_BAR;
            PG8_LDA(At, 1, 1); PG8_STAGE(PG8_SA(1, 0), a3, voffA);
            PG8_BAR; PG8_WAIT_L(0); PG8_MMA(1, 0, At, B0); PG8_BAR; PG8_SCHED;
            PG8_STAGE(PG8_SB(1, 1), b3 + hstep, voffB);
            PG8_WAIT_V(6); PG8_BAR; PG8_MMA(1, 1, At, B1); PG8_BAR;
            }
        }
        if constexpr (ALIGN_EPI) { if (wr == 0) PG8_BAR; }
        if constexpr (!Epi::AFTER_DRAIN) { E(acc, cur, wr, wc, fr, fq); S.done(cur); }
        if (!has_next) break;
#pragma unroll
        for (int a = 0; a < 2; ++a)
#pragma unroll
            for (int b = 0; b < 2; ++b)
#pragma unroll
                for (int m = 0; m < 4; ++m)
#pragma unroll
                    for (int n = 0; n < 2; ++n) acc[a][b][m][n] = (f32x4){0.f, 0.f, 0.f, 0.f};
        cur = nxt; cA = nA; cB = nB; ++ui;
        if constexpr (ALIGN_EPI) { if (wr == 1) PG8_BAR; }
    }
    PG8_WAIT_V(0);
    if constexpr (!ALIGN_EPI) { if (wr == 0) PG8_BAR; }
    PG8_BAR;
    if constexpr (Epi::AFTER_DRAIN) { E.fused(acc, cur, wr, wc, fr, fq, lds, wid, lane); S.done(cur); }
#undef PG8_SA
#undef PG8_SB
#undef PG8_STAGE
#undef PG8_LDA
#undef PG8_LDB
#undef PG8_MMA
#undef PG8_WAIT_V
#undef PG8_WAIT_L
#undef PG8_BAR
#undef PG8_SCHED
}
}
#define GAS __attribute__((address_space(1)))
#define LAS __attribute__((address_space(3)))
typedef unsigned short bf16;
typedef unsigned v4u __attribute__((ext_vector_type(4)));
typedef unsigned v2u __attribute__((ext_vector_type(2)));
typedef float f32x4 __attribute__((ext_vector_type(4)));
typedef short bf16x8 __attribute__((ext_vector_type(8)));
typedef short s16x4 __attribute__((ext_vector_type(4)));

constexpr int NWAVES = 8, NTHR = 512;
constexpr int T = 8192, D = 1024, M = 16384, NPROJ = 3072, DIN = 3104, FF = 4096;
constexpr float EPS = 1e-6f;
constexpr int C_QA = 0, C_KA = 512, C_VA = 1024, C_QG = 1536, C_KG = 1792, C_VG = 2048, C_RG = 2560;

constexpr size_t MiB = 1u << 20;
constexpr size_t WS_SS2 = 0, WS_SS3 = 65536, WS_BAR = 131072, WS_PCNT = 131072 + 16384, WS_ZERO_BYTES = 32768, WS_DEC = 262144, WS_Z = 1 * MiB;
constexpr size_t WS_WIN = 4 * MiB, WS_WO = 11 * MiB, WS_W1 = 13 * MiB, WS_W2 = 21 * MiB;
constexpr size_t WS_XN = 32 * MiB, WS_Y = 32 * MiB, WS_PROJ = 64 * MiB, WS_CON = 160 * MiB, WS_SP = 224 * MiB;
constexpr size_t WS_HB = 64 * MiB, WS_ACT = 96 * MiB, WS_END = 256 * MiB;
constexpr int LDS_BYTES = 163840;

__device__ __forceinline__ unsigned f2bf(float f) { unsigned u = __builtin_bit_cast(unsigned, f); return (u + 0x7fffu + ((u >> 16) & 1u)) >> 16; }
__device__ __forceinline__ unsigned pk2(float lo, float hi) { return f2bf(lo) | (f2bf(hi) << 16); }
__device__ __forceinline__ float bf2f(unsigned short h) { return __builtin_bit_cast(float, (unsigned)h << 16); }
__device__ __forceinline__ float wave_sum(float v) {
#pragma unroll
    for (int o = 1; o < 64; o <<= 1) v += __shfl_xor(v, o);
    return v;
}
__device__ __forceinline__ f32x4 mfma16(bf16x8 x, bf16x8 y, f32x4 c) { return __builtin_amdgcn_mfma_f32_16x16x32_bf16(x, y, c, 0, 0, 0); }
typedef short v4i16_t __attribute__((ext_vector_type(4)));
__device__ __forceinline__ s16x4 tr4(const LAS unsigned char* p) { return __builtin_bit_cast(s16x4, __builtin_amdgcn_ds_read_tr16_b64_v4i16((LAS v4i16_t*)p)); }
__device__ __forceinline__ bf16x8 cat8(s16x4 a, s16x4 b) { bf16x8 r; r[0] = a[0]; r[1] = a[1]; r[2] = a[2]; r[3] = a[3]; r[4] = b[0]; r[5] = b[1]; r[6] = b[2]; r[7] = b[3]; return r; }
__device__ __forceinline__ bf16x8 pack8(f32x4 a, f32x4 b) {
    v4u w; w.x = pg8::cvt_pk_bf16(a[0], a[1]); w.y = pg8::cvt_pk_bf16(a[2], a[3]); w.z = pg8::cvt_pk_bf16(b[0], b[1]); w.w = pg8::cvt_pk_bf16(b[2], b[3]);
    return __builtin_bit_cast(bf16x8, w);
}

struct Frame {
    LAS unsigned char* lds;
    int tid, lane, wave, vcu, G;
};

__device__ __forceinline__ void p0_transpose_item(const float* W, int K, int N, bf16* WT, const float* gk, LAS float* scr, int item, int lane) {
    const int nblk = N / 32, kb = item / nblk, nb = item % nblk, k0 = 64 * kb, n0 = 32 * nb;
#pragma unroll 16
    for (int i = 0; i < 32; ++i) { const int kk = 2 * i + (lane >> 5); float v = W[(size_t)(k0 + kk) * N + n0 + (lane & 31)]; if (gk) v *= gk[k0 + kk]; scr[kk * 33 + (lane & 31)] = v; }
    asm volatile("s_waitcnt lgkmcnt(0)" ::: "memory");
    const int c = lane & 7;
#pragma unroll
    for (int j = 0; j < 4; ++j) { const int n = (lane >> 3) + 8 * j; const LAS float* s = scr + (8 * c) * 33 + n;
        v4u o; o.x = pk2(s[0 * 33], s[1 * 33]); o.y = pk2(s[2 * 33], s[3 * 33]); o.z = pk2(s[4 * 33], s[5 * 33]); o.w = pk2(s[6 * 33], s[7 * 33]);
        *(v4u*)(WT + (size_t)(n0 + n) * K + k0 + 8 * c) = o; }
    asm volatile("s_waitcnt lgkmcnt(0)" ::: "memory");
}
__device__ __forceinline__ void phase_prologue(const Frame& F, const float* x, const float* g_mix, const float* w_in, const float* w_out, const float* g_ff, const float* w1, const float* w2, unsigned char* ws) {
    LAS float* scr = (LAS float*)(F.lds + F.wave * 16384);
    const int gw = F.vcu * NWAVES + F.wave, NGW = F.G * NWAVES;
    constexpr int I_IN = (D / 64) * (DIN / 32), I_O = (D / 64) * (D / 32), I_1 = (D / 64) * (FF / 32), I_2 = (FF / 64) * (D / 32);
    constexpr int NITEMS = I_IN + I_O + I_1 + I_2;
    for (int it = gw; it < NITEMS; it += NGW) {
        int r = it;
        if (r < I_IN) { p0_transpose_item(w_in, D, DIN, (bf16*)(ws + WS_WIN), nullptr, scr, r, F.lane); continue; } r -= I_IN;
        if (r < I_O) { p0_transpose_item(w_out, D, D, (bf16*)(ws + WS_WO), nullptr, scr, r, F.lane); continue; } r -= I_O;
        if (r < I_1) { p0_transpose_item(w1, D, FF, (bf16*)(ws + WS_W1), g_ff, scr, r, F.lane); continue; } r -= I_1;
        p0_transpose_item(w2, FF, D, (bf16*)(ws + WS_W2), nullptr, scr, r, F.lane);
    }
    { float* ss = (float*)(ws + WS_SS2); for (int i = (F.vcu * NTHR + F.tid); i < 2 * M; i += F.G * NTHR) ss[i] = 0.f; }
    bf16* XN = (bf16*)(ws + WS_XN);
    f32x4 gv[4];
#pragma unroll
    for (int j = 0; j < 4; ++j) gv[j] = ((const f32x4*)g_mix)[F.lane + 64 * j];
    for (int m0 = gw; m0 < M; m0 += 4 * NGW) {
        f32x4 v[4][4]; float s[4];
#pragma unroll
        for (int q = 0; q < 4; ++q) { const int m = min(m0 + q * NGW, M - 1); const f32x4* xr = (const f32x4*)(x + (size_t)m * D) + F.lane;
#pragma unroll
            for (int j = 0; j < 4; ++j) v[q][j] = xr[64 * j]; }
#pragma unroll
        for (int q = 0; q < 4; ++q) { float t = 0.f;
#pragma unroll
            for (int j = 0; j < 4; ++j) t += (v[q][j].x * v[q][j].x + v[q][j].y * v[q][j].y) + (v[q][j].z * v[q][j].z + v[q][j].w * v[q][j].w);
            s[q] = t; }
#pragma unroll
        for (int o = 1; o < 64; o <<= 1) {
#pragma unroll
            for (int q = 0; q < 4; ++q) s[q] += __shfl_xor(s[q], o); }
#pragma unroll
        for (int q = 0; q < 4; ++q) { const int m = m0 + q * NGW; if (m < M) { const float rs = 1.0f / sqrtf(s[q] * (1.f / D) + EPS);
            unsigned long long* o8 = (unsigned long long*)(XN + (size_t)m * D) + F.lane;
#pragma unroll
            for (int j = 0; j < 4; ++j) { const f32x4 o = v[q][j] * rs * gv[j]; o8[64 * j] = (unsigned long long)pk2(o.x, o.y) | ((unsigned long long)pk2(o.z, o.w) << 32); } } }
    }
}

__device__ __forceinline__ void phase_z(const Frame& F, const bf16* XN, const bf16* Wz, float* Z) {
    const int fr = F.lane & 15, fq = F.lane >> 4, w = F.wave;
    LAS float* red = (LAS float*)F.lds;
    for (int rb = F.vcu; rb < M / 64; rb += F.G) {
        bf16x8 a[4][4], b[2][4];
#pragma unroll
        for (int mt = 0; mt < 4; ++mt)
#pragma unroll
            for (int ks = 0; ks < 4; ++ks) a[mt][ks] = *(const bf16x8*)(XN + (size_t)(rb * 64 + mt * 16 + fr) * D + 128 * w + ks * 32 + 8 * fq);
#pragma unroll
        for (int nt = 0; nt < 2; ++nt)
#pragma unroll
            for (int ks = 0; ks < 4; ++ks) b[nt][ks] = *(const bf16x8*)(Wz + (size_t)(nt * 16 + fr) * D + 128 * w + ks * 32 + 8 * fq);
#pragma unroll
        for (int mt = 0; mt < 4; ++mt)
#pragma unroll
            for (int nt = 0; nt < 2; ++nt) { f32x4 acc = {0.f, 0.f, 0.f, 0.f};
#pragma unroll
                for (int ks = 0; ks < 4; ++ks) acc = mfma16(b[nt][ks], a[mt][ks], acc);
                *(LAS f32x4*)(red + ((w * 8 + mt * 2 + nt) * 64 + F.lane) * 4) = acc; }
        __syncthreads();
        { const int t = F.tid & 7, ln = F.tid >> 3 & 63;
          const int tile = F.tid >> 6, lane = F.tid & 63; (void)t; (void)ln;
          f32x4 sacc = {0.f, 0.f, 0.f, 0.f};
#pragma unroll
          for (int ww = 0; ww < 8; ++ww) sacc += *(const LAS f32x4*)(red + ((ww * 8 + tile) * 64 + lane) * 4);
          const int mt = tile >> 1, nt = tile & 1, lfr = lane & 15, lfq = lane >> 4;
          *(f32x4*)(Z + (size_t)(rb * 64 + mt * 16 + lfr) * 32 + nt * 16 + 4 * lfq) = sacc; }
        __syncthreads();
    }
}

constexpr int NA_STR = 144, NA_VSTR = 136, NA_K_OFF = 0, NA_V_OFF = 512 * NA_STR, NA_RPB_OFF = NA_V_OFF + 512 * NA_VSTR, NA_X_OFF = NA_RPB_OFF + 1872, NA_X_PAIR = 18 * 256;
static_assert(NA_X_OFF + 4 * NA_X_PAIR <= LDS_BYTES - 64, "natten LDS map");
__device__ __forceinline__ void natten_compute(const Frame& F, const bf16x8 (&qf)[2], bf16* Y, int b, int h, int r, int rs, bool slide, int newrow, const v4u& nk, const v4u& nv) {
    LAS unsigned char* lds = F.lds;
    const size_t tokq0 = (size_t)b * T + r * 64;
    const int fr = F.lane & 15, fq = F.lane >> 4, jq = F.wave & 3, kh = F.wave >> 2;
    const int wc0 = (jq == 0) ? 0 : (jq == 1) ? 8 : (jq == 2) ? 24 : 32;
    f32x4 s[8];
#pragma unroll
    for (int il = 0; il < 4; ++il)
#pragma unroll
        for (int ct = 0; ct < 2; ++ct) {
            const LAS unsigned char* kp = lds + NA_K_OFF + (((rs + 4 * kh + il) & 7) * 64 + wc0 + 16 * ct + fr) * NA_STR + fq * 16;
            const bf16x8 k0 = *(const LAS bf16x8*)kp, k1 = *(const LAS bf16x8*)(kp + 64);
            f32x4 a = {0.f, 0.f, 0.f, 0.f}; a = mfma16(k0, qf[0], a); a = mfma16(k1, qf[1], a); s[il * 2 + ct] = a; }
    const int cq = 16 * jq + fr, cs = min(max(cq - 8, 0), 48);
    const LAS float* rp = (const LAS float*)(lds + NA_RPB_OFF);
    float mx = -INFINITY;
#pragma unroll
    for (int il = 0; il < 4; ++il) { const int dr = rs + 4 * kh + il - r + 7;
#pragma unroll
        for (int ct = 0; ct < 2; ++ct)
#pragma unroll
            for (int e = 0; e < 4; ++e) { const int ck = wc0 + 16 * ct + 4 * fq + e; const bool in = (ck >= cs) && (ck < cs + 16);
                const int dc = min(max(ck - cq + 15, 0), 30);
                const float v = in ? s[il * 2 + ct][e] * 0.125f + rp[dr * 31 + dc] : -INFINITY; s[il * 2 + ct][e] = v; mx = fmaxf(mx, v); } }
    mx = fmaxf(mx, __shfl_xor(mx, 16)); mx = fmaxf(mx, __shfl_xor(mx, 32));
    float l = 0.f;
#pragma unroll
    for (int t = 0; t < 8; ++t)
#pragma unroll
        for (int e = 0; e < 4; ++e) { const float p = __expf(s[t][e] - mx); s[t][e] = p; l += p; }
    l += __shfl_xor(l, 16); l += __shfl_xor(l, 32);
    f32x4 o[4];
#pragma unroll
    for (int dt = 0; dt < 4; ++dt) o[dt] = (f32x4){0.f, 0.f, 0.f, 0.f};
#pragma unroll
    for (int il = 0; il < 4; ++il) { const bf16x8 pb = pack8(s[2 * il], s[2 * il + 1]);
#pragma unroll
        for (int dt = 0; dt < 4; ++dt) {
            const LAS unsigned char* vp = lds + NA_V_OFF + (((rs + 4 * kh + il) & 7) * 64 + wc0 + 4 * fq + (fr >> 2)) * NA_VSTR + (16 * dt + 4 * (fr & 3)) * 2;
            const bf16x8 x = cat8(tr4(vp), tr4(vp + 16 * NA_VSTR)); o[dt] = mfma16(x, pb, o[dt]); } }
    LAS float* xch = (LAS float*)(lds + NA_X_OFF + jq * NA_X_PAIR) + F.lane;
    if (kh == 1) {
#pragma unroll
        for (int dt = 0; dt < 4; ++dt)
#pragma unroll
            for (int e = 0; e < 4; ++e) xch[(dt * 4 + e) * 64] = o[dt][e];
        xch[16 * 64] = mx; xch[17 * 64] = l;
    }
    __syncthreads();
    if (slide) { const int col = F.tid >> 3, ch = F.tid & 7, kk = ((newrow & 7) * 64) + col; *(LAS v4u*)(lds + NA_K_OFF + kk * NA_STR + ch * 16) = nk;
        *(LAS v2u*)(lds + NA_V_OFF + kk * NA_VSTR + ch * 16) = (v2u){nv.x, nv.y}; *(LAS v2u*)(lds + NA_V_OFF + kk * NA_VSTR + ch * 16 + 8) = (v2u){nv.z, nv.w}; }
    if (kh == 0) {
        const float m1 = xch[16 * 64], l1 = xch[17 * 64], m = fmaxf(mx, m1), a0 = __expf(mx - m), a1 = __expf(m1 - m), inv = 1.0f / (a0 * l + a1 * l1), c0 = a0 * inv, c1 = a1 * inv;
#pragma unroll
        for (int dt = 0; dt < 4; ++dt) { float ov[4];
#pragma unroll
            for (int e = 0; e < 4; ++e) ov[e] = o[dt][e] * c0 + xch[(dt * 4 + e) * 64] * c1;
            v2u w; w.x = pg8::cvt_pk_bf16(ov[0], ov[1]); w.y = pg8::cvt_pk_bf16(ov[2], ov[3]);
            *(v2u*)(Y + (tokq0 + 16 * jq + fr) * D + h * 64 + 16 * dt + 4 * fq) = w; }
    }
}
__device__ __forceinline__ void natten_wg(const Frame& F, const bf16* PROJ, const float* rpb, bf16* Y, int wgi) {
    LAS unsigned char* lds = F.lds;
    const int bh = wgi >> 4, r0 = 8 * (wgi & 15), h = bh & 7, b = bh >> 3;
    const int fr = F.lane & 15, fq = F.lane >> 4, jq = F.wave & 3;
    const bf16* qbase = PROJ + ((size_t)b * T + 16 * jq + fr) * NPROJ + C_QA + h * 64 + 8 * fq;
    bf16x8 qf[2], qn[2];
    { const bf16* qp = qbase + (size_t)r0 * 64 * NPROJ; qf[0] = *(const bf16x8*)qp; qf[1] = *(const bf16x8*)(qp + 32); }
    { const int rs0 = min(max(r0 - 4, 0), 120);
#pragma unroll
      for (int it = 0; it < 8; ++it) { const int id = F.tid + NTHR * it, key = id >> 3, ch = id & 7, row = rs0 + (key >> 6), col = key & 63;
        const bf16* src = PROJ + ((size_t)b * T + row * 64 + col) * NPROJ + C_KA + h * 64 + ch * 8;
        const v4u kv = *(const v4u*)src, vv = *(const v4u*)(src + (C_VA - C_KA));
        const int kk = (row & 7) * 64 + col;
        *(LAS v4u*)(lds + NA_K_OFF + kk * NA_STR + ch * 16) = kv; *(LAS v2u*)(lds + NA_V_OFF + kk * NA_VSTR + ch * 16) = (v2u){vv.x, vv.y}; *(LAS v2u*)(lds + NA_V_OFF + kk * NA_VSTR + ch * 16 + 8) = (v2u){vv.z, vv.w}; } }
    if (F.tid < 465) ((LAS float*)(lds + NA_RPB_OFF))[F.tid] = rpb[h * 465 + F.tid];
    __syncthreads();
    for (int rr = 0; rr < 8; ++rr) {
        const int r = r0 + rr, rs = min(max(r - 4, 0), 120), rsn = min(max(r - 3, 0), 120);
        const bool more = rr < 7, slide = more && (rsn != rs);
        v4u nk = {0u, 0u, 0u, 0u}, nv = {0u, 0u, 0u, 0u};
        if (more) { const bf16* qp = qbase + (size_t)(r + 1) * 64 * NPROJ; qn[0] = *(const bf16x8*)qp; qn[1] = *(const bf16x8*)(qp + 32); }
        if (slide) { const int col = F.tid >> 3, ch = F.tid & 7; const bf16* src = PROJ + ((size_t)b * T + (rsn + 7) * 64 + col) * NPROJ + C_KA + h * 64 + ch * 8; nk = *(const v4u*)src; nv = *(const v4u*)(src + (C_VA - C_KA)); }
        natten_compute(F, qf, Y, b, h, r, rs, slide, rsn + 7, nk, nv);
        if (more) { qf[0] = qn[0]; qf[1] = qn[1]; }
        __syncthreads();
    }
}

constexpr int GL_Z = 0, GL_GU = 8192, GL_GB = 16384, GL_GT = 16896, GL_I0 = 20992;
constexpr int IS = 144, IMG = 64 * IS;
constexpr int VS = 272, VIMG = 64 * VS;
constexpr int GL_QF = GL_I0, GL_QB = GL_I0 + IMG, GL_KF = GL_I0 + 2 * IMG, GL_KB = GL_I0 + 3 * IMG, GL_V = GL_I0 + 4 * IMG, GL_SF = GL_V + VIMG, GL_SB = GL_SF + VIMG;
static_assert(GL_SB + VIMG <= LDS_BYTES, "GLA LDS map");
__device__ __forceinline__ float logsig(float x) { return fminf(x, 0.f) - __logf(1.0f + __expf(-fabsf(x))); }

__device__ __forceinline__ void gla_gate_core(const Frame& F, float (&bf)[8], float (&bb)[8], float& totf, float& totb) {
    LAS unsigned char* lds = F.lds; const int tid = F.tid, d = tid & 63, g = F.wave;
    const LAS float* Zl = (const LAS float*)(lds + GL_Z); const LAS float* GU = (const LAS float*)(lds + GL_GU); const LAS float* GB = (const LAS float*)(lds + GL_GB);
    float uf[16], ub[16];
#pragma unroll
    for (int rr = 0; rr < 16; ++rr) { uf[rr] = GU[rr * 64 + d]; ub[rr] = GU[1024 + rr * 64 + d]; }
    const float gf0 = GB[d], gb0 = GB[64 + d];
    float laf[8], lab[8];
#pragma unroll
    for (int j = 0; j < 8; ++j) { const int c = 8 * g + j; float pf = gf0, pb = gb0;
#pragma unroll
        for (int r4 = 0; r4 < 4; ++r4) { const f32x4 zf = *(const LAS f32x4*)(Zl + c * 32 + 4 * r4), zb = *(const LAS f32x4*)(Zl + c * 32 + 16 + 4 * r4);
#pragma unroll
            for (int e = 0; e < 4; ++e) { pf += zf[e] * uf[4 * r4 + e]; pb += zb[e] * ub[4 * r4 + e]; } }
        laf[j] = logsig(pf) * (1.0f / 16.0f); lab[j] = logsig(pb) * (1.0f / 16.0f); }
    float run = 0.f;
#pragma unroll
    for (int j = 0; j < 8; ++j) { run += laf[j]; bf[j] = run; }
    float runb = 0.f;
#pragma unroll
    for (int j = 7; j >= 0; --j) { runb += lab[j]; bb[j] = runb; }
    LAS float* GT = (LAS float*)(lds + GL_GT);
    GT[g * 64 + d] = run; GT[512 + g * 64 + d] = runb;
    __syncthreads();
    float of = 0.f, ob = 0.f; totf = 0.f; totb = 0.f;
#pragma unroll
    for (int gp = 0; gp < 8; ++gp) { const float a = GT[gp * 64 + d], c = GT[512 + gp * 64 + d]; totf += a; totb += c; if (gp < g) of += a; if (gp > g) ob += c; }
#pragma unroll
    for (int j = 0; j < 8; ++j) { bf[j] += of; bb[j] += ob; }
}
__device__ __forceinline__ void stage_img128(LAS unsigned char* dst, const bf16* src, size_t row_stride, int tid) {
#pragma unroll
    for (int it = 0; it < 2; ++it) { const int id = tid + NTHR * it, row = id >> 4, ch = id & 15; *(LAS v4u*)(dst + row * VS + ch * 16) = *(const v4u*)(src + (size_t)row * row_stride + ch * 8); }
}

struct GlaAFetch { unsigned short kraw[8], qraw[8]; v4u v[2]; f32x4 z, gu; float gb; };
__device__ __forceinline__ void gla_a_fetch(GlaAFetch& R, const Frame& F, const bf16* PROJ, const float* Z, const float* guf, const float* gbf, const float* gub, const float* gbb, int unit) {
    const int tid = F.tid, d = tid & 63, g = F.wave;
    const int n = unit & 127, bh = unit >> 7, h = bh & 3, b = bh >> 2; const size_t t0 = (size_t)b * T + 64 * n;
#pragma unroll
    for (int j = 0; j < 8; ++j) { const bf16* p = PROJ + (t0 + 8 * g + j) * NPROJ + h * 64 + d; R.qraw[j] = p[C_QG]; R.kraw[j] = p[C_KG]; }
#pragma unroll
    for (int it = 0; it < 2; ++it) { const int id = tid + NTHR * it, row = id >> 4, ch = id & 15; R.v[it] = *(const v4u*)(PROJ + (t0 + row) * NPROJ + C_VG + h * 128 + ch * 8); }
    R.z = *(const f32x4*)(Z + t0 * 32 + tid * 4);
    { const int idx = tid * 4, dir = idx >> 10, rr = (idx >> 6) & 15, dd = idx & 63; R.gu = *(const f32x4*)((dir ? gub : guf) + rr * 256 + h * 64 + dd); }
    R.gb = (tid < 128) ? ((tid >> 6) ? gbb : gbf)[h * 64 + (tid & 63)] : 0.f;
}
__device__ __forceinline__ void phase_gla_a(const Frame& F, const bf16* PROJ, const float* Z, const float* guf, const float* gbf, const float* gub, const float* gbb, float* CON, float* DEC, bf16* IMGS) {
    LAS unsigned char* lds = F.lds; const int tid = F.tid, d = tid & 63, g = F.wave;
    GlaAFetch R;
    int unit = F.vcu;
    if (unit < 1024) gla_a_fetch(R, F, PROJ, Z, guf, gbf, gub, gbb, unit);
    for (; unit < 1024; unit += F.G) {
        unsigned short kraw[8], qraw[8];
#pragma unroll
        for (int j = 0; j < 8; ++j) { kraw[j] = R.kraw[j]; qraw[j] = R.qraw[j]; }
#pragma unroll
        for (int it = 0; it < 2; ++it) { const int id = tid + NTHR * it, row = id >> 4, ch = id & 15; *(LAS v4u*)(lds + GL_V + row * VS + ch * 16) = R.v[it]; }
        *(LAS f32x4*)(lds + GL_Z + tid * 16) = R.z; *(LAS f32x4*)(lds + GL_GU + tid * 16) = R.gu;
        if (tid < 128) ((LAS float*)(lds + GL_GB))[tid] = R.gb;
        __syncthreads();
        if (unit + F.G < 1024) gla_a_fetch(R, F, PROJ, Z, guf, gbf, gub, gbb, unit + F.G);
        float bf[8], bb[8], totf, totb;
        gla_gate_core(F, bf, bb, totf, totb);
        const float decf = __expf(totf), decb = __expf(totb);
        bf16* im = IMGS + (size_t)unit * 16384 + d;
#pragma unroll
        for (int j = 0; j < 8; ++j) { const float k = bf2f(kraw[j]), q = bf2f(qraw[j]) * 0.125f; const int c = 8 * g + j;
            const float ef = __expf(bf[j]), eb = __expf(bb[j]), rf = 1.0f / ef, rb = 1.0f / eb, kif = k * rf, kib = k * rb;
            *(LAS unsigned short*)(lds + GL_KF + c * IS + d * 2) = (unsigned short)f2bf(kif * decf);
            *(LAS unsigned short*)(lds + GL_KB + c * IS + d * 2) = (unsigned short)f2bf(kib * decb);
            im[c * 64] = (bf16)f2bf(q * ef); im[4096 + c * 64] = (bf16)f2bf(kif); im[8192 + c * 64] = (bf16)f2bf(q * eb); im[12288 + c * 64] = (bf16)f2bf(kib); }
        if (g == 0) { DEC[(size_t)unit * 64 + d] = decf; DEC[(size_t)(1024 + unit) * 64 + d] = decb; }
        __syncthreads();
        const int fr = F.lane & 15, fq = F.lane >> 4, dir = F.wave >> 2, dt = F.wave & 3;
        const LAS unsigned char* kimg = lds + (dir ? GL_KB : GL_KF);
        bf16x8 yk[2];
#pragma unroll
        for (int s = 0; s < 2; ++s) { const LAS unsigned char* p = kimg + (32 * s + 4 * fq + (fr >> 2)) * IS + (16 * dt + 4 * (fr & 3)) * 2; yk[s] = cat8(tr4(p), tr4(p + 16 * IS)); }
        float* cbase = CON + ((size_t)(dir * 1024 + unit) * 64 + 16 * dt + fr) * 128 + 4 * fq;
#pragma unroll
        for (int et = 0; et < 8; ++et) { f32x4 acc = {0.f, 0.f, 0.f, 0.f};
#pragma unroll
            for (int s = 0; s < 2; ++s) { const LAS unsigned char* p = lds + GL_V + (32 * s + 4 * fq + (fr >> 2)) * VS + (16 * et + 4 * (fr & 3)) * 2; acc = mfma16(cat8(tr4(p), tr4(p + 16 * VS)), yk[s], acc); }
            *(f32x4*)(cbase + 16 * et) = acc; }
        __syncthreads();
    }
}

__device__ __forceinline__ void phase_scan(const Frame& F, const float* __restrict__ CON, const float* __restrict__ DEC, bf16* __restrict__ SP) {
    for (int chain = F.vcu * NTHR + F.tid; chain < 2 * 8 * 64 * 128; chain += F.G * NTHR) {
        const int e = chain & 127, d = (chain >> 7) & 63, bh = (chain >> 13) & 7, dir = chain >> 16;
        const size_t ubase = (size_t)dir * 1024 + bh * 128;
        const float* con = CON + (ubase * 64 + d) * 128 + e; const float* dec = DEC + ubase * 64 + d; bf16* sp = SP + (ubase * 64 + d) * 128 + e;
        float S = 0.f;
        for (int nb = 0; nb < 8; ++nb) { float c[16], gg[16];
#pragma unroll
            for (int u = 0; u < 16; ++u) { const int n = nb * 16 + u, ne = dir ? 127 - n : n; c[u] = con[(size_t)ne * 8192]; gg[u] = dec[ne * 64]; }
#pragma unroll
            for (int u = 0; u < 16; ++u) { const int n = nb * 16 + u, ne = dir ? 127 - n : n; sp[(size_t)ne * 8192] = (bf16)f2bf(S); S = gg[u] * S + c[u]; } }
    }
}

struct GlaCFetch { v4u im[4], v[2], sf[2], sb[2]; };
__device__ __forceinline__ void gla_c_fetch(GlaCFetch& R, const bf16* PROJ, const bf16* SP, const bf16* IMGS, int unit, int tid) {
    const int n = unit & 127, bh = unit >> 7, h = bh & 3, b = bh >> 2; const size_t t0 = (size_t)b * T + 64 * n;
#pragma unroll
    for (int k = 0; k < 4; ++k) R.im[k] = *(const v4u*)(IMGS + (size_t)unit * 16384 + k * 4096 + tid * 8);
#pragma unroll
    for (int it = 0; it < 2; ++it) { const int id = tid + NTHR * it, row = id >> 4, ch = id & 15;
        R.v[it] = *(const v4u*)(PROJ + (t0 + row) * NPROJ + C_VG + h * 128 + ch * 8);
        R.sf[it] = *(const v4u*)(SP + (size_t)unit * 8192 + row * 128 + ch * 8);
        R.sb[it] = *(const v4u*)(SP + (size_t)(1024 + unit) * 8192 + row * 128 + ch * 8); }
}
__device__ __forceinline__ void gla_c_commit(const GlaCFetch& R, LAS unsigned char* lds, int tid) {
    { const int row = tid >> 3, ch = tid & 7, o = row * IS + ch * 16;
      *(LAS v4u*)(lds + GL_QF + o) = R.im[0]; *(LAS v4u*)(lds + GL_KF + o) = R.im[1]; *(LAS v4u*)(lds + GL_QB + o) = R.im[2]; *(LAS v4u*)(lds + GL_KB + o) = R.im[3]; }
#pragma unroll
    for (int it = 0; it < 2; ++it) { const int id = tid + NTHR * it, row = id >> 4, ch = id & 15, o = row * VS + ch * 16;
        *(LAS v4u*)(lds + GL_V + o) = R.v[it]; *(LAS v4u*)(lds + GL_SF + o) = R.sf[it]; *(LAS v4u*)(lds + GL_SB + o) = R.sb[it]; }
}
__device__ __forceinline__ void gla_c_compute(const Frame& F, const bf16* PROJ, const float* norm_g, bf16* Y, int unit) {
    LAS unsigned char* lds = F.lds;
    const int n = unit & 127, bh = unit >> 7, h = bh & 3, b = bh >> 2; const size_t t0 = (size_t)b * T + 64 * n;
    if (F.wave < 4) {
        const int fr = F.lane & 15, fq = F.lane >> 4, it = F.wave;
        const int i = 16 * it + fr;
        const bf16* rp = PROJ + (t0 + i) * NPROJ + C_RG + h * 128 + 4 * fq; bf16* yp = Y + (t0 + i) * D + 512 + h * 128 + 4 * fq;
        v2u rw[8];
#pragma unroll
        for (int et = 0; et < 8; ++et) rw[et] = *(const v2u*)(rp + 16 * et);
        bf16x8 yqf[2], yqb[2];
#pragma unroll
        for (int s = 0; s < 2; ++s) { const int off = (16 * it + fr) * IS + (32 * s + 8 * fq) * 2; yqf[s] = *(const LAS bf16x8*)(lds + GL_QF + off); yqb[s] = *(const LAS bf16x8*)(lds + GL_QB + off); }
        f32x4 a[4];
#pragma unroll
        for (int jt = 0; jt < 4; ++jt) { f32x4 af = {0.f, 0.f, 0.f, 0.f}, ab = {0.f, 0.f, 0.f, 0.f};
#pragma unroll
            for (int s = 0; s < 2; ++s) { const int off = (16 * jt + fr) * IS + (32 * s + 8 * fq) * 2;
                af = mfma16(*(const LAS bf16x8*)(lds + GL_KF + off), yqf[s], af); ab = mfma16(*(const LAS bf16x8*)(lds + GL_KB + off), yqb[s], ab); }
#pragma unroll
            for (int e = 0; e < 4; ++e) { const int j = 16 * jt + 4 * fq + e; a[jt][e] = (j <= i) ? af[e] : ab[e]; } }
        f32x4 o[8];
#pragma unroll
        for (int et = 0; et < 8; ++et) o[et] = (f32x4){0.f, 0.f, 0.f, 0.f};
#pragma unroll
        for (int s = 0; s < 2; ++s) { const bf16x8 pb = pack8(a[2 * s], a[2 * s + 1]);
#pragma unroll
            for (int et = 0; et < 8; ++et) { const LAS unsigned char* p = lds + GL_V + (32 * s + 4 * fq + (fr >> 2)) * VS + (16 * et + 4 * (fr & 3)) * 2; o[et] = mfma16(cat8(tr4(p), tr4(p + 16 * VS)), pb, o[et]); } }
#pragma unroll
        for (int s = 0; s < 2; ++s)
#pragma unroll
            for (int et = 0; et < 8; ++et) { const int off = (32 * s + 8 * fq + (fr >> 2)) * VS + (16 * et + 4 * (fr & 3)) * 2;
                o[et] = mfma16(cat8(tr4(lds + GL_SF + off), tr4(lds + GL_SF + off + 4 * VS)), yqf[s], o[et]);
                o[et] = mfma16(cat8(tr4(lds + GL_SB + off), tr4(lds + GL_SB + off + 4 * VS)), yqb[s], o[et]); }
        float ss = 0.f;
#pragma unroll
        for (int et = 0; et < 8; ++et) ss += (o[et][0] * o[et][0] + o[et][1] * o[et][1]) + (o[et][2] * o[et][2] + o[et][3] * o[et][3]);
        ss += __shfl_xor(ss, 16); ss += __shfl_xor(ss, 32);
        const float rs = 1.0f / sqrtf(ss * (1.0f / 128.0f) + EPS);
#pragma unroll
        for (int et = 0; et < 8; ++et) { const f32x4 gn = *(const f32x4*)(norm_g + 16 * et + 4 * fq);
            float rv[4] = {__builtin_bit_cast(float, rw[et].x << 16), __builtin_bit_cast(float, rw[et].x & 0xffff0000u), __builtin_bit_cast(float, rw[et].y << 16), __builtin_bit_cast(float, rw[et].y & 0xffff0000u)};
            float ov[4];
#pragma unroll
            for (int e = 0; e < 4; ++e) { const float sg = rv[e] / (1.0f + __expf(-rv[e])); ov[e] = o[et][e] * rs * gn[e] * sg; }
            v2u w; w.x = pg8::cvt_pk_bf16(ov[0], ov[1]); w.y = pg8::cvt_pk_bf16(ov[2], ov[3]); *(v2u*)(yp + 16 * et) = w; }
    }
}
__device__ __forceinline__ void phase_gla_c(const Frame& F, const bf16* PROJ, const bf16* SP, const bf16* IMGS, const float* norm_g, bf16* Y) {
    GlaCFetch R;
    int u = F.vcu;
    if (u < 1024) gla_c_fetch(R, PROJ, SP, IMGS, u, F.tid);
    for (; u < 1024; u += F.G) {
        gla_c_commit(R, F.lds, F.tid);
        __syncthreads();
        if (u + F.G < 1024) gla_c_fetch(R, PROJ, SP, IMGS, u + F.G, F.tid);
        gla_c_compute(F, PROJ, norm_g, Y, u);
        __syncthreads();
    }
}

__device__ __forceinline__ void phase_final(const Frame& F, float* out, const float* ss, const float* g) {
    const int gw = F.vcu * NWAVES + F.wave, NGW = F.G * NWAVES;
    f32x4 gv[4];
#pragma unroll
    for (int j = 0; j < 4; ++j) gv[j] = ((const f32x4*)g)[F.lane + 64 * j];
    for (int m = gw; m < M; m += NGW) { f32x4* xr = (f32x4*)(out + (size_t)m * D) + F.lane; const float rs = 1.0f / sqrtf(ss[m] * (1.f / D) + EPS);
#pragma unroll
        for (int j = 0; j < 4; ++j) xr[64 * j] = xr[64 * j] * rs * gv[j]; }
}

#define XB_TMO      128
#define XB_XCNT(j)  (256  + 64 * (j))
#define XB_XSUB(j)  (1280 + 64 * (j))
#define XB_XGEN(j)  (2304 + 64 * (j))
#define XB_TOP      3328
#define XB_TOPGEN   3392
#define XCD_BAR_WORDS 3456
#define XB_SPIN_CAP (1u << 18)

__device__ __forceinline__ unsigned xb_ld(unsigned* p)              { return __hip_atomic_load(p, __ATOMIC_RELAXED, __HIP_MEMORY_SCOPE_AGENT); }
__device__ __forceinline__ unsigned xb_add(unsigned* p, unsigned v) { return __hip_atomic_fetch_add(p, v, __ATOMIC_RELAXED, __HIP_MEMORY_SCOPE_AGENT); }
__device__ __forceinline__ unsigned xb_xcc_id() { return (unsigned)__builtin_amdgcn_s_getreg((3 << 11) | 20) & 0xFu; }
#define XB_SPIN(cond, bar) do { unsigned _sp = 0; while (cond) { __builtin_amdgcn_s_sleep(1); \
    if ((++_sp & 255u) == 0u) { if (xb_ld(&(bar)[XB_TMO])) break; if (_sp > XB_SPIN_CAP) { atomicAdd(&(bar)[XB_TMO], 1u); break; } } } } while (0)

struct XcdBarrier {
    unsigned* bar; unsigned x;
    volatile LAS unsigned* st;
};

__device__ __forceinline__ XcdBarrier xcd_barrier_post(unsigned* bar, volatile LAS unsigned* st) {
    XcdBarrier b; b.bar = bar; b.x = xb_xcc_id(); b.st = st;
    if (threadIdx.x == 0) (void)xb_add(&bar[XB_XCNT(b.x)], 1u);
    return b;
}
__device__ __forceinline__ void xcd_barrier_complete(unsigned* bar, unsigned x, unsigned& nloc, unsigned& nx) {
    const unsigned G = gridDim.x * gridDim.y * gridDim.z;
    unsigned sum, cnt, mine, sp = 0u;
    for (;;) {
        sum = 0u; cnt = 0u; mine = 0u;
#pragma unroll
        for (unsigned j = 0; j < 16; ++j) { const unsigned c = xb_ld(&bar[XB_XCNT(j)]); sum += c; cnt += (c > 0u) ? 1u : 0u; mine = (j == x) ? c : mine; }
        if (sum == G) break;
        __builtin_amdgcn_s_sleep(1);
        if ((++sp & 255u) == 0u) { if (xb_ld(&bar[XB_TMO])) break; if (sp > XB_SPIN_CAP) { atomicAdd(&bar[XB_TMO], 1u); break; } }
    }
    nloc = mine > 0u ? mine : 1u; nx = cnt > 0u ? cnt : 1u;
}

__device__ __forceinline__ void xcd_barrier(const XcdBarrier& b) {
    asm volatile("s_waitcnt vmcnt(0)" ::: "memory");
    __syncthreads();
    if (threadIdx.x == 0) {
        unsigned* bar = b.bar;
        __builtin_amdgcn_s_waitcnt(0);
        unsigned nloc = b.st[0], nx = b.st[1];
        if (nloc == 0u) { xcd_barrier_complete(bar, b.x, nloc, nx); b.st[0] = nloc; b.st[1] = nx; }
        const unsigned old = xb_add(&bar[XB_XSUB(b.x)], 1u);
        const unsigned gen = old / nloc;
        if (old + 1u == (gen + 1u) * nloc) {
            __builtin_amdgcn_fence(__ATOMIC_RELEASE, "agent");
            asm volatile("s_waitcnt vmcnt(0)" ::: "memory");
            const unsigned og = xb_add(&bar[XB_TOP], 1u);
            const unsigned tg = og / nx;
            if (og + 1u == (tg + 1u) * nx) xb_add(&bar[XB_TOPGEN], 1u);
            else XB_SPIN(xb_ld(&bar[XB_TOPGEN]) == tg, bar);
            __builtin_amdgcn_fence(__ATOMIC_ACQUIRE, "agent");
            xb_add(&bar[XB_XGEN(b.x)], 1u);
            asm volatile("s_waitcnt vmcnt(0)" ::: "memory");
        } else {
            XB_SPIN(xb_ld(&bar[XB_XGEN(b.x)]) == gen, bar);
            __builtin_amdgcn_fence(__ATOMIC_ACQUIRE, "agent");
            asm volatile("s_waitcnt vmcnt(0)" ::: "memory");
        }
    }
    __syncthreads();
}
#ifndef MK_DUP
#define MK_DUP 0
#endif
struct Args { const float* in[14]; float* out; unsigned char* ws; int lo, hi; };
constexpr int NPHASE = 9;
__global__ void __launch_bounds__(NTHR, 2) mk_fwd(Args a) {
    extern __shared__ __attribute__((aligned(16))) unsigned char lds_raw[];
    Frame F; F.lds = (LAS unsigned char*)lds_raw; F.tid = threadIdx.x; F.lane = F.tid & 63; F.wave = __builtin_amdgcn_readfirstlane(F.tid >> 6);
    F.G = gridDim.x; { const int bx = blockIdx.x; F.vcu = (F.G % 8 == 0) ? (bx % 8) * (F.G / 8) + bx / 8 : bx; }
    unsigned char* ws = a.ws;
    const float* x = a.in[0];
    bf16* XN = (bf16*)(ws + WS_XN); bf16* Yb = (bf16*)(ws + WS_Y); bf16* PROJ = (bf16*)(ws + WS_PROJ); bf16* HB = (bf16*)(ws + WS_HB); bf16* ACT = (bf16*)(ws + WS_ACT);
    float* Z = (float*)(ws + WS_Z); float* CON = (float*)(ws + WS_CON); float* DEC = (float*)(ws + WS_DEC); bf16* SP = (bf16*)(ws + WS_SP);
    float* SS2 = (float*)(ws + WS_SS2); float* SS3 = (float*)(ws + WS_SS3);
    const int lo = a.lo, hi = a.hi;
#define IN(k) (lo <= (k) && (k) < hi)
#define SEAM(k) do { if (IN(k) && IN((k) + 1)) xcd_barrier(bar); } while (0)
    volatile LAS unsigned* MISC = (volatile LAS unsigned*)(F.lds + LDS_BYTES - 64);
    if (F.tid < 16) MISC[F.tid] = 0u;
    __syncthreads();
    unsigned* barw = (unsigned*)(ws + WS_BAR);
    if (a.lo < 0) cg::this_grid().sync();
    XcdBarrier bar; bar.bar = barw; bar.x = 0; bar.st = nullptr;
    if (hi - lo > 1) bar = xcd_barrier_post(barw, MISC + 8);
    for (int rep_ = 0; rep_ < 1 + (MK_DUP & 1); ++rep_) if (IN(0)) phase_prologue(F, x, a.in[1], a.in[2], a.in[9], a.in[10], a.in[11], a.in[12], ws);
    SEAM(0);
    if (IN(1)) {
        pg8::Gemm g{XN, (const bf16*)(ws + WS_WIN), M, NPROJ, D}; pg8::StaticOrder S; S.init(M, NPROJ, F.G, (int)blockIdx.x);
        pg8::EpiProj E{PROJ, NPROJ};
        pg8::gemm_phase<pg8::EpiProj, pg8::StaticOrder, true, true>(F.lds, g, S, E);
        phase_z(F, XN, (const bf16*)(ws + WS_WIN) + (size_t)NPROJ * D, Z);
    }
#if (MK_DUP >> 1) & 1
    if (IN(1)) {
        pg8::Gemm g{XN, (const bf16*)(ws + WS_WIN), M, NPROJ, D}; pg8::StaticOrder S; S.init(M, NPROJ, F.G, (int)blockIdx.x);
        pg8::EpiProj E{PROJ, NPROJ};
        pg8::gemm_phase<pg8::EpiProj, pg8::StaticOrder, true, true>(F.lds, g, S, E);
        phase_z(F, XN, (const bf16*)(ws + WS_WIN) + (size_t)NPROJ * D, Z);
    }
#endif
    SEAM(1);
    for (int rep_ = 0; rep_ < 1 + ((MK_DUP >> 2) & 1); ++rep_) if (IN(2)) {
        for (int rep2_ = 0; rep2_ < 1 + ((MK_DUP >> 9) & 1); ++rep2_)
        phase_gla_a(F, PROJ, Z, a.in[4], a.in[5], a.in[6], a.in[7], CON, DEC, (bf16*)a.out);
        for (int rep2_ = 0; rep2_ < 1 + ((MK_DUP >> 10) & 1); ++rep2_)
        for (int w = F.vcu; w < 256; w += F.G) natten_wg(F, PROJ, a.in[3], Yb, w);
    }
    SEAM(2);
    for (int rep_ = 0; rep_ < 1 + ((MK_DUP >> 3) & 1); ++rep_) if (IN(3)) phase_scan(F, CON, DEC, SP);
    SEAM(3);
    for (int rep_ = 0; rep_ < 1 + ((MK_DUP >> 4) & 1); ++rep_) if (IN(4)) phase_gla_c(F, PROJ, SP, (const bf16*)a.out, a.in[8], Yb);
    SEAM(4);
    if (IN(5)) {
        pg8::Gemm g{Yb, (const bf16*)(ws + WS_WO), M, D, D}; pg8::StaticOrder S; S.init(M, D, F.G, (int)blockIdx.x);
#if (MK_DUP >> 5) & 1
        { pg8::EpiResB E0{x, HB, (float*)(ws + WS_DEC), D}; pg8::gemm_phase<pg8::EpiResB, pg8::StaticOrder, false, true>(F.lds, g, S, E0); }
#endif
        pg8::EpiResB E{x, HB, SS2, D};
        pg8::gemm_phase<pg8::EpiResB, pg8::StaticOrder, false, true>(F.lds, g, S, E);
    }
    SEAM(5);
    if (IN(6)) {
        pg8::Gemm g{HB, (const bf16*)(ws + WS_W1), M, FF, D}; pg8::StaticOrder S; S.init(M, FF, F.G, (int)blockIdx.x);
        pg8::EpiFF1 E{ACT, FF, SS2, 1.0f / D, EPS};
        pg8::gemm_phase<pg8::EpiFF1, pg8::StaticOrder, true, true>(F.lds, g, S, E);
    }
#if (MK_DUP >> 6) & 1
    if (IN(6)) {
        pg8::Gemm g{HB, (const bf16*)(ws + WS_W1), M, FF, D}; pg8::StaticOrder S; S.init(M, FF, F.G, (int)blockIdx.x);
        pg8::EpiFF1 E{ACT, FF, SS2, 1.0f / D, EPS};
        pg8::gemm_phase<pg8::EpiFF1, pg8::StaticOrder, true, true>(F.lds, g, S, E);
    }
#endif
    SEAM(6);
#if (MK_DUP >> 11) & 1
    for (int k_ = 0; k_ < 8; ++k_) xcd_barrier(bar);
#endif
    if (IN(7)) {
        pg8::Gemm g{ACT, (const bf16*)(ws + WS_W2), M, D, FF}; pg8::StaticOrder S; S.init(M, D, F.G, (int)blockIdx.x);
        const int fuse = (F.G == 256 && hi - lo > 1) ? 1 : 0;
#if (MK_DUP >> 7) & 1
        { pg8::EpiResNormB E0{HB, a.out, (float*)(ws + WS_DEC), (unsigned*)(ws + WS_PCNT), a.in[13], D, 0, 8u * (D / 256), 1.0f / D, EPS}; pg8::gemm_phase<pg8::EpiResNormB, pg8::StaticOrder, false, true>(F.lds, g, S, E0); }
#endif
        pg8::EpiResNormB E{HB, a.out, SS3, (unsigned*)(ws + WS_PCNT), a.in[13], D, fuse, 8u * (D / 256), 1.0f / D, EPS};
        pg8::gemm_phase<pg8::EpiResNormB, pg8::StaticOrder, false, true>(F.lds, g, S, E);
    }
    if (!(F.G == 256 && hi - lo > 1)) {
        SEAM(7);
        if (IN(8)) phase_final(F, a.out, SS3, a.in[13]);
    }
#undef IN
#undef SEAM
}

#ifndef MK_ONE_LAUNCH
#define MK_ONE_LAUNCH 1
#endif
extern "C" void kernel_launch(void* const* d_in, const int* in_sizes, int n_in, void* d_out, int out_size, void* d_ws, size_t ws_size, hipStream_t stream) {
    static int grid = 0;
    if (grid == 0) {
        if (n_in != 14 || out_size != M * D || ws_size < WS_END) { fprintf(stderr, "kernel_launch: unexpected shapes (n_in %d out %d ws %zu)\n", n_in, out_size, ws_size); grid = -1; return; }
        int dev = 0, cus = 0, per_cu = 0;
        hipGetDevice(&dev); hipDeviceGetAttribute(&cus, hipDeviceAttributeMultiprocessorCount, dev);
        if (hipFuncSetAttribute((const void*)mk_fwd, hipFuncAttributeMaxDynamicSharedMemorySize, LDS_BYTES) != hipSuccess) { fprintf(stderr, "kernel_launch: hipFuncSetAttribute failed\n"); grid = -1; return; }
        if (hipOccupancyMaxActiveBlocksPerMultiprocessor(&per_cu, (const void*)mk_fwd, NTHR, LDS_BYTES) != hipSuccess || per_cu < 1) { fprintf(stderr, "kernel_launch: occupancy query says %d\n", per_cu); per_cu = 1; }
        (void)hipGetLastError();
        grid = cus * 1;
    }
    if (grid < 0) return;
    Args a{};
    for (int i = 0; i < 14; ++i) a.in[i] = (const float*)d_in[i];
    a.out = (float*)d_out; a.ws = (unsigned char*)d_ws;
#if MK_ONE_LAUNCH
    if (hipMemsetAsync((char*)d_ws + WS_BAR, 0, WS_ZERO_BYTES, stream) != hipSuccess) { fprintf(stderr, "kernel_launch: memset of the barrier words failed\n"); return; }
    a.lo = 0; a.hi = NPHASE;
    void* args[] = {&a};
    hipError_t e = hipLaunchCooperativeKernel((const void*)mk_fwd, dim3(grid), dim3(NTHR), args, LDS_BYTES, stream);
    if (e != hipSuccess) fprintf(stderr, "cooperative launch failed: %s (grid %d)\n", hipGetErrorString(e), grid);
#else
    for (int p = 0; p < NPHASE; ++p) { a.lo = p; a.hi = p + 1; hipLaunchKernelGGL(mk_fwd, dim3(grid), dim3(NTHR), LDS_BYTES, stream, a); }
#endif
}
```

```cpp
#include <hip/hip_runtime.h>
#include <hip/hip_cooperative_groups.h>
#include <cstdio>
#include <cstdint>
#include <cmath>
namespace cg = cooperative_groups;
namespace pg8 {
#define PG8_LAS __attribute__((address_space(3)))
typedef unsigned short bf16_t;
typedef short bf16x8 __attribute__((ext_vector_type(8)));
typedef float f32x4 __attribute__((ext_vector_type(4)));
typedef unsigned u32x4 __attribute__((ext_vector_type(4)));
constexpr int BM = 256, BK = 64, HALF = 128, HTB = HALF * BK * 2  , STAGE_BYTES = 8 * HTB, NXCD = 8, WGM = 8;

__host__ __device__ __forceinline__ int lds_byte(int r, int c) { const int st = (r >> 4) * 2 + (c >> 5), rr = r & 15, cc = c & 31, ob = rr * 64 + cc * 2; return st * 1024 + (ob ^ (((ob >> 9) & 1) << 5)); }
__host__ __device__ __forceinline__ void stage_rc(int b, int& R, int& C) { const int st = b / 1024, sb = b % 1024, swz = sb ^ (((sb >> 9) & 1) << 5); R = (st >> 1) * 16 + swz / 64; C = (st & 1) * 32 + (swz % 64) / 2; }
__host__ __device__ __forceinline__ int perm32(int rho) { const int n = rho >> 4, i = rho & 15; return 8 * (i >> 2) + 4 * n + (i & 3); }

struct Unit { int pm, pn; };
struct Gemm { const bf16_t* A; const bf16_t* Bt; int M, N, K; };

struct StaticOrder {
    int nM, nN, nwg, G, c;
    __host__ __device__ void init(int M, int N, int G_, int c_) { nM = M / BM; nN = N / BM; nwg = nM * nN; G = G_; c = c_; }
    __host__ __device__ bool next(int i, Unit& u) const {
        const long L = (long)i * G + c; if (L >= nwg) return false;
        int wgid = (int)L; { const int q = nwg / NXCD, r = nwg % NXCD, xcd = wgid % NXCD, off = wgid / NXCD; wgid = (xcd < r ? xcd * (q + 1) : r * (q + 1) + (xcd - r) * q) + off; }
        const int nig = WGM * nN, gid = wgid / nig, fm = gid * WGM, gsz = (nM - fm) < WGM ? (nM - fm) : WGM;
        u.pm = fm + ((wgid % nig) % gsz); u.pn = (wgid % nig) / gsz; return true;
    }
    __device__ __forceinline__ void a_ready(const Unit&) const {}
    __device__ __forceinline__ void done(const Unit&) const {}
};

__device__ __forceinline__ unsigned cvt_pk_bf16(float lo, float hi) { unsigned r; asm volatile("v_cvt_pk_bf16_f32 %0, %1, %2" : "=v"(r) : "v"(lo), "v"(hi)); return r; }
typedef unsigned u32x2 __attribute__((ext_vector_type(2)));
struct EpiProj {
    static constexpr bool PERM = true, AFTER_DRAIN = false;
    bf16_t* O; int ldc;
    __device__ __forceinline__ void operator()(const f32x4 (&acc)[2][2][4][2], const Unit& u, int wr, int wc, int fr, int fq) const {
        const int row0 = u.pm * BM + wr * 64 + fr, col0 = u.pn * BM + wc * 32 + 8 * fq;
#pragma unroll
        for (int ai = 0; ai < 2; ++ai)
#pragma unroll
            for (int m = 0; m < 4; ++m) { bf16_t* rowp = O + (size_t)(row0 + ai * HALF + m * 16) * ldc + col0;
#pragma unroll
                for (int bj = 0; bj < 2; ++bj) { const f32x4 v0 = acc[ai][bj][m][0], v1 = acc[ai][bj][m][1];
                    u32x4 w; w.x = cvt_pk_bf16(v0[0], v0[1]); w.y = cvt_pk_bf16(v0[2], v0[3]); w.z = cvt_pk_bf16(v1[0], v1[1]); w.w = cvt_pk_bf16(v1[2], v1[3]);
                    *(u32x4*)(rowp + bj * HALF) = w; } }
    }
};
struct EpiFF1 {
    static constexpr bool PERM = true, AFTER_DRAIN = false;
    bf16_t* O; int ldc; const float* sumsq; float inv_n, eps;
    __device__ __forceinline__ void operator()(const f32x4 (&acc)[2][2][4][2], const Unit& u, int wr, int wc, int fr, int fq) const {
        const int row0 = u.pm * BM + wr * 64 + fr, col0 = u.pn * BM + wc * 32 + 8 * fq;
#pragma unroll
        for (int ai = 0; ai < 2; ++ai)
#pragma unroll
            for (int m = 0; m < 4; ++m) { const int row = row0 + ai * HALF + m * 16; bf16_t* rowp = O + (size_t)row * ldc + col0;
                const float rs = 1.0f / sqrtf(sumsq[row] * inv_n + eps);
#pragma unroll
                for (int bj = 0; bj < 2; ++bj) { f32x4 v0 = acc[ai][bj][m][0] * rs, v1 = acc[ai][bj][m][1] * rs;
#pragma unroll
                    for (int e = 0; e < 4; ++e) { const float a = fmaxf(v0[e], 0.f), b = fmaxf(v1[e], 0.f); v0[e] = a * a; v1[e] = b * b; }
                    u32x4 w; w.x = cvt_pk_bf16(v0[0], v0[1]); w.y = cvt_pk_bf16(v0[2], v0[3]); w.z = cvt_pk_bf16(v1[0], v1[1]); w.w = cvt_pk_bf16(v1[2], v1[3]);
                    *(u32x4*)(rowp + bj * HALF) = w; } }
    }
};
struct EpiRes {
    static constexpr bool PERM = false, AFTER_DRAIN = false;
    const float* base; float* out; bf16_t* hb; float* sumsq; int ldc;
    __device__ __forceinline__ void operator()(const f32x4 (&acc)[2][2][4][2], const Unit& u, int wr, int wc, int fr, int fq) const {
        const int col0 = u.pn * BM + wc * 32 + 4 * fq;
#pragma unroll
        for (int ai = 0; ai < 2; ++ai)
#pragma unroll
            for (int m = 0; m < 4; ++m) { const int row = u.pm * BM + ai * HALF + wr * 64 + m * 16 + fr; const size_t off = (size_t)row * ldc + col0; float s = 0.f;
#pragma unroll
                for (int bj = 0; bj < 2; ++bj)
#pragma unroll
                    for (int n = 0; n < 2; ++n) { const f32x4 bs = *(const f32x4*)(base + off + bj * HALF + n * 16); const f32x4 o = bs + acc[ai][bj][m][n];
                        *(f32x4*)(out + off + bj * HALF + n * 16) = o;
                        if (hb) { u32x2 w; w.x = cvt_pk_bf16(o[0], o[1]); w.y = cvt_pk_bf16(o[2], o[3]); *(u32x2*)(hb + off + bj * HALF + n * 16) = w; }
                        s += (o[0] * o[0] + o[1] * o[1]) + (o[2] * o[2] + o[3] * o[3]); }
                s += __shfl_xor(s, 16); s += __shfl_xor(s, 32);
                if (fq == 0) unsafeAtomicAdd(sumsq + row, s);
                asm volatile("" ::: "memory"); }
    }
};

struct EpiResNorm {
    static constexpr bool PERM = false, AFTER_DRAIN = true;
    const float* base; float* out; float* sumsq; unsigned* cnt; const float* g; int ldc; int fuse; unsigned want; float inv_n, eps;
    __device__ __forceinline__ void fused(f32x4 (&acc)[2][2][4][2], const Unit& u, int wr, int wc, int fr, int fq, PG8_LAS unsigned char* lds, int wid, int lane) const {
        const int col0 = u.pn * BM + wc * 32 + 4 * fq;
#pragma unroll
        for (int ai = 0; ai < 2; ++ai)
#pragma unroll
            for (int m = 0; m < 4; ++m) { const int row = u.pm * BM + ai * HALF + wr * 64 + m * 16 + fr; const size_t off = (size_t)row * ldc + col0; float s = 0.f;
#pragma unroll
                for (int bj = 0; bj < 2; ++bj)
#pragma unroll
                    for (int n = 0; n < 2; ++n) { const f32x4 bs = *(const f32x4*)(base + off + bj * HALF + n * 16); const f32x4 o = bs + acc[ai][bj][m][n]; acc[ai][bj][m][n] = o;
                        if (!fuse) *(f32x4*)(out + off + bj * HALF + n * 16) = o;
                        s += (o[0] * o[0] + o[1] * o[1]) + (o[2] * o[2] + o[3] * o[3]); }
                s += __shfl_xor(s, 16); s += __shfl_xor(s, 32);
                if (fq == 0) unsafeAtomicAdd(sumsq + row, s);
                asm volatile("" ::: "memory"); }
        if (!fuse) return;
        asm volatile("s_waitcnt vmcnt(0)" ::: "memory");
        if (lane == 0) __hip_atomic_fetch_add(cnt + 64 * u.pm, 1u, __ATOMIC_RELAXED, __HIP_MEMORY_SCOPE_AGENT);
        if (wid == 0) { while ((unsigned)__builtin_amdgcn_readfirstlane(__hip_atomic_load(cnt + 64 * u.pm, __ATOMIC_RELAXED, __HIP_MEMORY_SCOPE_AGENT)) < want) __builtin_amdgcn_s_sleep(2); }
        asm volatile("s_waitcnt vmcnt(0) lgkmcnt(0)" ::: "memory"); __builtin_amdgcn_s_barrier(); asm volatile("" ::: "memory");
        __builtin_amdgcn_fence(__ATOMIC_ACQUIRE, "agent");
        f32x4 gv[2][2];
#pragma unroll
        for (int bj = 0; bj < 2; ++bj)
#pragma unroll
            for (int n = 0; n < 2; ++n) gv[bj][n] = *(const f32x4*)(g + col0 + bj * HALF + n * 16);
#pragma unroll
        for (int ai = 0; ai < 2; ++ai)
#pragma unroll
            for (int m = 0; m < 4; ++m) { const int row = u.pm * BM + ai * HALF + wr * 64 + m * 16 + fr; const size_t off = (size_t)row * ldc + col0;
                const float ssv = __hip_atomic_load(sumsq + row, __ATOMIC_RELAXED, __HIP_MEMORY_SCOPE_AGENT); const float rs = 1.0f / sqrtf(ssv * inv_n + eps);
#pragma unroll
                for (int bj = 0; bj < 2; ++bj)
#pragma unroll
                    for (int n = 0; n < 2; ++n) *(f32x4*)(out + off + bj * HALF + n * 16) = acc[ai][bj][m][n] * rs * gv[bj][n]; }
    }
};

struct EpiResB {
    static constexpr bool PERM = true, AFTER_DRAIN = false;
    const float* base; bf16_t* hb; float* sumsq; int ldc;
    __device__ __forceinline__ void operator()(const f32x4 (&acc)[2][2][4][2], const Unit& u, int wr, int wc, int fr, int fq) const {
        const int col0 = u.pn * BM + wc * 32 + 8 * fq;
#pragma unroll
        for (int ai = 0; ai < 2; ++ai)
#pragma unroll
            for (int m = 0; m < 4; ++m) { const int row = u.pm * BM + ai * HALF + wr * 64 + m * 16 + fr; const size_t off = (size_t)row * ldc + col0; float s = 0.f;
#pragma unroll
                for (int bj = 0; bj < 2; ++bj) { const f32x4 b0 = *(const f32x4*)(base + off + bj * HALF), b1 = *(const f32x4*)(base + off + bj * HALF + 4);
                    const f32x4 o0 = b0 + acc[ai][bj][m][0], o1 = b1 + acc[ai][bj][m][1];
                    u32x4 w; w.x = cvt_pk_bf16(o0[0], o0[1]); w.y = cvt_pk_bf16(o0[2], o0[3]); w.z = cvt_pk_bf16(o1[0], o1[1]); w.w = cvt_pk_bf16(o1[2], o1[3]);
                    *(u32x4*)(hb + off + bj * HALF) = w;
                    s += (o0[0] * o0[0] + o0[1] * o0[1]) + (o0[2] * o0[2] + o0[3] * o0[3]) + (o1[0] * o1[0] + o1[1] * o1[1]) + (o1[2] * o1[2] + o1[3] * o1[3]); }
                s += __shfl_xor(s, 16); s += __shfl_xor(s, 32);
                if (fq == 0) unsafeAtomicAdd(sumsq + row, s);
                asm volatile("" ::: "memory"); }
    }
};
struct EpiResNormB {
    static constexpr bool PERM = true, AFTER_DRAIN = true;
    const bf16_t* hb; float* out; float* sumsq; unsigned* cnt; const float* g; int ldc; int fuse; unsigned want; float inv_n, eps;
    __device__ __forceinline__ void fused(f32x4 (&acc)[2][2][4][2], const Unit& u, int wr, int wc, int fr, int fq, PG8_LAS unsigned char* lds, int wid, int lane) const {
        const int col0 = u.pn * BM + wc * 32 + 8 * fq;
#pragma unroll
        for (int ai = 0; ai < 2; ++ai)
#pragma unroll
            for (int m = 0; m < 4; ++m) { const int row = u.pm * BM + ai * HALF + wr * 64 + m * 16 + fr; const size_t off = (size_t)row * ldc + col0; float s = 0.f;
#pragma unroll
                for (int bj = 0; bj < 2; ++bj) { const u32x4 w = *(const u32x4*)(hb + off + bj * HALF);
                    const f32x4 b0 = {__builtin_bit_cast(float, w.x << 16), __builtin_bit_cast(float, w.x & 0xffff0000u), __builtin_bit_cast(float, w.y << 16), __builtin_bit_cast(float, w.y & 0xffff0000u)};
                    const f32x4 b1 = {__builtin_bit_cast(float, w.z << 16), __builtin_bit_cast(float, w.z & 0xffff0000u), __builtin_bit_cast(float, w.w << 16), __builtin_bit_cast(float, w.w & 0xffff0000u)};
                    const f32x4 o0 = b0 + acc[ai][bj][m][0], o1 = b1 + acc[ai][bj][m][1]; acc[ai][bj][m][0] = o0; acc[ai][bj][m][1] = o1;
                    if (!fuse) { *(f32x4*)(out + off + bj * HALF) = o0; *(f32x4*)(out + off + bj * HALF + 4) = o1; }
                    s += (o0[0] * o0[0] + o0[1] * o0[1]) + (o0[2] * o0[2] + o0[3] * o0[3]) + (o1[0] * o1[0] + o1[1] * o1[1]) + (o1[2] * o1[2] + o1[3] * o1[3]); }
                s += __shfl_xor(s, 16); s += __shfl_xor(s, 32);
                if (fq == 0) unsafeAtomicAdd(sumsq + row, s);
                asm volatile("" ::: "memory"); }
        if (!fuse) return;
        asm volatile("s_waitcnt vmcnt(0)" ::: "memory");
        if (lane == 0) __hip_atomic_fetch_add(cnt + 64 * u.pm, 1u, __ATOMIC_RELAXED, __HIP_MEMORY_SCOPE_AGENT);
        if (wid == 0) { while ((unsigned)__builtin_amdgcn_readfirstlane(__hip_atomic_load(cnt + 64 * u.pm, __ATOMIC_RELAXED, __HIP_MEMORY_SCOPE_AGENT)) < want) __builtin_amdgcn_s_sleep(2); }
        asm volatile("s_waitcnt vmcnt(0) lgkmcnt(0)" ::: "memory"); __builtin_amdgcn_s_barrier(); asm volatile("" ::: "memory");
        __builtin_amdgcn_fence(__ATOMIC_ACQUIRE, "agent");
        f32x4 gv[2][2];
#pragma unroll
        for (int bj = 0; bj < 2; ++bj)
#pragma unroll
            for (int n = 0; n < 2; ++n) gv[bj][n] = *(const f32x4*)(g + col0 + bj * HALF + n * 4);
#pragma unroll
        for (int ai = 0; ai < 2; ++ai)
#pragma unroll
            for (int m = 0; m < 4; ++m) { const int row = u.pm * BM + ai * HALF + wr * 64 + m * 16 + fr; const size_t off = (size_t)row * ldc + col0;
                const float ssv = __hip_atomic_load(sumsq + row, __ATOMIC_RELAXED, __HIP_MEMORY_SCOPE_AGENT); const float rs = 1.0f / sqrtf(ssv * inv_n + eps);
#pragma unroll
                for (int bj = 0; bj < 2; ++bj)
#pragma unroll
                    for (int n = 0; n < 2; ++n) *(f32x4*)(out + off + bj * HALF + n * 4) = acc[ai][bj][m][n] * rs * gv[bj][n]; }
    }
};
template <class Epi, class Sched, bool ALIGN_EPI = false, bool SP2 = false>
__device__ __forceinline__ void gemm_phase(PG8_LAS unsigned char* lds, const Gemm g, const Sched& S, const Epi& E) {
    const int tid = threadIdx.x, wid = __builtin_amdgcn_readfirstlane(tid >> 6), lane = tid & 63, wr = wid >> 2, wc = wid & 3, fr = lane & 15, fq = lane >> 4;
    const int K = g.K, nt = K / BK;
    unsigned voffA[2], voffB[2];
#pragma unroll
    for (int i = 0; i < 2; ++i) { int R, C; stage_rc(tid * 16 + i * 8192, R, C); const int Rb = Epi::PERM ? ((R & ~31) + perm32(R & 31)) : R;
        voffA[i] = (unsigned)(R * K + C) * 2u; voffB[i] = (unsigned)(Rb * K + C) * 2u; }
    const size_t kstep = (size_t)(BK * 2);
    const size_t hstep = (size_t)HALF * K * 2;
    const size_t tstep = 2 * hstep;
    const unsigned ldsw = (unsigned)wid * 1024u;
    const int aoff = lds_byte(wr * 64 + fr, fq * 8), boff = lds_byte(wc * 32 + fr, fq * 8);
#define PG8_SA(b, h) (((b) * 2 + (h)) * HTB)
#define PG8_SB(b, h) ((4 + (b) * 2 + (h)) * HTB)
#define PG8_STAGE(bufoff, gbase, voff) do { _Pragma("unroll") for (int _i = 0; _i < 2; ++_i) \
        __builtin_amdgcn_global_load_lds((const unsigned*)((const char*)(gbase) + (voff)[_i]), (PG8_LAS unsigned*)(lds + (bufoff) + ldsw + _i * 8192), 16, 0, 0); } while (0)
#define PG8_LDA(dst, b, h) do { _Pragma("unroll") for (int m = 0; m < 4; ++m) _Pragma("unroll") for (int k = 0; k < 2; ++k) dst[m][k] = *(const PG8_LAS bf16x8*)(lds + PG8_SA(b, h) + aoff + m * 2048 + k * 1024); } while (0)
#define PG8_LDB(dst, b, h) do { _Pragma("unroll") for (int n = 0; n < 2; ++n) _Pragma("unroll") for (int k = 0; k < 2; ++k) dst[n][k] = *(const PG8_LAS bf16x8*)(lds + PG8_SB(b, h) + boff + n * 2048 + k * 1024); } while (0)
#define PG8_MMA(ai, bj, At, Bt) do { __builtin_amdgcn_s_setprio(1); _Pragma("unroll") for (int m = 0; m < 4; ++m) _Pragma("unroll") for (int n = 0; n < 2; ++n) _Pragma("unroll") for (int k = 0; k < 2; ++k) \
        acc[ai][bj][m][n] = __builtin_amdgcn_mfma_f32_16x16x32_bf16(Bt[n][k], At[m][k], acc[ai][bj][m][n], 0, 0, 0); __builtin_amdgcn_s_setprio(0); } while (0)
#define PG8_WAIT_V(n) asm volatile("s_waitcnt vmcnt(" #n ")" ::: "memory")
#define PG8_WAIT_L(n) asm volatile("s_waitcnt lgkmcnt(" #n ")" ::: "memory")
#define PG8_BAR __builtin_amdgcn_s_barrier()
#define PG8_SCHED __builtin_amdgcn_sched_barrier(0)
    Unit cur, nxt; int ui = 0;
    if (!S.next(0, cur)) return;
    f32x4 acc[2][2][4][2];
#pragma unroll
    for (int a = 0; a < 2; ++a)
#pragma unroll
        for (int b = 0; b < 2; ++b)
#pragma unroll
            for (int m = 0; m < 4; ++m)
#pragma unroll
                for (int n = 0; n < 2; ++n) acc[a][b][m][n] = (f32x4){0.f, 0.f, 0.f, 0.f};
    bf16x8 At[4][2], B0[2][2], B1[2][2];
    const char* cA = (const char*)g.A + (size_t)cur.pm * tstep; const char* cB = (const char*)g.Bt + (size_t)cur.pn * tstep;
    S.a_ready(cur);
    if constexpr (SP2) {
        PG8_STAGE(PG8_SB(0, 0), cB, voffB); PG8_STAGE(PG8_SB(0, 1), cB + hstep, voffB); PG8_STAGE(PG8_SA(0, 0), cA, voffA); PG8_STAGE(PG8_SA(0, 1), cA + hstep, voffA);
        if (wr == 1) PG8_BAR;
        PG8_WAIT_V(2); PG8_BAR;
        PG8_STAGE(PG8_SB(1, 0), cB + kstep, voffB); PG8_STAGE(PG8_SA(1, 0), cA + kstep, voffA); PG8_STAGE(PG8_SB(1, 1), cB + hstep + kstep, voffB);
        PG8_WAIT_V(6); PG8_BAR;
    } else {
        PG8_STAGE(PG8_SB(0, 0), cB, voffB); PG8_STAGE(PG8_SA(0, 0), cA, voffA); PG8_STAGE(PG8_SB(0, 1), cB + hstep, voffB); PG8_STAGE(PG8_SA(0, 1), cA + hstep, voffA);
        if (wr == 1) PG8_BAR;
        PG8_WAIT_V(4); PG8_BAR;
        PG8_STAGE(PG8_SB(1, 0), cB + kstep, voffB); PG8_STAGE(PG8_SA(1, 0), cA + kstep, voffA); PG8_STAGE(PG8_SB(1, 1), cB + hstep + kstep, voffB);
        PG8_WAIT_V(6); PG8_BAR;
    }
    for (;;) {
        const bool has_next = S.next(ui + 1, nxt);
        const char* nA = has_next ? (const char*)g.A + (size_t)nxt.pm * tstep : cA; const char* nB = has_next ? (const char*)g.Bt + (size_t)nxt.pn * tstep : cB;
        for (int t = 0; t < nt; t += 2) {
            const bool last = (t == nt - 2);
            const char* a1 = cA + (size_t)(t + 1) * kstep;
            const char* a2 = last ? nA : cA + (size_t)(t + 2) * kstep; const char* b2 = last ? nB : cB + (size_t)(t + 2) * kstep;
            const char* a3 = a2 + kstep; const char* b3 = b2 + kstep;
            if (last && has_next) S.a_ready(nxt);
            if constexpr (SP2) {
            PG8_LDB(B0, 0, 0); PG8_LDB(B1, 0, 1); PG8_SCHED; PG8_LDA(At, 0, 0); PG8_STAGE(PG8_SA(1, 1), a1 + hstep, voffA);
            PG8_WAIT_V(8); PG8_WAIT_L(0); PG8_BAR; PG8_MMA(0, 0, At, B0); PG8_MMA(0, 1, At, B1); PG8_BAR; PG8_SCHED;
            PG8_LDA(At, 0, 1); PG8_STAGE(PG8_SB(0, 0), b2, voffB); PG8_STAGE(PG8_SB(0, 1), b2 + hstep, voffB); PG8_STAGE(PG8_SA(0, 0), a2, voffA);
            PG8_WAIT_V(8); PG8_WAIT_L(0); PG8_BAR; PG8_MMA(1, 0, At, B0); PG8_MMA(1, 1, At, B1); PG8_BAR; PG8_SCHED;
            PG8_LDB(B0, 1, 0); PG8_LDB(B1, 1, 1); PG8_SCHED; PG8_LDA(At, 1, 0); PG8_STAGE(PG8_SA(0, 1), a2 + hstep, voffA);
            PG8_WAIT_V(8); PG8_WAIT_L(0); PG8_BAR; PG8_MMA(0, 0, At, B0); PG8_MMA(0, 1, At, B1); PG8_BAR; PG8_SCHED;
            PG8_LDA(At, 1, 1); PG8_STAGE(PG8_SB(1, 0), b3, voffB); PG8_STAGE(PG8_SB(1, 1), b3 + hstep, voffB); PG8_STAGE(PG8_SA(1, 0), a3, voffA);
            PG8_WAIT_V(8); PG8_WAIT_L(0); PG8_BAR; PG8_MMA(1, 0, At, B0); PG8_MMA(1, 1, At, B1); PG8_BAR; PG8_SCHED;
            } else {
            PG8_LDB(B0, 0, 0); PG8_SCHED; PG8_LDA(At, 0, 0); PG8_STAGE(PG8_SA(1, 1), a1 + hstep, voffA);
            PG8_WAIT_L(8); PG8_BAR; PG8_WAIT_L(0); PG8_MMA(0, 0, At, B0); PG8_BAR; PG8_SCHED;
            PG8_LDB(B1, 0, 1); PG8_STAGE(PG8_SB(0, 0), b2, voffB);
            PG8_BAR; PG8_WAIT_L(0); PG8_MMA(0, 1, At, B1); PG8_BAR;
            PG8_LDA(At, 0, 1); PG8_STAGE(PG8_SA(0, 0), a2, voffA);
            PG8_BAR; PG8_WAIT_L(0); PG8_MMA(1, 0, At, B0); PG8_BAR; PG8_SCHED;
            PG8_STAGE(PG8_SB(0, 1), b2 + hstep, voffB);
            PG8_WAIT_V(6); PG8_BAR; PG8_MMA(1, 1, At, B1); PG8_BAR;
            PG8_LDB(B0, 1, 0); PG8_SCHED; PG8_LDA(At, 1, 0); PG8_STAGE(PG8_SA(0, 1), a2 + hstep, voffA);
            PG8_WAIT_L(8); PG8_BAR; PG8_WAIT_L(0); PG8_MMA(0, 0, At, B0); PG8_BAR; PG8_SCHED;
            PG8_LDB(B1, 1, 1); PG8_STAGE(PG8_SB(1, 0), b3, voffB);
            PG8_BAR; PG8_WAIT_L(0); PG8_MMA(0, 1, At, B1); PG8_BAR;
            PG8_LDA(At, 1, 1); PG8_STAGE(PG8_SA(1, 0), a3, voffA);
            PG8_BAR; PG8_WAIT_L(0); PG8_MMA(1, 0, At, B0); PG8_BAR; PG8_SCHED;
            PG8_STAGE(PG8_SB(1, 1), b3 + hstep, voffB);
            PG8_WAIT_V(6); PG8_BAR; PG8_MMA(1, 1, At, B1); PG8_BAR;
            }
        }
        if constexpr (ALIGN_EPI) { if (wr == 0) PG8_BAR; }
        if constexpr (!Epi::AFTER_DRAIN) { E(acc, cur, wr, wc, fr, fq); S.done(cur); }
        if (!has_next) break;
#pragma unroll
        for (int a = 0; a < 2; ++a)
#pragma unroll
            for (int b = 0; b < 2; ++b)
#pragma unroll
                for (int m = 0; m < 4; ++m)
#pragma unroll
                    for (int n = 0; n < 2; ++n) acc[a][b][m][n] = (f32x4){0.f, 0.f, 0.f, 0.f};
        cur = nxt; cA = nA; cB = nB; ++ui;
        if constexpr (ALIGN_EPI) { if (wr == 1) PG8_BAR; }
    }
    PG8_WAIT_V(0);
    if constexpr (!ALIGN_EPI) { if (wr == 0) PG8_BAR; }
    PG8_BAR;
    if constexpr (Epi::AFTER_DRAIN) { E.fused(acc, cur, wr, wc, fr, fq, lds, wid, lane); S.done(cur); }
#undef PG8_SA
#undef PG8_SB
#undef PG8_STAGE
#undef PG8_LDA
#undef PG8_LDB
#undef PG8_MMA
#undef PG8_WAIT_V
#undef PG8_WAIT_L
#undef PG8_BAR
#undef PG8_SCHED
}
}
#define GAS __attribute__((address_space(1)))
#define LAS __attribute__((address_space(3)))
typedef unsigned short bf16;
typedef unsigned v4u __attribute__((ext_vector_type(4)));
typedef unsigned v2u __attribute__((ext_vector_type(2)));
typedef float f32x4 __attribute__((ext_vector_type(4)));
typedef short bf16x8 __attribute__((ext_vector_type(8)));
typedef short s16x4 __attribute__((ext_vector_type(4)));

constexpr int NWAVES = 8, NTHR = 512;
constexpr int T = 8192, D = 1024, M = 16384, NPROJ = 3072, DIN = 3104, FF = 4096;
constexpr float EPS = 1e-6f;
constexpr int C_QA = 0, C_KA = 512, C_VA = 1024, C_QG = 1536, C_KG = 1792, C_VG = 2048, C_RG = 2560;

constexpr size_t MiB = 1u << 20;
constexpr size_t WS_SS2 = 0, WS_SS3 = 65536, WS_BAR = 131072, WS_PCNT = 131072 + 16384, WS_ZERO_BYTES = 32768, WS_DEC = 262144, WS_Z = 1 * MiB;
constexpr size_t WS_WIN = 4 * MiB, WS_WO = 11 * MiB, WS_W1 = 13 * MiB, WS_W2 = 21 * MiB;
constexpr size_t WS_XN = 32 * MiB, WS_Y = 32 * MiB, WS_PROJ = 64 * MiB, WS_CON = 160 * MiB, WS_SP = 224 * MiB;
constexpr size_t WS_HB = 64 * MiB, WS_ACT = 96 * MiB, WS_END = 256 * MiB;
constexpr int LDS_BYTES = 163840;

__device__ __forceinline__ unsigned f2bf(float f) { unsigned u = __builtin_bit_cast(unsigned, f); return (u + 0x7fffu + ((u >> 16) & 1u)) >> 16; }
__device__ __forceinline__ unsigned pk2(float lo, float hi) { return f2bf(lo) | (f2bf(hi) << 16); }
__device__ __forceinline__ float bf2f(unsigned short h) { return __builtin_bit_cast(float, (unsigned)h << 16); }
__device__ __forceinline__ float wave_sum(float v) {
#pragma unroll
    for (int o = 1; o < 64; o <<= 1) v += __shfl_xor(v, o);
    return v;
}
__device__ __forceinline__ f32x4 mfma16(bf16x8 x, bf16x8 y, f32x4 c) { return __builtin_amdgcn_mfma_f32_16x16x32_bf16(x, y, c, 0, 0, 0); }
typedef short v4i16_t __attribute__((ext_vector_type(4)));
__device__ __forceinline__ s16x4 tr4(const LAS unsigned char* p) { return __builtin_bit_cast(s16x4, __builtin_amdgcn_ds_read_tr16_b64_v4i16((LAS v4i16_t*)p)); }
__device__ __forceinline__ bf16x8 cat8(s16x4 a, s16x4 b) { bf16x8 r; r[0] = a[0]; r[1] = a[1]; r[2] = a[2]; r[3] = a[3]; r[4] = b[0]; r[5] = b[1]; r[6] = b[2]; r[7] = b[3]; return r; }
__device__ __forceinline__ bf16x8 pack8(f32x4 a, f32x4 b) {
    v4u w; w.x = pg8::cvt_pk_bf16(a[0], a[1]); w.y = pg8::cvt_pk_bf16(a[2], a[3]); w.z = pg8::cvt_pk_bf16(b[0], b[1]); w.w = pg8::cvt_pk_bf16(b[2], b[3]);
    return __builtin_bit_cast(bf16x8, w);
}

struct Frame {
    LAS unsigned char* lds;
    int tid, lane, wave, vcu, G;
};

__device__ __forceinline__ void p0_transpose_item(const float* W, int K, int N, bf16* WT, const float* gk, LAS float* scr, int item, int lane) {
    const int nblk = N / 32, kb = item / nblk, nb = item % nblk, k0 = 64 * kb, n0 = 32 * nb;
#pragma unroll 16
    for (int i = 0; i < 32; ++i) { const int kk = 2 * i + (lane >> 5); float v = W[(size_t)(k0 + kk) * N + n0 + (lane & 31)]; if (gk) v *= gk[k0 + kk]; scr[kk * 33 + (lane & 31)] = v; }
    asm volatile("s_waitcnt lgkmcnt(0)" ::: "memory");
    const int c = lane & 7;
#pragma unroll
    for (int j = 0; j < 4; ++j) { const int n = (lane >> 3) + 8 * j; const LAS float* s = scr + (8 * c) * 33 + n;
        v4u o; o.x = pk2(s[0 * 33], s[1 * 33]); o.y = pk2(s[2 * 33], s[3 * 33]); o.z = pk2(s[4 * 33], s[5 * 33]); o.w = pk2(s[6 * 33], s[7 * 33]);
        *(v4u*)(WT + (size_t)(n0 + n) * K + k0 + 8 * c) = o; }
    asm volatile("s_waitcnt lgkmcnt(0)" ::: "memory");
}
__device__ __forceinline__ void phase_prologue(const Frame& F, const float* x, const float* g_mix, const float* w_in, const float* w_out, const float* g_ff, const float* w1, const float* w2, unsigned char* ws) {
    LAS float* scr = (LAS float*)(F.lds + F.wave * 16384);
    const int gw = F.vcu * NWAVES + F.wave, NGW = F.G * NWAVES;
    constexpr int I_IN = (D / 64) * (DIN / 32), I_O = (D / 64) * (D / 32), I_1 = (D / 64) * (FF / 32), I_2 = (FF / 64) * (D / 32);
    constexpr int NITEMS = I_IN + I_O + I_1 + I_2;
    for (int it = gw; it < NITEMS; it += NGW) {
        int r = it;
        if (r < I_IN) { p0_transpose_item(w_in, D, DIN, (bf16*)(ws + WS_WIN), nullptr, scr, r, F.lane); continue; } r -= I_IN;
        if (r < I_O) { p0_transpose_item(w_out, D, D, (bf16*)(ws + WS_WO), nullptr, scr, r, F.lane); continue; } r -= I_O;
        if (r < I_1) { p0_transpose_item(w1, D, FF, (bf16*)(ws + WS_W1), g_ff, scr, r, F.lane); continue; } r -= I_1;
        p0_transpose_item(w2, FF, D, (bf16*)(ws + WS_W2), nullptr, scr, r, F.lane);
    }
    { float* ss = (float*)(ws + WS_SS2); for (int i = (F.vcu * NTHR + F.tid); i < 2 * M; i += F.G * NTHR) ss[i] = 0.f; }
    bf16* XN = (bf16*)(ws + WS_XN);
    f32x4 gv[4];
#pragma unroll
    for (int j = 0; j < 4; ++j) gv[j] = ((const f32x4*)g_mix)[F.lane + 64 * j];
    for (int m0 = gw; m0 < M; m0 += 4 * NGW) {
        f32x4 v[4][4]; float s[4];
#pragma unroll
        for (int q = 0; q < 4; ++q) { const int m = min(m0 + q * NGW, M - 1); const f32x4* xr = (const f32x4*)(x + (size_t)m * D) + F.lane;
#pragma unroll
            for (int j = 0; j < 4; ++j) v[q][j] = xr[64 * j]; }
#pragma unroll
        for (int q = 0; q < 4; ++q) { float t = 0.f;
#pragma unroll
            for (int j = 0; j < 4; ++j) t += (v[q][j].x * v[q][j].x + v[q][j].y * v[q][j].y) + (v[q][j].z * v[q][j].z + v[q][j].w * v[q][j].w);
            s[q] = t; }
#pragma unroll
        for (int o = 1; o < 64; o <<= 1) {
#pragma unroll
            for (int q = 0; q < 4; ++q) s[q] += __shfl_xor(s[q], o); }
#pragma unroll
        for (int q = 0; q < 4; ++q) { const int m = m0 + q * NGW; if (m < M) { const float rs = 1.0f / sqrtf(s[q] * (1.f / D) + EPS);
            unsigned long long* o8 = (unsigned long long*)(XN + (size_t)m * D) + F.lane;
#pragma unroll
            for (int j = 0; j < 4; ++j) { const f32x4 o = v[q][j] * rs * gv[j]; o8[64 * j] = (unsigned long long)pk2(o.x, o.y) | ((unsigned long long)pk2(o.z, o.w) << 32); } } }
    }
}

__device__ __forceinline__ void phase_z(const Frame& F, const bf16* XN, const bf16* Wz, float* Z) {
    const int fr = F.lane & 15, fq = F.lane >> 4, w = F.wave;
    LAS float* red = (LAS float*)F.lds;
    for (int rb = F.vcu; rb < M / 64; rb += F.G) {
        bf16x8 a[4][4], b[2][4];
#pragma unroll
        for (int mt = 0; mt < 4; ++mt)
#pragma unroll
            for (int ks = 0; ks < 4; ++ks) a[mt][ks] = *(const bf16x8*)(XN + (size_t)(rb * 64 + mt * 16 + fr) * D + 128 * w + ks * 32 + 8 * fq);
#pragma unroll
        for (int nt = 0; nt < 2; ++nt)
#pragma unroll
            for (int ks = 0; ks < 4; ++ks) b[nt][ks] = *(const bf16x8*)(Wz + (size_t)(nt * 16 + fr) * D + 128 * w + ks * 32 + 8 * fq);
#pragma unroll
        for (int mt = 0; mt < 4; ++mt)
#pragma unroll
            for (int nt = 0; nt < 2; ++nt) { f32x4 acc = {0.f, 0.f, 0.f, 0.f};
#pragma unroll
                for (int ks = 0; ks < 4; ++ks) acc = mfma16(b[nt][ks], a[mt][ks], acc);
                *(LAS f32x4*)(red + ((w * 8 + mt * 2 + nt) * 64 + F.lane) * 4) = acc; }
        __syncthreads();
        { const int t = F.tid & 7, ln = F.tid >> 3 & 63;
          const int tile = F.tid >> 6, lane = F.tid & 63; (void)t; (void)ln;
          f32x4 sacc = {0.f, 0.f, 0.f, 0.f};
#pragma unroll
          for (int ww = 0; ww < 8; ++ww) sacc += *(const LAS f32x4*)(red + ((ww * 8 + tile) * 64 + lane) * 4);
          const int mt = tile >> 1, nt = tile & 1, lfr = lane & 15, lfq = lane >> 4;
          *(f32x4*)(Z + (size_t)(rb * 64 + mt * 16 + lfr) * 32 + nt * 16 + 4 * lfq) = sacc; }
        __syncthreads();
    }
}

constexpr int NA_STR = 144, NA_VSTR = 136, NA_K_OFF = 0, NA_V_OFF = 512 * NA_STR, NA_RPB_OFF = NA_V_OFF + 512 * NA_VSTR, NA_X_OFF = NA_RPB_OFF + 1872, NA_X_PAIR = 18 * 256;
static_assert(NA_X_OFF + 4 * NA_X_PAIR <= LDS_BYTES - 64, "natten LDS map");
__device__ __forceinline__ void natten_compute(const Frame& F, const bf16x8 (&qf)[2], bf16* Y, int b, int h, int r, int rs, bool slide, int newrow, const v4u& nk, const v4u& nv) {
    LAS unsigned char* lds = F.lds;
    const size_t tokq0 = (size_t)b * T + r * 64;
    const int fr = F.lane & 15, fq = F.lane >> 4, jq = F.wave & 3, kh = F.wave >> 2;
    const int wc0 = (jq == 0) ? 0 : (jq == 1) ? 8 : (jq == 2) ? 24 : 32;
    f32x4 s[8];
#pragma unroll
    for (int il = 0; il < 4; ++il)
#pragma unroll
        for (int ct = 0; ct < 2; ++ct) {
            const LAS unsigned char* kp = lds + NA_K_OFF + (((rs + 4 * kh + il) & 7) * 64 + wc0 + 16 * ct + fr) * NA_STR + fq * 16;
            const bf16x8 k0 = *(const LAS bf16x8*)kp, k1 = *(const LAS bf16x8*)(kp + 64);
            f32x4 a = {0.f, 0.f, 0.f, 0.f}; a = mfma16(k0, qf[0], a); a = mfma16(k1, qf[1], a); s[il * 2 + ct] = a; }
    const int cq = 16 * jq + fr, cs = min(max(cq - 8, 0), 48);
    const LAS float* rp = (const LAS float*)(lds + NA_RPB_OFF);
    float mx = -INFINITY;
#pragma unroll
    for (int il = 0; il < 4; ++il) { const int dr = rs + 4 * kh + il - r + 7;
#pragma unroll
        for (int ct = 0; ct < 2; ++ct)
#pragma unroll
            for (int e = 0; e < 4; ++e) { const int ck = wc0 + 16 * ct + 4 * fq + e; const bool in = (ck >= cs) && (ck < cs + 16);
                const int dc = min(max(ck - cq + 15, 0), 30);
                const float v = in ? s[il * 2 + ct][e] * 0.125f + rp[dr * 31 + dc] : -INFINITY; s[il * 2 + ct][e] = v; mx = fmaxf(mx, v); } }
    mx = fmaxf(mx, __shfl_xor(mx, 16)); mx = fmaxf(mx, __shfl_xor(mx, 32));
    float l = 0.f;
#pragma unroll
    for (int t = 0; t < 8; ++t)
#pragma unroll
        for (int e = 0; e < 4; ++e) { const float p = __expf(s[t][e] - mx); s[t][e] = p; l += p; }
    l += __shfl_xor(l, 16); l += __shfl_xor(l, 32);
    f32x4 o[4];
#pragma unroll
    for (int dt = 0; dt < 4; ++dt) o[dt] = (f32x4){0.f, 0.f, 0.f, 0.f};
#pragma unroll
    for (int il = 0; il < 4; ++il) { const bf16x8 pb = pack8(s[2 * il], s[2 * il + 1]);
#pragma unroll
        for (int dt = 0; dt < 4; ++dt) {
            const LAS unsigned char* vp = lds + NA_V_OFF + (((rs + 4 * kh + il) & 7) * 64 + wc0 + 4 * fq + (fr >> 2)) * NA_VSTR + (16 * dt + 4 * (fr & 3)) * 2;
            const bf16x8 x = cat8(tr4(vp), tr4(vp + 16 * NA_VSTR)); o[dt] = mfma16(x, pb, o[dt]); } }
    LAS float* xch = (LAS float*)(lds + NA_X_OFF + jq * NA_X_PAIR) + F.lane;
    if (kh == 1) {
#pragma unroll
        for (int dt = 0; dt < 4; ++dt)
#pragma unroll
            for (int e = 0; e < 4; ++e) xch[(dt * 4 + e) * 64] = o[dt][e];
        xch[16 * 64] = mx; xch[17 * 64] = l;
    }
    __syncthreads();
    if (slide) { const int col = F.tid >> 3, ch = F.tid & 7, kk = ((newrow & 7) * 64) + col; *(LAS v4u*)(lds + NA_K_OFF + kk * NA_STR + ch * 16) = nk;
        *(LAS v2u*)(lds + NA_V_OFF + kk * NA_VSTR + ch * 16) = (v2u){nv.x, nv.y}; *(LAS v2u*)(lds + NA_V_OFF + kk * NA_VSTR + ch * 16 + 8) = (v2u){nv.z, nv.w}; }
    if (kh == 0) {
        const float m1 = xch[16 * 64], l1 = xch[17 * 64], m = fmaxf(mx, m1), a0 = __expf(mx - m), a1 = __expf(m1 - m), inv = 1.0f / (a0 * l + a1 * l1), c0 = a0 * inv, c1 = a1 * inv;
#pragma unroll
        for (int dt = 0; dt < 4; ++dt) { float ov[4];
#pragma unroll
            for (int e = 0; e < 4; ++e) ov[e] = o[dt][e] * c0 + xch[(dt * 4 + e) * 64] * c1;
            v2u w; w.x = pg8::cvt_pk_bf16(ov[0], ov[1]); w.y = pg8::cvt_pk_bf16(ov[2], ov[3]);
            *(v2u*)(Y + (tokq0 + 16 * jq + fr) * D + h * 64 + 16 * dt + 4 * fq) = w; }
    }
}
__device__ __forceinline__ void natten_wg(const Frame& F, const bf16* PROJ, const float* rpb, bf16* Y, int wgi) {
    LAS unsigned char* lds = F.lds;
    const int bh = wgi >> 4, r0 = 8 * (wgi & 15), h = bh & 7, b = bh >> 3;
    const int fr = F.lane & 15, fq = F.lane >> 4, jq = F.wave & 3;
    const bf16* qbase = PROJ + ((size_t)b * T + 16 * jq + fr) * NPROJ + C_QA + h * 64 + 8 * fq;
    bf16x8 qf[2], qn[2];
    { const bf16* qp = qbase + (size_t)r0 * 64 * NPROJ; qf[0] = *(const bf16x8*)qp; qf[1] = *(const bf16x8*)(qp + 32); }
    { const int rs0 = min(max(r0 - 4, 0), 120);
#pragma unroll
      for (int it = 0; it < 8; ++it) { const int id = F.tid + NTHR * it, key = id >> 3, ch = id & 7, row = rs0 + (key >> 6), col = key & 63;
        const bf16* src = PROJ + ((size_t)b * T + row * 64 + col) * NPROJ + C_KA + h * 64 + ch * 8;
        const v4u kv = *(const v4u*)src, vv = *(const v4u*)(src + (C_VA - C_KA));
        const int kk = (row & 7) * 64 + col;
        *(LAS v4u*)(lds + NA_K_OFF + kk * NA_STR + ch * 16) = kv; *(LAS v2u*)(lds + NA_V_OFF + kk * NA_VSTR + ch * 16) = (v2u){vv.x, vv.y}; *(LAS v2u*)(lds + NA_V_OFF + kk * NA_VSTR + ch * 16 + 8) = (v2u){vv.z, vv.w}; } }
    if (F.tid < 465) ((LAS float*)(lds + NA_RPB_OFF))[F.tid] = rpb[h * 465 + F.tid];
    __syncthreads();
    for (int rr = 0; rr < 8; ++rr) {
        const int r = r0 + rr, rs = min(max(r - 4, 0), 120), rsn = min(max(r - 3, 0), 120);
        const bool more = rr < 7, slide = more && (rsn != rs);
        v4u nk = {0u, 0u, 0u, 0u}, nv = {0u, 0u, 0u, 0u};
        if (more) { const bf16* qp = qbase + (size_t)(r + 1) * 64 * NPROJ; qn[0] = *(const bf16x8*)qp; qn[1] = *(const bf16x8*)(qp + 32); }
        if (slide) { const int col = F.tid >> 3, ch = F.tid & 7; const bf16* src = PROJ + ((size_t)b * T + (rsn + 7) * 64 + col) * NPROJ + C_KA + h * 64 + ch * 8; nk = *(const v4u*)src; nv = *(const v4u*)(src + (C_VA - C_KA)); }
        natten_compute(F, qf, Y, b, h, r, rs, slide, rsn + 7, nk, nv);
        if (more) { qf[0] = qn[0]; qf[1] = qn[1]; }
        __syncthreads();
    }
}

constexpr int GL_Z = 0, GL_GU = 8192, GL_GB = 16384, GL_GT = 16896, GL_I0 = 20992;
constexpr int IS = 144, IMG = 64 * IS;
constexpr int VS = 272, VIMG = 64 * VS;
constexpr int GL_QF = GL_I0, GL_QB = GL_I0 + IMG, GL_KF = GL_I0 + 2 * IMG, GL_KB = GL_I0 + 3 * IMG, GL_V = GL_I0 + 4 * IMG, GL_SF = GL_V + VIMG, GL_SB = GL_SF + VIMG;
static_assert(GL_SB + VIMG <= LDS_BYTES, "GLA LDS map");
__device__ __forceinline__ float logsig(float x) { return fminf(x, 0.f) - __logf(1.0f + __expf(-fabsf(x))); }

__device__ __forceinline__ void gla_gate_core(const Frame& F, float (&bf)[8], float (&bb)[8], float& totf, float& totb) {
    LAS unsigned char* lds = F.lds; const int tid = F.tid, d = tid & 63, g = F.wave;
    const LAS float* Zl = (const LAS float*)(lds + GL_Z); const LAS float* GU = (const LAS float*)(lds + GL_GU); const LAS float* GB = (const LAS float*)(lds + GL_GB);
    float uf[16], ub[16];
#pragma unroll
    for (int rr = 0; rr < 16; ++rr) { uf[rr] = GU[rr * 64 + d]; ub[rr] = GU[1024 + rr * 64 + d]; }
    const float gf0 = GB[d], gb0 = GB[64 + d];
    float laf[8], lab[8];
#pragma unroll
    for (int j = 0; j < 8; ++j) { const int c = 8 * g + j; float pf = gf0, pb = gb0;
#pragma unroll
        for (int r4 = 0; r4 < 4; ++r4) { const f32x4 zf = *(const LAS f32x4*)(Zl + c * 32 + 4 * r4), zb = *(const LAS f32x4*)(Zl + c * 32 + 16 + 4 * r4);
#pragma unroll
            for (int e = 0; e < 4; ++e) { pf += zf[e] * uf[4 * r4 + e]; pb += zb[e] * ub[4 * r4 + e]; } }
        laf[j] = logsig(pf) * (1.0f / 16.0f); lab[j] = logsig(pb) * (1.0f / 16.0f); }
    float run = 0.f;
#pragma unroll
    for (int j = 0; j < 8; ++j) { run += laf[j]; bf[j] = run; }
    float runb = 0.f;
#pragma unroll
    for (int j = 7; j >= 0; --j) { runb += lab[j]; bb[j] = runb; }
    LAS float* GT = (LAS float*)(lds + GL_GT);
    GT[g * 64 + d] = run; GT[512 + g * 64 + d] = runb;
    __syncthreads();
    float of = 0.f, ob = 0.f; totf = 0.f; totb = 0.f;
#pragma unroll
    for (int gp = 0; gp < 8; ++gp) { const float a = GT[gp * 64 + d], c = GT[512 + gp * 64 + d]; totf += a; totb += c; if (gp < g) of += a; if (gp > g) ob += c; }
#pragma unroll
    for (int j = 0; j < 8; ++j) { bf[j] += of; bb[j] += ob; }
}
__device__ __forceinline__ void stage_img128(LAS unsigned char* dst, const bf16* src, size_t row_stride, int tid) {
#pragma unroll
    for (int it = 0; it < 2; ++it) { const int id = tid + NTHR * it, row = id >> 4, ch = id & 15; *(LAS v4u*)(dst + row * VS + ch * 16) = *(const v4u*)(src + (size_t)row * row_stride + ch * 8); }
}

struct GlaAFetch { unsigned short kraw[8], qraw[8]; v4u v[2]; f32x4 z, gu; float gb; };
__device__ __forceinline__ void gla_a_fetch(GlaAFetch& R, const Frame& F, const bf16* PROJ, const float* Z, const float* guf, const float* gbf, const float* gub, const float* gbb, int unit) {
    const int tid = F.tid, d = tid & 63, g = F.wave;
    const int n = unit & 127, bh = unit >> 7, h = bh & 3, b = bh >> 2; const size_t t0 = (size_t)b * T + 64 * n;
#pragma unroll
    for (int j = 0; j < 8; ++j) { const bf16* p = PROJ + (t0 + 8 * g + j) * NPROJ + h * 64 + d; R.qraw[j] = p[C_QG]; R.kraw[j] = p[C_KG]; }
#pragma unroll
    for (int it = 0; it < 2; ++it) { const int id = tid + NTHR * it, row = id >> 4, ch = id & 15; R.v[it] = *(const v4u*)(PROJ + (t0 + row) * NPROJ + C_VG + h * 128 + ch * 8); }
    R.z = *(const f32x4*)(Z + t0 * 32 + tid * 4);
    { const int idx = tid * 4, dir = idx >> 10, rr = (idx >> 6) & 15, dd = idx & 63; R.gu = *(const f32x4*)((dir ? gub : guf) + rr * 256 + h * 64 + dd); }
    R.gb = (tid < 128) ? ((tid >> 6) ? gbb : gbf)[h * 64 + (tid & 63)] : 0.f;
}
__device__ __forceinline__ void phase_gla_a(const Frame& F, const bf16* PROJ, const float* Z, const float* guf, const float* gbf, const float* gub, const float* gbb, float* CON, float* DEC, bf16* IMGS) {
    LAS unsigned char* lds = F.lds; const int tid = F.tid, d = tid & 63, g = F.wave;
    GlaAFetch R;
    int unit = F.vcu;
    if (unit < 1024) gla_a_fetch(R, F, PROJ, Z, guf, gbf, gub, gbb, unit);
    for (; unit < 1024; unit += F.G) {
        unsigned short kraw[8], qraw[8];
#pragma unroll
        for (int j = 0; j < 8; ++j) { kraw[j] = R.kraw[j]; qraw[j] = R.qraw[j]; }
#pragma unroll
        for (int it = 0; it < 2; ++it) { const int id = tid + NTHR * it, row = id >> 4, ch = id & 15; *(LAS v4u*)(lds + GL_V + row * VS + ch * 16) = R.v[it]; }
        *(LAS f32x4*)(lds + GL_Z + tid * 16) = R.z; *(LAS f32x4*)(lds + GL_GU + tid * 16) = R.gu;
        if (tid < 128) ((LAS float*)(lds + GL_GB))[tid] = R.gb;
        __syncthreads();
        if (unit + F.G < 1024) gla_a_fetch(R, F, PROJ, Z, guf, gbf, gub, gbb, unit + F.G);
        float bf[8], bb[8], totf, totb;
        gla_gate_core(F, bf, bb, totf, totb);
        const float decf = __expf(totf), decb = __expf(totb);
        bf16* im = IMGS + (size_t)unit * 16384 + d;
#pragma unroll
        for (int j = 0; j < 8; ++j) { const float k = bf2f(kraw[j]), q = bf2f(qraw[j]) * 0.125f; const int c = 8 * g + j;
            const float ef = __expf(bf[j]), eb = __expf(bb[j]), rf = 1.0f / ef, rb = 1.0f / eb, kif = k * rf, kib = k * rb;
            *(LAS unsigned short*)(lds + GL_KF + c * IS + d * 2) = (unsigned short)f2bf(kif * decf);
            *(LAS unsigned short*)(lds + GL_KB + c * IS + d * 2) = (unsigned short)f2bf(kib * decb);
            im[c * 64] = (bf16)f2bf(q * ef); im[4096 + c * 64] = (bf16)f2bf(kif); im[8192 + c * 64] = (bf16)f2bf(q * eb); im[12288 + c * 64] = (bf16)f2bf(kib); }
        if (g == 0) { DEC[(size_t)unit * 64 + d] = decf; DEC[(size_t)(1024 + unit) * 64 + d] = decb; }
        __syncthreads();
        const int fr = F.lane & 15, fq = F.lane >> 4, dir = F.wave >> 2, dt = F.wave & 3;
        const LAS unsigned char* kimg = lds + (dir ? GL_KB : GL_KF);
        bf16x8 yk[2];
#pragma unroll
        for (int s = 0; s < 2; ++s) { const LAS unsigned char* p = kimg + (32 * s + 4 * fq + (fr >> 2)) * IS + (16 * dt + 4 * (fr & 3)) * 2; yk[s] = cat8(tr4(p), tr4(p + 16 * IS)); }
        float* cbase = CON + ((size_t)(dir * 1024 + unit) * 64 + 16 * dt + fr) * 128 + 4 * fq;
#pragma unroll
        for (int et = 0; et < 8; ++et) { f32x4 acc = {0.f, 0.f, 0.f, 0.f};
#pragma unroll
            for (int s = 0; s < 2; ++s) { const LAS unsigned char* p = lds + GL_V + (32 * s + 4 * fq + (fr >> 2)) * VS + (16 * et + 4 * (fr & 3)) * 2; acc = mfma16(cat8(tr4(p), tr4(p + 16 * VS)), yk[s], acc); }
            *(f32x4*)(cbase + 16 * et) = acc; }
        __syncthreads();
    }
}

__device__ __forceinline__ void phase_scan(const Frame& F, const float* __restrict__ CON, const float* __restrict__ DEC, bf16* __restrict__ SP) {
    for (int chain = F.vcu * NTHR + F.tid; chain < 2 * 8 * 64 * 128; chain += F.G * NTHR) {
        const int e = chain & 127, d = (chain >> 7) & 63, bh = (chain >> 13) & 7, dir = chain >> 16;
        const size_t ubase = (size_t)dir * 1024 + bh * 128;
        const float* con = CON + (ubase * 64 + d) * 128 + e; const float* dec = DEC + ubase * 64 + d; bf16* sp = SP + (ubase * 64 + d) * 128 + e;
        float S = 0.f;
        for (int nb = 0; nb < 8; ++nb) { float c[16], gg[16];
#pragma unroll
            for (int u = 0; u < 16; ++u) { const int n = nb * 16 + u, ne = dir ? 127 - n : n; c[u] = con[(size_t)ne * 8192]; gg[u] = dec[ne * 64]; }
#pragma unroll
            for (int u = 0; u < 16; ++u) { const int n = nb * 16 + u, ne = dir ? 127 - n : n; sp[(size_t)ne * 8192] = (bf16)f2bf(S); S = gg[u] * S + c[u]; } }
    }
}

struct GlaCFetch { v4u im[4], v[2], sf[2], sb[2]; };
__device__ __forceinline__ void gla_c_fetch(GlaCFetch& R, const bf16* PROJ, const bf16* SP, const bf16* IMGS, int unit, int tid) {
    const int n = unit & 127, bh = unit >> 7, h = bh & 3, b = bh >> 2; const size_t t0 = (size_t)b * T + 64 * n;
#pragma unroll
    for (int k = 0; k < 4; ++k) R.im[k] = *(const v4u*)(IMGS + (size_t)unit * 16384 + k * 4096 + tid * 8);
#pragma unroll
    for (int it = 0; it < 2; ++it) { const int id = tid + NTHR * it, row = id >> 4, ch = id & 15;
        R.v[it] = *(const v4u*)(PROJ + (t0 + row) * NPROJ + C_VG + h * 128 + ch * 8);
        R.sf[it] = *(const v4u*)(SP + (size_t)unit * 8192 + row * 128 + ch * 8);
        R.sb[it] = *(const v4u*)(SP + (size_t)(1024 + unit) * 8192 + row * 128 + ch * 8); }
}
__device__ __forceinline__ void gla_c_commit(const GlaCFetch& R, LAS unsigned char* lds, int tid) {
    { const int row = tid >> 3, ch = tid & 7, o = row * IS + ch * 16;
      *(LAS v4u*)(lds + GL_QF + o) = R.im[0]; *(LAS v4u*)(lds + GL_KF + o) = R.im[1]; *(LAS v4u*)(lds + GL_QB + o) = R.im[2]; *(LAS v4u*)(lds + GL_KB + o) = R.im[3]; }
#pragma unroll
    for (int it = 0; it < 2; ++it) { const int id = tid + NTHR * it, row = id >> 4, ch = id & 15, o = row * VS + ch * 16;
        *(LAS v4u*)(lds + GL_V + o) = R.v[it]; *(LAS v4u*)(lds + GL_SF + o) = R.sf[it]; *(LAS v4u*)(lds + GL_SB + o) = R.sb[it]; }
}
constexpr int GL_SSX = 110592;
static_assert(GL_SSX >= GL_SB + VIMG && GL_SSX + 512 <= LDS_BYTES - 64, "GLA-c exchange words");
__device__ __forceinline__ void gla_c_compute(const Frame& F, const bf16* PROJ, const float* norm_g, bf16* Y, int unit) {
    LAS unsigned char* lds = F.lds;
    const int n = unit & 127, bh = unit >> 7, h = bh & 3, b = bh >> 2; const size_t t0 = (size_t)b * T + 64 * n;
    const int fr = F.lane & 15, fq = F.lane >> 4, it = F.wave & 3, eh = F.wave >> 2;
    const int i = 16 * it + fr;
    const bf16* rp = PROJ + (t0 + i) * NPROJ + C_RG + h * 128 + 64 * eh + 4 * fq; bf16* yp = Y + (t0 + i) * D + 512 + h * 128 + 64 * eh + 4 * fq;
    v2u rw[4];
#pragma unroll
    for (int el = 0; el < 4; ++el) rw[el] = *(const v2u*)(rp + 16 * el);
    bf16x8 yqf[2], yqb[2];
#pragma unroll
    for (int s = 0; s < 2; ++s) { const int off = (16 * it + fr) * IS + (32 * s + 8 * fq) * 2; yqf[s] = *(const LAS bf16x8*)(lds + GL_QF + off); yqb[s] = *(const LAS bf16x8*)(lds + GL_QB + off); }
    f32x4 a[4];
#pragma unroll
    for (int jt = 0; jt < 4; ++jt) { f32x4 af = {0.f, 0.f, 0.f, 0.f}, ab = {0.f, 0.f, 0.f, 0.f};
#pragma unroll
        for (int s = 0; s < 2; ++s) { const int off = (16 * jt + fr) * IS + (32 * s + 8 * fq) * 2;
            af = mfma16(*(const LAS bf16x8*)(lds + GL_KF + off), yqf[s], af); ab = mfma16(*(const LAS bf16x8*)(lds + GL_KB + off), yqb[s], ab); }
#pragma unroll
        for (int e = 0; e < 4; ++e) { const int j = 16 * jt + 4 * fq + e; a[jt][e] = (j <= i) ? af[e] : ab[e]; } }
    f32x4 o[4];
#pragma unroll
    for (int el = 0; el < 4; ++el) o[el] = (f32x4){0.f, 0.f, 0.f, 0.f};
#pragma unroll
    for (int s = 0; s < 2; ++s) { const bf16x8 pb = pack8(a[2 * s], a[2 * s + 1]);
#pragma unroll
        for (int el = 0; el < 4; ++el) { const LAS unsigned char* p = lds + GL_V + (32 * s + 4 * fq + (fr >> 2)) * VS + (16 * (4 * eh + el) + 4 * (fr & 3)) * 2; o[el] = mfma16(cat8(tr4(p), tr4(p + 16 * VS)), pb, o[el]); } }
#pragma unroll
    for (int s = 0; s < 2; ++s)
#pragma unroll
        for (int el = 0; el < 4; ++el) { const int off = (32 * s + 8 * fq + (fr >> 2)) * VS + (16 * (4 * eh + el) + 4 * (fr & 3)) * 2;
            o[el] = mfma16(cat8(tr4(lds + GL_SF + off), tr4(lds + GL_SF + off + 4 * VS)), yqf[s], o[el]);
            o[el] = mfma16(cat8(tr4(lds + GL_SB + off), tr4(lds + GL_SB + off + 4 * VS)), yqb[s], o[el]); }
    float ss = 0.f;
#pragma unroll
    for (int el = 0; el < 4; ++el) ss += (o[el][0] * o[el][0] + o[el][1] * o[el][1]) + (o[el][2] * o[el][2] + o[el][3] * o[el][3]);
    ss += __shfl_xor(ss, 16); ss += __shfl_xor(ss, 32);
    LAS float* ssx = (LAS float*)(lds + GL_SSX);
    if (fq == 0) ssx[eh * 64 + i] = ss;
    __syncthreads();
    ss += ssx[(1 - eh) * 64 + i];
    const float rs = 1.0f / sqrtf(ss * (1.0f / 128.0f) + EPS);
#pragma unroll
    for (int el = 0; el < 4; ++el) { const f32x4 gn = *(const f32x4*)(norm_g + 64 * eh + 16 * el + 4 * fq);
        float rv[4] = {__builtin_bit_cast(float, rw[el].x << 16), __builtin_bit_cast(float, rw[el].x & 0xffff0000u), __builtin_bit_cast(float, rw[el].y << 16), __builtin_bit_cast(float, rw[el].y & 0xffff0000u)};
        float ov[4];
#pragma unroll
        for (int e = 0; e < 4; ++e) { const float sg = rv[e] / (1.0f + __expf(-rv[e])); ov[e] = o[el][e] * rs * gn[e] * sg; }
        v2u w; w.x = pg8::cvt_pk_bf16(ov[0], ov[1]); w.y = pg8::cvt_pk_bf16(ov[2], ov[3]); *(v2u*)(yp + 16 * el) = w; }
}
__device__ __forceinline__ void phase_gla_c(const Frame& F, const bf16* PROJ, const bf16* SP, const bf16* IMGS, const float* norm_g, bf16* Y) {
    GlaCFetch R;
    int u = F.vcu;
    if (u < 1024) gla_c_fetch(R, PROJ, SP, IMGS, u, F.tid);
    for (; u < 1024; u += F.G) {
        gla_c_commit(R, F.lds, F.tid);
        __syncthreads();
        if (u + F.G < 1024) gla_c_fetch(R, PROJ, SP, IMGS, u + F.G, F.tid);
        gla_c_compute(F, PROJ, norm_g, Y, u);
        __syncthreads();
    }
}

__device__ __forceinline__ void phase_final(const Frame& F, float* out, const float* ss, const float* g) {
    const int gw = F.vcu * NWAVES + F.wave, NGW = F.G * NWAVES;
    f32x4 gv[4];
#pragma unroll
    for (int j = 0; j < 4; ++j) gv[j] = ((const f32x4*)g)[F.lane + 64 * j];
    for (int m = gw; m < M; m += NGW) { f32x4* xr = (f32x4*)(out + (size_t)m * D) + F.lane; const float rs = 1.0f / sqrtf(ss[m] * (1.f / D) + EPS);
#pragma unroll
        for (int j = 0; j < 4; ++j) xr[64 * j] = xr[64 * j] * rs * gv[j]; }
}

#define XB_TMO      128
#define XB_XCNT(j)  (256  + 64 * (j))
#define XB_XSUB(j)  (1280 + 64 * (j))
#define XB_XGEN(j)  (2304 + 64 * (j))
#define XB_TOP      3328
#define XB_TOPGEN   3392
#define XCD_BAR_WORDS 3456
#define XB_SPIN_CAP (1u << 18)

__device__ __forceinline__ unsigned xb_ld(unsigned* p)              { return __hip_atomic_load(p, __ATOMIC_RELAXED, __HIP_MEMORY_SCOPE_AGENT); }
__device__ __forceinline__ unsigned xb_add(unsigned* p, unsigned v) { return __hip_atomic_fetch_add(p, v, __ATOMIC_RELAXED, __HIP_MEMORY_SCOPE_AGENT); }
__device__ __forceinline__ unsigned xb_xcc_id() { return (unsigned)__builtin_amdgcn_s_getreg((3 << 11) | 20) & 0xFu; }
#define XB_SPIN(cond, bar) do { unsigned _sp = 0; while (cond) { __builtin_amdgcn_s_sleep(1); \
    if ((++_sp & 255u) == 0u) { if (xb_ld(&(bar)[XB_TMO])) break; if (_sp > XB_SPIN_CAP) { atomicAdd(&(bar)[XB_TMO], 1u); break; } } } } while (0)

struct XcdBarrier {
    unsigned* bar; unsigned x;
    volatile LAS unsigned* st;
};

__device__ __forceinline__ XcdBarrier xcd_barrier_post(unsigned* bar, volatile LAS unsigned* st) {
    XcdBarrier b; b.bar = bar; b.x = xb_xcc_id(); b.st = st;
    if (threadIdx.x == 0) (void)xb_add(&bar[XB_XCNT(b.x)], 1u);
    return b;
}
__device__ __forceinline__ void xcd_barrier_complete(unsigned* bar, unsigned x, unsigned& nloc, unsigned& nx) {
    const unsigned G = gridDim.x * gridDim.y * gridDim.z;
    unsigned sum, cnt, mine, sp = 0u;
    for (;;) {
        sum = 0u; cnt = 0u; mine = 0u;
#pragma unroll
        for (unsigned j = 0; j < 16; ++j) { const unsigned c = xb_ld(&bar[XB_XCNT(j)]); sum += c; cnt += (c > 0u) ? 1u : 0u; mine = (j == x) ? c : mine; }
        if (sum == G) break;
        __builtin_amdgcn_s_sleep(1);
        if ((++sp & 255u) == 0u) { if (xb_ld(&bar[XB_TMO])) break; if (sp > XB_SPIN_CAP) { atomicAdd(&bar[XB_TMO], 1u); break; } }
    }
    nloc = mine > 0u ? mine : 1u; nx = cnt > 0u ? cnt : 1u;
}

__device__ __forceinline__ void xcd_barrier(const XcdBarrier& b) {
    asm volatile("s_waitcnt vmcnt(0)" ::: "memory");
    __syncthreads();
    if (threadIdx.x == 0) {
        unsigned* bar = b.bar;
        __builtin_amdgcn_s_waitcnt(0);
        unsigned nloc = b.st[0], nx = b.st[1];
        if (nloc == 0u) { xcd_barrier_complete(bar, b.x, nloc, nx); b.st[0] = nloc; b.st[1] = nx; }
        const unsigned old = xb_add(&bar[XB_XSUB(b.x)], 1u);
        const unsigned gen = old / nloc;
        if (old + 1u == (gen + 1u) * nloc) {
            __builtin_amdgcn_fence(__ATOMIC_RELEASE, "agent");
            asm volatile("s_waitcnt vmcnt(0)" ::: "memory");
            const unsigned og = xb_add(&bar[XB_TOP], 1u);
            const unsigned tg = og / nx;
            if (og + 1u == (tg + 1u) * nx) xb_add(&bar[XB_TOPGEN], 1u);
            else XB_SPIN(xb_ld(&bar[XB_TOPGEN]) == tg, bar);
            __builtin_amdgcn_fence(__ATOMIC_ACQUIRE, "agent");
            xb_add(&bar[XB_XGEN(b.x)], 1u);
            asm volatile("s_waitcnt vmcnt(0)" ::: "memory");
        } else {
            XB_SPIN(xb_ld(&bar[XB_XGEN(b.x)]) == gen, bar);
            __builtin_amdgcn_fence(__ATOMIC_ACQUIRE, "agent");
            asm volatile("s_waitcnt vmcnt(0)" ::: "memory");
        }
    }
    __syncthreads();
}
#ifndef MK_DUP
#define MK_DUP 0
#endif
struct Args { const float* in[14]; float* out; unsigned char* ws; int lo, hi; };
constexpr int NPHASE = 9;
__global__ void __launch_bounds__(NTHR, 2) mk_fwd(Args a) {
    extern __shared__ __attribute__((aligned(16))) unsigned char lds_raw[];
    Frame F; F.lds = (LAS unsigned char*)lds_raw; F.tid = threadIdx.x; F.lane = F.tid & 63; F.wave = __builtin_amdgcn_readfirstlane(F.tid >> 6);
    F.G = gridDim.x; { const int bx = blockIdx.x; F.vcu = (F.G % 8 == 0) ? (bx % 8) * (F.G / 8) + bx / 8 : bx; }
    unsigned char* ws = a.ws;
    const float* x = a.in[0];
    bf16* XN = (bf16*)(ws + WS_XN); bf16* Yb = (bf16*)(ws + WS_Y); bf16* PROJ = (bf16*)(ws + WS_PROJ); bf16* HB = (bf16*)(ws + WS_HB); bf16* ACT = (bf16*)(ws + WS_ACT);
    float* Z = (float*)(ws + WS_Z); float* CON = (float*)(ws + WS_CON); float* DEC = (float*)(ws + WS_DEC); bf16* SP = (bf16*)(ws + WS_SP);
    float* SS2 = (float*)(ws + WS_SS2); float* SS3 = (float*)(ws + WS_SS3);
    const int lo = a.lo, hi = a.hi;
#define IN(k) (lo <= (k) && (k) < hi)
#define SEAM(k) do { if (IN(k) && IN((k) + 1)) xcd_barrier(bar); } while (0)
    volatile LAS unsigned* MISC = (volatile LAS unsigned*)(F.lds + LDS_BYTES - 64);
    if (F.tid < 16) MISC[F.tid] = 0u;
    __syncthreads();
    unsigned* barw = (unsigned*)(ws + WS_BAR);
    if (a.lo < 0) cg::this_grid().sync();
    XcdBarrier bar; bar.bar = barw; bar.x = 0; bar.st = nullptr;
    if (hi - lo > 1) bar = xcd_barrier_post(barw, MISC + 8);
    for (int rep_ = 0; rep_ < 1 + (MK_DUP & 1); ++rep_) if (IN(0)) phase_prologue(F, x, a.in[1], a.in[2], a.in[9], a.in[10], a.in[11], a.in[12], ws);
    SEAM(0);
    if (IN(1)) {
        pg8::Gemm g{XN, (const bf16*)(ws + WS_WIN), M, NPROJ, D}; pg8::StaticOrder S; S.init(M, NPROJ, F.G, (int)blockIdx.x);
        pg8::EpiProj E{PROJ, NPROJ};
        pg8::gemm_phase<pg8::EpiProj, pg8::StaticOrder, true, true>(F.lds, g, S, E);
        phase_z(F, XN, (const bf16*)(ws + WS_WIN) + (size_t)NPROJ * D, Z);
    }
#if (MK_DUP >> 1) & 1
    if (IN(1)) {
        pg8::Gemm g{XN, (const bf16*)(ws + WS_WIN), M, NPROJ, D}; pg8::StaticOrder S; S.init(M, NPROJ, F.G, (int)blockIdx.x);
        pg8::EpiProj E{PROJ, NPROJ};
        pg8::gemm_phase<pg8::EpiProj, pg8::StaticOrder, true, true>(F.lds, g, S, E);
        phase_z(F, XN, (const bf16*)(ws + WS_WIN) + (size_t)NPROJ * D, Z);
    }
#endif
    SEAM(1);
    for (int rep_ = 0; rep_ < 1 + ((MK_DUP >> 2) & 1); ++rep_) if (IN(2)) {
        for (int rep2_ = 0; rep2_ < 1 + ((MK_DUP >> 9) & 1); ++rep2_)
        phase_gla_a(F, PROJ, Z, a.in[4], a.in[5], a.in[6], a.in[7], CON, DEC, (bf16*)a.out);
        for (int rep2_ = 0; rep2_ < 1 + ((MK_DUP >> 10) & 1); ++rep2_)
        for (int w = F.vcu; w < 256; w += F.G) natten_wg(F, PROJ, a.in[3], Yb, w);
    }
    SEAM(2);
    for (int rep_ = 0; rep_ < 1 + ((MK_DUP >> 3) & 1); ++rep_) if (IN(3)) phase_scan(F, CON, DEC, SP);
    SEAM(3);
    for (int rep_ = 0; rep_ < 1 + ((MK_DUP >> 4) & 1); ++rep_) if (IN(4)) phase_gla_c(F, PROJ, SP, (const bf16*)a.out, a.in[8], Yb);
    SEAM(4);
    if (IN(5)) {
        pg8::Gemm g{Yb, (const bf16*)(ws + WS_WO), M, D, D}; pg8::StaticOrder S; S.init(M, D, F.G, (int)blockIdx.x);
#if (MK_DUP >> 5) & 1
        { pg8::EpiResB E0{x, HB, (float*)(ws + WS_DEC), D}; pg8::gemm_phase<pg8::EpiResB, pg8::StaticOrder, false, true>(F.lds, g, S, E0); }
#endif
        pg8::EpiResB E{x, HB, SS2, D};
        pg8::gemm_phase<pg8::EpiResB, pg8::StaticOrder, true, true>(F.lds, g, S, E);
    }
    SEAM(5);
    if (IN(6)) {
        pg8::Gemm g{HB, (const bf16*)(ws + WS_W1), M, FF, D}; pg8::StaticOrder S; S.init(M, FF, F.G, (int)blockIdx.x);
        pg8::EpiFF1 E{ACT, FF, SS2, 1.0f / D, EPS};
        pg8::gemm_phase<pg8::EpiFF1, pg8::StaticOrder, true, true>(F.lds, g, S, E);
    }
#if (MK_DUP >> 6) & 1
    if (IN(6)) {
        pg8::Gemm g{HB, (const bf16*)(ws + WS_W1), M, FF, D}; pg8::StaticOrder S; S.init(M, FF, F.G, (int)blockIdx.x);
        pg8::EpiFF1 E{ACT, FF, SS2, 1.0f / D, EPS};
        pg8::gemm_phase<pg8::EpiFF1, pg8::StaticOrder, true, true>(F.lds, g, S, E);
    }
#endif
    SEAM(6);
#if (MK_DUP >> 11) & 1
    for (int k_ = 0; k_ < 8; ++k_) xcd_barrier(bar);
#endif
    if (IN(7)) {
        pg8::Gemm g{ACT, (const bf16*)(ws + WS_W2), M, D, FF}; pg8::StaticOrder S; S.init(M, D, F.G, (int)blockIdx.x);
        const int fuse = (F.G == 256 && hi - lo > 1) ? 1 : 0;
#if (MK_DUP >> 7) & 1
        { pg8::EpiResNormB E0{HB, a.out, (float*)(ws + WS_DEC), (unsigned*)(ws + WS_PCNT), a.in[13], D, 0, 8u * (D / 256), 1.0f / D, EPS}; pg8::gemm_phase<pg8::EpiResNormB, pg8::StaticOrder, false, true>(F.lds, g, S, E0); }
#endif
        pg8::EpiResNormB E{HB, a.out, SS3, (unsigned*)(ws + WS_PCNT), a.in[13], D, fuse, 8u * (D / 256), 1.0f / D, EPS};
        pg8::gemm_phase<pg8::EpiResNormB, pg8::StaticOrder, false, true>(F.lds, g, S, E);
    }
    if (!(F.G == 256 && hi - lo > 1)) {
        SEAM(7);
        if (IN(8)) phase_final(F, a.out, SS3, a.in[13]);
    }
#undef IN
#undef SEAM
}

#ifndef MK_ONE_LAUNCH
#define MK_ONE_LAUNCH 1
#endif
extern "C" void kernel_launch(void* const* d_in, const int* in_sizes, int n_in, void* d_out, int out_size, void* d_ws, size_t ws_size, hipStream_t stream) {
    static int grid = 0;
    if (grid == 0) {
        if (n_in != 14 || out_size != M * D || ws_size < WS_END) { fprintf(stderr, "kernel_launch: unexpected shapes (n_in %d out %d ws %zu)\n", n_in, out_size, ws_size); grid = -1; return; }
        int dev = 0, cus = 0, per_cu = 0;
        hipGetDevice(&dev); hipDeviceGetAttribute(&cus, hipDeviceAttributeMultiprocessorCount, dev);
        if (hipFuncSetAttribute((const void*)mk_fwd, hipFuncAttributeMaxDynamicSharedMemorySize, LDS_BYTES) != hipSuccess) { fprintf(stderr, "kernel_launch: hipFuncSetAttribute failed\n"); grid = -1; return; }
        if (hipOccupancyMaxActiveBlocksPerMultiprocessor(&per_cu, (const void*)mk_fwd, NTHR, LDS_BYTES) != hipSuccess || per_cu < 1) { fprintf(stderr, "kernel_launch: occupancy query says %d\n", per_cu); per_cu = 1; }
        (void)hipGetLastError();
        grid = cus * 1;
    }
    if (grid < 0) return;
    Args a{};
    for (int i = 0; i < 14; ++i) a.in[i] = (const float*)d_in[i];
    a.out = (float*)d_out; a.ws = (unsigned char*)d_ws;
#if MK_ONE_LAUNCH
    if (hipMemsetAsync((char*)d_ws + WS_BAR, 0, WS_ZERO_BYTES, stream) != hipSuccess) { fprintf(stderr, "kernel_launch: memset of the barrier words failed\n"); return; }
    a.lo = 0; a.hi = NPHASE;
    void* args[] = {&a};
    hipError_t e = hipLaunchCooperativeKernel((const void*)mk_fwd, dim3(grid), dim3(NTHR), args, LDS_BYTES, stream);
    if (e != hipSuccess) fprintf(stderr, "cooperative launch failed: %s (grid %d)\n", hipGetErrorString(e), grid);
#else
    for (int p = 0; p < NPHASE; ++p) { a.lo = p; a.hi = p + 1; hipLaunchKernelGGL(mk_fwd, dim3(grid), dim3(NTHR), LDS_BYTES, stream, a); }
#endif
}
```

```cpp
#include <hip/hip_runtime.h>
#include <hip/hip_cooperative_groups.h>
#include <cstdio>
#include <cstdint>
#include <cmath>
namespace cg = cooperative_groups;
namespace pg8 {
#define PG8_LAS __attribute__((address_space(3)))
typedef unsigned short bf16_t;
typedef short bf16x8 __attribute__((ext_vector_type(8)));
typedef float f32x4 __attribute__((ext_vector_type(4)));
typedef unsigned u32x4 __attribute__((ext_vector_type(4)));
constexpr int BM = 256, BK = 64, HALF = 128, HTB = HALF * BK * 2  , STAGE_BYTES = 8 * HTB, NXCD = 8, WGM = 8;

__host__ __device__ __forceinline__ int lds_byte(int r, int c) { const int st = (r >> 4) * 2 + (c >> 5), rr = r & 15, cc = c & 31, ob = rr * 64 + cc * 2; return st * 1024 + (ob ^ (((ob >> 9) & 1) << 5)); }
__host__ __device__ __forceinline__ void stage_rc(int b, int& R, int& C) { const int st = b / 1024, sb = b % 1024, swz = sb ^ (((sb >> 9) & 1) << 5); R = (st >> 1) * 16 + swz / 64; C = (st & 1) * 32 + (swz % 64) / 2; }
__host__ __device__ __forceinline__ int perm32(int rho) { const int n = rho >> 4, i = rho & 15; return 8 * (i >> 2) + 4 * n + (i & 3); }

struct Unit { int pm, pn; };
struct Gemm { const bf16_t* A; const bf16_t* Bt; int M, N, K; };

struct StaticOrder {
    int nM, nN, nwg, G, c;
    __host__ __device__ void init(int M, int N, int G_, int c_) { nM = M / BM; nN = N / BM; nwg = nM * nN; G = G_; c = c_; }
    __host__ __device__ bool next(int i, Unit& u) const {
        const long L = (long)i * G + c; if (L >= nwg) return false;
        int wgid = (int)L; { const int q = nwg / NXCD, r = nwg % NXCD, xcd = wgid % NXCD, off = wgid / NXCD; wgid = (xcd < r ? xcd * (q + 1) : r * (q + 1) + (xcd - r) * q) + off; }
        const int nig = WGM * nN, gid = wgid / nig, fm = gid * WGM, gsz = (nM - fm) < WGM ? (nM - fm) : WGM;
        u.pm = fm + ((wgid % nig) % gsz); u.pn = (wgid % nig) / gsz; return true;
    }
    __device__ __forceinline__ void a_ready(const Unit&) const {}
    __device__ __forceinline__ void done(const Unit&) const {}
};

__device__ __forceinline__ unsigned cvt_pk_bf16(float lo, float hi) { unsigned r; asm volatile("v_cvt_pk_bf16_f32 %0, %1, %2" : "=v"(r) : "v"(lo), "v"(hi)); return r; }
typedef unsigned u32x2 __attribute__((ext_vector_type(2)));
struct EpiProj {
    static constexpr bool PERM = true, AFTER_DRAIN = false;
    bf16_t* O; int ldc;
    struct Pre {}; __device__ __forceinline__ void prefetch(Pre&, const Unit&, int, int, int, int) const {}
    __device__ __forceinline__ void operator()(const f32x4 (&acc)[2][2][4][2], const Unit& u, int wr, int wc, int fr, int fq, const Pre&) const {
        const int row0 = u.pm * BM + wr * 64 + fr, col0 = u.pn * BM + wc * 32 + 8 * fq;
#pragma unroll
        for (int ai = 0; ai < 2; ++ai)
#pragma unroll
            for (int m = 0; m < 4; ++m) { bf16_t* rowp = O + (size_t)(row0 + ai * HALF + m * 16) * ldc + col0;
#pragma unroll
                for (int bj = 0; bj < 2; ++bj) { const f32x4 v0 = acc[ai][bj][m][0], v1 = acc[ai][bj][m][1];
                    u32x4 w; w.x = cvt_pk_bf16(v0[0], v0[1]); w.y = cvt_pk_bf16(v0[2], v0[3]); w.z = cvt_pk_bf16(v1[0], v1[1]); w.w = cvt_pk_bf16(v1[2], v1[3]);
                    *(u32x4*)(rowp + bj * HALF) = w; } }
    }
};
struct EpiFF1 {
    static constexpr bool PERM = true, AFTER_DRAIN = false;
    bf16_t* O; int ldc; const float* sumsq; float inv_n, eps;
    struct Pre { float ss[2][4]; };
    __device__ __forceinline__ void prefetch(Pre& P, const Unit& u, int wr, int wc, int fr, int fq) const {
        const int row0 = u.pm * BM + wr * 64 + fr;
#pragma unroll
        for (int ai = 0; ai < 2; ++ai)
#pragma unroll
            for (int m = 0; m < 4; ++m) P.ss[ai][m] = sumsq[row0 + ai * HALF + m * 16];
    }
    __device__ __forceinline__ void operator()(const f32x4 (&acc)[2][2][4][2], const Unit& u, int wr, int wc, int fr, int fq, const Pre& P) const {
        const int row0 = u.pm * BM + wr * 64 + fr, col0 = u.pn * BM + wc * 32 + 8 * fq;
#pragma unroll
        for (int ai = 0; ai < 2; ++ai)
#pragma unroll
            for (int m = 0; m < 4; ++m) { const int row = row0 + ai * HALF + m * 16; bf16_t* rowp = O + (size_t)row * ldc + col0;
                const float rs = 1.0f / sqrtf(P.ss[ai][m] * inv_n + eps);
#pragma unroll
                for (int bj = 0; bj < 2; ++bj) { f32x4 v0 = acc[ai][bj][m][0] * rs, v1 = acc[ai][bj][m][1] * rs;
#pragma unroll
                    for (int e = 0; e < 4; ++e) { const float a = fmaxf(v0[e], 0.f), b = fmaxf(v1[e], 0.f); v0[e] = a * a; v1[e] = b * b; }
                    u32x4 w; w.x = cvt_pk_bf16(v0[0], v0[1]); w.y = cvt_pk_bf16(v0[2], v0[3]); w.z = cvt_pk_bf16(v1[0], v1[1]); w.w = cvt_pk_bf16(v1[2], v1[3]);
                    *(u32x4*)(rowp + bj * HALF) = w; } }
    }
};
struct EpiRes {
    static constexpr bool PERM = false, AFTER_DRAIN = false;
    const float* base; float* out; bf16_t* hb; float* sumsq; int ldc;
    struct Pre {}; __device__ __forceinline__ void prefetch(Pre&, const Unit&, int, int, int, int) const {}
    __device__ __forceinline__ void operator()(const f32x4 (&acc)[2][2][4][2], const Unit& u, int wr, int wc, int fr, int fq, const Pre&) const {
        const int col0 = u.pn * BM + wc * 32 + 4 * fq;
#pragma unroll
        for (int ai = 0; ai < 2; ++ai)
#pragma unroll
            for (int m = 0; m < 4; ++m) { const int row = u.pm * BM + ai * HALF + wr * 64 + m * 16 + fr; const size_t off = (size_t)row * ldc + col0; float s = 0.f;
#pragma unroll
                for (int bj = 0; bj < 2; ++bj)
#pragma unroll
                    for (int n = 0; n < 2; ++n) { const f32x4 bs = *(const f32x4*)(base + off + bj * HALF + n * 16); const f32x4 o = bs + acc[ai][bj][m][n];
                        *(f32x4*)(out + off + bj * HALF + n * 16) = o;
                        if (hb) { u32x2 w; w.x = cvt_pk_bf16(o[0], o[1]); w.y = cvt_pk_bf16(o[2], o[3]); *(u32x2*)(hb + off + bj * HALF + n * 16) = w; }
                        s += (o[0] * o[0] + o[1] * o[1]) + (o[2] * o[2] + o[3] * o[3]); }
                s += __shfl_xor(s, 16); s += __shfl_xor(s, 32);
                if (fq == 0) unsafeAtomicAdd(sumsq + row, s);
                asm volatile("" ::: "memory"); }
    }
};

struct EpiResNorm {
    static constexpr bool PERM = false, AFTER_DRAIN = true;
    const float* base; float* out; float* sumsq; unsigned* cnt; const float* g; int ldc; int fuse; unsigned want; float inv_n, eps;
    struct Pre {}; __device__ __forceinline__ void prefetch(Pre&, const Unit&, int, int, int, int) const {}
    __device__ __forceinline__ void fused(f32x4 (&acc)[2][2][4][2], const Unit& u, int wr, int wc, int fr, int fq, PG8_LAS unsigned char* lds, int wid, int lane) const {
        const int col0 = u.pn * BM + wc * 32 + 4 * fq;
#pragma unroll
        for (int ai = 0; ai < 2; ++ai)
#pragma unroll
            for (int m = 0; m < 4; ++m) { const int row = u.pm * BM + ai * HALF + wr * 64 + m * 16 + fr; const size_t off = (size_t)row * ldc + col0; float s = 0.f;
#pragma unroll
                for (int bj = 0; bj < 2; ++bj)
#pragma unroll
                    for (int n = 0; n < 2; ++n) { const f32x4 bs = *(const f32x4*)(base + off + bj * HALF + n * 16); const f32x4 o = bs + acc[ai][bj][m][n]; acc[ai][bj][m][n] = o;
                        if (!fuse) *(f32x4*)(out + off + bj * HALF + n * 16) = o;
                        s += (o[0] * o[0] + o[1] * o[1]) + (o[2] * o[2] + o[3] * o[3]); }
                s += __shfl_xor(s, 16); s += __shfl_xor(s, 32);
                if (fq == 0) unsafeAtomicAdd(sumsq + row, s);
                asm volatile("" ::: "memory"); }
        if (!fuse) return;
        asm volatile("s_waitcnt vmcnt(0)" ::: "memory");
        if (lane == 0) __hip_atomic_fetch_add(cnt + 64 * u.pm, 1u, __ATOMIC_RELAXED, __HIP_MEMORY_SCOPE_AGENT);
        if (wid == 0) { while ((unsigned)__builtin_amdgcn_readfirstlane(__hip_atomic_load(cnt + 64 * u.pm, __ATOMIC_RELAXED, __HIP_MEMORY_SCOPE_AGENT)) < want) __builtin_amdgcn_s_sleep(2); }
        asm volatile("s_waitcnt vmcnt(0) lgkmcnt(0)" ::: "memory"); __builtin_amdgcn_s_barrier(); asm volatile("" ::: "memory");
        __builtin_amdgcn_fence(__ATOMIC_ACQUIRE, "agent");
        f32x4 gv[2][2];
#pragma unroll
        for (int bj = 0; bj < 2; ++bj)
#pragma unroll
            for (int n = 0; n < 2; ++n) gv[bj][n] = *(const f32x4*)(g + col0 + bj * HALF + n * 16);
#pragma unroll
        for (int ai = 0; ai < 2; ++ai)
#pragma unroll
            for (int m = 0; m < 4; ++m) { const int row = u.pm * BM + ai * HALF + wr * 64 + m * 16 + fr; const size_t off = (size_t)row * ldc + col0;
                const float ssv = __hip_atomic_load(sumsq + row, __ATOMIC_RELAXED, __HIP_MEMORY_SCOPE_AGENT); const float rs = 1.0f / sqrtf(ssv * inv_n + eps);
#pragma unroll
                for (int bj = 0; bj < 2; ++bj)
#pragma unroll
                    for (int n = 0; n < 2; ++n) *(f32x4*)(out + off + bj * HALF + n * 16) = acc[ai][bj][m][n] * rs * gv[bj][n]; }
    }
};

struct EpiResB {
    static constexpr bool PERM = true, AFTER_DRAIN = false;
    const float* base; bf16_t* hb; float* sumsq; int ldc;
    struct Pre {}; __device__ __forceinline__ void prefetch(Pre&, const Unit&, int, int, int, int) const {}
    __device__ __forceinline__ void operator()(const f32x4 (&acc)[2][2][4][2], const Unit& u, int wr, int wc, int fr, int fq, const Pre&) const {
        const int col0 = u.pn * BM + wc * 32 + 8 * fq; const int rowb = u.pm * BM + wr * 64 + fr;
        f32x4 nb[4];
        { const size_t off = (size_t)rowb * ldc + col0;
#pragma unroll
          for (int bj = 0; bj < 2; ++bj) { nb[2 * bj] = *(const f32x4*)(base + off + bj * HALF); nb[2 * bj + 1] = *(const f32x4*)(base + off + bj * HALF + 4); } }
#pragma unroll
        for (int gi = 0; gi < 8; ++gi) { const int ai = gi >> 2, m = gi & 3; const int row = rowb + ai * HALF + m * 16; const size_t off = (size_t)row * ldc + col0; float s = 0.f;
            f32x4 cb[4];
#pragma unroll
            for (int k = 0; k < 4; ++k) cb[k] = nb[k];
            if (gi < 7) { const int ai2 = (gi + 1) >> 2, m2 = (gi + 1) & 3; const size_t off2 = (size_t)(rowb + ai2 * HALF + m2 * 16) * ldc + col0;
#pragma unroll
                for (int bj = 0; bj < 2; ++bj) { nb[2 * bj] = *(const f32x4*)(base + off2 + bj * HALF); nb[2 * bj + 1] = *(const f32x4*)(base + off2 + bj * HALF + 4); } }
            asm volatile("" ::: "memory");
#pragma unroll
            for (int bj = 0; bj < 2; ++bj) { const f32x4 o0 = cb[2 * bj] + acc[ai][bj][m][0], o1 = cb[2 * bj + 1] + acc[ai][bj][m][1];
                u32x4 w; w.x = cvt_pk_bf16(o0[0], o0[1]); w.y = cvt_pk_bf16(o0[2], o0[3]); w.z = cvt_pk_bf16(o1[0], o1[1]); w.w = cvt_pk_bf16(o1[2], o1[3]);
                *(u32x4*)(hb + off + bj * HALF) = w;
                s += (o0[0] * o0[0] + o0[1] * o0[1]) + (o0[2] * o0[2] + o0[3] * o0[3]) + (o1[0] * o1[0] + o1[1] * o1[1]) + (o1[2] * o1[2] + o1[3] * o1[3]); }
            s += __shfl_xor(s, 16); s += __shfl_xor(s, 32);
            if (fq == 0) unsafeAtomicAdd(sumsq + row, s); }
    }
};
struct EpiResNormB {
    static constexpr bool PERM = true, AFTER_DRAIN = true;
    const bf16_t* hb; float* out; float* sumsq; unsigned* cnt; const float* g; int ldc; int fuse; unsigned want; float inv_n, eps;
    struct Pre {}; __device__ __forceinline__ void prefetch(Pre&, const Unit&, int, int, int, int) const {}
    __device__ __forceinline__ void fused(f32x4 (&acc)[2][2][4][2], const Unit& u, int wr, int wc, int fr, int fq, PG8_LAS unsigned char* lds, int wid, int lane) const {
        const int col0 = u.pn * BM + wc * 32 + 8 * fq; const int rowb = u.pm * BM + wr * 64 + fr;
        u32x4 nw[2];
#pragma unroll
        for (int bj = 0; bj < 2; ++bj) nw[bj] = *(const u32x4*)(hb + (size_t)rowb * ldc + col0 + bj * HALF);
#pragma unroll
        for (int gi = 0; gi < 8; ++gi) { const int ai = gi >> 2, m = gi & 3; const int row = rowb + ai * HALF + m * 16; const size_t off = (size_t)row * ldc + col0; float s = 0.f;
            u32x4 cw[2] = {nw[0], nw[1]};
            if (gi < 7) { const int ai2 = (gi + 1) >> 2, m2 = (gi + 1) & 3; const size_t off2 = (size_t)(rowb + ai2 * HALF + m2 * 16) * ldc + col0;
#pragma unroll
                for (int bj = 0; bj < 2; ++bj) nw[bj] = *(const u32x4*)(hb + off2 + bj * HALF); }
            asm volatile("" ::: "memory");
#pragma unroll
            for (int bj = 0; bj < 2; ++bj) { const u32x4 w = cw[bj];
                const f32x4 b0 = {__builtin_bit_cast(float, w.x << 16), __builtin_bit_cast(float, w.x & 0xffff0000u), __builtin_bit_cast(float, w.y << 16), __builtin_bit_cast(float, w.y & 0xffff0000u)};
                const f32x4 b1 = {__builtin_bit_cast(float, w.z << 16), __builtin_bit_cast(float, w.z & 0xffff0000u), __builtin_bit_cast(float, w.w << 16), __builtin_bit_cast(float, w.w & 0xffff0000u)};
                const f32x4 o0 = b0 + acc[ai][bj][m][0], o1 = b1 + acc[ai][bj][m][1]; acc[ai][bj][m][0] = o0; acc[ai][bj][m][1] = o1;
                if (!fuse) { *(f32x4*)(out + off + bj * HALF) = o0; *(f32x4*)(out + off + bj * HALF + 4) = o1; }
                s += (o0[0] * o0[0] + o0[1] * o0[1]) + (o0[2] * o0[2] + o0[3] * o0[3]) + (o1[0] * o1[0] + o1[1] * o1[1]) + (o1[2] * o1[2] + o1[3] * o1[3]); }
            s += __shfl_xor(s, 16); s += __shfl_xor(s, 32);
            if (fq == 0) unsafeAtomicAdd(sumsq + row, s); }
        if (!fuse) return;
        asm volatile("s_waitcnt vmcnt(0)" ::: "memory");
        if (lane == 0) __hip_atomic_fetch_add(cnt + 64 * u.pm, 1u, __ATOMIC_RELAXED, __HIP_MEMORY_SCOPE_AGENT);
        if (wid == 0) { while ((unsigned)__builtin_amdgcn_readfirstlane(__hip_atomic_load(cnt + 64 * u.pm, __ATOMIC_RELAXED, __HIP_MEMORY_SCOPE_AGENT)) < want) __builtin_amdgcn_s_sleep(2); }
        asm volatile("s_waitcnt vmcnt(0) lgkmcnt(0)" ::: "memory"); __builtin_amdgcn_s_barrier(); asm volatile("" ::: "memory");
        __builtin_amdgcn_fence(__ATOMIC_ACQUIRE, "agent");
        f32x4 gv[2][2];
#pragma unroll
        for (int bj = 0; bj < 2; ++bj)
#pragma unroll
            for (int n = 0; n < 2; ++n) gv[bj][n] = *(const f32x4*)(g + col0 + bj * HALF + n * 4);
#pragma unroll
        for (int ai = 0; ai < 2; ++ai)
#pragma unroll
            for (int m = 0; m < 4; ++m) { const int row = u.pm * BM + ai * HALF + wr * 64 + m * 16 + fr; const size_t off = (size_t)row * ldc + col0;
                const float ssv = __hip_atomic_load(sumsq + row, __ATOMIC_RELAXED, __HIP_MEMORY_SCOPE_AGENT); const float rs = 1.0f / sqrtf(ssv * inv_n + eps);
#pragma unroll
                for (int bj = 0; bj < 2; ++bj)
#pragma unroll
                    for (int n = 0; n < 2; ++n) *(f32x4*)(out + off + bj * HALF + n * 4) = acc[ai][bj][m][n] * rs * gv[bj][n]; }
    }
};
template <class Epi, class Sched, bool ALIGN_EPI = false, bool SP2 = false>
__device__ __forceinline__ void gemm_phase(PG8_LAS unsigned char* lds, const Gemm g, const Sched& S, const Epi& E) {
    const int tid = threadIdx.x, wid = __builtin_amdgcn_readfirstlane(tid >> 6), lane = tid & 63, wr = wid >> 2, wc = wid & 3, fr = lane & 15, fq = lane >> 4;
    const int K = g.K, nt = K / BK;
    unsigned voffA[2], voffB[2];
#pragma unroll
    for (int i = 0; i < 2; ++i) { int R, C; stage_rc(tid * 16 + i * 8192, R, C); const int Rb = Epi::PERM ? ((R & ~31) + perm32(R & 31)) : R;
        voffA[i] = (unsigned)(R * K + C) * 2u; voffB[i] = (unsigned)(Rb * K + C) * 2u; }
    const size_t kstep = (size_t)(BK * 2);
    const size_t hstep = (size_t)HALF * K * 2;
    const size_t tstep = 2 * hstep;
    const unsigned ldsw = (unsigned)wid * 1024u;
    const int aoff = lds_byte(wr * 64 + fr, fq * 8), boff = lds_byte(wc * 32 + fr, fq * 8);
#define PG8_SA(b, h) (((b) * 2 + (h)) * HTB)
#define PG8_SB(b, h) ((4 + (b) * 2 + (h)) * HTB)
#define PG8_STAGE(bufoff, gbase, voff) do { _Pragma("unroll") for (int _i = 0; _i < 2; ++_i) \
        __builtin_amdgcn_global_load_lds((const unsigned*)((const char*)(gbase) + (voff)[_i]), (PG8_LAS unsigned*)(lds + (bufoff) + ldsw + _i * 8192), 16, 0, 0); } while (0)
#define PG8_LDA(dst, b, h) do { _Pragma("unroll") for (int m = 0; m < 4; ++m) _Pragma("unroll") for (int k = 0; k < 2; ++k) dst[m][k] = *(const PG8_LAS bf16x8*)(lds + PG8_SA(b, h) + aoff + m * 2048 + k * 1024); } while (0)
#define PG8_LDB(dst, b, h) do { _Pragma("unroll") for (int n = 0; n < 2; ++n) _Pragma("unroll") for (int k = 0; k < 2; ++k) dst[n][k] = *(const PG8_LAS bf16x8*)(lds + PG8_SB(b, h) + boff + n * 2048 + k * 1024); } while (0)
#define PG8_MMA(ai, bj, At, Bt) do { __builtin_amdgcn_s_setprio(1); _Pragma("unroll") for (int m = 0; m < 4; ++m) _Pragma("unroll") for (int n = 0; n < 2; ++n) _Pragma("unroll") for (int k = 0; k < 2; ++k) \
        acc[ai][bj][m][n] = __builtin_amdgcn_mfma_f32_16x16x32_bf16(Bt[n][k], At[m][k], acc[ai][bj][m][n], 0, 0, 0); __builtin_amdgcn_s_setprio(0); } while (0)
#define PG8_WAIT_V(n) asm volatile("s_waitcnt vmcnt(" #n ")" ::: "memory")
#define PG8_WAIT_L(n) asm volatile("s_waitcnt lgkmcnt(" #n ")" ::: "memory")
#define PG8_BAR __builtin_amdgcn_s_barrier()
#define PG8_SCHED __builtin_amdgcn_sched_barrier(0)
    Unit cur, nxt; int ui = 0;
    if (!S.next(0, cur)) return;
    f32x4 acc[2][2][4][2];
#pragma unroll
    for (int a = 0; a < 2; ++a)
#pragma unroll
        for (int b = 0; b < 2; ++b)
#pragma unroll
            for (int m = 0; m < 4; ++m)
#pragma unroll
                for (int n = 0; n < 2; ++n) acc[a][b][m][n] = (f32x4){0.f, 0.f, 0.f, 0.f};
    bf16x8 At[4][2], B0[2][2], B1[2][2];
    const char* cA = (const char*)g.A + (size_t)cur.pm * tstep; const char* cB = (const char*)g.Bt + (size_t)cur.pn * tstep;
    S.a_ready(cur);
    typename Epi::Pre pre; E.prefetch(pre, cur, wr, wc, fr, fq);
    if constexpr (SP2) {
        PG8_STAGE(PG8_SB(0, 0), cB, voffB); PG8_STAGE(PG8_SB(0, 1), cB + hstep, voffB); PG8_STAGE(PG8_SA(0, 0), cA, voffA); PG8_STAGE(PG8_SA(0, 1), cA + hstep, voffA);
        if (wr == 1) PG8_BAR;
        PG8_WAIT_V(2); PG8_BAR;
        PG8_STAGE(PG8_SB(1, 0), cB + kstep, voffB); PG8_STAGE(PG8_SA(1, 0), cA + kstep, voffA); PG8_STAGE(PG8_SB(1, 1), cB + hstep + kstep, voffB);
        PG8_WAIT_V(6); PG8_BAR;
    } else {
        PG8_STAGE(PG8_SB(0, 0), cB, voffB); PG8_STAGE(PG8_SA(0, 0), cA, voffA); PG8_STAGE(PG8_SB(0, 1), cB + hstep, voffB); PG8_STAGE(PG8_SA(0, 1), cA + hstep, voffA);
        if (wr == 1) PG8_BAR;
        PG8_WAIT_V(4); PG8_BAR;
        PG8_STAGE(PG8_SB(1, 0), cB + kstep, voffB); PG8_STAGE(PG8_SA(1, 0), cA + kstep, voffA); PG8_STAGE(PG8_SB(1, 1), cB + hstep + kstep, voffB);
        PG8_WAIT_V(6); PG8_BAR;
    }
    for (;;) {
        const bool has_next = S.next(ui + 1, nxt);
        const char* nA = has_next ? (const char*)g.A + (size_t)nxt.pm * tstep : cA; const char* nB = has_next ? (const char*)g.Bt + (size_t)nxt.pn * tstep : cB;
        for (int t = 0; t < nt; t += 2) {
            const bool last = (t == nt - 2);
            const char* a1 = cA + (size_t)(t + 1) * kstep;
            const char* a2 = last ? nA : cA + (size_t)(t + 2) * kstep; const char* b2 = last ? nB : cB + (size_t)(t + 2) * kstep;
            const char* a3 = a2 + kstep; const char* b3 = b2 + kstep;
            if (last && has_next) S.a_ready(nxt);
            if constexpr (SP2) {
            PG8_LDB(B0, 0, 0); PG8_LDB(B1, 0, 1); PG8_SCHED; PG8_LDA(At, 0, 0); PG8_STAGE(PG8_SA(1, 1), a1 + hstep, voffA);
            PG8_WAIT_V(8); PG8_WAIT_L(0); PG8_BAR; PG8_MMA(0, 0, At, B0); PG8_MMA(0, 1, At, B1); PG8_BAR; PG8_SCHED;
            PG8_LDA(At, 0, 1); PG8_STAGE(PG8_SB(0, 0), b2, voffB); PG8_STAGE(PG8_SB(0, 1), b2 + hstep, voffB); PG8_STAGE(PG8_SA(0, 0), a2, voffA);
            PG8_WAIT_V(8); PG8_WAIT_L(0); PG8_BAR; PG8_MMA(1, 0, At, B0); PG8_MMA(1, 1, At, B1); PG8_BAR; PG8_SCHED;
            PG8_LDB(B0, 1, 0); PG8_LDB(B1, 1, 1); PG8_SCHED; PG8_LDA(At, 1, 0); PG8_STAGE(PG8_SA(0, 1), a2 + hstep, voffA);
            PG8_WAIT_V(8); PG8_WAIT_L(0); PG8_BAR; PG8_MMA(0, 0, At, B0); PG8_MMA(0, 1, At, B1); PG8_BAR; PG8_SCHED;
            PG8_LDA(At, 1, 1); PG8_STAGE(PG8_SB(1, 0), b3, voffB); PG8_STAGE(PG8_SB(1, 1), b3 + hstep, voffB); PG8_STAGE(PG8_SA(1, 0), a3, voffA);
            PG8_WAIT_V(8); PG8_WAIT_L(0); PG8_BAR; PG8_MMA(1, 0, At, B0); PG8_MMA(1, 1, At, B1); PG8_BAR; PG8_SCHED;
            } else {
            PG8_LDB(B0, 0, 0); PG8_SCHED; PG8_LDA(At, 0, 0); PG8_STAGE(PG8_SA(1, 1), a1 + hstep, voffA);
            PG8_WAIT_L(8); PG8_BAR; PG8_WAIT_L(0); PG8_MMA(0, 0, At, B0); PG8_BAR; PG8_SCHED;
            PG8_LDB(B1, 0, 1); PG8_STAGE(PG8_SB(0, 0), b2, voffB);
            PG8_BAR; PG8_WAIT_L(0); PG8_MMA(0, 1, At, B1); PG8_BAR;
            PG8_LDA(At, 0, 1); PG8_STAGE(PG8_SA(0, 0), a2, voffA);
            PG8_BAR; PG8_WAIT_L(0); PG8_MMA(1, 0, At, B0); PG8_BAR; PG8_SCHED;
            PG8_STAGE(PG8_SB(0, 1), b2 + hstep, voffB);
            PG8_WAIT_V(6); PG8_BAR; PG8_MMA(1, 1, At, B1); PG8_BAR;
            PG8_LDB(B0, 1, 0); PG8_SCHED; PG8_LDA(At, 1, 0); PG8_STAGE(PG8_SA(0, 1), a2 + hstep, voffA);
            PG8_WAIT_L(8); PG8_BAR; PG8_WAIT_L(0); PG8_MMA(0, 0, At, B0); PG8_BAR; PG8_SCHED;
            PG8_LDB(B1, 1, 1); PG8_STAGE(PG8_SB(1, 0), b3, voffB);
            PG8_BAR; PG8_WAIT_L(0); PG8_MMA(0, 1, At, B1); PG8_BAR;
            PG8_LDA(At, 1, 1); PG8_STAGE(PG8_SA(1, 0), a3, voffA);
            PG8_BAR; PG8_WAIT_L(0); PG8_MMA(1, 0, At, B0); PG8_BAR; PG8_SCHED;
            PG8_STAGE(PG8_SB(1, 1), b3 + hstep, voffB);
            PG8_WAIT_V(6); PG8_BAR; PG8_MMA(1, 1, At, B1); PG8_BAR;
            }
        }
        if constexpr (ALIGN_EPI) { if (wr == 0) PG8_BAR; }
        if constexpr (!Epi::AFTER_DRAIN) { E(acc, cur, wr, wc, fr, fq, pre); S.done(cur); }
        if (!has_next) break;
#pragma unroll
        for (int a = 0; a < 2; ++a)
#pragma unroll
            for (int b = 0; b < 2; ++b)
#pragma unroll
                for (int m = 0; m < 4; ++m)
#pragma unroll
                    for (int n = 0; n < 2; ++n) acc[a][b][m][n] = (f32x4){0.f, 0.f, 0.f, 0.f};
        cur = nxt; cA = nA; cB = nB; ++ui;
        E.prefetch(pre, cur, wr, wc, fr, fq);
        if constexpr (ALIGN_EPI) { if (wr == 1) PG8_BAR; }
    }
    PG8_WAIT_V(0);
    if constexpr (!ALIGN_EPI) { if (wr == 0) PG8_BAR; }
    PG8_BAR;
    if constexpr (Epi::AFTER_DRAIN) { E.fused(acc, cur, wr, wc, fr, fq, lds, wid, lane); S.done(cur); }
#undef PG8_SA
#undef PG8_SB
#undef PG8_STAGE
#undef PG8_LDA
#undef PG8_LDB
#undef PG8_MMA
#undef PG8_WAIT_V
#undef PG8_WAIT_L
#undef PG8_BAR
#undef PG8_SCHED
}
}
#define GAS __attribute__((address_space(1)))
#define LAS __attribute__((address_space(3)))
typedef unsigned short bf16;
typedef unsigned v4u __attribute__((ext_vector_type(4)));
typedef unsigned v2u __attribute__((ext_vector_type(2)));
typedef float f32x4 __attribute__((ext_vector_type(4)));
typedef short bf16x8 __attribute__((ext_vector_type(8)));
typedef short s16x4 __attribute__((ext_vector_type(4)));

constexpr int NWAVES = 8, NTHR = 512;
constexpr int T = 8192, D = 1024, M = 16384, NPROJ = 3072, DIN = 3104, FF = 4096;
constexpr float EPS = 1e-6f;
constexpr int C_QA = 0, C_KA = 512, C_VA = 1024, C_QG = 1536, C_KG = 1792, C_VG = 2048, C_RG = 2560;

constexpr size_t MiB = 1u << 20;
constexpr size_t WS_SS2 = 0, WS_SS3 = 65536, WS_BAR = 131072, WS_PCNT = 131072 + 16384, WS_ZERO_BYTES = 32768, WS_DEC = 262144, WS_Z = 1 * MiB;
constexpr size_t WS_WIN = 4 * MiB, WS_WO = 11 * MiB, WS_W1 = 13 * MiB, WS_W2 = 21 * MiB;
constexpr size_t WS_XN = 32 * MiB, WS_Y = 32 * MiB, WS_PROJ = 64 * MiB, WS_CON = 160 * MiB, WS_SP = 224 * MiB;
constexpr size_t WS_HB = 64 * MiB, WS_ACT = 96 * MiB, WS_END = 256 * MiB;
constexpr int LDS_BYTES = 163840;

__device__ __forceinline__ unsigned f2bf(float f) { unsigned u = __builtin_bit_cast(unsigned, f); return (u + 0x7fffu + ((u >> 16) & 1u)) >> 16; }
__device__ __forceinline__ unsigned pk2(float lo, float hi) { return f2bf(lo) | (f2bf(hi) << 16); }
__device__ __forceinline__ float bf2f(unsigned short h) { return __builtin_bit_cast(float, (unsigned)h << 16); }
__device__ __forceinline__ float wave_sum(float v) {
#pragma unroll
    for (int o = 1; o < 64; o <<= 1) v += __shfl_xor(v, o);
    return v;
}
__device__ __forceinline__ f32x4 mfma16(bf16x8 x, bf16x8 y, f32x4 c) { return __builtin_amdgcn_mfma_f32_16x16x32_bf16(x, y, c, 0, 0, 0); }
typedef short v4i16_t __attribute__((ext_vector_type(4)));
__device__ __forceinline__ s16x4 tr4(const LAS unsigned char* p) { return __builtin_bit_cast(s16x4, __builtin_amdgcn_ds_read_tr16_b64_v4i16((LAS v4i16_t*)p)); }
__device__ __forceinline__ bf16x8 cat8(s16x4 a, s16x4 b) { bf16x8 r; r[0] = a[0]; r[1] = a[1]; r[2] = a[2]; r[3] = a[3]; r[4] = b[0]; r[5] = b[1]; r[6] = b[2]; r[7] = b[3]; return r; }
__device__ __forceinline__ bf16x8 pack8(f32x4 a, f32x4 b) {
    v4u w; w.x = pg8::cvt_pk_bf16(a[0], a[1]); w.y = pg8::cvt_pk_bf16(a[2], a[3]); w.z = pg8::cvt_pk_bf16(b[0], b[1]); w.w = pg8::cvt_pk_bf16(b[2], b[3]);
    return __builtin_bit_cast(bf16x8, w);
}

struct Frame {
    LAS unsigned char* lds;
    int tid, lane, wave, vcu, G;
};

__device__ __forceinline__ void p0_transpose_item(const float* W, int K, int N, bf16* WT, const float* gk, LAS float* scr, int item, int lane) {
    const int nblk = N / 32, kb = item / nblk, nb = item % nblk, k0 = 64 * kb, n0 = 32 * nb;
#pragma unroll 16
    for (int i = 0; i < 32; ++i) { const int kk = 2 * i + (lane >> 5); float v = W[(size_t)(k0 + kk) * N + n0 + (lane & 31)]; if (gk) v *= gk[k0 + kk]; scr[kk * 33 + (lane & 31)] = v; }
    asm volatile("s_waitcnt lgkmcnt(0)" ::: "memory");
    const int c = lane & 7;
#pragma unroll
    for (int j = 0; j < 4; ++j) { const int n = (lane >> 3) + 8 * j; const LAS float* s = scr + (8 * c) * 33 + n;
        v4u o; o.x = pk2(s[0 * 33], s[1 * 33]); o.y = pk2(s[2 * 33], s[3 * 33]); o.z = pk2(s[4 * 33], s[5 * 33]); o.w = pk2(s[6 * 33], s[7 * 33]);
        *(v4u*)(WT + (size_t)(n0 + n) * K + k0 + 8 * c) = o; }
    asm volatile("s_waitcnt lgkmcnt(0)" ::: "memory");
}
__device__ __forceinline__ void phase_prologue(const Frame& F, const float* x, const float* g_mix, const float* w_in, const float* w_out, const float* g_ff, const float* w1, const float* w2, unsigned char* ws) {
    LAS float* scr = (LAS float*)(F.lds + F.wave * 16384);
    const int gw = F.vcu * NWAVES + F.wave, NGW = F.G * NWAVES;
    constexpr int I_IN = (D / 64) * (DIN / 32), I_O = (D / 64) * (D / 32), I_1 = (D / 64) * (FF / 32), I_2 = (FF / 64) * (D / 32);
    constexpr int NITEMS = I_IN + I_O + I_1 + I_2;
    for (int it = gw; it < NITEMS; it += NGW) {
        int r = it;
        if (r < I_IN) { p0_transpose_item(w_in, D, DIN, (bf16*)(ws + WS_WIN), nullptr, scr, r, F.lane); continue; } r -= I_IN;
        if (r < I_O) { p0_transpose_item(w_out, D, D, (bf16*)(ws + WS_WO), nullptr, scr, r, F.lane); continue; } r -= I_O;
        if (r < I_1) { p0_transpose_item(w1, D, FF, (bf16*)(ws + WS_W1), g_ff, scr, r, F.lane); continue; } r -= I_1;
        p0_transpose_item(w2, FF, D, (bf16*)(ws + WS_W2), nullptr, scr, r, F.lane);
    }
    { float* ss = (float*)(ws + WS_SS2); for (int i = (F.vcu * NTHR + F.tid); i < 2 * M; i += F.G * NTHR) ss[i] = 0.f; }
    bf16* XN = (bf16*)(ws + WS_XN);
    f32x4 gv[4];
#pragma unroll
    for (int j = 0; j < 4; ++j) gv[j] = ((const f32x4*)g_mix)[F.lane + 64 * j];
    for (int m0 = gw; m0 < M; m0 += 4 * NGW) {
        f32x4 v[4][4]; float s[4];
#pragma unroll
        for (int q = 0; q < 4; ++q) { const int m = min(m0 + q * NGW, M - 1); const f32x4* xr = (const f32x4*)(x + (size_t)m * D) + F.lane;
#pragma unroll
            for (int j = 0; j < 4; ++j) v[q][j] = xr[64 * j]; }
#pragma unroll
        for (int q = 0; q < 4; ++q) { float t = 0.f;
#pragma unroll
            for (int j = 0; j < 4; ++j) t += (v[q][j].x * v[q][j].x + v[q][j].y * v[q][j].y) + (v[q][j].z * v[q][j].z + v[q][j].w * v[q][j].w);
            s[q] = t; }
#pragma unroll
        for (int o = 1; o < 64; o <<= 1) {
#pragma unroll
            for (int q = 0; q < 4; ++q) s[q] += __shfl_xor(s[q], o); }
#pragma unroll
        for (int q = 0; q < 4; ++q) { const int m = m0 + q * NGW; if (m < M) { const float rs = 1.0f / sqrtf(s[q] * (1.f / D) + EPS);
            unsigned long long* o8 = (unsigned long long*)(XN + (size_t)m * D) + F.lane;
#pragma unroll
            for (int j = 0; j < 4; ++j) { const f32x4 o = v[q][j] * rs * gv[j]; o8[64 * j] = (unsigned long long)pk2(o.x, o.y) | ((unsigned long long)pk2(o.z, o.w) << 32); } } }
    }
}

__device__ __forceinline__ void phase_z(const Frame& F, const bf16* XN, const bf16* Wz, float* Z) {
    const int fr = F.lane & 15, fq = F.lane >> 4, w = F.wave;
    LAS float* red = (LAS float*)F.lds;
    for (int rb = F.vcu; rb < M / 64; rb += F.G) {
        bf16x8 a[4][4], b[2][4];
#pragma unroll
        for (int mt = 0; mt < 4; ++mt)
#pragma unroll
            for (int ks = 0; ks < 4; ++ks) a[mt][ks] = *(const bf16x8*)(XN + (size_t)(rb * 64 + mt * 16 + fr) * D + 128 * w + ks * 32 + 8 * fq);
#pragma unroll
        for (int nt = 0; nt < 2; ++nt)
#pragma unroll
            for (int ks = 0; ks < 4; ++ks) b[nt][ks] = *(const bf16x8*)(Wz + (size_t)(nt * 16 + fr) * D + 128 * w + ks * 32 + 8 * fq);
#pragma unroll
        for (int mt = 0; mt < 4; ++mt)
#pragma unroll
            for (int nt = 0; nt < 2; ++nt) { f32x4 acc = {0.f, 0.f, 0.f, 0.f};
#pragma unroll
                for (int ks = 0; ks < 4; ++ks) acc = mfma16(b[nt][ks], a[mt][ks], acc);
                *(LAS f32x4*)(red + ((w * 8 + mt * 2 + nt) * 64 + F.lane) * 4) = acc; }
        __syncthreads();
        { const int t = F.tid & 7, ln = F.tid >> 3 & 63;
          const int tile = F.tid >> 6, lane = F.tid & 63; (void)t; (void)ln;
          f32x4 sacc = {0.f, 0.f, 0.f, 0.f};
#pragma unroll
          for (int ww = 0; ww < 8; ++ww) sacc += *(const LAS f32x4*)(red + ((ww * 8 + tile) * 64 + lane) * 4);
          const int mt = tile >> 1, nt = tile & 1, lfr = lane & 15, lfq = lane >> 4;
          *(f32x4*)(Z + (size_t)(rb * 64 + mt * 16 + lfr) * 32 + nt * 16 + 4 * lfq) = sacc; }
        __syncthreads();
    }
}

constexpr int NA_STR = 144, NA_VSTR = 136, NA_K_OFF = 0, NA_V_OFF = 512 * NA_STR, NA_RPB_OFF = NA_V_OFF + 512 * NA_VSTR, NA_X_OFF = NA_RPB_OFF + 1872, NA_X_PAIR = 18 * 256;
static_assert(NA_X_OFF + 4 * NA_X_PAIR <= LDS_BYTES - 64, "natten LDS map");
__device__ __forceinline__ void natten_compute(const Frame& F, const bf16x8 (&qf)[2], bf16* Y, int b, int h, int r, int rs, bool slide, int newrow, const v4u& nk, const v4u& nv) {
    LAS unsigned char* lds = F.lds;
    const size_t tokq0 = (size_t)b * T + r * 64;
    const int fr = F.lane & 15, fq = F.lane >> 4, jq = F.wave & 3, kh = F.wave >> 2;
    const int wc0 = (jq == 0) ? 0 : (jq == 1) ? 8 : (jq == 2) ? 24 : 32;
    f32x4 s[8];
#pragma unroll
    for (int il = 0; il < 4; ++il)
#pragma unroll
        for (int ct = 0; ct < 2; ++ct) {
            const LAS unsigned char* kp = lds + NA_K_OFF + (((rs + 4 * kh + il) & 7) * 64 + wc0 + 16 * ct + fr) * NA_STR + fq * 16;
            const bf16x8 k0 = *(const LAS bf16x8*)kp, k1 = *(const LAS bf16x8*)(kp + 64);
            f32x4 a = {0.f, 0.f, 0.f, 0.f}; a = mfma16(k0, qf[0], a); a = mfma16(k1, qf[1], a); s[il * 2 + ct] = a; }
    const int cq = 16 * jq + fr, cs = min(max(cq - 8, 0), 48);
    const LAS float* rp = (const LAS float*)(lds + NA_RPB_OFF);
    float mx = -INFINITY;
#pragma unroll
    for (int il = 0; il < 4; ++il) { const int dr = rs + 4 * kh + il - r + 7;
#pragma unroll
        for (int ct = 0; ct < 2; ++ct)
#pragma unroll
            for (int e = 0; e < 4; ++e) { const int ck = wc0 + 16 * ct + 4 * fq + e; const bool in = (ck >= cs) && (ck < cs + 16);
                const int dc = min(max(ck - cq + 15, 0), 30);
                const float v = in ? s[il * 2 + ct][e] * 0.125f + rp[dr * 31 + dc] : -INFINITY; s[il * 2 + ct][e] = v; mx = fmaxf(mx, v); } }
    mx = fmaxf(mx, __shfl_xor(mx, 16)); mx = fmaxf(mx, __shfl_xor(mx, 32));
    float l = 0.f;
#pragma unroll
    for (int t = 0; t < 8; ++t)
#pragma unroll
        for (int e = 0; e < 4; ++e) { const float p = __expf(s[t][e] - mx); s[t][e] = p; l += p; }
    l += __shfl_xor(l, 16); l += __shfl_xor(l, 32);
    f32x4 o[4];
#pragma unroll
    for (int dt = 0; dt < 4; ++dt) o[dt] = (f32x4){0.f, 0.f, 0.f, 0.f};
#pragma unroll
    for (int il = 0; il < 4; ++il) { const bf16x8 pb = pack8(s[2 * il], s[2 * il + 1]);
#pragma unroll
        for (int dt = 0; dt < 4; ++dt) {
            const LAS unsigned char* vp = lds + NA_V_OFF + (((rs + 4 * kh + il) & 7) * 64 + wc0 + 4 * fq + (fr >> 2)) * NA_VSTR + (16 * dt + 4 * (fr & 3)) * 2;
            const bf16x8 x = cat8(tr4(vp), tr4(vp + 16 * NA_VSTR)); o[dt] = mfma16(x, pb, o[dt]); } }
    LAS float* xch = (LAS float*)(lds + NA_X_OFF + jq * NA_X_PAIR) + F.lane;
    if (kh == 1) {
#pragma unroll
        for (int dt = 0; dt < 4; ++dt)
#pragma unroll
            for (int e = 0; e < 4; ++e) xch[(dt * 4 + e) * 64] = o[dt][e];
        xch[16 * 64] = mx; xch[17 * 64] = l;
    }
    __syncthreads();
    if (slide) { const int col = F.tid >> 3, ch = F.tid & 7, kk = ((newrow & 7) * 64) + col; *(LAS v4u*)(lds + NA_K_OFF + kk * NA_STR + ch * 16) = nk;
        *(LAS v2u*)(lds + NA_V_OFF + kk * NA_VSTR + ch * 16) = (v2u){nv.x, nv.y}; *(LAS v2u*)(lds + NA_V_OFF + kk * NA_VSTR + ch * 16 + 8) = (v2u){nv.z, nv.w}; }
    if (kh == 0) {
        const float m1 = xch[16 * 64], l1 = xch[17 * 64], m = fmaxf(mx, m1), a0 = __expf(mx - m), a1 = __expf(m1 - m), inv = 1.0f / (a0 * l + a1 * l1), c0 = a0 * inv, c1 = a1 * inv;
#pragma unroll
        for (int dt = 0; dt < 4; ++dt) { float ov[4];
#pragma unroll
            for (int e = 0; e < 4; ++e) ov[e] = o[dt][e] * c0 + xch[(dt * 4 + e) * 64] * c1;
            v2u w; w.x = pg8::cvt_pk_bf16(ov[0], ov[1]); w.y = pg8::cvt_pk_bf16(ov[2], ov[3]);
            *(v2u*)(Y + (tokq0 + 16 * jq + fr) * D + h * 64 + 16 * dt + 4 * fq) = w; }
    }
}
__device__ __forceinline__ void natten_wg(const Frame& F, const bf16* PROJ, const float* rpb, bf16* Y, int wgi) {
    LAS unsigned char* lds = F.lds;
    const int bh = wgi >> 4, r0 = 8 * (wgi & 15), h = bh & 7, b = bh >> 3;
    const int fr = F.lane & 15, fq = F.lane >> 4, jq = F.wave & 3;
    const bf16* qbase = PROJ + ((size_t)b * T + 16 * jq + fr) * NPROJ + C_QA + h * 64 + 8 * fq;
    bf16x8 qf[2], qn[2];
    { const bf16* qp = qbase + (size_t)r0 * 64 * NPROJ; qf[0] = *(const bf16x8*)qp; qf[1] = *(const bf16x8*)(qp + 32); }
    { const int rs0 = min(max(r0 - 4, 0), 120);
#pragma unroll
      for (int it = 0; it < 8; ++it) { const int id = F.tid + NTHR * it, key = id >> 3, ch = id & 7, row = rs0 + (key >> 6), col = key & 63;
        const bf16* src = PROJ + ((size_t)b * T + row * 64 + col) * NPROJ + C_KA + h * 64 + ch * 8;
        const v4u kv = *(const v4u*)src, vv = *(const v4u*)(src + (C_VA - C_KA));
        const int kk = (row & 7) * 64 + col;
        *(LAS v4u*)(lds + NA_K_OFF + kk * NA_STR + ch * 16) = kv; *(LAS v2u*)(lds + NA_V_OFF + kk * NA_VSTR + ch * 16) = (v2u){vv.x, vv.y}; *(LAS v2u*)(lds + NA_V_OFF + kk * NA_VSTR + ch * 16 + 8) = (v2u){vv.z, vv.w}; } }
    if (F.tid < 465) ((LAS float*)(lds + NA_RPB_OFF))[F.tid] = rpb[h * 465 + F.tid];
    __syncthreads();
    for (int rr = 0; rr < 8; ++rr) {
        const int r = r0 + rr, rs = min(max(r - 4, 0), 120), rsn = min(max(r - 3, 0), 120);
        const bool more = rr < 7, slide = more && (rsn != rs);
        v4u nk = {0u, 0u, 0u, 0u}, nv = {0u, 0u, 0u, 0u};
        if (more) { const bf16* qp = qbase + (size_t)(r + 1) * 64 * NPROJ; qn[0] = *(const bf16x8*)qp; qn[1] = *(const bf16x8*)(qp + 32); }
        if (slide) { const int col = F.tid >> 3, ch = F.tid & 7; const bf16* src = PROJ + ((size_t)b * T + (rsn + 7) * 64 + col) * NPROJ + C_KA + h * 64 + ch * 8; nk = *(const v4u*)src; nv = *(const v4u*)(src + (C_VA - C_KA)); }
        natten_compute(F, qf, Y, b, h, r, rs, slide, rsn + 7, nk, nv);
        if (more) { qf[0] = qn[0]; qf[1] = qn[1]; }
        __syncthreads();
    }
}

constexpr int GL_Z = 0, GL_GU = 8192, GL_GB = 16384, GL_GT = 16896, GL_I0 = 20992;
constexpr int IS = 144, IMG = 64 * IS;
constexpr int VS = 272, VIMG = 64 * VS;
constexpr int GL_QF = GL_I0, GL_QB = GL_I0 + IMG, GL_KF = GL_I0 + 2 * IMG, GL_KB = GL_I0 + 3 * IMG, GL_V = GL_I0 + 4 * IMG, GL_SF = GL_V + VIMG, GL_SB = GL_SF + VIMG;
static_assert(GL_SB + VIMG <= LDS_BYTES, "GLA LDS map");
__device__ __forceinline__ float logsig(float x) { return fminf(x, 0.f) - __logf(1.0f + __expf(-fabsf(x))); }

__device__ __forceinline__ void gla_gate_core(const Frame& F, float (&bf)[8], float (&bb)[8], float& totf, float& totb) {
    LAS unsigned char* lds = F.lds; const int tid = F.tid, d = tid & 63, g = F.wave;
    const LAS float* Zl = (const LAS float*)(lds + GL_Z); const LAS float* GU = (const LAS float*)(lds + GL_GU); const LAS float* GB = (const LAS float*)(lds + GL_GB);
    float uf[16], ub[16];
#pragma unroll
    for (int rr = 0; rr < 16; ++rr) { uf[rr] = GU[rr * 64 + d]; ub[rr] = GU[1024 + rr * 64 + d]; }
    const float gf0 = GB[d], gb0 = GB[64 + d];
    float laf[8], lab[8];
#pragma unroll
    for (int j = 0; j < 8; ++j) { const int c = 8 * g + j; float pf = gf0, pb = gb0;
#pragma unroll
        for (int r4 = 0; r4 < 4; ++r4) { const f32x4 zf = *(const LAS f32x4*)(Zl + c * 32 + 4 * r4), zb = *(const LAS f32x4*)(Zl + c * 32 + 16 + 4 * r4);
#pragma unroll
            for (int e = 0; e < 4; ++e) { pf += zf[e] * uf[4 * r4 + e]; pb += zb[e] * ub[4 * r4 + e]; } }
        laf[j] = logsig(pf) * (1.0f / 16.0f); lab[j] = logsig(pb) * (1.0f / 16.0f); }
    float run = 0.f;
#pragma unroll
    for (int j = 0; j < 8; ++j) { run += laf[j]; bf[j] = run; }
    float runb = 0.f;
#pragma unroll
    for (int j = 7; j >= 0; --j) { runb += lab[j]; bb[j] = runb; }
    LAS float* GT = (LAS float*)(lds + GL_GT);
    GT[g * 64 + d] = run; GT[512 + g * 64 + d] = runb;
    __syncthreads();
    float of = 0.f, ob = 0.f; totf = 0.f; totb = 0.f;
#pragma unroll
    for (int gp = 0; gp < 8; ++gp) { const float a = GT[gp * 64 + d], c = GT[512 + gp * 64 + d]; totf += a; totb += c; if (gp < g) of += a; if (gp > g) ob += c; }
#pragma unroll
    for (int j = 0; j < 8; ++j) { bf[j] += of; bb[j] += ob; }
}
__device__ __forceinline__ void stage_img128(LAS unsigned char* dst, const bf16* src, size_t row_stride, int tid) {
#pragma unroll
    for (int it = 0; it < 2; ++it) { const int id = tid + NTHR * it, row = id >> 4, ch = id & 15; *(LAS v4u*)(dst + row * VS + ch * 16) = *(const v4u*)(src + (size_t)row * row_stride + ch * 8); }
}

struct GlaAFetch { unsigned short kraw[8], qraw[8]; v4u v[2]; f32x4 z, gu; float gb; };
__device__ __forceinline__ void gla_a_fetch(GlaAFetch& R, const Frame& F, const bf16* PROJ, const float* Z, const float* guf, const float* gbf, const float* gub, const float* gbb, int unit) {
    const int tid = F.tid, d = tid & 63, g = F.wave;
    const int n = unit & 127, bh = unit >> 7, h = bh & 3, b = bh >> 2; const size_t t0 = (size_t)b * T + 64 * n;
#pragma unroll
    for (int j = 0; j < 8; ++j) { const bf16* p = PROJ + (t0 + 8 * g + j) * NPROJ + h * 64 + d; R.qraw[j] = p[C_QG]; R.kraw[j] = p[C_KG]; }
#pragma unroll
    for (int it = 0; it < 2; ++it) { const int id = tid + NTHR * it, row = id >> 4, ch = id & 15; R.v[it] = *(const v4u*)(PROJ + (t0 + row) * NPROJ + C_VG + h * 128 + ch * 8); }
    R.z = *(const f32x4*)(Z + t0 * 32 + tid * 4);
    { const int idx = tid * 4, dir = idx >> 10, rr = (idx >> 6) & 15, dd = idx & 63; R.gu = *(const f32x4*)((dir ? gub : guf) + rr * 256 + h * 64 + dd); }
    R.gb = (tid < 128) ? ((tid >> 6) ? gbb : gbf)[h * 64 + (tid & 63)] : 0.f;
}
__device__ __forceinline__ void phase_gla_a(const Frame& F, const bf16* PROJ, const float* Z, const float* guf, const float* gbf, const float* gub, const float* gbb, float* CON, float* DEC, bf16* IMGS) {
    LAS unsigned char* lds = F.lds; const int tid = F.tid, d = tid & 63, g = F.wave;
    GlaAFetch R;
    int unit = F.vcu;
    if (unit < 1024) gla_a_fetch(R, F, PROJ, Z, guf, gbf, gub, gbb, unit);
    for (; unit < 1024; unit += F.G) {
        unsigned short kraw[8], qraw[8];
#pragma unroll
        for (int j = 0; j < 8; ++j) { kraw[j] = R.kraw[j]; qraw[j] = R.qraw[j]; }
#pragma unroll
        for (int it = 0; it < 2; ++it) { const int id = tid + NTHR * it, row = id >> 4, ch = id & 15; *(LAS v4u*)(lds + GL_V + row * VS + ch * 16) = R.v[it]; }
        *(LAS f32x4*)(lds + GL_Z + tid * 16) = R.z; *(LAS f32x4*)(lds + GL_GU + tid * 16) = R.gu;
        if (tid < 128) ((LAS float*)(lds + GL_GB))[tid] = R.gb;
        __syncthreads();
        if (unit + F.G < 1024) gla_a_fetch(R, F, PROJ, Z, guf, gbf, gub, gbb, unit + F.G);
        float bf[8], bb[8], totf, totb;
        gla_gate_core(F, bf, bb, totf, totb);
        const float decf = __expf(totf), decb = __expf(totb);
        bf16* im = IMGS + (size_t)unit * 16384 + d;
#pragma unroll
        for (int j = 0; j < 8; ++j) { const float k = bf2f(kraw[j]), q = bf2f(qraw[j]) * 0.125f; const int c = 8 * g + j;
            const float ef = __expf(bf[j]), eb = __expf(bb[j]), rf = 1.0f / ef, rb = 1.0f / eb, kif = k * rf, kib = k * rb;
            *(LAS unsigned short*)(lds + GL_KF + c * IS + d * 2) = (unsigned short)f2bf(kif * decf);
            *(LAS unsigned short*)(lds + GL_KB + c * IS + d * 2) = (unsigned short)f2bf(kib * decb);
            im[c * 64] = (bf16)f2bf(q * ef); im[4096 + c * 64] = (bf16)f2bf(kif); im[8192 + c * 64] = (bf16)f2bf(q * eb); im[12288 + c * 64] = (bf16)f2bf(kib); }
        if (g == 0) { DEC[(size_t)unit * 64 + d] = decf; DEC[(size_t)(1024 + unit) * 64 + d] = decb; }
        __syncthreads();
        const int fr = F.lane & 15, fq = F.lane >> 4, dir = F.wave >> 2, dt = F.wave & 3;
        const LAS unsigned char* kimg = lds + (dir ? GL_KB : GL_KF);
        bf16x8 yk[2];
#pragma unroll
        for (int s = 0; s < 2; ++s) { const LAS unsigned char* p = kimg + (32 * s + 4 * fq + (fr >> 2)) * IS + (16 * dt + 4 * (fr & 3)) * 2; yk[s] = cat8(tr4(p), tr4(p + 16 * IS)); }
        float* cbase = CON + ((size_t)(dir * 1024 + unit) * 64 + 16 * dt + fr) * 128 + 4 * fq;
#pragma unroll
        for (int et = 0; et < 8; ++et) { f32x4 acc = {0.f, 0.f, 0.f, 0.f};
#pragma unroll
            for (int s = 0; s < 2; ++s) { const LAS unsigned char* p = lds + GL_V + (32 * s + 4 * fq + (fr >> 2)) * VS + (16 * et + 4 * (fr & 3)) * 2; acc = mfma16(cat8(tr4(p), tr4(p + 16 * VS)), yk[s], acc); }
            *(f32x4*)(cbase + 16 * et) = acc; }
        __syncthreads();
    }
}

__device__ __forceinline__ void phase_scan(const Frame& F, const float* __restrict__ CON, const float* __restrict__ DEC, bf16* __restrict__ SP) {
    for (int chain = F.vcu * NTHR + F.tid; chain < 2 * 8 * 64 * 128; chain += F.G * NTHR) {
        const int e = chain & 127, d = (chain >> 7) & 63, bh = (chain >> 13) & 7, dir = chain >> 16;
        const size_t ubase = (size_t)dir * 1024 + bh * 128;
        const float* con = CON + (ubase * 64 + d) * 128 + e; const float* dec = DEC + ubase * 64 + d; bf16* sp = SP + (ubase * 64 + d) * 128 + e;
        float S = 0.f;
        for (int nb = 0; nb < 8; ++nb) { float c[16], gg[16];
#pragma unroll
            for (int u = 0; u < 16; ++u) { const int n = nb * 16 + u, ne = dir ? 127 - n : n; c[u] = con[(size_t)ne * 8192]; gg[u] = dec[ne * 64]; }
#pragma unroll
            for (int u = 0; u < 16; ++u) { const int n = nb * 16 + u, ne = dir ? 127 - n : n; sp[(size_t)ne * 8192] = (bf16)f2bf(S); S = gg[u] * S + c[u]; } }
    }
}

struct GlaCFetch { v4u im[4], v[2], sf[2], sb[2]; };
__device__ __forceinline__ void gla_c_fetch(GlaCFetch& R, const bf16* PROJ, const bf16* SP, const bf16* IMGS, int unit, int tid) {
    const int n = unit & 127, bh = unit >> 7, h = bh & 3, b = bh >> 2; const size_t t0 = (size_t)b * T + 64 * n;
#pragma unroll
    for (int k = 0; k < 4; ++k) R.im[k] = *(const v4u*)(IMGS + (size_t)unit * 16384 + k * 4096 + tid * 8);
#pragma unroll
    for (int it = 0; it < 2; ++it) { const int id = tid + NTHR * it, row = id >> 4, ch = id & 15;
        R.v[it] = *(const v4u*)(PROJ + (t0 + row) * NPROJ + C_VG + h * 128 + ch * 8);
        R.sf[it] = *(const v4u*)(SP + (size_t)unit * 8192 + row * 128 + ch * 8);
        R.sb[it] = *(const v4u*)(SP + (size_t)(1024 + unit) * 8192 + row * 128 + ch * 8); }
}
__device__ __forceinline__ void gla_c_commit(const GlaCFetch& R, LAS unsigned char* lds, int tid) {
    { const int row = tid >> 3, ch = tid & 7, o = row * IS + ch * 16;
      *(LAS v4u*)(lds + GL_QF + o) = R.im[0]; *(LAS v4u*)(lds + GL_KF + o) = R.im[1]; *(LAS v4u*)(lds + GL_QB + o) = R.im[2]; *(LAS v4u*)(lds + GL_KB + o) = R.im[3]; }
#pragma unroll
    for (int it = 0; it < 2; ++it) { const int id = tid + NTHR * it, row = id >> 4, ch = id & 15, o = row * VS + ch * 16;
        *(LAS v4u*)(lds + GL_V + o) = R.v[it]; *(LAS v4u*)(lds + GL_SF + o) = R.sf[it]; *(LAS v4u*)(lds + GL_SB + o) = R.sb[it]; }
}
constexpr int GL_SSX = 110592;
static_assert(GL_SSX >= GL_SB + VIMG && GL_SSX + 512 <= LDS_BYTES - 64, "GLA-c exchange words");
__device__ __forceinline__ void gla_c_compute(const Frame& F, const bf16* PROJ, const float* norm_g, bf16* Y, int unit) {
    LAS unsigned char* lds = F.lds;
    const int n = unit & 127, bh = unit >> 7, h = bh & 3, b = bh >> 2; const size_t t0 = (size_t)b * T + 64 * n;
    const int fr = F.lane & 15, fq = F.lane >> 4, it = F.wave & 3, eh = F.wave >> 2;
    const int i = 16 * it + fr;
    const bf16* rp = PROJ + (t0 + i) * NPROJ + C_RG + h * 128 + 64 * eh + 4 * fq; bf16* yp = Y + (t0 + i) * D + 512 + h * 128 + 64 * eh + 4 * fq;
    v2u rw[4];
#pragma unroll
    for (int el = 0; el < 4; ++el) rw[el] = *(const v2u*)(rp + 16 * el);
    bf16x8 yqf[2], yqb[2];
#pragma unroll
    for (int s = 0; s < 2; ++s) { const int off = (16 * it + fr) * IS + (32 * s + 8 * fq) * 2; yqf[s] = *(const LAS bf16x8*)(lds + GL_QF + off); yqb[s] = *(const LAS bf16x8*)(lds + GL_QB + off); }
    f32x4 a[4];
#pragma unroll
    for (int jt = 0; jt < 4; ++jt) { f32x4 af = {0.f, 0.f, 0.f, 0.f}, ab = {0.f, 0.f, 0.f, 0.f};
#pragma unroll
        for (int s = 0; s < 2; ++s) { const int off = (16 * jt + fr) * IS + (32 * s + 8 * fq) * 2;
            af = mfma16(*(const LAS bf16x8*)(lds + GL_KF + off), yqf[s], af); ab = mfma16(*(const LAS bf16x8*)(lds + GL_KB + off), yqb[s], ab); }
#pragma unroll
        for (int e = 0; e < 4; ++e) { const int j = 16 * jt + 4 * fq + e; a[jt][e] = (j <= i) ? af[e] : ab[e]; } }
    f32x4 o[4];
#pragma unroll
    for (int el = 0; el < 4; ++el) o[el] = (f32x4){0.f, 0.f, 0.f, 0.f};
#pragma unroll
    for (int s = 0; s < 2; ++s) { const bf16x8 pb = pack8(a[2 * s], a[2 * s + 1]);
#pragma unroll
        for (int el = 0; el < 4; ++el) { const LAS unsigned char* p = lds + GL_V + (32 * s + 4 * fq + (fr >> 2)) * VS + (16 * (4 * eh + el) + 4 * (fr & 3)) * 2; o[el] = mfma16(cat8(tr4(p), tr4(p + 16 * VS)), pb, o[el]); } }
#pragma unroll
    for (int s = 0; s < 2; ++s)
#pragma unroll
        for (int el = 0; el < 4; ++el) { const int off = (32 * s + 8 * fq + (fr >> 2)) * VS + (16 * (4 * eh + el) + 4 * (fr & 3)) * 2;
            o[el] = mfma16(cat8(tr4(lds + GL_SF + off), tr4(lds + GL_SF + off + 4 * VS)), yqf[s], o[el]);
            o[el] = mfma16(cat8(tr4(lds + GL_SB + off), tr4(lds + GL_SB + off + 4 * VS)), yqb[s], o[el]); }
    float ss = 0.f;
#pragma unroll
    for (int el = 0; el < 4; ++el) ss += (o[el][0] * o[el][0] + o[el][1] * o[el][1]) + (o[el][2] * o[el][2] + o[el][3] * o[el][3]);
    ss += __shfl_xor(ss, 16); ss += __shfl_xor(ss, 32);
    LAS float* ssx = (LAS float*)(lds + GL_SSX);
    if (fq == 0) ssx[eh * 64 + i] = ss;
    __syncthreads();
    ss += ssx[(1 - eh) * 64 + i];
    const float rs = 1.0f / sqrtf(ss * (1.0f / 128.0f) + EPS);
#pragma unroll
    for (int el = 0; el < 4; ++el) { const f32x4 gn = *(const f32x4*)(norm_g + 64 * eh + 16 * el + 4 * fq);
        float rv[4] = {__builtin_bit_cast(float, rw[el].x << 16), __builtin_bit_cast(float, rw[el].x & 0xffff0000u), __builtin_bit_cast(float, rw[el].y << 16), __builtin_bit_cast(float, rw[el].y & 0xffff0000u)};
        float ov[4];
#pragma unroll
        for (int e = 0; e < 4; ++e) { const float sg = rv[e] / (1.0f + __expf(-rv[e])); ov[e] = o[el][e] * rs * gn[e] * sg; }
        v2u w; w.x = pg8::cvt_pk_bf16(ov[0], ov[1]); w.y = pg8::cvt_pk_bf16(ov[2], ov[3]); *(v2u*)(yp + 16 * el) = w; }
}
__device__ __forceinline__ void phase_gla_c(const Frame& F, const bf16* PROJ, const bf16* SP, const bf16* IMGS, const float* norm_g, bf16* Y) {
    GlaCFetch R;
    int u = F.vcu;
    if (u < 1024) gla_c_fetch(R, PROJ, SP, IMGS, u, F.tid);
    for (; u < 1024; u += F.G) {
        gla_c_commit(R, F.lds, F.tid);
        __syncthreads();
        if (u + F.G < 1024) gla_c_fetch(R, PROJ, SP, IMGS, u + F.G, F.tid);
        gla_c_compute(F, PROJ, norm_g, Y, u);
        __syncthreads();
    }
}

__device__ __forceinline__ void phase_final(const Frame& F, float* out, const float* ss, const float* g) {
    const int gw = F.vcu * NWAVES + F.wave, NGW = F.G * NWAVES;
    f32x4 gv[4];
#pragma unroll
    for (int j = 0; j < 4; ++j) gv[j] = ((const f32x4*)g)[F.lane + 64 * j];
    for (int m = gw; m < M; m += NGW) { f32x4* xr = (f32x4*)(out + (size_t)m * D) + F.lane; const float rs = 1.0f / sqrtf(ss[m] * (1.f / D) + EPS);
#pragma unroll
        for (int j = 0; j < 4; ++j) xr[64 * j] = xr[64 * j] * rs * gv[j]; }
}

#define XB_TMO      128
#define XB_XCNT(j)  (256  + 64 * (j))
#define XB_XSUB(j)  (1280 + 64 * (j))
#define XB_XGEN(j)  (2304 + 64 * (j))
#define XB_TOP      3328
#define XB_TOPGEN   3392
#define XCD_BAR_WORDS 3456
#define XB_SPIN_CAP (1u << 18)

__device__ __forceinline__ unsigned xb_ld(unsigned* p)              { return __hip_atomic_load(p, __ATOMIC_RELAXED, __HIP_MEMORY_SCOPE_AGENT); }
__device__ __forceinline__ unsigned xb_add(unsigned* p, unsigned v) { return __hip_atomic_fetch_add(p, v, __ATOMIC_RELAXED, __HIP_MEMORY_SCOPE_AGENT); }
__device__ __forceinline__ unsigned xb_xcc_id() { return (unsigned)__builtin_amdgcn_s_getreg((3 << 11) | 20) & 0xFu; }
#define XB_SPIN(cond, bar) do { unsigned _sp = 0; while (cond) { __builtin_amdgcn_s_sleep(1); \
    if ((++_sp & 255u) == 0u) { if (xb_ld(&(bar)[XB_TMO])) break; if (_sp > XB_SPIN_CAP) { atomicAdd(&(bar)[XB_TMO], 1u); break; } } } } while (0)

struct XcdBarrier {
    unsigned* bar; unsigned x;
    volatile LAS unsigned* st;
};

__device__ __forceinline__ XcdBarrier xcd_barrier_post(unsigned* bar, volatile LAS unsigned* st) {
    XcdBarrier b; b.bar = bar; b.x = xb_xcc_id(); b.st = st;
    if (threadIdx.x == 0) (void)xb_add(&bar[XB_XCNT(b.x)], 1u);
    return b;
}
__device__ __forceinline__ void xcd_barrier_complete(unsigned* bar, unsigned x, unsigned& nloc, unsigned& nx) {
    const unsigned G = gridDim.x * gridDim.y * gridDim.z;
    unsigned sum, cnt, mine, sp = 0u;
    for (;;) {
        sum = 0u; cnt = 0u; mine = 0u;
#pragma unroll
        for (unsigned j = 0; j < 16; ++j) { const unsigned c = xb_ld(&bar[XB_XCNT(j)]); sum += c; cnt += (c > 0u) ? 1u : 0u; mine = (j == x) ? c : mine; }
        if (sum == G) break;
        __builtin_amdgcn_s_sleep(1);
        if ((++sp & 255u) == 0u) { if (xb_ld(&bar[XB_TMO])) break; if (sp > XB_SPIN_CAP) { atomicAdd(&bar[XB_TMO], 1u); break; } }
    }
    nloc = mine > 0u ? mine : 1u; nx = cnt > 0u ? cnt : 1u;
}

__device__ __forceinline__ void xcd_barrier(const XcdBarrier& b) {
    asm volatile("s_waitcnt vmcnt(0)" ::: "memory");
    __syncthreads();
    if (threadIdx.x == 0) {
        unsigned* bar = b.bar;
        __builtin_amdgcn_s_waitcnt(0);
        unsigned nloc = b.st[0], nx = b.st[1];
        if (nloc == 0u) { xcd_barrier_complete(bar, b.x, nloc, nx); b.st[0] = nloc; b.st[1] = nx; }
        const unsigned old = xb_add(&bar[XB_XSUB(b.x)], 1u);
        const unsigned gen = old / nloc;
        if (old + 1u == (gen + 1u) * nloc) {
            __builtin_amdgcn_fence(__ATOMIC_RELEASE, "agent");
            asm volatile("s_waitcnt vmcnt(0)" ::: "memory");
            const unsigned og = xb_add(&bar[XB_TOP], 1u);
            const unsigned tg = og / nx;
            if (og + 1u == (tg + 1u) * nx) xb_add(&bar[XB_TOPGEN], 1u);
            else XB_SPIN(xb_ld(&bar[XB_TOPGEN]) == tg, bar);
            __builtin_amdgcn_fence(__ATOMIC_ACQUIRE, "agent");
            xb_add(&bar[XB_XGEN(b.x)], 1u);
            asm volatile("s_waitcnt vmcnt(0)" ::: "memory");
        } else {
            XB_SPIN(xb_ld(&bar[XB_XGEN(b.x)]) == gen, bar);
            __builtin_amdgcn_fence(__ATOMIC_ACQUIRE, "agent");
            asm volatile("s_waitcnt vmcnt(0)" ::: "memory");
        }
    }
    __syncthreads();
}
#ifndef MK_DUP
#define MK_DUP 0
#endif
struct Args { const float* in[14]; float* out; unsigned char* ws; int lo, hi; };
constexpr int NPHASE = 9;
__global__ void __launch_bounds__(NTHR, 2) mk_fwd(Args a) {
    extern __shared__ __attribute__((aligned(16))) unsigned char lds_raw[];
    Frame F; F.lds = (LAS unsigned char*)lds_raw; F.tid = threadIdx.x; F.lane = F.tid & 63; F.wave = __builtin_amdgcn_readfirstlane(F.tid >> 6);
    F.G = gridDim.x; { const int bx = blockIdx.x; F.vcu = (F.G % 8 == 0) ? (bx % 8) * (F.G / 8) + bx / 8 : bx; }
    unsigned char* ws = a.ws;
    const float* x = a.in[0];
    bf16* XN = (bf16*)(ws + WS_XN); bf16* Yb = (bf16*)(ws + WS_Y); bf16* PROJ = (bf16*)(ws + WS_PROJ); bf16* HB = (bf16*)(ws + WS_HB); bf16* ACT = (bf16*)(ws + WS_ACT);
    float* Z = (float*)(ws + WS_Z); float* CON = (float*)(ws + WS_CON); float* DEC = (float*)(ws + WS_DEC); bf16* SP = (bf16*)(ws + WS_SP);
    float* SS2 = (float*)(ws + WS_SS2); float* SS3 = (float*)(ws + WS_SS3);
    const int lo = a.lo, hi = a.hi;
#define IN(k) (lo <= (k) && (k) < hi)
#define SEAM(k) do { if (IN(k) && IN((k) + 1)) xcd_barrier(bar); } while (0)
    volatile LAS unsigned* MISC = (volatile LAS unsigned*)(F.lds + LDS_BYTES - 64);
    if (F.tid < 16) MISC[F.tid] = 0u;
    __syncthreads();
    unsigned* barw = (unsigned*)(ws + WS_BAR);
    if (a.lo < 0) cg::this_grid().sync();
    XcdBarrier bar; bar.bar = barw; bar.x = 0; bar.st = nullptr;
    if (hi - lo > 1) bar = xcd_barrier_post(barw, MISC + 8);
    for (int rep_ = 0; rep_ < 1 + (MK_DUP & 1); ++rep_) if (IN(0)) phase_prologue(F, x, a.in[1], a.in[2], a.in[9], a.in[10], a.in[11], a.in[12], ws);
    SEAM(0);
    if (IN(1)) {
        pg8::Gemm g{XN, (const bf16*)(ws + WS_WIN), M, NPROJ, D}; pg8::StaticOrder S; S.init(M, NPROJ, F.G, (int)blockIdx.x);
        pg8::EpiProj E{PROJ, NPROJ};
        pg8::gemm_phase<pg8::EpiProj, pg8::StaticOrder, true, true>(F.lds, g, S, E);
        phase_z(F, XN, (const bf16*)(ws + WS_WIN) + (size_t)NPROJ * D, Z);
    }
#if (MK_DUP >> 1) & 1
    if (IN(1)) {
        pg8::Gemm g{XN, (const bf16*)(ws + WS_WIN), M, NPROJ, D}; pg8::StaticOrder S; S.init(M, NPROJ, F.G, (int)blockIdx.x);
        pg8::EpiProj E{PROJ, NPROJ};
        pg8::gemm_phase<pg8::EpiProj, pg8::StaticOrder, true, true>(F.lds, g, S, E);
        phase_z(F, XN, (const bf16*)(ws + WS_WIN) + (size_t)NPROJ * D, Z);
    }
#endif
    SEAM(1);
    for (int rep_ = 0; rep_ < 1 + ((MK_DUP >> 2) & 1); ++rep_) if (IN(2)) {
        for (int rep2_ = 0; rep2_ < 1 + ((MK_DUP >> 9) & 1); ++rep2_)
        phase_gla_a(F, PROJ, Z, a.in[4], a.in[5], a.in[6], a.in[7], CON, DEC, (bf16*)a.out);
        for (int rep2_ = 0; rep2_ < 1 + ((MK_DUP >> 10) & 1); ++rep2_)
        for (int w = F.vcu; w < 256; w += F.G) natten_wg(F, PROJ, a.in[3], Yb, w);
    }
    SEAM(2);
    for (int rep_ = 0; rep_ < 1 + ((MK_DUP >> 3) & 1); ++rep_) if (IN(3)) phase_scan(F, CON, DEC, SP);
    SEAM(3);
    for (int rep_ = 0; rep_ < 1 + ((MK_DUP >> 4) & 1); ++rep_) if (IN(4)) phase_gla_c(F, PROJ, SP, (const bf16*)a.out, a.in[8], Yb);
    SEAM(4);
    if (IN(5)) {
        pg8::Gemm g{Yb, (const bf16*)(ws + WS_WO), M, D, D}; pg8::StaticOrder S; S.init(M, D, F.G, (int)blockIdx.x);
#if (MK_DUP >> 5) & 1
        { pg8::EpiResB E0{x, HB, (float*)(ws + WS_DEC), D}; pg8::gemm_phase<pg8::EpiResB, pg8::StaticOrder, false, true>(F.lds, g, S, E0); }
#endif
        pg8::EpiResB E{x, HB, SS2, D};
        pg8::gemm_phase<pg8::EpiResB, pg8::StaticOrder, true, true>(F.lds, g, S, E);
    }
    SEAM(5);
    if (IN(6)) {
        pg8::Gemm g{HB, (const bf16*)(ws + WS_W1), M, FF, D}; pg8::StaticOrder S; S.init(M, FF, F.G, (int)blockIdx.x);
        pg8::EpiFF1 E{ACT, FF, SS2, 1.0f / D, EPS};
        pg8::gemm_phase<pg8::EpiFF1, pg8::StaticOrder, true, true>(F.lds, g, S, E);
    }
#if (MK_DUP >> 6) & 1
    if (IN(6)) {
        pg8::Gemm g{HB, (const bf16*)(ws + WS_W1), M, FF, D}; pg8::StaticOrder S; S.init(M, FF, F.G, (int)blockIdx.x);
        pg8::EpiFF1 E{ACT, FF, SS2, 1.0f / D, EPS};
        pg8::gemm_phase<pg8::EpiFF1, pg8::StaticOrder, true, true>(F.lds, g, S, E);
    }
#endif
    SEAM(6);
#if (MK_DUP >> 11) & 1
    for (int k_ = 0; k_ < 8; ++k_) xcd_barrier(bar);
#endif
    if (IN(7)) {
        pg8::Gemm g{ACT, (const bf16*)(ws + WS_W2), M, D, FF}; pg8::StaticOrder S; S.init(M, D, F.G, (int)blockIdx.x);
        const int fuse = (F.G == 256 && hi - lo > 1) ? 1 : 0;
#if (MK_DUP >> 7) & 1
        { pg8::EpiResNormB E0{HB, a.out, (float*)(ws + WS_DEC), (unsigned*)(ws + WS_PCNT), a.in[13], D, 0, 8u * (D / 256), 1.0f / D, EPS}; pg8::gemm_phase<pg8::EpiResNormB, pg8::StaticOrder, false, true>(F.lds, g, S, E0); }
#endif
        pg8::EpiResNormB E{HB, a.out, SS3, (unsigned*)(ws + WS_PCNT), a.in[13], D, fuse, 8u * (D / 256), 1.0f / D, EPS};
        pg8::gemm_phase<pg8::EpiResNormB, pg8::StaticOrder, false, true>(F.lds, g, S, E);
    }
    if (!(F.G == 256 && hi - lo > 1)) {
        SEAM(7);
        if (IN(8)) phase_final(F, a.out, SS3, a.in[13]);
    }
#undef IN
#undef SEAM
}

#ifndef MK_ONE_LAUNCH
#define MK_ONE_LAUNCH 1
#endif
extern "C" void kernel_launch(void* const* d_in, const int* in_sizes, int n_in, void* d_out, int out_size, void* d_ws, size_t ws_size, hipStream_t stream) {
    static int grid = 0;
    if (grid == 0) {
        if (n_in != 14 || out_size != M * D || ws_size < WS_END) { fprintf(stderr, "kernel_launch: unexpected shapes (n_in %d out %d ws %zu)\n", n_in, out_size, ws_size); grid = -1; return; }
        int dev = 0, cus = 0, per_cu = 0;
        hipGetDevice(&dev); hipDeviceGetAttribute(&cus, hipDeviceAttributeMultiprocessorCount, dev);
        if (hipFuncSetAttribute((const void*)mk_fwd, hipFuncAttributeMaxDynamicSharedMemorySize, LDS_BYTES) != hipSuccess) { fprintf(stderr, "kernel_launch: hipFuncSetAttribute failed\n"); grid = -1; return; }
        if (hipOccupancyMaxActiveBlocksPerMultiprocessor(&per_cu, (const void*)mk_fwd, NTHR, LDS_BYTES) != hipSuccess || per_cu < 1) { fprintf(stderr, "kernel_launch: occupancy query says %d\n", per_cu); per_cu = 1; }
        (void)hipGetLastError();
        grid = cus * 1;
    }
    if (grid < 0) return;
    Args a{};
    for (int i = 0; i < 14; ++i) a.in[i] = (const float*)d_in[i];
    a.out = (float*)d_out; a.ws = (unsigned char*)d_ws;
#if MK_ONE_LAUNCH
    if (hipMemsetAsync((char*)d_ws + WS_BAR, 0, WS_ZERO_BYTES, stream) != hipSuccess) { fprintf(stderr, "kernel_launch: memset of the barrier words failed\n"); return; }
    a.lo = 0; a.hi = NPHASE;
    void* args[] = {&a};
    hipError_t e = hipLaunchCooperativeKernel((const void*)mk_fwd, dim3(grid), dim3(NTHR), args, LDS_BYTES, stream);
    if (e != hipSuccess) fprintf(stderr, "cooperative launch failed: %s (grid %d)\n", hipGetErrorString(e), grid);
#else
    for (int p = 0; p < NPHASE; ++p) { a.lo = p; a.hi = p + 1; hipLaunchKernelGGL(mk_fwd, dim3(grid), dim3(NTHR), LDS_BYTES, stream, a); }
#endif
}
```

```cpp
#include <hip/hip_runtime.h>
#include <hip/hip_cooperative_groups.h>
#include <cstdio>
#include <cstdint>
#include <cmath>
namespace cg = cooperative_groups;
namespace pg8 {
#define PG8_LAS __attribute__((address_space(3)))
typedef unsigned short bf16_t;
typedef short bf16x8 __attribute__((ext_vector_type(8)));
typedef float f32x4 __attribute__((ext_vector_type(4)));
typedef unsigned u32x4 __attribute__((ext_vector_type(4)));
constexpr int BM = 256, BK = 64, HALF = 128, HTB = HALF * BK * 2  , STAGE_BYTES = 8 * HTB, NXCD = 8, WGM = 8;

__host__ __device__ __forceinline__ int lds_byte(int r, int c) { const int st = (r >> 4) * 2 + (c >> 5), rr = r & 15, cc = c & 31, ob = rr * 64 + cc * 2; return st * 1024 + (ob ^ (((ob >> 9) & 1) << 5)); }
__host__ __device__ __forceinline__ void stage_rc(int b, int& R, int& C) { const int st = b / 1024, sb = b % 1024, swz = sb ^ (((sb >> 9) & 1) << 5); R = (st >> 1) * 16 + swz / 64; C = (st & 1) * 32 + (swz % 64) / 2; }
__host__ __device__ __forceinline__ int perm32(int rho) { const int n = rho >> 4, i = rho & 15; return 8 * (i >> 2) + 4 * n + (i & 3); }

struct Unit { int pm, pn; };
struct Gemm { const bf16_t* A; const bf16_t* Bt; int M, N, K; };

struct StaticOrder {
    int nM, nN, nwg, G, c;
    __host__ __device__ void init(int M, int N, int G_, int c_) { nM = M / BM; nN = N / BM; nwg = nM * nN; G = G_; c = c_; }
    __host__ __device__ bool next(int i, Unit& u) const {
        const long L = (long)i * G + c; if (L >= nwg) return false;
        int wgid = (int)L; { const int q = nwg / NXCD, r = nwg % NXCD, xcd = wgid % NXCD, off = wgid / NXCD; wgid = (xcd < r ? xcd * (q + 1) : r * (q + 1) + (xcd - r) * q) + off; }
        const int nig = WGM * nN, gid = wgid / nig, fm = gid * WGM, gsz = (nM - fm) < WGM ? (nM - fm) : WGM;
        u.pm = fm + ((wgid % nig) % gsz); u.pn = (wgid % nig) / gsz; return true;
    }
    __device__ __forceinline__ void a_ready(const Unit&) const {}
    __device__ __forceinline__ void done(const Unit&) const {}
};

__device__ __forceinline__ unsigned cvt_pk_bf16(float lo, float hi) { unsigned r; asm volatile("v_cvt_pk_bf16_f32 %0, %1, %2" : "=v"(r) : "v"(lo), "v"(hi)); return r; }
typedef unsigned u32x2 __attribute__((ext_vector_type(2)));
struct EpiProj {
    static constexpr bool PERM = true, AFTER_DRAIN = false;
    bf16_t* O; int ldc;
    struct Pre {}; __device__ __forceinline__ void prefetch(Pre&, const Unit&, int, int, int, int) const {}
    __device__ __forceinline__ void operator()(const f32x4 (&acc)[2][2][4][2], const Unit& u, int wr, int wc, int fr, int fq, const Pre&) const {
        const int row0 = u.pm * BM + wr * 64 + fr, col0 = u.pn * BM + wc * 32 + 8 * fq;
#pragma unroll
        for (int ai = 0; ai < 2; ++ai)
#pragma unroll
            for (int m = 0; m < 4; ++m) { bf16_t* rowp = O + (size_t)(row0 + ai * HALF + m * 16) * ldc + col0;
#pragma unroll
                for (int bj = 0; bj < 2; ++bj) { const f32x4 v0 = acc[ai][bj][m][0], v1 = acc[ai][bj][m][1];
                    u32x4 w; w.x = cvt_pk_bf16(v0[0], v0[1]); w.y = cvt_pk_bf16(v0[2], v0[3]); w.z = cvt_pk_bf16(v1[0], v1[1]); w.w = cvt_pk_bf16(v1[2], v1[3]);
                    *(u32x4*)(rowp + bj * HALF) = w; } }
    }
};
struct EpiFF1 {
    static constexpr bool PERM = true, AFTER_DRAIN = false;
    bf16_t* O; int ldc; const float* sumsq; float inv_n, eps;
    struct Pre { float ss[2][4]; };
    __device__ __forceinline__ void prefetch(Pre& P, const Unit& u, int wr, int wc, int fr, int fq) const {
        const int row0 = u.pm * BM + wr * 64 + fr;
#pragma unroll
        for (int ai = 0; ai < 2; ++ai)
#pragma unroll
            for (int m = 0; m < 4; ++m) P.ss[ai][m] = sumsq[row0 + ai * HALF + m * 16];
    }
    __device__ __forceinline__ void operator()(const f32x4 (&acc)[2][2][4][2], const Unit& u, int wr, int wc, int fr, int fq, const Pre& P) const {
        const int row0 = u.pm * BM + wr * 64 + fr, col0 = u.pn * BM + wc * 32 + 8 * fq;
#pragma unroll
        for (int ai = 0; ai < 2; ++ai)
#pragma unroll
            for (int m = 0; m < 4; ++m) { const int row = row0 + ai * HALF + m * 16; bf16_t* rowp = O + (size_t)row * ldc + col0;
                const float rs = 1.0f / sqrtf(P.ss[ai][m] * inv_n + eps);
#pragma unroll
                for (int bj = 0; bj < 2; ++bj) { f32x4 v0 = acc[ai][bj][m][0] * rs, v1 = acc[ai][bj][m][1] * rs;
#pragma unroll
                    for (int e = 0; e < 4; ++e) { const float a = fmaxf(v0[e], 0.f), b = fmaxf(v1[e], 0.f); v0[e] = a * a; v1[e] = b * b; }
                    u32x4 w; w.x = cvt_pk_bf16(v0[0], v0[1]); w.y = cvt_pk_bf16(v0[2], v0[3]); w.z = cvt_pk_bf16(v1[0], v1[1]); w.w = cvt_pk_bf16(v1[2], v1[3]);
                    *(u32x4*)(rowp + bj * HALF) = w; } }
    }
};
struct EpiRes {
    static constexpr bool PERM = false, AFTER_DRAIN = false;
    const float* base; float* out; bf16_t* hb; float* sumsq; int ldc;
    struct Pre {}; __device__ __forceinline__ void prefetch(Pre&, const Unit&, int, int, int, int) const {}
    __device__ __forceinline__ void operator()(const f32x4 (&acc)[2][2][4][2], const Unit& u, int wr, int wc, int fr, int fq, const Pre&) const {
        const int col0 = u.pn * BM + wc * 32 + 4 * fq;
#pragma unroll
        for (int ai = 0; ai < 2; ++ai)
#pragma unroll
            for (int m = 0; m < 4; ++m) { const int row = u.pm * BM + ai * HALF + wr * 64 + m * 16 + fr; const size_t off = (size_t)row * ldc + col0; float s = 0.f;
#pragma unroll
                for (int bj = 0; bj < 2; ++bj)
#pragma unroll
                    for (int n = 0; n < 2; ++n) { const f32x4 bs = *(const f32x4*)(base + off + bj * HALF + n * 16); const f32x4 o = bs + acc[ai][bj][m][n];
                        *(f32x4*)(out + off + bj * HALF + n * 16) = o;
                        if (hb) { u32x2 w; w.x = cvt_pk_bf16(o[0], o[1]); w.y = cvt_pk_bf16(o[2], o[3]); *(u32x2*)(hb + off + bj * HALF + n * 16) = w; }
                        s += (o[0] * o[0] + o[1] * o[1]) + (o[2] * o[2] + o[3] * o[3]); }
                s += __shfl_xor(s, 16); s += __shfl_xor(s, 32);
                if (fq == 0) unsafeAtomicAdd(sumsq + row, s);
                asm volatile("" ::: "memory"); }
    }
};

struct EpiResNorm {
    static constexpr bool PERM = false, AFTER_DRAIN = true;
    const float* base; float* out; float* sumsq; unsigned* cnt; const float* g; int ldc; int fuse; unsigned want; float inv_n, eps;
    struct Pre {}; __device__ __forceinline__ void prefetch(Pre&, const Unit&, int, int, int, int) const {}
    __device__ __forceinline__ void fused(f32x4 (&acc)[2][2][4][2], const Unit& u, int wr, int wc, int fr, int fq, PG8_LAS unsigned char* lds, int wid, int lane) const {
        const int col0 = u.pn * BM + wc * 32 + 4 * fq;
#pragma unroll
        for (int ai = 0; ai < 2; ++ai)
#pragma unroll
            for (int m = 0; m < 4; ++m) { const int row = u.pm * BM + ai * HALF + wr * 64 + m * 16 + fr; const size_t off = (size_t)row * ldc + col0; float s = 0.f;
#pragma unroll
                for (int bj = 0; bj < 2; ++bj)
#pragma unroll
                    for (int n = 0; n < 2; ++n) { const f32x4 bs = *(const f32x4*)(base + off + bj * HALF + n * 16); const f32x4 o = bs + acc[ai][bj][m][n]; acc[ai][bj][m][n] = o;
                        if (!fuse) *(f32x4*)(out + off + bj * HALF + n * 16) = o;
                        s += (o[0] * o[0] + o[1] * o[1]) + (o[2] * o[2] + o[3] * o[3]); }
                s += __shfl_xor(s, 16); s += __shfl_xor(s, 32);
                if (fq == 0) unsafeAtomicAdd(sumsq + row, s);
                asm volatile("" ::: "memory"); }
        if (!fuse) return;
        asm volatile("s_waitcnt vmcnt(0)" ::: "memory");
        if (lane == 0) __hip_atomic_fetch_add(cnt + 64 * u.pm, 1u, __ATOMIC_RELAXED, __HIP_MEMORY_SCOPE_AGENT);
        if (wid == 0) { while ((unsigned)__builtin_amdgcn_readfirstlane(__hip_atomic_load(cnt + 64 * u.pm, __ATOMIC_RELAXED, __HIP_MEMORY_SCOPE_AGENT)) < want) __builtin_amdgcn_s_sleep(2); }
        asm volatile("s_waitcnt vmcnt(0) lgkmcnt(0)" ::: "memory"); __builtin_amdgcn_s_barrier(); asm volatile("" ::: "memory");
        __builtin_amdgcn_fence(__ATOMIC_ACQUIRE, "agent");
        f32x4 gv[2][2];
#pragma unroll
        for (int bj = 0; bj < 2; ++bj)
#pragma unroll
            for (int n = 0; n < 2; ++n) gv[bj][n] = *(const f32x4*)(g + col0 + bj * HALF + n * 16);
#pragma unroll
        for (int ai = 0; ai < 2; ++ai)
#pragma unroll
            for (int m = 0; m < 4; ++m) { const int row = u.pm * BM + ai * HALF + wr * 64 + m * 16 + fr; const size_t off = (size_t)row * ldc + col0;
                const float ssv = __hip_atomic_load(sumsq + row, __ATOMIC_RELAXED, __HIP_MEMORY_SCOPE_AGENT); const float rs = 1.0f / sqrtf(ssv * inv_n + eps);
#pragma unroll
                for (int bj = 0; bj < 2; ++bj)
#pragma unroll
                    for (int n = 0; n < 2; ++n) *(f32x4*)(out + off + bj * HALF + n * 16) = acc[ai][bj][m][n] * rs * gv[bj][n]; }
    }
};

struct EpiResB {
    static constexpr bool PERM = true, AFTER_DRAIN = false;
    const float* base; bf16_t* hb; float* sumsq; int ldc;
    struct Pre {}; __device__ __forceinline__ void prefetch(Pre&, const Unit&, int, int, int, int) const {}
    __device__ __forceinline__ void operator()(const f32x4 (&acc)[2][2][4][2], const Unit& u, int wr, int wc, int fr, int fq, const Pre&) const {
        const int col0 = u.pn * BM + wc * 32 + 8 * fq; const int rowb = u.pm * BM + wr * 64 + fr;
        f32x4 nb[4];
        { const size_t off = (size_t)rowb * ldc + col0;
#pragma unroll
          for (int bj = 0; bj < 2; ++bj) { nb[2 * bj] = *(const f32x4*)(base + off + bj * HALF); nb[2 * bj + 1] = *(const f32x4*)(base + off + bj * HALF + 4); } }
#pragma unroll
        for (int gi = 0; gi < 8; ++gi) { const int ai = gi >> 2, m = gi & 3; const int row = rowb + ai * HALF + m * 16; const size_t off = (size_t)row * ldc + col0; float s = 0.f;
            f32x4 cb[4];
#pragma unroll
            for (int k = 0; k < 4; ++k) cb[k] = nb[k];
            if (gi < 7) { const int ai2 = (gi + 1) >> 2, m2 = (gi + 1) & 3; const size_t off2 = (size_t)(rowb + ai2 * HALF + m2 * 16) * ldc + col0;
#pragma unroll
                for (int bj = 0; bj < 2; ++bj) { nb[2 * bj] = *(const f32x4*)(base + off2 + bj * HALF); nb[2 * bj + 1] = *(const f32x4*)(base + off2 + bj * HALF + 4); } }
            asm volatile("" ::: "memory");
#pragma unroll
            for (int bj = 0; bj < 2; ++bj) { const f32x4 o0 = cb[2 * bj] + acc[ai][bj][m][0], o1 = cb[2 * bj + 1] + acc[ai][bj][m][1];
                u32x4 w; w.x = cvt_pk_bf16(o0[0], o0[1]); w.y = cvt_pk_bf16(o0[2], o0[3]); w.z = cvt_pk_bf16(o1[0], o1[1]); w.w = cvt_pk_bf16(o1[2], o1[3]);
                *(u32x4*)(hb + off + bj * HALF) = w;
                s += (o0[0] * o0[0] + o0[1] * o0[1]) + (o0[2] * o0[2] + o0[3] * o0[3]) + (o1[0] * o1[0] + o1[1] * o1[1]) + (o1[2] * o1[2] + o1[3] * o1[3]); }
            s += __shfl_xor(s, 16); s += __shfl_xor(s, 32);
            if (fq == 0) unsafeAtomicAdd(sumsq + row, s); }
    }
};
struct EpiResNormB {
    static constexpr bool PERM = true, AFTER_DRAIN = true;
    const bf16_t* hb; float* out; float* sumsq; unsigned* cnt; const float* g; int ldc; int fuse; unsigned want; float inv_n, eps;
    struct Pre {}; __device__ __forceinline__ void prefetch(Pre&, const Unit&, int, int, int, int) const {}
    __device__ __forceinline__ void fused(f32x4 (&acc)[2][2][4][2], const Unit& u, int wr, int wc, int fr, int fq, PG8_LAS unsigned char* lds, int wid, int lane) const {
        const int col0 = u.pn * BM + wc * 32 + 8 * fq; const int rowb = u.pm * BM + wr * 64 + fr;
        u32x4 nw[2];
#pragma unroll
        for (int bj = 0; bj < 2; ++bj) nw[bj] = *(const u32x4*)(hb + (size_t)rowb * ldc + col0 + bj * HALF);
#pragma unroll
        for (int gi = 0; gi < 8; ++gi) { const int ai = gi >> 2, m = gi & 3; const int row = rowb + ai * HALF + m * 16; const size_t off = (size_t)row * ldc + col0; float s = 0.f;
            u32x4 cw[2] = {nw[0], nw[1]};
            if (gi < 7) { const int ai2 = (gi + 1) >> 2, m2 = (gi + 1) & 3; const size_t off2 = (size_t)(rowb + ai2 * HALF + m2 * 16) * ldc + col0;
#pragma unroll
                for (int bj = 0; bj < 2; ++bj) nw[bj] = *(const u32x4*)(hb + off2 + bj * HALF); }
            asm volatile("" ::: "memory");
#pragma unroll
            for (int bj = 0; bj < 2; ++bj) { const u32x4 w = cw[bj];
                const f32x4 b0 = {__builtin_bit_cast(float, w.x << 16), __builtin_bit_cast(float, w.x & 0xffff0000u), __builtin_bit_cast(float, w.y << 16), __builtin_bit_cast(float, w.y & 0xffff0000u)};
                const f32x4 b1 = {__builtin_bit_cast(float, w.z << 16), __builtin_bit_cast(float, w.z & 0xffff0000u), __builtin_bit_cast(float, w.w << 16), __builtin_bit_cast(float, w.w & 0xffff0000u)};
                const f32x4 o0 = b0 + acc[ai][bj][m][0], o1 = b1 + acc[ai][bj][m][1]; acc[ai][bj][m][0] = o0; acc[ai][bj][m][1] = o1;
                if (!fuse) { *(f32x4*)(out + off + bj * HALF) = o0; *(f32x4*)(out + off + bj * HALF + 4) = o1; }
                s += (o0[0] * o0[0] + o0[1] * o0[1]) + (o0[2] * o0[2] + o0[3] * o0[3]) + (o1[0] * o1[0] + o1[1] * o1[1]) + (o1[2] * o1[2] + o1[3] * o1[3]); }
            s += __shfl_xor(s, 16); s += __shfl_xor(s, 32);
            if (fq == 0) unsafeAtomicAdd(sumsq + row, s); }
        if (!fuse) return;
        asm volatile("s_waitcnt vmcnt(0)" ::: "memory");
        if (lane == 0) __hip_atomic_fetch_add(cnt + 64 * u.pm, 1u, __ATOMIC_RELAXED, __HIP_MEMORY_SCOPE_AGENT);
        if (wid == 0) { while ((unsigned)__builtin_amdgcn_readfirstlane(__hip_atomic_load(cnt + 64 * u.pm, __ATOMIC_RELAXED, __HIP_MEMORY_SCOPE_AGENT)) < want) __builtin_amdgcn_s_sleep(2); }
        asm volatile("s_waitcnt vmcnt(0) lgkmcnt(0)" ::: "memory"); __builtin_amdgcn_s_barrier(); asm volatile("" ::: "memory");
        __builtin_amdgcn_fence(__ATOMIC_ACQUIRE, "agent");
        f32x4 gv[2][2];
#pragma unroll
        for (int bj = 0; bj < 2; ++bj)
#pragma unroll
            for (int n = 0; n < 2; ++n) gv[bj][n] = *(const f32x4*)(g + col0 + bj * HALF + n * 4);
#pragma unroll
        for (int ai = 0; ai < 2; ++ai)
#pragma unroll
            for (int m = 0; m < 4; ++m) { const int row = u.pm * BM + ai * HALF + wr * 64 + m * 16 + fr; const size_t off = (size_t)row * ldc + col0;
                const float ssv = __hip_atomic_load(sumsq + row, __ATOMIC_RELAXED, __HIP_MEMORY_SCOPE_AGENT); const float rs = 1.0f / sqrtf(ssv * inv_n + eps);
#pragma unroll
                for (int bj = 0; bj < 2; ++bj)
#pragma unroll
                    for (int n = 0; n < 2; ++n) *(f32x4*)(out + off + bj * HALF + n * 4) = acc[ai][bj][m][n] * rs * gv[bj][n]; }
    }
};
template <class Epi, class Sched, bool ALIGN_EPI = false, bool SP2 = false>
__device__ __forceinline__ void gemm_phase(PG8_LAS unsigned char* lds, const Gemm g, const Sched& S, const Epi& E) {
    const int tid = threadIdx.x, wid = __builtin_amdgcn_readfirstlane(tid >> 6), lane = tid & 63, wr = wid >> 2, wc = wid & 3, fr = lane & 15, fq = lane >> 4;
    const int K = g.K, nt = K / BK;
    unsigned voffA[2], voffB[2];
#pragma unroll
    for (int i = 0; i < 2; ++i) { int R, C; stage_rc(tid * 16 + i * 8192, R, C); const int Rb = Epi::PERM ? ((R & ~31) + perm32(R & 31)) : R;
        voffA[i] = (unsigned)(R * K + C) * 2u; voffB[i] = (unsigned)(Rb * K + C) * 2u; }
    const size_t kstep = (size_t)(BK * 2);
    const size_t hstep = (size_t)HALF * K * 2;
    const size_t tstep = 2 * hstep;
    const unsigned ldsw = (unsigned)wid * 1024u;
    const int aoff = lds_byte(wr * 64 + fr, fq * 8), boff = lds_byte(wc * 32 + fr, fq * 8);
#define PG8_SA(b, h) (((b) * 2 + (h)) * HTB)
#define PG8_SB(b, h) ((4 + (b) * 2 + (h)) * HTB)
#define PG8_STAGE(bufoff, gbase, voff) do { _Pragma("unroll") for (int _i = 0; _i < 2; ++_i) \
        __builtin_amdgcn_global_load_lds((const unsigned*)((const char*)(gbase) + (voff)[_i]), (PG8_LAS unsigned*)(lds + (bufoff) + ldsw + _i * 8192), 16, 0, 0); } while (0)
#define PG8_LDA(dst, b, h) do { _Pragma("unroll") for (int m = 0; m < 4; ++m) _Pragma("unroll") for (int k = 0; k < 2; ++k) dst[m][k] = *(const PG8_LAS bf16x8*)(lds + PG8_SA(b, h) + aoff + m * 2048 + k * 1024); } while (0)
#define PG8_LDB(dst, b, h) do { _Pragma("unroll") for (int n = 0; n < 2; ++n) _Pragma("unroll") for (int k = 0; k < 2; ++k) dst[n][k] = *(const PG8_LAS bf16x8*)(lds + PG8_SB(b, h) + boff + n * 2048 + k * 1024); } while (0)
#define PG8_MMA(ai, bj, At, Bt) do { __builtin_amdgcn_s_setprio(1); _Pragma("unroll") for (int m = 0; m < 4; ++m) _Pragma("unroll") for (int n = 0; n < 2; ++n) _Pragma("unroll") for (int k = 0; k < 2; ++k) \
        acc[ai][bj][m][n] = __builtin_amdgcn_mfma_f32_16x16x32_bf16(Bt[n][k], At[m][k], acc[ai][bj][m][n], 0, 0, 0); __builtin_amdgcn_s_setprio(0); } while (0)
#define PG8_WAIT_V(n) asm volatile("s_waitcnt vmcnt(" #n ")" ::: "memory")
#define PG8_WAIT_L(n) asm volatile("s_waitcnt lgkmcnt(" #n ")" ::: "memory")
#define PG8_BAR __builtin_amdgcn_s_barrier()
#define PG8_SCHED __builtin_amdgcn_sched_barrier(0)
    Unit cur, nxt; int ui = 0;
    if (!S.next(0, cur)) return;
    f32x4 acc[2][2][4][2];
#pragma unroll
    for (int a = 0; a < 2; ++a)
#pragma unroll
        for (int b = 0; b < 2; ++b)
#pragma unroll
            for (int m = 0; m < 4; ++m)
#pragma unroll
                for (int n = 0; n < 2; ++n) acc[a][b][m][n] = (f32x4){0.f, 0.f, 0.f, 0.f};
    bf16x8 At[4][2], B0[2][2], B1[2][2];
    const char* cA = (const char*)g.A + (size_t)cur.pm * tstep; const char* cB = (const char*)g.Bt + (size_t)cur.pn * tstep;
    S.a_ready(cur);
    typename Epi::Pre pre; E.prefetch(pre, cur, wr, wc, fr, fq);
    if constexpr (SP2) {
        PG8_STAGE(PG8_SB(0, 0), cB, voffB); PG8_STAGE(PG8_SB(0, 1), cB + hstep, voffB); PG8_STAGE(PG8_SA(0, 0), cA, voffA); PG8_STAGE(PG8_SA(0, 1), cA + hstep, voffA);
        if (wr == 1) PG8_BAR;
        PG8_WAIT_V(2); PG8_BAR;
        PG8_STAGE(PG8_SB(1, 0), cB + kstep, voffB); PG8_STAGE(PG8_SA(1, 0), cA + kstep, voffA); PG8_STAGE(PG8_SB(1, 1), cB + hstep + kstep, voffB);
        PG8_WAIT_V(6); PG8_BAR;
    } else {
        PG8_STAGE(PG8_SB(0, 0), cB, voffB); PG8_STAGE(PG8_SA(0, 0), cA, voffA); PG8_STAGE(PG8_SB(0, 1), cB + hstep, voffB); PG8_STAGE(PG8_SA(0, 1), cA + hstep, voffA);
        if (wr == 1) PG8_BAR;
        PG8_WAIT_V(4); PG8_BAR;
        PG8_STAGE(PG8_SB(1, 0), cB + kstep, voffB); PG8_STAGE(PG8_SA(1, 0), cA + kstep, voffA); PG8_STAGE(PG8_SB(1, 1), cB + hstep + kstep, voffB);
        PG8_WAIT_V(6); PG8_BAR;
    }
    for (;;) {
        const bool has_next = S.next(ui + 1, nxt);
        const char* nA = has_next ? (const char*)g.A + (size_t)nxt.pm * tstep : cA; const char* nB = has_next ? (const char*)g.Bt + (size_t)nxt.pn * tstep : cB;
        for (int t = 0; t < nt; t += 2) {
            const bool last = (t == nt - 2);
            const char* a1 = cA + (size_t)(t + 1) * kstep;
            const char* a2 = last ? nA : cA + (size_t)(t + 2) * kstep; const char* b2 = last ? nB : cB + (size_t)(t + 2) * kstep;
            const char* a3 = a2 + kstep; const char* b3 = b2 + kstep;
            if (last && has_next) S.a_ready(nxt);
            if constexpr (SP2) {
            PG8_LDB(B0, 0, 0); PG8_LDB(B1, 0, 1); PG8_SCHED; PG8_LDA(At, 0, 0); PG8_STAGE(PG8_SA(1, 1), a1 + hstep, voffA);
            PG8_WAIT_V(8); PG8_WAIT_L(0); PG8_BAR; PG8_MMA(0, 0, At, B0); PG8_MMA(0, 1, At, B1); PG8_BAR; PG8_SCHED;
            PG8_LDA(At, 0, 1); PG8_STAGE(PG8_SB(0, 0), b2, voffB); PG8_STAGE(PG8_SB(0, 1), b2 + hstep, voffB); PG8_STAGE(PG8_SA(0, 0), a2, voffA);
            PG8_WAIT_V(8); PG8_WAIT_L(0); PG8_BAR; PG8_MMA(1, 0, At, B0); PG8_MMA(1, 1, At, B1); PG8_BAR; PG8_SCHED;
            PG8_LDB(B0, 1, 0); PG8_LDB(B1, 1, 1); PG8_SCHED; PG8_LDA(At, 1, 0); PG8_STAGE(PG8_SA(0, 1), a2 + hstep, voffA);
            PG8_WAIT_V(8); PG8_WAIT_L(0); PG8_BAR; PG8_MMA(0, 0, At, B0); PG8_MMA(0, 1, At, B1); PG8_BAR; PG8_SCHED;
            PG8_LDA(At, 1, 1); PG8_STAGE(PG8_SB(1, 0), b3, voffB); PG8_STAGE(PG8_SB(1, 1), b3 + hstep, voffB); PG8_STAGE(PG8_SA(1, 0), a3, voffA);
            PG8_WAIT_V(8); PG8_WAIT_L(0); PG8_BAR; PG8_MMA(1, 0, At, B0); PG8_MMA(1, 1, At, B1); PG8_BAR; PG8_SCHED;
            } else {
            PG8_LDB(B0, 0, 0); PG8_SCHED; PG8_LDA(At, 0, 0); PG8_STAGE(PG8_SA(1, 1), a1 + hstep, voffA);
            PG8_WAIT_L(8); PG8_BAR; PG8_WAIT_L(0); PG8_MMA(0, 0, At, B0); PG8_BAR; PG8_SCHED;
            PG8_LDB(B1, 0, 1); PG8_STAGE(PG8_SB(0, 0), b2, voffB);
            PG8_BAR; PG8_WAIT_L(0); PG8_MMA(0, 1, At, B1); PG8_BAR;
            PG8_LDA(At, 0, 1); PG8_STAGE(PG8_SA(0, 0), a2, voffA);
            PG8_BAR; PG8_WAIT_L(0); PG8_MMA(1, 0, At, B0); PG8_BAR; PG8_SCHED;
            PG8_STAGE(PG8_SB(0, 1), b2 + hstep, voffB);
            PG8_WAIT_V(6); PG8_BAR; PG8_MMA(1, 1, At, B1); PG8_BAR;
            PG8_LDB(B0, 1, 0); PG8_SCHED; PG8_LDA(At, 1, 0); PG8_STAGE(PG8_SA(0, 1), a2 + hstep, voffA);
            PG8_WAIT_L(8); PG8_BAR; PG8_WAIT_L(0); PG8_MMA(0, 0, At, B0); PG8_BAR; PG8_SCHED;
            PG8_LDB(B1, 1, 1); PG8_STAGE(PG8_SB(1, 0), b3, voffB);
            PG8_BAR; PG8_WAIT_L(0); PG8_MMA(0, 1, At, B1); PG8_BAR;
            PG8_LDA(At, 1, 1); PG8_STAGE(PG8_SA(1, 0), a3, voffA);
            PG8_BAR; PG8_WAIT_L(0); PG8_MMA(1, 0, At, B0); PG8_BAR; PG8_SCHED;
            PG8_STAGE(PG8_SB(1, 1), b3 + hstep, voffB);
            PG8_WAIT_V(6); PG8_BAR; PG8_MMA(1, 1, At, B1); PG8_BAR;
            }
        }
        if constexpr (ALIGN_EPI) { if (wr == 0) PG8_BAR; }
        if constexpr (!Epi::AFTER_DRAIN) { E(acc, cur, wr, wc, fr, fq, pre); S.done(cur); }
        if (!has_next) break;
#pragma unroll
        for (int a = 0; a < 2; ++a)
#pragma unroll
            for (int b = 0; b < 2; ++b)
#pragma unroll
                for (int m = 0; m < 4; ++m)
#pragma unroll
                    for (int n = 0; n < 2; ++n) acc[a][b][m][n] = (f32x4){0.f, 0.f, 0.f, 0.f};
        cur = nxt; cA = nA; cB = nB; ++ui;
        E.prefetch(pre, cur, wr, wc, fr, fq);
        if constexpr (ALIGN_EPI) { if (wr == 1) PG8_BAR; }
    }
    PG8_WAIT_V(0);
    if constexpr (!ALIGN_EPI) { if (wr == 0) PG8_BAR; }
    PG8_BAR;
    if constexpr (Epi::AFTER_DRAIN) { E.fused(acc, cur, wr, wc, fr, fq, lds, wid, lane); S.done(cur); }
#undef PG8_SA
#undef PG8_SB
#undef PG8_STAGE
#undef PG8_LDA
#undef PG8_LDB
#undef PG8_MMA
#undef PG8_WAIT_V
#undef PG8_WAIT_L
#undef PG8_BAR
#undef PG8_SCHED
}
}
#define GAS __attribute__((address_space(1)))
#define LAS __attribute__((address_space(3)))
typedef unsigned short bf16;
typedef unsigned v4u __attribute__((ext_vector_type(4)));
typedef unsigned v2u __attribute__((ext_vector_type(2)));
typedef float f32x4 __attribute__((ext_vector_type(4)));
typedef short bf16x8 __attribute__((ext_vector_type(8)));
typedef short s16x4 __attribute__((ext_vector_type(4)));

constexpr int NWAVES = 8, NTHR = 512;
constexpr int T = 8192, D = 1024, M = 16384, NPROJ = 3072, DIN = 3104, FF = 4096;
constexpr float EPS = 1e-6f;
constexpr int C_QA = 0, C_KA = 512, C_VA = 1024, C_QG = 1536, C_KG = 1792, C_VG = 2048, C_RG = 2560;

constexpr size_t MiB = 1u << 20;
constexpr size_t WS_SS2 = 0, WS_SS3 = 65536, WS_BAR = 131072, WS_PCNT = 131072 + 16384, WS_ZERO_BYTES = 32768, WS_DEC = 262144, WS_Z = 1 * MiB;
constexpr size_t WS_WIN = 4 * MiB, WS_WO = 11 * MiB, WS_W1 = 13 * MiB, WS_W2 = 21 * MiB;
constexpr size_t WS_XN = 32 * MiB, WS_Y = 32 * MiB, WS_PROJ = 64 * MiB, WS_CON = 160 * MiB, WS_SP = 224 * MiB;
constexpr size_t WS_HB = 64 * MiB, WS_ACT = 96 * MiB, WS_END = 256 * MiB;
constexpr int LDS_BYTES = 163840;

__device__ __forceinline__ unsigned f2bf(float f) { unsigned u = __builtin_bit_cast(unsigned, f); return (u + 0x7fffu + ((u >> 16) & 1u)) >> 16; }
__device__ __forceinline__ unsigned pk2(float lo, float hi) { return f2bf(lo) | (f2bf(hi) << 16); }
__device__ __forceinline__ float bf2f(unsigned short h) { return __builtin_bit_cast(float, (unsigned)h << 16); }
__device__ __forceinline__ float wave_sum(float v) {
#pragma unroll
    for (int o = 1; o < 64; o <<= 1) v += __shfl_xor(v, o);
    return v;
}
__device__ __forceinline__ f32x4 mfma16(bf16x8 x, bf16x8 y, f32x4 c) { return __builtin_amdgcn_mfma_f32_16x16x32_bf16(x, y, c, 0, 0, 0); }
typedef short v4i16_t __attribute__((ext_vector_type(4)));
__device__ __forceinline__ s16x4 tr4(const LAS unsigned char* p) { return __builtin_bit_cast(s16x4, __builtin_amdgcn_ds_read_tr16_b64_v4i16((LAS v4i16_t*)p)); }
__device__ __forceinline__ bf16x8 cat8(s16x4 a, s16x4 b) { bf16x8 r; r[0] = a[0]; r[1] = a[1]; r[2] = a[2]; r[3] = a[3]; r[4] = b[0]; r[5] = b[1]; r[6] = b[2]; r[7] = b[3]; return r; }
__device__ __forceinline__ bf16x8 pack8(f32x4 a, f32x4 b) {
    v4u w; w.x = pg8::cvt_pk_bf16(a[0], a[1]); w.y = pg8::cvt_pk_bf16(a[2], a[3]); w.z = pg8::cvt_pk_bf16(b[0], b[1]); w.w = pg8::cvt_pk_bf16(b[2], b[3]);
    return __builtin_bit_cast(bf16x8, w);
}

struct Frame {
    LAS unsigned char* lds;
    int tid, lane, wave, vcu, G;
};

__device__ __forceinline__ void p0_transpose_item(const float* W, int K, int N, bf16* WT, const float* gk, LAS float* scr, int item, int lane) {
    const int nblk = N / 32, kb = item / nblk, nb = item % nblk, k0 = 64 * kb, n0 = 32 * nb;
#pragma unroll 16
    for (int i = 0; i < 32; ++i) { const int kk = 2 * i + (lane >> 5); float v = W[(size_t)(k0 + kk) * N + n0 + (lane & 31)]; if (gk) v *= gk[k0 + kk]; scr[kk * 33 + (lane & 31)] = v; }
    asm volatile("s_waitcnt lgkmcnt(0)" ::: "memory");
    const int c = lane & 7;
#pragma unroll
    for (int j = 0; j < 4; ++j) { const int n = (lane >> 3) + 8 * j; const LAS float* s = scr + (8 * c) * 33 + n;
        v4u o; o.x = pk2(s[0 * 33], s[1 * 33]); o.y = pk2(s[2 * 33], s[3 * 33]); o.z = pk2(s[4 * 33], s[5 * 33]); o.w = pk2(s[6 * 33], s[7 * 33]);
        *(v4u*)(WT + (size_t)(n0 + n) * K + k0 + 8 * c) = o; }
    asm volatile("s_waitcnt lgkmcnt(0)" ::: "memory");
}
__device__ __forceinline__ void phase_prologue(const Frame& F, const float* x, const float* g_mix, const float* w_in, const float* w_out, const float* g_ff, const float* w1, const float* w2, unsigned char* ws) {
    LAS float* scr = (LAS float*)(F.lds + F.wave * 16384);
    const int gw = F.vcu * NWAVES + F.wave, NGW = F.G * NWAVES;
    constexpr int I_IN = (D / 64) * (DIN / 32), I_O = (D / 64) * (D / 32), I_1 = (D / 64) * (FF / 32), I_2 = (FF / 64) * (D / 32);
    constexpr int NITEMS = I_IN + I_O + I_1 + I_2;
    for (int it = gw; it < NITEMS; it += NGW) {
        int r = it;
        if (r < I_IN) { p0_transpose_item(w_in, D, DIN, (bf16*)(ws + WS_WIN), nullptr, scr, r, F.lane); continue; } r -= I_IN;
        if (r < I_O) { p0_transpose_item(w_out, D, D, (bf16*)(ws + WS_WO), nullptr, scr, r, F.lane); continue; } r -= I_O;
        if (r < I_1) { p0_transpose_item(w1, D, FF, (bf16*)(ws + WS_W1), g_ff, scr, r, F.lane); continue; } r -= I_1;
        p0_transpose_item(w2, FF, D, (bf16*)(ws + WS_W2), nullptr, scr, r, F.lane);
    }
    { float* ss = (float*)(ws + WS_SS2); for (int i = (F.vcu * NTHR + F.tid); i < 2 * M; i += F.G * NTHR) ss[i] = 0.f; }
    bf16* XN = (bf16*)(ws + WS_XN);
    f32x4 gv[4];
#pragma unroll
    for (int j = 0; j < 4; ++j) gv[j] = ((const f32x4*)g_mix)[F.lane + 64 * j];
    for (int m0 = gw; m0 < M; m0 += 4 * NGW) {
        f32x4 v[4][4]; float s[4];
#pragma unroll
        for (int q = 0; q < 4; ++q) { const int m = min(m0 + q * NGW, M - 1); const f32x4* xr = (const f32x4*)(x + (size_t)m * D) + F.lane;
#pragma unroll
            for (int j = 0; j < 4; ++j) v[q][j] = xr[64 * j]; }
#pragma unroll
        for (int q = 0; q < 4; ++q) { float t = 0.f;
#pragma unroll
            for (int j = 0; j < 4; ++j) t += (v[q][j].x * v[q][j].x + v[q][j].y * v[q][j].y) + (v[q][j].z * v[q][j].z + v[q][j].w * v[q][j].w);
            s[q] = t; }
#pragma unroll
        for (int o = 1; o < 64; o <<= 1) {
#pragma unroll
            for (int q = 0; q < 4; ++q) s[q] += __shfl_xor(s[q], o); }
#pragma unroll
        for (int q = 0; q < 4; ++q) { const int m = m0 + q * NGW; if (m < M) { const float rs = 1.0f / sqrtf(s[q] * (1.f / D) + EPS);
            unsigned long long* o8 = (unsigned long long*)(XN + (size_t)m * D) + F.lane;
#pragma unroll
            for (int j = 0; j < 4; ++j) { const f32x4 o = v[q][j] * rs * gv[j]; o8[64 * j] = (unsigned long long)pk2(o.x, o.y) | ((unsigned long long)pk2(o.z, o.w) << 32); } } }
    }
}

__device__ __forceinline__ void phase_z(const Frame& F, const bf16* XN, const bf16* Wz, float* Z) {
    const int fr = F.lane & 15, fq = F.lane >> 4, w = F.wave;
    LAS float* red = (LAS float*)F.lds;
    for (int rb = F.vcu; rb < M / 64; rb += F.G) {
        bf16x8 a[4][4], b[2][4];
#pragma unroll
        for (int mt = 0; mt < 4; ++mt)
#pragma unroll
            for (int ks = 0; ks < 4; ++ks) a[mt][ks] = *(const bf16x8*)(XN + (size_t)(rb * 64 + mt * 16 + fr) * D + 128 * w + ks * 32 + 8 * fq);
#pragma unroll
        for (int nt = 0; nt < 2; ++nt)
#pragma unroll
            for (int ks = 0; ks < 4; ++ks) b[nt][ks] = *(const bf16x8*)(Wz + (size_t)(nt * 16 + fr) * D + 128 * w + ks * 32 + 8 * fq);
#pragma unroll
        for (int mt = 0; mt < 4; ++mt)
#pragma unroll
            for (int nt = 0; nt < 2; ++nt) { f32x4 acc = {0.f, 0.f, 0.f, 0.f};
#pragma unroll
                for (int ks = 0; ks < 4; ++ks) acc = mfma16(b[nt][ks], a[mt][ks], acc);
                *(LAS f32x4*)(red + ((w * 8 + mt * 2 + nt) * 64 + F.lane) * 4) = acc; }
        __syncthreads();
        { const int t = F.tid & 7, ln = F.tid >> 3 & 63;
          const int tile = F.tid >> 6, lane = F.tid & 63; (void)t; (void)ln;
          f32x4 sacc = {0.f, 0.f, 0.f, 0.f};
#pragma unroll
          for (int ww = 0; ww < 8; ++ww) sacc += *(const LAS f32x4*)(red + ((ww * 8 + tile) * 64 + lane) * 4);
          const int mt = tile >> 1, nt = tile & 1, lfr = lane & 15, lfq = lane >> 4;
          *(f32x4*)(Z + (size_t)(rb * 64 + mt * 16 + lfr) * 32 + nt * 16 + 4 * lfq) = sacc; }
        __syncthreads();
    }
}

constexpr int NA_STR = 144, NA_VSTR = 136, NA_K_OFF = 0, NA_V_OFF = 512 * NA_STR, NA_RPB_OFF = NA_V_OFF + 512 * NA_VSTR, NA_X_OFF = NA_RPB_OFF + 1872, NA_X_PAIR = 18 * 256;
static_assert(NA_X_OFF + 4 * NA_X_PAIR <= LDS_BYTES - 64, "natten LDS map");
__device__ __forceinline__ void natten_compute(const Frame& F, const bf16x8 (&qf)[2], bf16* Y, int b, int h, int r, int rs, bool slide, int newrow, const v4u& nk, const v4u& nv) {
    LAS unsigned char* lds = F.lds;
    const size_t tokq0 = (size_t)b * T + r * 64;
    const int fr = F.lane & 15, fq = F.lane >> 4, jq = F.wave & 3, kh = F.wave >> 2;
    const int wc0 = (jq == 0) ? 0 : (jq == 1) ? 8 : (jq == 2) ? 24 : 32;
    f32x4 s[8];
#pragma unroll
    for (int il = 0; il < 4; ++il)
#pragma unroll
        for (int ct = 0; ct < 2; ++ct) {
            const LAS unsigned char* kp = lds + NA_K_OFF + (((rs + 4 * kh + il) & 7) * 64 + wc0 + 16 * ct + fr) * NA_STR + fq * 16;
            const bf16x8 k0 = *(const LAS bf16x8*)kp, k1 = *(const LAS bf16x8*)(kp + 64);
            f32x4 a = {0.f, 0.f, 0.f, 0.f}; a = mfma16(k0, qf[0], a); a = mfma16(k1, qf[1], a); s[il * 2 + ct] = a; }
    const int cq = 16 * jq + fr, cs = min(max(cq - 8, 0), 48);
    const LAS float* rp = (const LAS float*)(lds + NA_RPB_OFF);
    float mx = -INFINITY;
#pragma unroll
    for (int il = 0; il < 4; ++il) { const int dr = rs + 4 * kh + il - r + 7;
#pragma unroll
        for (int ct = 0; ct < 2; ++ct)
#pragma unroll
            for (int e = 0; e < 4; ++e) { const int ck = wc0 + 16 * ct + 4 * fq + e; const bool in = (ck >= cs) && (ck < cs + 16);
                const int dc = min(max(ck - cq + 15, 0), 30);
                const float v = in ? s[il * 2 + ct][e] * (0.125f * 1.4426950408889634f) + rp[dr * 31 + dc] : -INFINITY; s[il * 2 + ct][e] = v; mx = fmaxf(mx, v); } }
    mx = fmaxf(mx, __shfl_xor(mx, 16)); mx = fmaxf(mx, __shfl_xor(mx, 32));
    float l = 0.f;
#pragma unroll
    for (int t = 0; t < 8; ++t)
#pragma unroll
        for (int e = 0; e < 4; ++e) { const float p = __builtin_amdgcn_exp2f(s[t][e] - mx); s[t][e] = p; l += p; }
    l += __shfl_xor(l, 16); l += __shfl_xor(l, 32);
    f32x4 o[4];
#pragma unroll
    for (int dt = 0; dt < 4; ++dt) o[dt] = (f32x4){0.f, 0.f, 0.f, 0.f};
#pragma unroll
    for (int il = 0; il < 4; ++il) { const bf16x8 pb = pack8(s[2 * il], s[2 * il + 1]);
#pragma unroll
        for (int dt = 0; dt < 4; ++dt) {
            const LAS unsigned char* vp = lds + NA_V_OFF + (((rs + 4 * kh + il) & 7) * 64 + wc0 + 4 * fq + (fr >> 2)) * NA_VSTR + (16 * dt + 4 * (fr & 3)) * 2;
            const bf16x8 x = cat8(tr4(vp), tr4(vp + 16 * NA_VSTR)); o[dt] = mfma16(x, pb, o[dt]); } }
    LAS float* xch = (LAS float*)(lds + NA_X_OFF + jq * NA_X_PAIR) + F.lane;
    if (kh == 1) {
#pragma unroll
        for (int dt = 0; dt < 4; ++dt)
#pragma unroll
            for (int e = 0; e < 4; ++e) xch[(dt * 4 + e) * 64] = o[dt][e];
        xch[16 * 64] = mx; xch[17 * 64] = l;
    }
    __syncthreads();
    if (slide) { const int col = F.tid >> 3, ch = F.tid & 7, kk = ((newrow & 7) * 64) + col; *(LAS v4u*)(lds + NA_K_OFF + kk * NA_STR + ch * 16) = nk;
        *(LAS v2u*)(lds + NA_V_OFF + kk * NA_VSTR + ch * 16) = (v2u){nv.x, nv.y}; *(LAS v2u*)(lds + NA_V_OFF + kk * NA_VSTR + ch * 16 + 8) = (v2u){nv.z, nv.w}; }
    if (kh == 0) {
        const float m1 = xch[16 * 64], l1 = xch[17 * 64], m = fmaxf(mx, m1), a0 = __builtin_amdgcn_exp2f(mx - m), a1 = __builtin_amdgcn_exp2f(m1 - m), inv = 1.0f / (a0 * l + a1 * l1), c0 = a0 * inv, c1 = a1 * inv;
#pragma unroll
        for (int dt = 0; dt < 4; ++dt) { float ov[4];
#pragma unroll
            for (int e = 0; e < 4; ++e) ov[e] = o[dt][e] * c0 + xch[(dt * 4 + e) * 64] * c1;
            v2u w; w.x = pg8::cvt_pk_bf16(ov[0], ov[1]); w.y = pg8::cvt_pk_bf16(ov[2], ov[3]);
            *(v2u*)(Y + (tokq0 + 16 * jq + fr) * D + h * 64 + 16 * dt + 4 * fq) = w; }
    }
}
__device__ __forceinline__ void natten_wg(const Frame& F, const bf16* PROJ, const float* rpb, bf16* Y, int wgi) {
    LAS unsigned char* lds = F.lds;
    const int bh = wgi >> 4, r0 = 8 * (wgi & 15), h = bh & 7, b = bh >> 3;
    const int fr = F.lane & 15, fq = F.lane >> 4, jq = F.wave & 3;
    const bf16* qbase = PROJ + ((size_t)b * T + 16 * jq + fr) * NPROJ + C_QA + h * 64 + 8 * fq;
    bf16x8 qf[2], qn[2];
    { const bf16* qp = qbase + (size_t)r0 * 64 * NPROJ; qf[0] = *(const bf16x8*)qp; qf[1] = *(const bf16x8*)(qp + 32); }
    { const int rs0 = min(max(r0 - 4, 0), 120);
#pragma unroll
      for (int it = 0; it < 8; ++it) { const int id = F.tid + NTHR * it, key = id >> 3, ch = id & 7, row = rs0 + (key >> 6), col = key & 63;
        const bf16* src = PROJ + ((size_t)b * T + row * 64 + col) * NPROJ + C_KA + h * 64 + ch * 8;
        const v4u kv = *(const v4u*)src, vv = *(const v4u*)(src + (C_VA - C_KA));
        const int kk = (row & 7) * 64 + col;
        *(LAS v4u*)(lds + NA_K_OFF + kk * NA_STR + ch * 16) = kv; *(LAS v2u*)(lds + NA_V_OFF + kk * NA_VSTR + ch * 16) = (v2u){vv.x, vv.y}; *(LAS v2u*)(lds + NA_V_OFF + kk * NA_VSTR + ch * 16 + 8) = (v2u){vv.z, vv.w}; } }
    if (F.tid < 465) ((LAS float*)(lds + NA_RPB_OFF))[F.tid] = rpb[h * 465 + F.tid] * 1.4426950408889634f;
    __syncthreads();
    for (int rr = 0; rr < 8; ++rr) {
        const int r = r0 + rr, rs = min(max(r - 4, 0), 120), rsn = min(max(r - 3, 0), 120);
        const bool more = rr < 7, slide = more && (rsn != rs);
        v4u nk = {0u, 0u, 0u, 0u}, nv = {0u, 0u, 0u, 0u};
        if (more) { const bf16* qp = qbase + (size_t)(r + 1) * 64 * NPROJ; qn[0] = *(const bf16x8*)qp; qn[1] = *(const bf16x8*)(qp + 32); }
        if (slide) { const int col = F.tid >> 3, ch = F.tid & 7; const bf16* src = PROJ + ((size_t)b * T + (rsn + 7) * 64 + col) * NPROJ + C_KA + h * 64 + ch * 8; nk = *(const v4u*)src; nv = *(const v4u*)(src + (C_VA - C_KA)); }
        natten_compute(F, qf, Y, b, h, r, rs, slide, rsn + 7, nk, nv);
        if (more) { qf[0] = qn[0]; qf[1] = qn[1]; }
        __syncthreads();
    }
}

constexpr int GL_Z = 0, GL_GU = 8192, GL_GB = 16384, GL_GT = 16896, GL_I0 = 20992;
constexpr int IS = 144, IMG = 64 * IS;
constexpr int VS = 272, VIMG = 64 * VS;
constexpr int GL_QF = GL_I0, GL_QB = GL_I0 + IMG, GL_KF = GL_I0 + 2 * IMG, GL_KB = GL_I0 + 3 * IMG, GL_V = GL_I0 + 4 * IMG, GL_SF = GL_V + VIMG, GL_SB = GL_SF + VIMG;
static_assert(GL_SB + VIMG <= LDS_BYTES, "GLA LDS map");
__device__ __forceinline__ float logsig(float x) { return fminf(x, 0.f) - __logf(1.0f + __expf(-fabsf(x))); }

__device__ __forceinline__ void gla_gate_core(const Frame& F, float (&bf)[8], float (&bb)[8], float& totf, float& totb) {
    LAS unsigned char* lds = F.lds; const int tid = F.tid, d = tid & 63, g = F.wave;
    const LAS float* Zl = (const LAS float*)(lds + GL_Z); const LAS float* GU = (const LAS float*)(lds + GL_GU); const LAS float* GB = (const LAS float*)(lds + GL_GB);
    float uf[16], ub[16];
#pragma unroll
    for (int rr = 0; rr < 16; ++rr) { uf[rr] = GU[rr * 64 + d]; ub[rr] = GU[1024 + rr * 64 + d]; }
    const float gf0 = GB[d], gb0 = GB[64 + d];
    float laf[8], lab[8];
#pragma unroll
    for (int j = 0; j < 8; ++j) { const int c = 8 * g + j; float pf = gf0, pb = gb0;
#pragma unroll
        for (int r4 = 0; r4 < 4; ++r4) { const f32x4 zf = *(const LAS f32x4*)(Zl + c * 32 + 4 * r4), zb = *(const LAS f32x4*)(Zl + c * 32 + 16 + 4 * r4);
#pragma unroll
            for (int e = 0; e < 4; ++e) { pf += zf[e] * uf[4 * r4 + e]; pb += zb[e] * ub[4 * r4 + e]; } }
        laf[j] = logsig(pf) * (1.0f / 16.0f); lab[j] = logsig(pb) * (1.0f / 16.0f); }
    float run = 0.f;
#pragma unroll
    for (int j = 0; j < 8; ++j) { run += laf[j]; bf[j] = run; }
    float runb = 0.f;
#pragma unroll
    for (int j = 7; j >= 0; --j) { runb += lab[j]; bb[j] = runb; }
    LAS float* GT = (LAS float*)(lds + GL_GT);
    GT[g * 64 + d] = run; GT[512 + g * 64 + d] = runb;
    __syncthreads();
    float of = 0.f, ob = 0.f; totf = 0.f; totb = 0.f;
#pragma unroll
    for (int gp = 0; gp < 8; ++gp) { const float a = GT[gp * 64 + d], c = GT[512 + gp * 64 + d]; totf += a; totb += c; if (gp < g) of += a; if (gp > g) ob += c; }
#pragma unroll
    for (int j = 0; j < 8; ++j) { bf[j] += of; bb[j] += ob; }
}
__device__ __forceinline__ void stage_img128(LAS unsigned char* dst, const bf16* src, size_t row_stride, int tid) {
#pragma unroll
    for (int it = 0; it < 2; ++it) { const int id = tid + NTHR * it, row = id >> 4, ch = id & 15; *(LAS v4u*)(dst + row * VS + ch * 16) = *(const v4u*)(src + (size_t)row * row_stride + ch * 8); }
}

struct GlaAFetch { unsigned short kraw[8], qraw[8]; v4u v[2]; f32x4 z, gu; float gb; };
__device__ __forceinline__ void gla_a_fetch(GlaAFetch& R, const Frame& F, const bf16* PROJ, const float* Z, const float* guf, const float* gbf, const float* gub, const float* gbb, int unit) {
    const int tid = F.tid, d = tid & 63, g = F.wave;
    const int n = unit & 127, bh = unit >> 7, h = bh & 3, b = bh >> 2; const size_t t0 = (size_t)b * T + 64 * n;
#pragma unroll
    for (int j = 0; j < 8; ++j) { const bf16* p = PROJ + (t0 + 8 * g + j) * NPROJ + h * 64 + d; R.qraw[j] = p[C_QG]; R.kraw[j] = p[C_KG]; }
#pragma unroll
    for (int it = 0; it < 2; ++it) { const int id = tid + NTHR * it, row = id >> 4, ch = id & 15; R.v[it] = *(const v4u*)(PROJ + (t0 + row) * NPROJ + C_VG + h * 128 + ch * 8); }
    R.z = *(const f32x4*)(Z + t0 * 32 + tid * 4);
    { const int idx = tid * 4, dir = idx >> 10, rr = (idx >> 6) & 15, dd = idx & 63; R.gu = *(const f32x4*)((dir ? gub : guf) + rr * 256 + h * 64 + dd); }
    R.gb = (tid < 128) ? ((tid >> 6) ? gbb : gbf)[h * 64 + (tid & 63)] : 0.f;
}
__device__ __forceinline__ void phase_gla_a(const Frame& F, const bf16* PROJ, const float* Z, const float* guf, const float* gbf, const float* gub, const float* gbb, float* CON, float* DEC, bf16* IMGS) {
    LAS unsigned char* lds = F.lds; const int tid = F.tid, d = tid & 63, g = F.wave;
    GlaAFetch R;
    int unit = F.vcu;
    if (unit < 1024) gla_a_fetch(R, F, PROJ, Z, guf, gbf, gub, gbb, unit);
    for (; unit < 1024; unit += F.G) {
        unsigned short kraw[8], qraw[8];
#pragma unroll
        for (int j = 0; j < 8; ++j) { kraw[j] = R.kraw[j]; qraw[j] = R.qraw[j]; }
#pragma unroll
        for (int it = 0; it < 2; ++it) { const int id = tid + NTHR * it, row = id >> 4, ch = id & 15; *(LAS v4u*)(lds + GL_V + row * VS + ch * 16) = R.v[it]; }
        *(LAS f32x4*)(lds + GL_Z + tid * 16) = R.z; *(LAS f32x4*)(lds + GL_GU + tid * 16) = R.gu;
        if (tid < 128) ((LAS float*)(lds + GL_GB))[tid] = R.gb;
        __syncthreads();
        if (unit + F.G < 1024) gla_a_fetch(R, F, PROJ, Z, guf, gbf, gub, gbb, unit + F.G);
        float bf[8], bb[8], totf, totb;
        gla_gate_core(F, bf, bb, totf, totb);
        const float decf = __expf(totf), decb = __expf(totb);
        bf16* im = IMGS + (size_t)unit * 16384 + d;
#pragma unroll
        for (int j = 0; j < 8; ++j) { const float k = bf2f(kraw[j]), q = bf2f(qraw[j]) * 0.125f; const int c = 8 * g + j;
            const float ef = __expf(bf[j]), eb = __expf(bb[j]), rf = 1.0f / ef, rb = 1.0f / eb, kif = k * rf, kib = k * rb;
            *(LAS unsigned short*)(lds + GL_KF + c * IS + d * 2) = (unsigned short)f2bf(kif * decf);
            *(LAS unsigned short*)(lds + GL_KB + c * IS + d * 2) = (unsigned short)f2bf(kib * decb);
            im[c * 64] = (bf16)f2bf(q * ef); im[4096 + c * 64] = (bf16)f2bf(kif); im[8192 + c * 64] = (bf16)f2bf(q * eb); im[12288 + c * 64] = (bf16)f2bf(kib); }
        if (g == 0) { DEC[(size_t)unit * 64 + d] = decf; DEC[(size_t)(1024 + unit) * 64 + d] = decb; }
        __syncthreads();
        const int fr = F.lane & 15, fq = F.lane >> 4, dir = F.wave >> 2, dt = F.wave & 3;
        const LAS unsigned char* kimg = lds + (dir ? GL_KB : GL_KF);
        bf16x8 yk[2];
#pragma unroll
        for (int s = 0; s < 2; ++s) { const LAS unsigned char* p = kimg + (32 * s + 4 * fq + (fr >> 2)) * IS + (16 * dt + 4 * (fr & 3)) * 2; yk[s] = cat8(tr4(p), tr4(p + 16 * IS)); }
        float* cbase = CON + ((size_t)(dir * 1024 + unit) * 64 + 16 * dt + fr) * 128 + 4 * fq;
#pragma unroll
        for (int et = 0; et < 8; ++et) { f32x4 acc = {0.f, 0.f, 0.f, 0.f};
#pragma unroll
            for (int s = 0; s < 2; ++s) { const LAS unsigned char* p = lds + GL_V + (32 * s + 4 * fq + (fr >> 2)) * VS + (16 * et + 4 * (fr & 3)) * 2; acc = mfma16(cat8(tr4(p), tr4(p + 16 * VS)), yk[s], acc); }
            *(f32x4*)(cbase + 16 * et) = acc; }
        __syncthreads();
    }
}

__device__ __forceinline__ void phase_scan(const Frame& F, const float* __restrict__ CON, const float* __restrict__ DEC, bf16* __restrict__ SP) {
    for (int chain = F.vcu * NTHR + F.tid; chain < 2 * 8 * 64 * 128; chain += F.G * NTHR) {
        const int e = chain & 127, d = (chain >> 7) & 63, bh = (chain >> 13) & 7, dir = chain >> 16;
        const size_t ubase = (size_t)dir * 1024 + bh * 128;
        const float* con = CON + (ubase * 64 + d) * 128 + e; const float* dec = DEC + ubase * 64 + d; bf16* sp = SP + (ubase * 64 + d) * 128 + e;
        float S = 0.f;
        for (int nb = 0; nb < 8; ++nb) { float c[16], gg[16];
#pragma unroll
            for (int u = 0; u < 16; ++u) { const int n = nb * 16 + u, ne = dir ? 127 - n : n; c[u] = con[(size_t)ne * 8192]; gg[u] = dec[ne * 64]; }
#pragma unroll
            for (int u = 0; u < 16; ++u) { const int n = nb * 16 + u, ne = dir ? 127 - n : n; sp[(size_t)ne * 8192] = (bf16)f2bf(S); S = gg[u] * S + c[u]; } }
    }
}

struct GlaCFetch { v4u im[4], v[2], sf[2], sb[2]; };
__device__ __forceinline__ void gla_c_fetch(GlaCFetch& R, const bf16* PROJ, const bf16* SP, const bf16* IMGS, int unit, int tid) {
    const int n = unit & 127, bh = unit >> 7, h = bh & 3, b = bh >> 2; const size_t t0 = (size_t)b * T + 64 * n;
#pragma unroll
    for (int k = 0; k < 4; ++k) R.im[k] = *(const v4u*)(IMGS + (size_t)unit * 16384 + k * 4096 + tid * 8);
#pragma unroll
    for (int it = 0; it < 2; ++it) { const int id = tid + NTHR * it, row = id >> 4, ch = id & 15;
        R.v[it] = *(const v4u*)(PROJ + (t0 + row) * NPROJ + C_VG + h * 128 + ch * 8);
        R.sf[it] = *(const v4u*)(SP + (size_t)unit * 8192 + row * 128 + ch * 8);
        R.sb[it] = *(const v4u*)(SP + (size_t)(1024 + unit) * 8192 + row * 128 + ch * 8); }
}
__device__ __forceinline__ void gla_c_commit(const GlaCFetch& R, LAS unsigned char* lds, int tid) {
    { const int row = tid >> 3, ch = tid & 7, o = row * IS + ch * 16;
      *(LAS v4u*)(lds + GL_QF + o) = R.im[0]; *(LAS v4u*)(lds + GL_KF + o) = R.im[1]; *(LAS v4u*)(lds + GL_QB + o) = R.im[2]; *(LAS v4u*)(lds + GL_KB + o) = R.im[3]; }
#pragma unroll
    for (int it = 0; it < 2; ++it) { const int id = tid + NTHR * it, row = id >> 4, ch = id & 15, o = row * VS + ch * 16;
        *(LAS v4u*)(lds + GL_V + o) = R.v[it]; *(LAS v4u*)(lds + GL_SF + o) = R.sf[it]; *(LAS v4u*)(lds + GL_SB + o) = R.sb[it]; }
}
constexpr int GL_SSX = 110592;
static_assert(GL_SSX >= GL_SB + VIMG && GL_SSX + 512 <= LDS_BYTES - 64, "GLA-c exchange words");
__device__ __forceinline__ void gla_c_compute(const Frame& F, const bf16* PROJ, const float* norm_g, bf16* Y, int unit) {
    LAS unsigned char* lds = F.lds;
    const int n = unit & 127, bh = unit >> 7, h = bh & 3, b = bh >> 2; const size_t t0 = (size_t)b * T + 64 * n;
    const int fr = F.lane & 15, fq = F.lane >> 4, it = F.wave & 3, eh = F.wave >> 2;
    const int i = 16 * it + fr;
    const bf16* rp = PROJ + (t0 + i) * NPROJ + C_RG + h * 128 + 64 * eh + 4 * fq; bf16* yp = Y + (t0 + i) * D + 512 + h * 128 + 64 * eh + 4 * fq;
    v2u rw[4];
#pragma unroll
    for (int el = 0; el < 4; ++el) rw[el] = *(const v2u*)(rp + 16 * el);
    bf16x8 yqf[2], yqb[2];
#pragma unroll
    for (int s = 0; s < 2; ++s) { const int off = (16 * it + fr) * IS + (32 * s + 8 * fq) * 2; yqf[s] = *(const LAS bf16x8*)(lds + GL_QF + off); yqb[s] = *(const LAS bf16x8*)(lds + GL_QB + off); }
    f32x4 a[4];
#pragma unroll
    for (int jt = 0; jt < 4; ++jt) { f32x4 af = {0.f, 0.f, 0.f, 0.f}, ab = {0.f, 0.f, 0.f, 0.f};
#pragma unroll
        for (int s = 0; s < 2; ++s) { const int off = (16 * jt + fr) * IS + (32 * s + 8 * fq) * 2;
            af = mfma16(*(const LAS bf16x8*)(lds + GL_KF + off), yqf[s], af); ab = mfma16(*(const LAS bf16x8*)(lds + GL_KB + off), yqb[s], ab); }
#pragma unroll
        for (int e = 0; e < 4; ++e) { const int j = 16 * jt + 4 * fq + e; a[jt][e] = (j <= i) ? af[e] : ab[e]; } }
    f32x4 o[4];
#pragma unroll
    for (int el = 0; el < 4; ++el) o[el] = (f32x4){0.f, 0.f, 0.f, 0.f};
#pragma unroll
    for (int s = 0; s < 2; ++s) { const bf16x8 pb = pack8(a[2 * s], a[2 * s + 1]);
#pragma unroll
        for (int el = 0; el < 4; ++el) { const LAS unsigned char* p = lds + GL_V + (32 * s + 4 * fq + (fr >> 2)) * VS + (16 * (4 * eh + el) + 4 * (fr & 3)) * 2; o[el] = mfma16(cat8(tr4(p), tr4(p + 16 * VS)), pb, o[el]); } }
#pragma unroll
    for (int s = 0; s < 2; ++s)
#pragma unroll
        for (int el = 0; el < 4; ++el) { const int off = (32 * s + 8 * fq + (fr >> 2)) * VS + (16 * (4 * eh + el) + 4 * (fr & 3)) * 2;
            o[el] = mfma16(cat8(tr4(lds + GL_SF + off), tr4(lds + GL_SF + off + 4 * VS)), yqf[s], o[el]);
            o[el] = mfma16(cat8(tr4(lds + GL_SB + off), tr4(lds + GL_SB + off + 4 * VS)), yqb[s], o[el]); }
    float ss = 0.f;
#pragma unroll
    for (int el = 0; el < 4; ++el) ss += (o[el][0] * o[el][0] + o[el][1] * o[el][1]) + (o[el][2] * o[el][2] + o[el][3] * o[el][3]);
    ss += __shfl_xor(ss, 16); ss += __shfl_xor(ss, 32);
    LAS float* ssx = (LAS float*)(lds + GL_SSX);
    if (fq == 0) ssx[eh * 64 + i] = ss;
    __syncthreads();
    ss += ssx[(1 - eh) * 64 + i];
    const float rs = 1.0f / sqrtf(ss * (1.0f / 128.0f) + EPS);
#pragma unroll
    for (int el = 0; el < 4; ++el) { const f32x4 gn = *(const f32x4*)(norm_g + 64 * eh + 16 * el + 4 * fq);
        float rv[4] = {__builtin_bit_cast(float, rw[el].x << 16), __builtin_bit_cast(float, rw[el].x & 0xffff0000u), __builtin_bit_cast(float, rw[el].y << 16), __builtin_bit_cast(float, rw[el].y & 0xffff0000u)};
        float ov[4];
#pragma unroll
        for (int e = 0; e < 4; ++e) { const float sg = rv[e] / (1.0f + __expf(-rv[e])); ov[e] = o[el][e] * rs * gn[e] * sg; }
        v2u w; w.x = pg8::cvt_pk_bf16(ov[0], ov[1]); w.y = pg8::cvt_pk_bf16(ov[2], ov[3]); *(v2u*)(yp + 16 * el) = w; }
}
__device__ __forceinline__ void phase_gla_c(const Frame& F, const bf16* PROJ, const bf16* SP, const bf16* IMGS, const float* norm_g, bf16* Y) {
    GlaCFetch R;
    int u = F.vcu;
    if (u < 1024) gla_c_fetch(R, PROJ, SP, IMGS, u, F.tid);
    for (; u < 1024; u += F.G) {
        gla_c_commit(R, F.lds, F.tid);
        __syncthreads();
        if (u + F.G < 1024) gla_c_fetch(R, PROJ, SP, IMGS, u + F.G, F.tid);
        gla_c_compute(F, PROJ, norm_g, Y, u);
        __syncthreads();
    }
}

__device__ __forceinline__ void phase_final(const Frame& F, float* out, const float* ss, const float* g) {
    const int gw = F.vcu * NWAVES + F.wave, NGW = F.G * NWAVES;
    f32x4 gv[4];
#pragma unroll
    for (int j = 0; j < 4; ++j) gv[j] = ((const f32x4*)g)[F.lane + 64 * j];
    for (int m = gw; m < M; m += NGW) { f32x4* xr = (f32x4*)(out + (size_t)m * D) + F.lane; const float rs = 1.0f / sqrtf(ss[m] * (1.f / D) + EPS);
#pragma unroll
        for (int j = 0; j < 4; ++j) xr[64 * j] = xr[64 * j] * rs * gv[j]; }
}

#define XB_TMO      128
#define XB_XCNT(j)  (256  + 64 * (j))
#define XB_XSUB(j)  (1280 + 64 * (j))
#define XB_XGEN(j)  (2304 + 64 * (j))
#define XB_TOP      3328
#define XB_TOPGEN   3392
#define XCD_BAR_WORDS 3456
#define XB_SPIN_CAP (1u << 18)

__device__ __forceinline__ unsigned xb_ld(unsigned* p)              { return __hip_atomic_load(p, __ATOMIC_RELAXED, __HIP_MEMORY_SCOPE_AGENT); }
__device__ __forceinline__ unsigned xb_add(unsigned* p, unsigned v) { return __hip_atomic_fetch_add(p, v, __ATOMIC_RELAXED, __HIP_MEMORY_SCOPE_AGENT); }
__device__ __forceinline__ unsigned xb_xcc_id() { return (unsigned)__builtin_amdgcn_s_getreg((3 << 11) | 20) & 0xFu; }
#define XB_SPIN(cond, bar) do { unsigned _sp = 0; while (cond) { __builtin_amdgcn_s_sleep(1); \
    if ((++_sp & 255u) == 0u) { if (xb_ld(&(bar)[XB_TMO])) break; if (_sp > XB_SPIN_CAP) { atomicAdd(&(bar)[XB_TMO], 1u); break; } } } } while (0)

struct XcdBarrier {
    unsigned* bar; unsigned x;
    volatile LAS unsigned* st;
};

__device__ __forceinline__ XcdBarrier xcd_barrier_post(unsigned* bar, volatile LAS unsigned* st) {
    XcdBarrier b; b.bar = bar; b.x = xb_xcc_id(); b.st = st;
    if (threadIdx.x == 0) (void)xb_add(&bar[XB_XCNT(b.x)], 1u);
    return b;
}
__device__ __forceinline__ void xcd_barrier_complete(unsigned* bar, unsigned x, unsigned& nloc, unsigned& nx) {
    const unsigned G = gridDim.x * gridDim.y * gridDim.z;
    unsigned sum, cnt, mine, sp = 0u;
    for (;;) {
        sum = 0u; cnt = 0u; mine = 0u;
#pragma unroll
        for (unsigned j = 0; j < 16; ++j) { const unsigned c = xb_ld(&bar[XB_XCNT(j)]); sum += c; cnt += (c > 0u) ? 1u : 0u; mine = (j == x) ? c : mine; }
        if (sum == G) break;
        __builtin_amdgcn_s_sleep(1);
        if ((++sp & 255u) == 0u) { if (xb_ld(&bar[XB_TMO])) break; if (sp > XB_SPIN_CAP) { atomicAdd(&bar[XB_TMO], 1u); break; } }
    }
    nloc = mine > 0u ? mine : 1u; nx = cnt > 0u ? cnt : 1u;
}

__device__ __forceinline__ void xcd_barrier(const XcdBarrier& b) {
    asm volatile("s_waitcnt vmcnt(0)" ::: "memory");
    __syncthreads();
    if (threadIdx.x == 0) {
        unsigned* bar = b.bar;
        __builtin_amdgcn_s_waitcnt(0);
        unsigned nloc = b.st[0], nx = b.st[1];
        if (nloc == 0u) { xcd_barrier_complete(bar, b.x, nloc, nx); b.st[0] = nloc; b.st[1] = nx; }
        const unsigned old = xb_add(&bar[XB_XSUB(b.x)], 1u);
        const unsigned gen = old / nloc;
        if (old + 1u == (gen + 1u) * nloc) {
            __builtin_amdgcn_fence(__ATOMIC_RELEASE, "agent");
            asm volatile("s_waitcnt vmcnt(0)" ::: "memory");
            const unsigned og = xb_add(&bar[XB_TOP], 1u);
            const unsigned tg = og / nx;
            if (og + 1u == (tg + 1u) * nx) xb_add(&bar[XB_TOPGEN], 1u);
            else XB_SPIN(xb_ld(&bar[XB_TOPGEN]) == tg, bar);
            __builtin_amdgcn_fence(__ATOMIC_ACQUIRE, "agent");
            xb_add(&bar[XB_XGEN(b.x)], 1u);
            asm volatile("s_waitcnt vmcnt(0)" ::: "memory");
        } else {
            XB_SPIN(xb_ld(&bar[XB_XGEN(b.x)]) == gen, bar);
            __builtin_amdgcn_fence(__ATOMIC_ACQUIRE, "agent");
            asm volatile("s_waitcnt vmcnt(0)" ::: "memory");
        }
    }
    __syncthreads();
}
#ifndef MK_DUP
#define MK_DUP 0
#endif
struct Args { const float* in[14]; float* out; unsigned char* ws; int lo, hi; };
constexpr int NPHASE = 9;
__global__ void __launch_bounds__(NTHR, 2) mk_fwd(Args a) {
    extern __shared__ __attribute__((aligned(16))) unsigned char lds_raw[];
    Frame F; F.lds = (LAS unsigned char*)lds_raw; F.tid = threadIdx.x; F.lane = F.tid & 63; F.wave = __builtin_amdgcn_readfirstlane(F.tid >> 6);
    F.G = gridDim.x; { const int bx = blockIdx.x; F.vcu = (F.G % 8 == 0) ? (bx % 8) * (F.G / 8) + bx / 8 : bx; }
    unsigned char* ws = a.ws;
    const float* x = a.in[0];
    bf16* XN = (bf16*)(ws + WS_XN); bf16* Yb = (bf16*)(ws + WS_Y); bf16* PROJ = (bf16*)(ws + WS_PROJ); bf16* HB = (bf16*)(ws + WS_HB); bf16* ACT = (bf16*)(ws + WS_ACT);
    float* Z = (float*)(ws + WS_Z); float* CON = (float*)(ws + WS_CON); float* DEC = (float*)(ws + WS_DEC); bf16* SP = (bf16*)(ws + WS_SP);
    float* SS2 = (float*)(ws + WS_SS2); float* SS3 = (float*)(ws + WS_SS3);
    const int lo = a.lo, hi = a.hi;
#define IN(k) (lo <= (k) && (k) < hi)
#define SEAM(k) do { if (IN(k) && IN((k) + 1)) xcd_barrier(bar); } while (0)
    volatile LAS unsigned* MISC = (volatile LAS unsigned*)(F.lds + LDS_BYTES - 64);
    if (F.tid < 16) MISC[F.tid] = 0u;
    __syncthreads();
    unsigned* barw = (unsigned*)(ws + WS_BAR);
    if (a.lo < 0) cg::this_grid().sync();
    XcdBarrier bar; bar.bar = barw; bar.x = 0; bar.st = nullptr;
    if (hi - lo > 1) bar = xcd_barrier_post(barw, MISC + 8);
    for (int rep_ = 0; rep_ < 1 + (MK_DUP & 1); ++rep_) if (IN(0)) phase_prologue(F, x, a.in[1], a.in[2], a.in[9], a.in[10], a.in[11], a.in[12], ws);
    SEAM(0);
    if (IN(1)) {
        pg8::Gemm g{XN, (const bf16*)(ws + WS_WIN), M, NPROJ, D}; pg8::StaticOrder S; S.init(M, NPROJ, F.G, (int)blockIdx.x);
        pg8::EpiProj E{PROJ, NPROJ};
        pg8::gemm_phase<pg8::EpiProj, pg8::StaticOrder, true, true>(F.lds, g, S, E);
        phase_z(F, XN, (const bf16*)(ws + WS_WIN) + (size_t)NPROJ * D, Z);
    }
#if (MK_DUP >> 1) & 1
    if (IN(1)) {
        pg8::Gemm g{XN, (const bf16*)(ws + WS_WIN), M, NPROJ, D}; pg8::StaticOrder S; S.init(M, NPROJ, F.G, (int)blockIdx.x);
        pg8::EpiProj E{PROJ, NPROJ};
        pg8::gemm_phase<pg8::EpiProj, pg8::StaticOrder, true, true>(F.lds, g, S, E);
        phase_z(F, XN, (const bf16*)(ws + WS_WIN) + (size_t)NPROJ * D, Z);
    }
#endif
    SEAM(1);
    for (int rep_ = 0; rep_ < 1 + ((MK_DUP >> 2) & 1); ++rep_) if (IN(2)) {
        for (int rep2_ = 0; rep2_ < 1 + ((MK_DUP >> 9) & 1); ++rep2_)
        phase_gla_a(F, PROJ, Z, a.in[4], a.in[5], a.in[6], a.in[7], CON, DEC, (bf16*)a.out);
        for (int rep2_ = 0; rep2_ < 1 + ((MK_DUP >> 10) & 1); ++rep2_)
        for (int w = F.vcu; w < 256; w += F.G) natten_wg(F, PROJ, a.in[3], Yb, w);
    }
    SEAM(2);
    for (int rep_ = 0; rep_ < 1 + ((MK_DUP >> 3) & 1); ++rep_) if (IN(3)) phase_scan(F, CON, DEC, SP);
    SEAM(3);
    for (int rep_ = 0; rep_ < 1 + ((MK_DUP >> 4) & 1); ++rep_) if (IN(4)) phase_gla_c(F, PROJ, SP, (const bf16*)a.out, a.in[8], Yb);
    SEAM(4);
    if (IN(5)) {
        pg8::Gemm g{Yb, (const bf16*)(ws + WS_WO), M, D, D}; pg8::StaticOrder S; S.init(M, D, F.G, (int)blockIdx.x);
#if (MK_DUP >> 5) & 1
        { pg8::EpiResB E0{x, HB, (float*)(ws + WS_DEC), D}; pg8::gemm_phase<pg8::EpiResB, pg8::StaticOrder, false, true>(F.lds, g, S, E0); }
#endif
        pg8::EpiResB E{x, HB, SS2, D};
        pg8::gemm_phase<pg8::EpiResB, pg8::StaticOrder, true, true>(F.lds, g, S, E);
    }
    SEAM(5);
    if (IN(6)) {
        pg8::Gemm g{HB, (const bf16*)(ws + WS_W1), M, FF, D}; pg8::StaticOrder S; S.init(M, FF, F.G, (int)blockIdx.x);
        pg8::EpiFF1 E{ACT, FF, SS2, 1.0f / D, EPS};
        pg8::gemm_phase<pg8::EpiFF1, pg8::StaticOrder, true, true>(F.lds, g, S, E);
    }
#if (MK_DUP >> 6) & 1
    if (IN(6)) {
        pg8::Gemm g{HB, (const bf16*)(ws + WS_W1), M, FF, D}; pg8::StaticOrder S; S.init(M, FF, F.G, (int)blockIdx.x);
        pg8::EpiFF1 E{ACT, FF, SS2, 1.0f / D, EPS};
        pg8::gemm_phase<pg8::EpiFF1, pg8::StaticOrder, true, true>(F.lds, g, S, E);
    }
#endif
    SEAM(6);
#if (MK_DUP >> 11) & 1
    for (int k_ = 0; k_ < 8; ++k_) xcd_barrier(bar);
#endif
    if (IN(7)) {
        pg8::Gemm g{ACT, (const bf16*)(ws + WS_W2), M, D, FF}; pg8::StaticOrder S; S.init(M, D, F.G, (int)blockIdx.x);
        const int fuse = (F.G == 256 && hi - lo > 1) ? 1 : 0;
#if (MK_DUP >> 7) & 1
        { pg8::EpiResNormB E0{HB, a.out, (float*)(ws + WS_DEC), (unsigned*)(ws + WS_PCNT), a.in[13], D, 0, 8u * (D / 256), 1.0f / D, EPS}; pg8::gemm_phase<pg8::EpiResNormB, pg8::StaticOrder, false, true>(F.lds, g, S, E0); }
#endif
        pg8::EpiResNormB E{HB, a.out, SS3, (unsigned*)(ws + WS_PCNT), a.in[13], D, fuse, 8u * (D / 256), 1.0f / D, EPS};
        pg8::gemm_phase<pg8::EpiResNormB, pg8::StaticOrder, false, true>(F.lds, g, S, E);
    }
    if (!(F.G == 256 && hi - lo > 1)) {
        SEAM(7);
        if (IN(8)) phase_final(F, a.out, SS3, a.in[13]);
    }
#undef IN
#undef SEAM
}

#ifndef MK_ONE_LAUNCH
#define MK_ONE_LAUNCH 1
#endif
extern "C" void kernel_launch(void* const* d_in, const int* in_sizes, int n_in, void* d_out, int out_size, void* d_ws, size_t ws_size, hipStream_t stream) {
    static int grid = 0;
    if (grid == 0) {
        if (n_in != 14 || out_size != M * D || ws_size < WS_END) { fprintf(stderr, "kernel_launch: unexpected shapes (n_in %d out %d ws %zu)\n", n_in, out_size, ws_size); grid = -1; return; }
        int dev = 0, cus = 0, per_cu = 0;
        hipGetDevice(&dev); hipDeviceGetAttribute(&cus, hipDeviceAttributeMultiprocessorCount, dev);
        if (hipFuncSetAttribute((const void*)mk_fwd, hipFuncAttributeMaxDynamicSharedMemorySize, LDS_BYTES) != hipSuccess) { fprintf(stderr, "kernel_launch: hipFuncSetAttribute failed\n"); grid = -1; return; }
        if (hipOccupancyMaxActiveBlocksPerMultiprocessor(&per_cu, (const void*)mk_fwd, NTHR, LDS_BYTES) != hipSuccess || per_cu < 1) { fprintf(stderr, "kernel_launch: occupancy query says %d\n", per_cu); per_cu = 1; }
        (void)hipGetLastError();
        grid = cus * 1;
    }
    if (grid < 0) return;
    Args a{};
    for (int i = 0; i < 14; ++i) a.in[i] = (const float*)d_in[i];
    a.out = (float*)d_out; a.ws = (unsigned char*)d_ws;
#if MK_ONE_LAUNCH
    if (hipMemsetAsync((char*)d_ws + WS_BAR, 0, WS_ZERO_BYTES, stream) != hipSuccess) { fprintf(stderr, "kernel_launch: memset of the barrier words failed\n"); return; }
    a.lo = 0; a.hi = NPHASE;
    void* args[] = {&a};
    hipError_t e = hipLaunchCooperativeKernel((const void*)mk_fwd, dim3(grid), dim3(NTHR), args, LDS_BYTES, stream);
    if (e != hipSuccess) fprintf(stderr, "cooperative launch failed: %s (grid %d)\n", hipGetErrorString(e), grid);
#else
    for (int p = 0; p < NPHASE; ++p) { a.lo = p; a.hi = p + 1; hipLaunchKernelGGL(mk_fwd, dim3(grid), dim3(NTHR), LDS_BYTES, stream, a); }
#endif
}
```
